# Optimizing an MI355X kernel written in HIP

```python
import math
import jax, jax.numpy as jnp
from jax import lax
import numpy as np

D_MODEL = 2048
BATCH = 4
SEQ = 4096
DEPTH = 4
DEC_BATCH = 1
DEC_SEQ = 8192
PAST_LEN = 128

N_MEM = 256
MLA_HEADS = 8
QK_NOPE = 128
QK_ROPE = 64
V_DIM = 128
Q_LORA = 512
KV_LORA = 512
ROPE_THETA = 10000.0
Q_BLOCK = 128
WIN_HEADS = 8
WIN_KV_HEADS = 2
WIN_HD = 128
WINDOW = 128
BLOCK = 128
MEM_HEADS = 4
MEM_HD = 256
D_FF = 4 * D_MODEL
N_BRANCH = 3
EPS = 1e-6

MLA_WIDTH = MLA_HEADS * V_DIM
WIN_WIDTH = WIN_HEADS * WIN_HD
MEM_WIDTH = MEM_HEADS * MEM_HD
IN_SPLITS = (Q_LORA, KV_LORA, QK_ROPE, WIN_HEADS * WIN_HD, WIN_KV_HEADS * WIN_HD,
             WIN_KV_HEADS * WIN_HD, MEM_HEADS * MEM_HD, N_BRANCH * D_MODEL)
D_IN = sum(IN_SPLITS)

kernel_name = "hybrid_mla_window_memory_encoder"


def rmsnorm(x, g):
    xf = x.astype(jnp.float32)
    r = lax.rsqrt(jnp.mean(xf * xf, axis=-1, keepdims=True) + EPS)
    return (xf * r).astype(x.dtype) * g


def rope_tables(S):
    inv = 1.0 / (ROPE_THETA ** (jnp.arange(0, QK_ROPE, 2, dtype=jnp.float32) / QK_ROPE))
    ang = jnp.arange(S, dtype=jnp.float32)[:, None] * inv[None, :]
    return jnp.cos(ang), jnp.sin(ang)


def apply_rope(x, cos, sin):
    x1, x2 = jnp.split(x.astype(jnp.float32), 2, axis=-1)
    return jnp.concatenate([x1 * cos - x2 * sin, x1 * sin + x2 * cos], axis=-1).astype(x.dtype)


def alibi_slopes(n):
    return jnp.asarray(np.array([2.0 ** (-8.0 * (h + 1) / n) for h in range(n)]), dtype=jnp.float32)


def mla_attention(c_q, c_kv, k_rope, g_q, g_kv, w_uq, w_ukv):
    B, S, _ = c_q.shape
    H = MLA_HEADS
    q = (rmsnorm(c_q, g_q) @ w_uq).reshape(B, S, H, QK_NOPE + QK_ROPE)
    kv = (rmsnorm(c_kv, g_kv) @ w_ukv).reshape(B, S, H, QK_NOPE + V_DIM)
    cos, sin = rope_tables(S)
    q_nope = q[..., :QK_NOPE]
    q_rope = apply_rope(q[..., QK_NOPE:], cos[:, None, :], sin[:, None, :])
    k_nope, v = kv[..., :QK_NOPE], kv[..., QK_NOPE:]
    k_rope = apply_rope(k_rope, cos, sin)
    scale = (QK_NOPE + QK_ROPE) ** -0.5
    nb = S // Q_BLOCK
    qn_b = q_nope.reshape(B, nb, Q_BLOCK, H, QK_NOPE).transpose(1, 0, 2, 3, 4)
    qr_b = q_rope.reshape(B, nb, Q_BLOCK, H, QK_ROPE).transpose(1, 0, 2, 3, 4)

    def block(args):
        qn, qr = args
        s = jnp.einsum('bqhd,bkhd->bhqk', qn, k_nope) + jnp.einsum('bqhr,bkr->bhqk', qr, k_rope)
        p = jax.nn.softmax(s.astype(jnp.float32) * scale, axis=-1).astype(v.dtype)
        return jnp.einsum('bhqk,bkhd->bqhd', p, v)

    o = lax.map(block, (qn_b, qr_b))
    return o.transpose(1, 0, 2, 3, 4).reshape(B, S, MLA_WIDTH)


def window_attention(q, k, v, sink):
    B, S, _ = q.shape
    nb = S // BLOCK
    KV = WIN_KV_HEADS
    G = WIN_HEADS // WIN_KV_HEADS
    qb = q.reshape(B, nb, BLOCK, KV, G, WIN_HD)

    def band(t):
        t = t.reshape(B, S, KV, WIN_HD)
        tp = jnp.pad(t, ((0, 0), (BLOCK, BLOCK), (0, 0), (0, 0))).reshape(B, nb + 2, BLOCK, KV, WIN_HD)
        return jnp.concatenate([tp[:, :-2], tp[:, 1:-1], tp[:, 2:]], axis=2)

    kb, vb = band(k), band(v)
    s = jnp.einsum('bnqkgd,bnjkd->bnkgqj', qb, kb).astype(jnp.float32) * (WIN_HD ** -0.5)
    blk = jnp.arange(nb)[:, None, None] * BLOCK
    qpos = blk + jnp.arange(BLOCK)[None, :, None]
    kpos = blk - BLOCK + jnp.arange(3 * BLOCK)[None, None, :]
    dist = jnp.abs(qpos - kpos)
    valid = (dist <= WINDOW) & (kpos >= 0) & (kpos < S)
    slopes = alibi_slopes(WIN_HEADS).reshape(KV, G)
    bias = -slopes[None, :, :, None, None] * dist.astype(jnp.float32)[:, None, None]
    s = jnp.where(valid[:, None, None], s + bias, -jnp.inf)
    sink_l = sink.astype(jnp.float32).reshape(KV, G)[None, None, :, :, None, None]
    m = jnp.maximum(jnp.max(s, axis=-1, keepdims=True), sink_l)
    e = jnp.exp(s - m)
    p = e / (jnp.sum(e, axis=-1, keepdims=True) + jnp.exp(sink_l - m))
    o = jnp.einsum('bnkgqj,bnjkd->bnqkgd', p.astype(v.dtype), vb)
    return o.reshape(B, S, WIN_WIDTH)


def memory_attention(q, mem_kv):
    B, S, _ = q.shape
    M = mem_kv.shape[1]
    q = q.reshape(B, S, MEM_HEADS, MEM_HD)
    k, v = jnp.split(mem_kv, 2, axis=-1)
    k = k.reshape(B, M, MEM_HEADS, MEM_HD)
    v = v.reshape(B, M, MEM_HEADS, MEM_HD)
    s = jnp.einsum('bshd,bmhd->bhsm', q, k).astype(jnp.float32) * (MEM_HD ** -0.5)
    p = jax.nn.softmax(s, axis=-1).astype(v.dtype)
    return jnp.einsum('bhsm,bmhd->bshd', p, v).reshape(B, S, MEM_WIDTH)


def encoder_layer(x, mem, g_attn_pre, g_attn_post, w_in, g_q_lat, g_kv_lat, w_uq, w_ukv,
                  g_mem, w_mem_kv, sink_logit, w_branch_mla, w_branch_win, w_branch_mem, w_out,
                  g_ffn_pre, g_ffn_post, w_ff_up, w_ff_down):
    h = rmsnorm(x, g_attn_pre)
    z = h @ w_in
    split_points = np.cumsum(np.array(IN_SPLITS))[:-1].tolist()
    c_q, c_kv, k_rope, q_w, k_w, v_w, q_m, gates = jnp.split(z, split_points, axis=-1)
    a = mla_attention(c_q, c_kv, k_rope, g_q_lat, g_kv_lat, w_uq, w_ukv)
    b = window_attention(q_w, k_w, v_w, sink_logit)
    c = memory_attention(q_m, rmsnorm(mem, g_mem) @ w_mem_kv)
    g_a, g_b, g_c = jnp.split(jax.nn.sigmoid(gates), N_BRANCH, axis=-1)
    merged = g_a * (a @ w_branch_mla) + g_b * (b @ w_branch_win) + g_c * (c @ w_branch_mem)
    x = x + rmsnorm(merged @ w_out, g_attn_post)
    h = rmsnorm(x, g_ffn_pre)
    u = jnp.square(jax.nn.relu(h @ w_ff_up))
    return x + rmsnorm(u @ w_ff_down, g_ffn_post)


def setup_inputs(seed: int = 0) -> dict:
    key = jax.random.key(seed)
    ks = jax.random.split(key, 24)
    f32 = jnp.float32

    def w(k, shape, fan_in):
        return jax.random.normal(k, shape, f32) * (fan_in ** -0.5)

    def gain(k, shape):
        return 1.0 + 0.01 * jax.random.normal(k, shape, f32)

    L = DEPTH
    return {
        "x_prompt": jax.random.normal(ks[0], (BATCH, SEQ, D_MODEL), f32),
        "x_sample": jax.random.normal(ks[1], (DEC_BATCH, DEC_SEQ, D_MODEL), f32),
        "mem_prompt": jax.random.normal(ks[2], (BATCH, N_MEM, D_MODEL), f32),
        "mem_sample": jax.random.normal(ks[3], (DEC_BATCH, N_MEM, D_MODEL), f32),
        "g_attn_pre": gain(ks[4], (L, D_MODEL)),
        "g_attn_post": gain(ks[5], (L, D_MODEL)),
        "w_in": w(ks[6], (L, D_MODEL, D_IN), D_MODEL),
        "g_q_lat": gain(ks[7], (L, Q_LORA)),
        "g_kv_lat": gain(ks[8], (L, KV_LORA)),
        "w_uq": w(ks[9], (L, Q_LORA, MLA_HEADS * (QK_NOPE + QK_ROPE)), Q_LORA),
        "w_ukv": w(ks[10], (L, KV_LORA, MLA_HEADS * (QK_NOPE + V_DIM)), KV_LORA),
        "g_mem": gain(ks[11], (L, D_MODEL)),
        "w_mem_kv": w(ks[12], (L, D_MODEL, 2 * MEM_WIDTH), D_MODEL),
        "sink_logit": 0.5 * jax.random.normal(ks[13], (L, WIN_HEADS), f32),
        "w_branch_mla": w(ks[14], (L, MLA_WIDTH, D_MODEL), MLA_WIDTH),
        "w_branch_win": w(ks[15], (L, WIN_WIDTH, D_MODEL), WIN_WIDTH),
        "w_branch_mem": w(ks[16], (L, MEM_WIDTH, D_MODEL), MEM_WIDTH),
        "w_out": w(ks[17], (L, D_MODEL, D_MODEL), D_MODEL),
        "g_ffn_pre": gain(ks[18], (L, D_MODEL)),
        "g_ffn_post": gain(ks[19], (L, D_MODEL)),
        "w_ff_up": w(ks[20], (L, D_MODEL, D_FF), D_MODEL),
        "w_ff_down": w(ks[21], (L, D_FF, D_MODEL), D_FF),
    }


def reference(x_prompt, x_sample, mem_prompt, mem_sample,
              g_attn_pre, g_attn_post, w_in, g_q_lat, g_kv_lat, w_uq, w_ukv,
              g_mem, w_mem_kv, sink_logit, w_branch_mla, w_branch_win, w_branch_mem, w_out,
              g_ffn_pre, g_ffn_post, w_ff_up, w_ff_down):
    def run(x, mem):
        for l in range(DEPTH):
            x = encoder_layer(x, mem, g_attn_pre[l], g_attn_post[l], w_in[l], g_q_lat[l], g_kv_lat[l],
                              w_uq[l], w_ukv[l], g_mem[l], w_mem_kv[l], sink_logit[l],
                              w_branch_mla[l], w_branch_win[l], w_branch_mem[l], w_out[l],
                              g_ffn_pre[l], g_ffn_post[l], w_ff_up[l], w_ff_down[l])
        return x

    y_prompt = run(x_prompt, mem_prompt)
    y_sample = run(x_sample, mem_sample)
    return (y_prompt, y_sample)
```

```cpp
#include <hip/hip_runtime.h>
#include <cstdio>
#include <cstdint>

#define DBG_LAST -1
#define DBG_DUMP_MASK 0x6

#ifndef MK_N_LAUNCHES
#define MK_N_LAUNCHES 1
#endif

constexpr int DM = 2048, NTOK = 24576, NPROMPT = 16384, DEPTH = 4, DFF = 8192;
constexpr int NZ = 9984, NZSRC = 9792;
constexpr int ZC_CQ = 0, ZC_CKV = 512, ZC_QW = 1024, ZC_KW = 2048, ZC_VW = 2304, ZC_QM = 2560, ZC_KR = 3584, ZC_G = 3840;
constexpr int NQC = 1536, NKVC = 2048, NMEMR = 1280, NABC = 3072;
constexpr float EPS = 1e-6f;
constexpr float LOG2E = 1.4426950408889634f;
constexpr float C_W = 0.088388347648318440f * LOG2E;
constexpr float C_M = 0.0625f * LOG2E;
constexpr float C_Q = 0.072168783648703220f * LOG2E;

constexpr size_t MiB = 1u << 20;
constexpr size_t WS_CTL = 0, CTL_ZERO_BYTES = 1 * MiB;
constexpr size_t WS_TAB = 2 * MiB;
constexpr size_t WS_RMEM = 4 * MiB;
constexpr size_t WS_SSQ = 6 * MiB;
constexpr size_t WS_MEMB = 8 * MiB;
constexpr size_t WS_MEMK = 13 * MiB;
constexpr size_t WS_MEMVT = 16 * MiB;
constexpr size_t WS_W = 32 * MiB;
constexpr size_t WO_IN = 0, WO_UQ = WO_IN + (size_t)NZ * DM * 2, WO_UKV = WO_UQ + (size_t)NQC * 512 * 2, WO_MEM = WO_UKV + (size_t)NKVC * 512 * 2,
                 WO_BR = WO_MEM + (size_t)2048 * DM * 2, WO_OUT = WO_BR + (size_t)DM * NABC * 2, WO_UP = WO_OUT + (size_t)DM * DM * 2,
                 WO_DOWN = WO_UP + (size_t)DFF * DM * 2, WO_END = WO_DOWN + (size_t)DM * DFF * 2;
static_assert(WO_END <= 136 * MiB, "weights region");
constexpr size_t WS_XN = 168 * MiB;
constexpr size_t WS_Z = 264 * MiB;
constexpr size_t WS_U = WS_Z;
constexpr size_t WS_Q = 732 * MiB;
constexpr size_t WS_KV = 804 * MiB;
constexpr size_t WS_PM = 900 * MiB;
constexpr size_t WS_ABC = 948 * MiB;
constexpr size_t WS_MERGED = 732 * MiB;
constexpr size_t WS_Y = 828 * MiB;
constexpr size_t WS_END = 1092 * MiB;
static_assert(WS_Z + (size_t)NTOK * NZ * 2 <= WS_Q && WS_MERGED + (size_t)NTOK * DM * 2 <= WS_Y && WS_Y + (size_t)NTOK * DM * 2 <= WS_ABC, "ws map");
constexpr int CW_TMO = 0, CW_BAR = 4096;

constexpr int RING_OFF = 0, RING_BYTES = 131072;
constexpr int LDSCTL_OFF = RING_BYTES, MISC_OFF = LDSCTL_OFF + 320;
constexpr int XCH_OFF = RING_BYTES + 1024;
constexpr int LDS_BYTES = 147456;
static_assert(XCH_OFF + 8192 <= LDS_BYTES, "LDS map");
constexpr int NWAVES = 8;

#define GAS __attribute__((address_space(1)))
#define LAS __attribute__((address_space(3)))
typedef unsigned short bf16;
typedef unsigned v4u __attribute__((ext_vector_type(4)));
typedef float f32x4 __attribute__((ext_vector_type(4)));
typedef float f32x2 __attribute__((ext_vector_type(2)));
typedef short bf16x8 __attribute__((ext_vector_type(8)));
typedef GAS unsigned gu32;
#define RLX_AGENT __ATOMIC_RELAXED, __HIP_MEMORY_SCOPE_AGENT
#define LDS_WAIT() asm volatile("s_waitcnt lgkmcnt(0)" ::: "memory")
#define VM_WAIT() asm volatile("s_waitcnt vmcnt(0)" ::: "memory")

typedef float f32x2_t __attribute__((ext_vector_type(2))); typedef __bf16 bf16x2_t __attribute__((ext_vector_type(2)));
__device__ __forceinline__ unsigned cvt_pk_bf16(float lo, float hi) { const f32x2_t v = {lo, hi}; const bf16x2_t b = __builtin_convertvector(v, bf16x2_t); return __builtin_bit_cast(unsigned, b); }
__device__ __forceinline__ float bf_lo(unsigned w) { return __uint_as_float(w << 16); }
__device__ __forceinline__ float bf_hi(unsigned w) { return __uint_as_float(w & 0xffff0000u); }
__device__ __forceinline__ float shfl_xor_l(float v, int m, int lane) { return __int_as_float(__builtin_amdgcn_ds_bpermute((lane ^ m) << 2, __float_as_int(v))); }
__device__ __forceinline__ int seq_pos(int m) { return m < NPROMPT ? (m & 4095) : (m - NPROMPT); }
__device__ __forceinline__ int seq_of_panel(int pm) { return pm < 64 ? (pm >> 4) : 4; }

namespace pg8 {
#define PG8_LAS __attribute__((address_space(3)))
typedef unsigned short bf16_t;
typedef short bf16x8 __attribute__((ext_vector_type(8)));
typedef float f32x4 __attribute__((ext_vector_type(4)));
typedef unsigned u32x4 __attribute__((ext_vector_type(4)));
constexpr int BM = 256, BK = 64, HALF = 128, HTB = HALF * BK * 2, STAGE_BYTES = 8 * HTB, NXCD = 8, WGM = 8;

__host__ __device__ __forceinline__ int lds_byte(int r, int c) { const int st = (r >> 4) * 2 + (c >> 5), rr = r & 15, cc = c & 31, ob = rr * 64 + cc * 2; return st * 1024 + (ob ^ (((ob >> 9) & 1) << 5)); }
__host__ __device__ __forceinline__ void stage_rc(int b, int& R, int& C) { const int st = b / 1024, sb = b % 1024, swz = sb ^ (((sb >> 9) & 1) << 5); R = (st >> 1) * 16 + swz / 64; C = (st & 1) * 32 + (swz % 64) / 2; }
__host__ __device__ __forceinline__ int perm32(int rho) { const int n = rho >> 4, i = rho & 15; return 8 * (i >> 2) + 4 * n + (i & 3); }

struct Unit { int pm, pn; };
struct Gemm { const char* A; const char* B; long a_pm, a_pn, b_pn, b_sq; int lda, ldb, K;
    __device__ __forceinline__ const char* aptr(const Unit& u) const { return A + (long)u.pm * a_pm + (long)u.pn * a_pn; }
    __device__ __forceinline__ const char* bptr(const Unit& u) const { return B + (long)u.pn * b_pn + (long)seq_of_panel(u.pm) * b_sq; } };
__device__ __forceinline__ Gemm plain_gemm(const void* A, int lda, const void* B, int ldb, int K) {
    Gemm g; g.A = (const char*)A; g.B = (const char*)B; g.a_pm = (long)BM * lda * 2; g.a_pn = 0; g.b_pn = (long)BM * ldb * 2; g.b_sq = 0; g.lda = lda; g.ldb = ldb; g.K = K; return g; }

struct StaticOrder {
    int nM, nN, nwg, G, c;
    __host__ __device__ void init(int nM_, int nN_, int G_, int c_) { nM = nM_; nN = nN_; nwg = nM * nN; G = G_; c = c_; }
    __host__ __device__ bool next(int i, Unit& u) const {
        const long L = (long)i * G + c; if (L >= nwg) return false;
        int wgid = (int)L; { const int q = nwg / NXCD, r = nwg % NXCD, xcd = wgid % NXCD, off = wgid / NXCD; wgid = (xcd < r ? xcd * (q + 1) : r * (q + 1) + (xcd - r) * q) + off; }
        const int nig = WGM * nN, gid = wgid / nig, fm = gid * WGM, gsz = (nM - fm) < WGM ? (nM - fm) : WGM;
        u.pm = fm + ((wgid % nig) % gsz); u.pn = (wgid % nig) / gsz; return true;
    }
};

typedef f32x4 Acc[2][2][4][2];

template <class Epi, class Sched, bool ALIGN_EPI = true, bool SP2 = true>
__device__ __forceinline__ void gemm_phase(int tid_in, PG8_LAS unsigned char* lds, PG8_LAS unsigned char* xlds, const Gemm g, const Sched& S, const Epi& E) {
    int tid_ = tid_in; asm volatile("" : "+v"(tid_));
    const int tid = tid_, wid = __builtin_amdgcn_readfirstlane(tid >> 6), lane = tid & 63, wr = wid >> 2, wc = wid & 3, fr = lane & 15, fq = lane >> 4;
    const int K = g.K, nt = K / BK;
    unsigned voffA[2], voffB[2];
#pragma unroll
    for (int i = 0; i < 2; ++i) { int R, C; stage_rc(tid * 16 + i * 8192, R, C); const int Rb = Epi::PERM ? ((R & ~31) + perm32(R & 31)) : R;
        voffA[i] = (unsigned)(R * g.lda + C) * 2u; voffB[i] = (unsigned)(Rb * g.ldb + C) * 2u; }
    const size_t kstep = (size_t)(BK * 2);
    const size_t hstepA = (size_t)HALF * g.lda * 2, hstepB = (size_t)HALF * g.ldb * 2;
    const unsigned ldsw = (unsigned)wid * 1024u;
    const int aoff = lds_byte(wr * 64 + fr, fq * 8), boff = lds_byte(wc * 32 + fr, fq * 8);
#define PG8_SA(b, h) (((b) * 2 + (h)) * HTB)
#define PG8_SB(b, h) ((4 + (b) * 2 + (h)) * HTB)
#define PG8_STAGE(bufoff, gbase, voff) do { _Pragma("unroll") for (int _i = 0; _i < 2; ++_i) \
        __builtin_amdgcn_global_load_lds((const unsigned*)((const char*)(gbase) + (voff)[_i]), (PG8_LAS unsigned*)(lds + (bufoff) + ldsw + _i * 8192), 16, 0, 0); } while (0)
#define PG8_LDA(dst, b, h) do { _Pragma("unroll") for (int m = 0; m < 4; ++m) _Pragma("unroll") for (int k = 0; k < 2; ++k) dst[m][k] = *(const PG8_LAS bf16x8*)(lds + PG8_SA(b, h) + aoff + m * 2048 + k * 1024); } while (0)
#define PG8_LDB(dst, b, h) do { _Pragma("unroll") for (int n = 0; n < 2; ++n) _Pragma("unroll") for (int k = 0; k < 2; ++k) dst[n][k] = *(const PG8_LAS bf16x8*)(lds + PG8_SB(b, h) + boff + n * 2048 + k * 1024); } while (0)
#define PG8_MMA(ai, bj, At, Bt) do { __builtin_amdgcn_s_setprio(1); _Pragma("unroll") for (int m = 0; m < 4; ++m) _Pragma("unroll") for (int n = 0; n < 2; ++n) _Pragma("unroll") for (int k = 0; k < 2; ++k) \
        acc[ai][bj][m][n] = __builtin_amdgcn_mfma_f32_16x16x32_bf16(Bt[n][k], At[m][k], acc[ai][bj][m][n], 0, 0, 0); __builtin_amdgcn_s_setprio(0); } while (0)
#define PG8_WAIT_V(n) asm volatile("s_waitcnt vmcnt(" #n ")" ::: "memory")
#define PG8_WAIT_L(n) asm volatile("s_waitcnt lgkmcnt(" #n ")" ::: "memory")
#define PG8_BAR __builtin_amdgcn_s_barrier()
#define PG8_SCHED __builtin_amdgcn_sched_barrier(0)
    Unit cur, nxt; int ui = 0;
    if (!S.next(0, cur)) return;
    f32x4 acc[2][2][4][2];
#pragma unroll
    for (int a = 0; a < 2; ++a)
#pragma unroll
        for (int b = 0; b < 2; ++b)
#pragma unroll
            for (int m = 0; m < 4; ++m)
#pragma unroll
                for (int n = 0; n < 2; ++n) acc[a][b][m][n] = (f32x4){0.f, 0.f, 0.f, 0.f};
    bf16x8 At[4][2], B0[2][2], B1[2][2];
    const char* cA = g.aptr(cur); const char* cB = g.bptr(cur);
    if constexpr (SP2) {
        PG8_STAGE(PG8_SB(0, 0), cB, voffB); PG8_STAGE(PG8_SB(0, 1), cB + hstepB, voffB); PG8_STAGE(PG8_SA(0, 0), cA, voffA); PG8_STAGE(PG8_SA(0, 1), cA + hstepA, voffA);
        if (wr == 1) PG8_BAR;
        PG8_WAIT_V(2); PG8_BAR;
        PG8_STAGE(PG8_SB(1, 0), cB + kstep, voffB); PG8_STAGE(PG8_SA(1, 0), cA + kstep, voffA); PG8_STAGE(PG8_SB(1, 1), cB + hstepB + kstep, voffB);
        PG8_WAIT_V(6); PG8_BAR;
    } else {
        PG8_STAGE(PG8_SB(0, 0), cB, voffB); PG8_STAGE(PG8_SA(0, 0), cA, voffA); PG8_STAGE(PG8_SB(0, 1), cB + hstepB, voffB); PG8_STAGE(PG8_SA(0, 1), cA + hstepA, voffA);
        if (wr == 1) PG8_BAR;
        PG8_WAIT_V(4); PG8_BAR;
        PG8_STAGE(PG8_SB(1, 0), cB + kstep, voffB); PG8_STAGE(PG8_SA(1, 0), cA + kstep, voffA); PG8_STAGE(PG8_SB(1, 1), cB + hstepB + kstep, voffB);
        PG8_WAIT_V(6); PG8_BAR;
    }
    for (;;) {
        const bool has_next = S.next(ui + 1, nxt);
        const char* nA = has_next ? g.aptr(nxt) : cA; const char* nB = has_next ? g.bptr(nxt) : cB;
        for (int t = 0; t < nt; t += 2) {
            const bool last = (t == nt - 2);
            if constexpr (Epi::HAS_MID) { if (t == Epi::MID1 || t == Epi::MID2) E.mid(acc, cur, t, wr, wc, fr, fq); }
            const char* a1 = cA + (size_t)(t + 1) * kstep;
            const char* a2 = last ? nA : cA + (size_t)(t + 2) * kstep; const char* b2 = last ? nB : cB + (size_t)(t + 2) * kstep;
            const char* a3 = a2 + kstep; const char* b3 = b2 + kstep;
            if constexpr (SP2) {
            PG8_LDB(B0, 0, 0); PG8_LDB(B1, 0, 1); PG8_SCHED; PG8_LDA(At, 0, 0); PG8_STAGE(PG8_SA(1, 1), a1 + hstepA, voffA);
            PG8_WAIT_V(8); PG8_WAIT_L(0); PG8_BAR; PG8_MMA(0, 0, At, B0); PG8_MMA(0, 1, At, B1); PG8_BAR; PG8_SCHED;
            PG8_LDA(At, 0, 1); PG8_STAGE(PG8_SB(0, 0), b2, voffB); PG8_STAGE(PG8_SB(0, 1), b2 + hstepB, voffB); PG8_STAGE(PG8_SA(0, 0), a2, voffA);
            PG8_WAIT_V(8); PG8_WAIT_L(0); PG8_BAR; PG8_MMA(1, 0, At, B0); PG8_MMA(1, 1, At, B1); PG8_BAR; PG8_SCHED;
            PG8_LDB(B0, 1, 0); PG8_LDB(B1, 1, 1); PG8_SCHED; PG8_LDA(At, 1, 0); PG8_STAGE(PG8_SA(0, 1), a2 + hstepA, voffA);
            PG8_WAIT_V(8); PG8_WAIT_L(0); PG8_BAR; PG8_MMA(0, 0, At, B0); PG8_MMA(0, 1, At, B1); PG8_BAR; PG8_SCHED;
            PG8_LDA(At, 1, 1); PG8_STAGE(PG8_SB(1, 0), b3, voffB); PG8_STAGE(PG8_SB(1, 1), b3 + hstepB, voffB); PG8_STAGE(PG8_SA(1, 0), a3, voffA);
            PG8_WAIT_V(8); PG8_WAIT_L(0); PG8_BAR; PG8_MMA(1, 0, At, B0); PG8_MMA(1, 1, At, B1); PG8_BAR; PG8_SCHED;
            } else {
            PG8_LDB(B0, 0, 0); PG8_SCHED; PG8_LDA(At, 0, 0); PG8_STAGE(PG8_SA(1, 1), a1 + hstepA, voffA);
            PG8_WAIT_L(8); PG8_BAR; PG8_WAIT_L(0); PG8_MMA(0, 0, At, B0); PG8_BAR; PG8_SCHED;
            PG8_LDB(B1, 0, 1); PG8_STAGE(PG8_SB(0, 0), b2, voffB);
            PG8_BAR; PG8_WAIT_L(0); PG8_MMA(0, 1, At, B1); PG8_BAR;
            PG8_LDA(At, 0, 1); PG8_STAGE(PG8_SA(0, 0), a2, voffA);
            PG8_BAR; PG8_WAIT_L(0); PG8_MMA(1, 0, At, B0); PG8_BAR; PG8_SCHED;
            PG8_STAGE(PG8_SB(0, 1), b2 + hstepB, voffB);
            PG8_WAIT_V(6); PG8_BAR; PG8_MMA(1, 1, At, B1); PG8_BAR;
            PG8_LDB(B0, 1, 0); PG8_SCHED; PG8_LDA(At, 1, 0); PG8_STAGE(PG8_SA(0, 1), a2 + hstepA, voffA);
            PG8_WAIT_L(8); PG8_BAR; PG8_WAIT_L(0); PG8_MMA(0, 0, At, B0); PG8_BAR; PG8_SCHED;
            PG8_LDB(B1, 1, 1); PG8_STAGE(PG8_SB(1, 0), b3, voffB);
            PG8_BAR; PG8_WAIT_L(0); PG8_MMA(0, 1, At, B1); PG8_BAR;
            PG8_LDA(At, 1, 1); PG8_STAGE(PG8_SA(1, 0), a3, voffA);
            PG8_BAR; PG8_WAIT_L(0); PG8_MMA(1, 0, At, B0); PG8_BAR; PG8_SCHED;
            PG8_STAGE(PG8_SB(1, 1), b3 + hstepB, voffB);
            PG8_WAIT_V(6); PG8_BAR; PG8_MMA(1, 1, At, B1); PG8_BAR;
            }
        }
        if constexpr (ALIGN_EPI) { if (wr == 0) PG8_BAR; }
        E(acc, cur, wr, wc, fr, fq, xlds, wid, lane);
        if (!has_next) break;
#pragma unroll
        for (int a = 0; a < 2; ++a)
#pragma unroll
            for (int b = 0; b < 2; ++b)
#pragma unroll
                for (int m = 0; m < 4; ++m)
#pragma unroll
                    for (int n = 0; n < 2; ++n) acc[a][b][m][n] = (f32x4){0.f, 0.f, 0.f, 0.f};
        cur = nxt; cA = nA; cB = nB; ++ui;
        if constexpr (ALIGN_EPI) { if (wr == 1) PG8_BAR; }
    }
    PG8_WAIT_V(0);
    if constexpr (!ALIGN_EPI) { if (wr == 0) PG8_BAR; }
    PG8_BAR;
#undef PG8_SA
#undef PG8_SB
#undef PG8_STAGE
#undef PG8_LDA
#undef PG8_LDB
#undef PG8_MMA
#undef PG8_WAIT_V
#undef PG8_WAIT_L
#undef PG8_BAR
#undef PG8_SCHED
}
}

namespace epi {
using pg8::Acc; using pg8::Unit; using pg8::HALF; using pg8::BM;
typedef float f32x2v __attribute__((ext_vector_type(2)));
#define EPI_COMMON static constexpr bool PERM = true;
#define EPI_PIN(a, b) asm volatile("" : "+v"(a), "+v"(b))
#define EPI_NOMID static constexpr bool HAS_MID = false; static constexpr int MID1 = -1, MID2 = -1;
__device__ __forceinline__ v4u pack8(const f32x4 v0, const f32x4 v1) { v4u w; w.x = cvt_pk_bf16(v0[0], v0[1]); w.y = cvt_pk_bf16(v0[2], v0[3]); w.z = cvt_pk_bf16(v1[0], v1[1]); w.w = cvt_pk_bf16(v1[2], v1[3]); return w; }
__device__ __forceinline__ void rope8(f32x4& v0, f32x4& v1, const f32x4 cs0, const f32x4 cs1, const f32x4 cs2, const f32x4 cs3) {
    (void)cs2; (void)cs3;
    const float a0 = v0[0] * cs0[0] - v0[1] * cs0[1], b0 = v0[0] * cs0[1] + v0[1] * cs0[0];
    const float a1 = v0[2] * cs0[2] - v0[3] * cs0[3], b1 = v0[2] * cs0[3] + v0[3] * cs0[2];
    const float a2 = v1[0] * cs1[0] - v1[1] * cs1[1], b2 = v1[0] * cs1[1] + v1[1] * cs1[0];
    const float a3 = v1[2] * cs1[2] - v1[3] * cs1[3], b3 = v1[2] * cs1[3] + v1[3] * cs1[2];
    v0 = (f32x4){a0, b0, a1, b1}; v1 = (f32x4){a2, b2, a3, b3};
}
__device__ __forceinline__ float sigmoidf_fast(float v) { return __builtin_amdgcn_rcpf(1.f + __builtin_amdgcn_exp2f(-LOG2E * v)); }

struct EpiZ { EPI_COMMON EPI_NOMID
    bf16* Z; float* SSQ; const float* tab;
    __device__ __forceinline__ void operator()(Acc& acc, const Unit& u, int wr, int wc, int fr, int fq, LAS unsigned char*, int, int lane) const {
        const int pn = u.pn; int row0 = u.pm * BM + wr * 64 + fr, col0 = pn * BM + wc * 32 + 8 * fq; EPI_PIN(row0, col0);
        if (pn >= 15) {
#pragma unroll
            for (int ai = 0; ai < 2; ++ai)
#pragma unroll
                for (int m = 0; m < 4; ++m) { bf16* rowp = Z + (size_t)(row0 + ai * HALF + m * 16) * NZ + col0;
#pragma unroll
                    for (int bj = 0; bj < 2; ++bj) { f32x4 v0 = acc[ai][bj][m][0], v1 = acc[ai][bj][m][1];
#pragma unroll
                        for (int j = 0; j < 4; ++j) { v0[j] = sigmoidf_fast(v0[j]); v1[j] = sigmoidf_fast(v1[j]); }
                        *(v4u*)(rowp + bj * HALF) = pack8(v0, v1); } }
        } else if (pn == 14) {
            const int i0 = 16 * (wc & 1) + 4 * fq;
#pragma unroll
            for (int ai = 0; ai < 2; ++ai)
#pragma unroll
                for (int m = 0; m < 4; ++m) { const int row = row0 + ai * HALF + m * 16; bf16* rowp = Z + (size_t)row * NZ + col0;
                    f32x4 v0 = acc[ai][0][m][0], v1 = acc[ai][0][m][1];
                    if (wc < 2) { const f32x4* cs = (const f32x4*)(tab + ((size_t)seq_pos(row) * 32 + i0) * 2); rope8(v0, v1, cs[0], cs[1], cs[0], cs[0]); }
                    *(v4u*)(rowp) = pack8(v0, v1);
                    *(v4u*)(rowp + HALF) = pack8(acc[ai][1][m][0], acc[ai][1][m][1]); }
        } else {
            const float sc = (pn >= 4 && pn < 8) ? C_W : ((pn >= 10) ? C_M : 1.f);
#pragma unroll
            for (int ai = 0; ai < 2; ++ai)
#pragma unroll
                for (int m = 0; m < 4; ++m) { const int row = row0 + ai * HALF + m * 16; bf16* rowp = Z + (size_t)row * NZ + col0; float ss = 0.f;
#pragma unroll
                    for (int bj = 0; bj < 2; ++bj) { const f32x4 v0 = acc[ai][bj][m][0] * sc, v1 = acc[ai][bj][m][1] * sc;
                        ss += (v0[0] * v0[0] + v0[1] * v0[1]) + (v0[2] * v0[2] + v0[3] * v0[3]) + (v1[0] * v1[0] + v1[1] * v1[1]) + (v1[2] * v1[2] + v1[3] * v1[3]);
                        *(v4u*)(rowp + bj * HALF) = pack8(v0, v1); }
                    if (pn < 4) { ss += shfl_xor_l(ss, 16, lane); ss += shfl_xor_l(ss, 32, lane); if (fq == 0) SSQ[(size_t)row * 16 + pn * 4 + wc] = ss; } }
        }
    }
};
template <int WHICH  > struct EpiLat { EPI_COMMON EPI_NOMID
    bf16* O; const float* SSQ; const float* tab;
    __device__ __forceinline__ void operator()(Acc& acc, const Unit& u, int wr, int wc, int fr, int fq, LAS unsigned char*, int, int) const {
        constexpr int LDC = WHICH == 0 ? NQC : NKVC;
        const int pn = u.pn; int row0 = u.pm * BM + wr * 64 + fr, col0 = pn * BM + wc * 32 + 8 * fq; EPI_PIN(row0, col0);
        const int i0 = 16 * (wc & 1) + 4 * fq;
#pragma unroll
        for (int ai = 0; ai < 2; ++ai)
#pragma unroll
            for (int m = 0; m < 4; ++m) { const int row = row0 + ai * HALF + m * 16; bf16* rowp = O + (size_t)row * LDC + col0;
                const f32x4* sp = (const f32x4*)(SSQ + (size_t)row * 16 + WHICH * 8); const f32x4 s0 = sp[0], s1 = sp[1];
                const float ssum = ((s0[0] + s0[1]) + (s0[2] + s0[3])) + ((s1[0] + s1[1]) + (s1[2] + s1[3]));
                const float rs = __builtin_amdgcn_rsqf(ssum * (1.f / 512.f) + EPS) * (WHICH == 0 ? C_Q : 1.f);
#pragma unroll
                for (int bj = 0; bj < 2; ++bj) { f32x4 v0 = acc[ai][bj][m][0] * rs, v1 = acc[ai][bj][m][1] * rs;
                    if (WHICH == 0 && pn >= 4) { const f32x4* cs = (const f32x4*)(tab + ((size_t)seq_pos(row) * 32 + i0) * 2); rope8(v0, v1, cs[0], cs[1], cs[0], cs[0]); }
                    *(v4u*)(rowp + bj * HALF) = pack8(v0, v1); } }
    }
};
template <int MODE> struct EpiStore { EPI_COMMON EPI_NOMID
    bf16* O; int ldc; int col_off; const float* rs;
    __device__ __forceinline__ void operator()(Acc& acc, const Unit& u, int wr, int wc, int fr, int fq, LAS unsigned char*, int, int) const {
        int row0 = u.pm * BM + wr * 64 + fr, ct = u.pn * BM + wc * 32 + 8 * fq; EPI_PIN(row0, ct); const int col0 = col_off + ct;
        f32x4 cs[2][2];
        if (MODE == 2) {
#pragma unroll
            for (int bj = 0; bj < 2; ++bj) { cs[bj][0] = *(const f32x4*)(rs + ct + bj * HALF); cs[bj][1] = *(const f32x4*)(rs + ct + bj * HALF + 4); } }
#pragma unroll
        for (int ai = 0; ai < 2; ++ai)
#pragma unroll
            for (int m = 0; m < 4; ++m) { const int row = row0 + ai * HALF + m * 16; bf16* rowp = O + (size_t)row * ldc + col0;
                float r = 1.f; if (MODE == 1) r = rs[row];
#pragma unroll
                for (int bj = 0; bj < 2; ++bj) { f32x4 v0 = acc[ai][bj][m][0], v1 = acc[ai][bj][m][1];
                    if (MODE == 1) { v0 = v0 * r; v1 = v1 * r; }
                    if (MODE == 2) { v0 = v0 * cs[bj][0]; v1 = v1 * cs[bj][1]; }
                    if (MODE == 3) {
#pragma unroll
                        for (int j = 0; j < 4; ++j) { const float a = fmaxf(v0[j], 0.f), b = fmaxf(v1[j], 0.f); v0[j] = a * a; v1[j] = b * b; } }
                    *(v4u*)(rowp + bj * HALF) = pack8(v0, v1); } }
    }
};
struct EpiSoftmax { EPI_COMMON EPI_NOMID
    bf16* O;
    __device__ __forceinline__ void operator()(Acc& acc, const Unit& u, int wr, int wc, int fr, int fq, LAS unsigned char* xl, int, int lane) const {
        LAS float* MX = (LAS float*)xl; LAS float* SM = (LAS float*)(xl + 4096);
        int row0 = u.pm * BM + wr * 64 + fr, col0 = u.pn * BM + wc * 32 + 8 * fq; EPI_PIN(row0, col0);
#pragma unroll
        for (int ai = 0; ai < 2; ++ai)
#pragma unroll
            for (int m = 0; m < 4; ++m) { float mx = -3.0e38f;
#pragma unroll
                for (int bj = 0; bj < 2; ++bj)
#pragma unroll
                    for (int n = 0; n < 2; ++n) { const f32x4 x = acc[ai][bj][m][n]; mx = fmaxf(mx, fmaxf(fmaxf(x[0], x[1]), fmaxf(x[2], x[3]))); }
                mx = fmaxf(mx, shfl_xor_l(mx, 16, lane)); mx = fmaxf(mx, shfl_xor_l(mx, 32, lane));
                if (fq == 0) MX[(ai * HALF + wr * 64 + m * 16 + fr) * 4 + wc] = mx; }
        asm volatile("s_waitcnt lgkmcnt(0)" ::: "memory"); __builtin_amdgcn_s_barrier(); asm volatile("" ::: "memory");
#pragma unroll
        for (int ai = 0; ai < 2; ++ai)
#pragma unroll
            for (int m = 0; m < 4; ++m) { const int lr = ai * HALF + wr * 64 + m * 16 + fr; const f32x4 q = *(LAS f32x4*)(MX + lr * 4);
                const float mx = fmaxf(fmaxf(q[0], q[1]), fmaxf(q[2], q[3])); float s = 0.f;
#pragma unroll
                for (int bj = 0; bj < 2; ++bj)
#pragma unroll
                    for (int n = 0; n < 2; ++n) { f32x4 x = acc[ai][bj][m][n];
#pragma unroll
                        for (int j = 0; j < 4; ++j) { x[j] = __builtin_amdgcn_exp2f(x[j] - mx); s += x[j]; }
                        acc[ai][bj][m][n] = x; }
                s += shfl_xor_l(s, 16, lane); s += shfl_xor_l(s, 32, lane);
                if (fq == 0) SM[lr * 4 + wc] = s; }
        asm volatile("s_waitcnt lgkmcnt(0)" ::: "memory"); __builtin_amdgcn_s_barrier(); asm volatile("" ::: "memory");
#pragma unroll
        for (int ai = 0; ai < 2; ++ai)
#pragma unroll
            for (int m = 0; m < 4; ++m) { const int lr = ai * HALF + wr * 64 + m * 16 + fr; const f32x4 q = *(LAS f32x4*)(SM + lr * 4);
                const float inv = __builtin_amdgcn_rcpf((q[0] + q[1]) + (q[2] + q[3]));
                bf16* rowp = O + (size_t)(row0 + ai * HALF + m * 16) * 1024 + col0;
#pragma unroll
                for (int bj = 0; bj < 2; ++bj) *(v4u*)(rowp + bj * HALF) = pack8(acc[ai][bj][m][0] * inv, acc[ai][bj][m][1] * inv); }
    }
};
struct EpiBranch { EPI_COMMON
    static constexpr bool HAS_MID = true; static constexpr int MID1 = 16, MID2 = 32;
    bf16* O; const bf16* Z;
    __device__ __forceinline__ void mid(Acc& acc, const Unit& u, int t, int wr, int wc, int fr, int fq) const {
        int row0 = u.pm * BM + wr * 64 + fr, col0 = u.pn * BM + wc * 32 + 8 * fq; EPI_PIN(row0, col0);
        const int gx = ZC_G + (t == MID1 ? 0 : 2048) + col0, gy = gx + 2048;
#pragma unroll
        for (int ai = 0; ai < 2; ++ai)
#pragma unroll
            for (int m = 0; m < 4; ++m) { const bf16* zr = Z + (size_t)(row0 + ai * HALF + m * 16) * NZ;
#pragma unroll
                for (int bj = 0; bj < 2; ++bj) { const v4u a = *(const v4u*)(zr + gx + bj * HALF), b = *(const v4u*)(zr + gy + bj * HALF);
                    f32x4 r0, r1;
                    r0[0] = bf_lo(a.x) * __builtin_amdgcn_rcpf(bf_lo(b.x)); r0[1] = bf_hi(a.x) * __builtin_amdgcn_rcpf(bf_hi(b.x));
                    r0[2] = bf_lo(a.y) * __builtin_amdgcn_rcpf(bf_lo(b.y)); r0[3] = bf_hi(a.y) * __builtin_amdgcn_rcpf(bf_hi(b.y));
                    r1[0] = bf_lo(a.z) * __builtin_amdgcn_rcpf(bf_lo(b.z)); r1[1] = bf_hi(a.z) * __builtin_amdgcn_rcpf(bf_hi(b.z));
                    r1[2] = bf_lo(a.w) * __builtin_amdgcn_rcpf(bf_lo(b.w)); r1[3] = bf_hi(a.w) * __builtin_amdgcn_rcpf(bf_hi(b.w));
                    acc[ai][bj][m][0] *= r0; acc[ai][bj][m][1] *= r1; }
                asm volatile("" ::: "memory"); }
    }
    __device__ __forceinline__ void operator()(Acc& acc, const Unit& u, int wr, int wc, int fr, int fq, LAS unsigned char*, int, int) const {
        int row0 = u.pm * BM + wr * 64 + fr, col0 = u.pn * BM + wc * 32 + 8 * fq; EPI_PIN(row0, col0);
#pragma unroll
        for (int ai = 0; ai < 2; ++ai)
#pragma unroll
            for (int m = 0; m < 4; ++m) { const int row = row0 + ai * HALF + m * 16; const bf16* zr = Z + (size_t)row * NZ + ZC_G + 4096 + col0; bf16* rowp = O + (size_t)row * DM + col0;
#pragma unroll
                for (int bj = 0; bj < 2; ++bj) { const v4u a = *(const v4u*)(zr + bj * HALF);
                    const f32x4 g0 = {bf_lo(a.x), bf_hi(a.x), bf_lo(a.y), bf_hi(a.y)}, g1 = {bf_lo(a.z), bf_hi(a.z), bf_lo(a.w), bf_hi(a.w)};
                    *(v4u*)(rowp + bj * HALF) = pack8(acc[ai][bj][m][0] * g0, acc[ai][bj][m][1] * g1); }
                asm volatile("" ::: "memory"); }
    }
};
}

namespace att {
using s16x4 = __attribute__((ext_vector_type(4))) short;
using f32x16 = __attribute__((ext_vector_type(16))) float;
using u32x4 = __attribute__((ext_vector_type(4))) unsigned;
constexpr int NW = 8, QBLK = 32, KVBLK = 64;
constexpr float THR2 = 8.f;
constexpr float NEGBIG = -1.0e30f;
#define SBAR() __builtin_amdgcn_sched_barrier(0)
__device__ __forceinline__ int crow(int r, int hi) { return (r & 3) + 8 * (r >> 2) + 4 * hi; }
template <int KROWB> __device__ __forceinline__ int kswz(int row, int colB) { return row * KROWB + (colB ^ ((row & 7) << 4)); }

struct Mask { int dq; float sl; };

template <bool WIN>
__device__ __forceinline__ void partialSM(f32x16& p0, f32x16& p1, float& m_reg, float& mn, float& alpha, const Mask& mk, int kt) {
  if (WIN) {
    const float fd = (float)(mk.dq - kt * KVBLK);
#pragma unroll
    for (int r = 0; r < 16; ++r) { const float d0 = fd - (float)((r & 3) + 8 * (r >> 2)), d1 = d0 - 32.f; const float a0 = fabsf(d0), a1 = fabsf(d1);
      const float t0 = p0[r] - mk.sl * a0, t1 = p1[r] - mk.sl * a1; p0[r] = (a0 <= 128.f) ? t0 : NEGBIG; p1[r] = (a1 <= 128.f) ? t1 : NEGBIG; }
  }
  float pmax = p0[0];
#pragma unroll
  for (int r = 1; r < 16; ++r) pmax = fmaxf(pmax, p0[r]);
#pragma unroll
  for (int r = 0; r < 16; ++r) pmax = fmaxf(pmax, p1[r]);
  { auto rr = __builtin_amdgcn_permlane32_swap(__float_as_uint(pmax), __float_as_uint(pmax), false, false);
    pmax = fmaxf(__uint_as_float(rr[0]), __uint_as_float(rr[1])); }
  if (__builtin_expect(__all(pmax - m_reg <= THR2), 1)) { mn = m_reg; alpha = 1.f; }
  else { mn = fmaxf(m_reg, pmax); alpha = __builtin_amdgcn_exp2f(m_reg - mn); m_reg = mn; }
#pragma unroll
  for (int r = 0; r < 16; ++r) p0[r] = p0[r] - mn;
#pragma unroll
  for (int r = 0; r < 16; ++r) p1[r] = p1[r] - mn;
#pragma unroll
  for (int r = 0; r < 16; ++r) p0[r] = __builtin_amdgcn_exp2f(p0[r]);
}
__device__ __forceinline__ void finishSM(f32x16& p0, f32x16& p1, float alpha, float& l_reg, bf16x8& pa0, bf16x8& pa1, bf16x8& pa2, bf16x8& pa3) {
#pragma unroll
  for (int r = 0; r < 16; ++r) p1[r] = __builtin_amdgcn_exp2f(p1[r]);
  float ps = 0;
#pragma unroll
  for (int r = 0; r < 16; ++r) ps += p0[r];
#pragma unroll
  for (int r = 0; r < 16; ++r) ps += p1[r];
  { auto rr = __builtin_amdgcn_permlane32_swap(__float_as_uint(ps), __float_as_uint(ps), false, false);
    ps = __uint_as_float(rr[0]) + __uint_as_float(rr[1]); }
  l_reg = l_reg * alpha + ps;
#define PK4(P, BASE, OUT) do { unsigned a0 = cvt_pk_bf16(P[BASE + 0], P[BASE + 1]), a1 = cvt_pk_bf16(P[BASE + 2], P[BASE + 3]);   \
    unsigned b0 = cvt_pk_bf16(P[BASE + 4], P[BASE + 5]), b1 = cvt_pk_bf16(P[BASE + 6], P[BASE + 7]);                              \
    auto r0 = __builtin_amdgcn_permlane32_swap(a0, b0, false, false); auto r1 = __builtin_amdgcn_permlane32_swap(a1, b1, false, false); \
    u32x4 w = {r0[0], r1[0], r0[1], r1[1]}; OUT = *reinterpret_cast<bf16x8*>(&w); } while (0)
  PK4(p0, 0, pa0); PK4(p0, 8, pa1); PK4(p1, 0, pa2); PK4(p1, 8, pa3);
#undef PK4
}
template <int NQF, int KROWB>
__device__ __forceinline__ void qkt(f32x16& p0, f32x16& p1, const LAS char* Ks, const bf16x8* qr, int r32, int hi) {
  p0 = f32x16{}; p1 = f32x16{};
#pragma unroll
  for (int d0 = 0; d0 < NQF; ++d0) { const int cb = (d0 * 16 + hi * 8) * 2;
    bf16x8 b0 = *(const LAS bf16x8*)(Ks + kswz<KROWB>(r32, cb));
    bf16x8 b1 = *(const LAS bf16x8*)(Ks + kswz<KROWB>(32 + r32, cb));
    p0 = __builtin_amdgcn_mfma_f32_32x32x16_bf16(b0, qr[d0], p0, 0, 0, 0);
    p1 = __builtin_amdgcn_mfma_f32_32x32x16_bf16(b1, qr[d0], p1, 0, 0, 0); }
}
__device__ __forceinline__ int v_st(int k, int c) { const int kk = (k & ~0xC) | ((k & 4) << 1) | ((k & 8) >> 1); return ((kk >> 3) * 4 + (c >> 5)) * 512 + ((kk & 7) * 32 + (c & 31)) * 2; }
__device__ __forceinline__ int v_rd_base(int lane) { return ((lane & 3) << 3) | (((lane >> 2) & 3) << 6) | (((lane >> 4) & 1) << 5) | (((lane >> 5) & 1) << 8); }
constexpr int v_rd_off(int d0, int ks, int half) { return d0 * 512 + ks * 4096 + half * 2048; }
template <int OFF> __device__ __forceinline__ s16x4 tr_read(int vb) {
  s16x4 r; asm volatile("ds_read_b64_tr_b16 %0, %1 offset:%2" : "=&v"(r) : "v"(vb), "i"(OFF) : "memory"); return r;
}
template <int D0> __device__ __forceinline__ void pv_one(f32x16& od, int vb, bf16x8 pa0, bf16x8 pa1, bf16x8 pa2, bf16x8 pa3) {
  const s16x4 l0 = tr_read<v_rd_off(D0, 0, 0)>(vb), h0 = tr_read<v_rd_off(D0, 0, 1)>(vb), l1 = tr_read<v_rd_off(D0, 1, 0)>(vb), h1 = tr_read<v_rd_off(D0, 1, 1)>(vb);
  const s16x4 l2 = tr_read<v_rd_off(D0, 2, 0)>(vb), h2 = tr_read<v_rd_off(D0, 2, 1)>(vb), l3 = tr_read<v_rd_off(D0, 3, 0)>(vb), h3 = tr_read<v_rd_off(D0, 3, 1)>(vb);
  asm volatile("s_waitcnt lgkmcnt(0)" ::: "memory"); SBAR();
#define PK(L, H) (bf16x8){L[0], L[1], L[2], L[3], H[0], H[1], H[2], H[3]}
  od = __builtin_amdgcn_mfma_f32_32x32x16_bf16(pa0, PK(l0, h0), od, 0, 0, 0);
  od = __builtin_amdgcn_mfma_f32_32x32x16_bf16(pa1, PK(l1, h1), od, 0, 0, 0);
  od = __builtin_amdgcn_mfma_f32_32x32x16_bf16(pa2, PK(l2, h2), od, 0, 0, 0);
  od = __builtin_amdgcn_mfma_f32_32x32x16_bf16(pa3, PK(l3, h3), od, 0, 0, 0);
#undef PK
}
__device__ __forceinline__ void pv_d0(f32x16* o, int vb, bf16x8 pa0, bf16x8 pa1, bf16x8 pa2, bf16x8 pa3) {
  pv_one<0>(o[0], vb, pa0, pa1, pa2, pa3); pv_one<1>(o[1], vb, pa0, pa1, pa2, pa3); pv_one<2>(o[2], vb, pa0, pa1, pa2, pa3); pv_one<3>(o[3], vb, pa0, pa1, pa2, pa3);
}

template <int KIND>
__device__ __forceinline__ void attn_unit(const bf16* __restrict__ Qb, const bf16* __restrict__ KVb, const bf16* __restrict__ Zb, bf16* __restrict__ Ob,
                                          int qm0, int km0, int NT, int h, int ocol, float m0, float l0, Mask mk, LAS char* lds, int tid_in) {
  constexpr int NQF = KIND == 0 ? 12 : 8, KROWB = KIND == 0 ? 384 : 256;
  constexpr int SHM_V = KVBLK * 128 * 2, SHM_K = KVBLK * KROWB;
  int tid_ = tid_in; asm volatile("" : "+v"(tid_));
  const int tid = tid_, wid = tid >> 6, lane = tid & 63, r32 = lane & 31, hi = lane >> 5;
  LAS char* V_lds = lds; LAS char* K_lds = lds + 2 * SHM_V;
  LAS float* ws = (LAS float*)(lds + 2 * SHM_V + 2 * SHM_K) + wid * 64; LAS float* li_l = ws; LAS float* al_l = ws + 32;
  float m_reg = m0, l_reg = l0; f32x16 o[4] = {}; bf16x8 qr[NQF];
  const int kvh = h >> 2;
  { const long qrow = (long)(qm0 + wid * QBLK + r32);
    if (KIND == 0) {
      const bf16* Qn = Qb + qrow * NQC + h * 128 + hi * 8; const bf16* Qr = Qb + qrow * NQC + 1024 + h * 64 + hi * 8;
#pragma unroll
      for (int d0 = 0; d0 < 8; ++d0) qr[d0] = *reinterpret_cast<const bf16x8*>(Qn + d0 * 16);
#pragma unroll
      for (int d0 = 8; d0 < NQF; ++d0) qr[d0] = *reinterpret_cast<const bf16x8*>(Qr + (d0 - 8) * 16);
    } else {
      const bf16* Qn = Zb + qrow * NZ + ZC_QW + h * 128 + hi * 8;
#pragma unroll
      for (int d0 = 0; d0 < 8; ++d0) qr[d0] = *reinterpret_cast<const bf16x8*>(Qn + d0 * 16);
    } }
  const int sr = tid >> 4, sc = (tid & 15) * 8, vst0 = v_st(sr, sc), vst1 = v_st(32 + sr, sc);
  const int rr_ = tid >> 3, rc_ = (tid & 7) * 8;
  const int vb0 = (int)(uintptr_t)V_lds + v_rd_base(lane);
  constexpr long kld = KIND == 0 ? NKVC : NZ;
  const char* Kbase = KIND == 0 ? (const char*)(KVb + (long)km0 * NKVC + h * 256) : (const char*)(Zb + (long)km0 * NZ + ZC_KW + kvh * 128);
  const char* Vbase = KIND == 0 ? Kbase + 256 : (const char*)(Zb + (long)km0 * NZ + ZC_VW + kvh * 128);
  const char* Rbase = (const char*)(Zb + (long)km0 * NZ + ZC_KR);
  const unsigned koff = (unsigned)((sr * kld + sc) * 2), roff = (unsigned)((rr_ * NZ + rc_) * 2);
  bf16x8 s_v0, s_v1, s_k0, s_k1, s_kr;
#define SLOAD(k0) do { const size_t o_ = (size_t)(k0) * kld * 2; const char* vb_ = Vbase + o_; const char* kb_ = Kbase + o_; \
    s_v0 = *reinterpret_cast<const bf16x8*>(vb_ + koff); s_v1 = *reinterpret_cast<const bf16x8*>(vb_ + 32 * kld * 2 + koff); \
    s_k0 = *reinterpret_cast<const bf16x8*>(kb_ + koff); s_k1 = *reinterpret_cast<const bf16x8*>(kb_ + 32 * kld * 2 + koff); \
    if (KIND == 0) s_kr = *reinterpret_cast<const bf16x8*>(Rbase + (size_t)(k0) * NZ * 2 + roff); } while (0)
#define SWRITE(b) do { *(LAS bf16x8*)(V_lds + (b) * SHM_V + vst0) = s_v0; *(LAS bf16x8*)(V_lds + (b) * SHM_V + vst1) = s_v1; const int kc = sc * 2; \
    *(LAS bf16x8*)(K_lds + (b) * SHM_K + kswz<KROWB>(sr, kc)) = s_k0; *(LAS bf16x8*)(K_lds + (b) * SHM_K + kswz<KROWB>(32 + sr, kc)) = s_k1; \
    if (KIND == 0) *(LAS bf16x8*)(K_lds + (b) * SHM_K + kswz<KROWB>(rr_, 256 + rc_ * 2)) = s_kr; } while (0)
#define SWAIT() asm volatile("s_waitcnt vmcnt(0)" ::: "memory")
#define RESC(a) do { if (__any((a) < 1.f)) { if (hi == 0) al_l[r32] = (a); asm volatile("s_waitcnt lgkmcnt(0)" ::: "memory"); \
    _Pragma("unroll") for (int d = 0; d < 4; ++d) _Pragma("unroll") for (int r = 0; r < 16; ++r) o[d][r] *= al_l[crow(r, hi)]; } } while (0)
  f32x16 pA0, pA1, pB0, pB1; float mnA, mnB, alA, alB; bf16x8 pa0, pa1, pa2, pa3;
  constexpr bool WIN = KIND == 1;
  SLOAD(0); SWAIT(); SWRITE(0); __syncthreads();
  qkt<NQF, KROWB>(pA0, pA1, K_lds, qr, r32, hi); partialSM<WIN>(pA0, pA1, m_reg, mnA, alA, mk, 0);
  SLOAD(KVBLK);
  SWAIT(); SWRITE(1); __syncthreads();
  for (int j = 1; j + 1 < NT; j += 2) {
    SBAR(); qkt<NQF, KROWB>(pB0, pB1, K_lds + SHM_K, qr, r32, hi);
    finishSM(pA0, pA1, alA, l_reg, pa0, pa1, pa2, pa3); SBAR();
    SLOAD((j + 1) * KVBLK); SBAR();
    pv_d0(o, vb0, pa0, pa1, pa2, pa3); partialSM<WIN>(pB0, pB1, m_reg, mnB, alB, mk, j);
    __syncthreads(); SWAIT(); SWRITE(0);
    RESC(alB); __syncthreads();
    SBAR(); qkt<NQF, KROWB>(pA0, pA1, K_lds, qr, r32, hi);
    finishSM(pB0, pB1, alB, l_reg, pa0, pa1, pa2, pa3); SBAR();
    SLOAD((j + 2) * KVBLK); SBAR();
    pv_d0(o, vb0 + SHM_V, pa0, pa1, pa2, pa3); partialSM<WIN>(pA0, pA1, m_reg, mnA, alA, mk, j + 1);
    __syncthreads(); SWAIT(); SWRITE(1);
    RESC(alA); __syncthreads();
  }
  SBAR(); qkt<NQF, KROWB>(pB0, pB1, K_lds + SHM_K, qr, r32, hi);
  finishSM(pA0, pA1, alA, l_reg, pa0, pa1, pa2, pa3); SBAR();
  pv_d0(o, vb0, pa0, pa1, pa2, pa3); partialSM<WIN>(pB0, pB1, m_reg, mnB, alB, mk, NT - 1);
  __syncthreads(); RESC(alB);
  finishSM(pB0, pB1, alB, l_reg, pa0, pa1, pa2, pa3); SBAR();
  pv_d0(o, vb0 + SHM_V, pa0, pa1, pa2, pa3);
  if (hi == 0) li_l[r32] = l_reg; asm volatile("s_waitcnt lgkmcnt(0)" ::: "memory");
  float rli[16];
#pragma unroll
  for (int r = 0; r < 16; ++r) rli[r] = __builtin_amdgcn_rcpf(li_l[crow(r, hi)]);
  bf16* Ow = Ob + (long)(qm0 + wid * QBLK) * NABC + ocol;
#pragma unroll
  for (int r = 0; r < 16; ++r) { const int orow = crow(r, hi);
#pragma unroll
    for (int d0 = 0; d0 < 4; ++d0) { const float v = o[d0][r] * rli[r]; Ow[(long)orow * NABC + d0 * 32 + r32] = (bf16)(cvt_pk_bf16(v, v) & 0xffffu); } }
  __syncthreads();
#undef SLOAD
#undef SWRITE
#undef SWAIT
#undef RESC
}
#undef SBAR
}

#define XB_TMO      128
#define XB_XCNT(j)  (256  + 64 * (j))
#define XB_XSUB(j)  (1280 + 64 * (j))
#define XB_XGEN(j)  (2304 + 64 * (j))
#define XB_TOP      3328
#define XB_TOPGEN   3392
#define XCD_BAR_WORDS 3456
#define XB_SPIN_CAP (1u << 18)

__device__ __forceinline__ unsigned xb_ld(unsigned* p)              { return __hip_atomic_load(p, __ATOMIC_RELAXED, __HIP_MEMORY_SCOPE_AGENT); }
__device__ __forceinline__ unsigned xb_add(unsigned* p, unsigned v) { return __hip_atomic_fetch_add(p, v, __ATOMIC_RELAXED, __HIP_MEMORY_SCOPE_AGENT); }
__device__ __forceinline__ unsigned xb_xcc_id() { return (unsigned)__builtin_amdgcn_s_getreg((3 << 11) | 20) & 0xFu; }
#define XB_SPIN(cond, bar) do { unsigned _sp = 0; while (cond) { __builtin_amdgcn_s_sleep(1); \
    if ((++_sp & 255u) == 0u) { if (xb_ld(&(bar)[XB_TMO])) break; if (_sp > XB_SPIN_CAP) { atomicAdd(&(bar)[XB_TMO], 1u); break; } } } } while (0)

struct XcdBarrier { unsigned* bar; unsigned x; volatile LAS unsigned* st; };

__device__ __forceinline__ XcdBarrier xcd_barrier_post(unsigned* bar, volatile LAS unsigned* st) {
    XcdBarrier b; b.bar = bar; b.x = xb_xcc_id(); b.st = st;
    if (threadIdx.x == 0) (void)xb_add(&bar[XB_XCNT(b.x)], 1u);
    return b;
}
__device__ __forceinline__ void xcd_barrier_complete(unsigned* bar, unsigned x, unsigned& nloc, unsigned& nx) {
    const unsigned G = gridDim.x * gridDim.y * gridDim.z;
    unsigned sum, cnt, mine, sp = 0u;
    for (;;) {
        sum = 0u; cnt = 0u; mine = 0u;
#pragma unroll
        for (unsigned j = 0; j < 16; ++j) { const unsigned c = xb_ld(&bar[XB_XCNT(j)]); sum += c; cnt += (c > 0u) ? 1u : 0u; mine = (j == x) ? c : mine; }
        if (sum == G) break;
        __builtin_amdgcn_s_sleep(1);
        if ((++sp & 255u) == 0u) { if (xb_ld(&bar[XB_TMO])) break; if (sp > XB_SPIN_CAP) { atomicAdd(&bar[XB_TMO], 1u); break; } }
    }
    nloc = mine > 0u ? mine : 1u; nx = cnt > 0u ? cnt : 1u;
}
__device__ __forceinline__ void xcd_barrier(const XcdBarrier& b, const int tid  ) {
    asm volatile("s_waitcnt vmcnt(0)" ::: "memory");
    __syncthreads();
    if (tid == 0) {
        unsigned* bar = b.bar;
        __builtin_amdgcn_s_waitcnt(0);
        unsigned nloc = b.st[0], nx = b.st[1];
        if (nloc == 0u) { xcd_barrier_complete(bar, b.x, nloc, nx); b.st[0] = nloc; b.st[1] = nx; }
        const unsigned old = xb_add(&bar[XB_XSUB(b.x)], 1u);
        const unsigned gen = old / nloc;
        if (old + 1u == (gen + 1u) * nloc) {
            __builtin_amdgcn_fence(__ATOMIC_RELEASE, "agent");
            asm volatile("s_waitcnt vmcnt(0)" ::: "memory");
            const unsigned og = xb_add(&bar[XB_TOP], 1u);
            const unsigned tg = og / nx;
            if (og + 1u == (tg + 1u) * nx) xb_add(&bar[XB_TOPGEN], 1u);
            else XB_SPIN(xb_ld(&bar[XB_TOPGEN]) == tg, bar);
            __builtin_amdgcn_fence(__ATOMIC_ACQUIRE, "agent");
            xb_add(&bar[XB_XGEN(b.x)], 1u);
            asm volatile("s_waitcnt vmcnt(0)" ::: "memory");
        } else {
            XB_SPIN(xb_ld(&bar[XB_XGEN(b.x)]) == gen, bar);
            __builtin_amdgcn_fence(__ATOMIC_ACQUIRE, "agent");
            asm volatile("s_waitcnt vmcnt(0)" ::: "memory");
        }
    }
    __syncthreads();
}

struct Args { const float* in[22]; float* out; unsigned char* ws; int ph_lo, ph_hi; };
typedef const __attribute__((address_space(4))) Args* KArgs;
#define KARGS() ({ KArgs p_ = (KArgs)__builtin_amdgcn_kernarg_segment_ptr(); asm volatile("" : "+s"(p_)); p_; })
struct Frame { LAS unsigned char* lds; int tid, lane, wave, vcu, G; };

__device__ __forceinline__ float wave_sum(float v, int lane) {
#pragma unroll
    for (int o = 1; o < 64; o <<= 1) v += shfl_xor_l(v, o, lane);
    return v;
}
__device__ const double ROPE_REV[32] = {
    1.59154943091895346e-01, 1.19349370211248862e-01, 8.94994016088910133e-02, 6.71150830052272551e-02, 5.03292121044870353e-02, 3.77415847174197711e-02, 2.83021958306233987e-02, 2.12236527647776604e-02,
    1.59154943091895339e-02, 1.19349370211248862e-02, 8.94994016088910237e-03, 6.71150830052272534e-03, 5.03292121044870370e-03, 3.77415847174197719e-03, 2.83021958306233987e-03, 2.12236527647776622e-03,
    1.59154943091895356e-03, 1.19349370211248849e-03, 8.94994016088910237e-04, 6.71150830052272599e-04, 5.03292121044870326e-04, 3.77415847174197741e-04, 2.83021958306233954e-04, 2.12236527647776605e-04,
    1.59154943091895351e-04, 1.19349370211248862e-04, 8.94994016088910182e-05, 6.71150830052272545e-05, 5.03292121044870354e-05, 3.77415847174197768e-05, 2.83021958306233961e-05, 2.12236527647776592e-05};

enum { MAP_ID = 0, MAP_WIN = 1, MAP_WUQ = 2 };
__device__ __forceinline__ int map_col(int mode, int n) {
    if (mode == MAP_ID) return n;
    if (mode == MAP_WIN) {
        if (n < 1024) return n;
        if (n < ZC_KR) return n + 64;
        if (n < ZC_KR + 64) { const int p = n - ZC_KR, i = p >> 1; return 1024 + ((p & 1) ? i + 32 : i); }
        if (n < ZC_G) return -1;
        return n - ZC_G + 3648;
    }
    if (n < 1024) return (n >> 7) * 192 + (n & 127);
    { const int r = n - 1024, h = r >> 6, p = r & 63, i = p >> 1; return h * 192 + 128 + ((p & 1) ? i + 32 : i); }
}
__device__ __forceinline__ void conv_item(const float* W, int K, int Nsrc, int nblk, const float* g, int mode, bf16* dst, int dst_ld, LAS float* scr, int item, int lane) {
    const int kb = item / nblk, nb = item % nblk, k0 = 64 * kb, n0 = 32 * nb;
    const int src = map_col(mode, n0 + (lane & 31));
#pragma unroll 8
    for (int i = 0; i < 32; ++i) { const int kk = 2 * i + (lane >> 5); float v = 0.f;
        if (src >= 0) { v = W[(size_t)(k0 + kk) * Nsrc + src]; if (g) v *= g[k0 + kk]; }
        scr[kk * 33 + (lane & 31)] = v; }
    LDS_WAIT(); asm volatile("" ::: "memory");
    const int c = lane & 7;
#pragma unroll
    for (int j = 0; j < 4; ++j) { const int n = (lane >> 3) + 8 * j; const LAS float* s = scr + (8 * c) * 33 + n;
        v4u o; o.x = cvt_pk_bf16(s[0 * 33], s[1 * 33]); o.y = cvt_pk_bf16(s[2 * 33], s[3 * 33]); o.z = cvt_pk_bf16(s[4 * 33], s[5 * 33]); o.w = cvt_pk_bf16(s[6 * 33], s[7 * 33]);
        *(GAS v4u*)(dst + (size_t)(n0 + n) * dst_ld + k0 + 8 * c) = o; }
    LDS_WAIT(); asm volatile("" ::: "memory");
}
__device__ __forceinline__ void convert_layer(const Frame& F, KArgs ap, int l, unsigned char* ws) {
    LAS float* scr = (LAS float*)(F.lds + RING_OFF + F.wave * 16384);
    const int gw = F.vcu * NWAVES + F.wave, NGW = F.G * NWAVES;
    unsigned char* W = ws + WS_W;
    constexpr int I_IN = 32 * (NZ / 32), I_UQ = 8 * (NQC / 32), I_UKV = 8 * (NKVC / 32), I_MEM = 32 * 64, I_BR = 16 * 64, I_OUT = 32 * 64, I_UP = 32 * 256, I_DOWN = 128 * 64;
    constexpr int NITEMS = I_IN + I_UQ + I_UKV + I_MEM + 3 * I_BR + I_OUT + I_UP + I_DOWN;
    for (int it = gw; it < NITEMS; it += NGW) {
        int r = it;
        if (r < I_IN) { conv_item(ap->in[6] + (size_t)l * DM * NZSRC, DM, NZSRC, NZ / 32, ap->in[4] + l * DM, MAP_WIN, (bf16*)(W + WO_IN), DM, scr, r, F.lane); continue; } r -= I_IN;
        if (r < I_UQ) { conv_item(ap->in[9] + (size_t)l * 512 * NQC, 512, NQC, NQC / 32, ap->in[7] + l * 512, MAP_WUQ, (bf16*)(W + WO_UQ), 512, scr, r, F.lane); continue; } r -= I_UQ;
        if (r < I_UKV) { conv_item(ap->in[10] + (size_t)l * 512 * NKVC, 512, NKVC, NKVC / 32, ap->in[8] + l * 512, MAP_ID, (bf16*)(W + WO_UKV), 512, scr, r, F.lane); continue; } r -= I_UKV;
        if (r < I_MEM) { conv_item(ap->in[12] + (size_t)l * DM * 2048, DM, 2048, 64, ap->in[11] + l * DM, MAP_ID, (bf16*)(W + WO_MEM), DM, scr, r, F.lane); continue; } r -= I_MEM;
        if (r < 3 * I_BR) { const int br = r / I_BR; conv_item(ap->in[14 + br] + (size_t)l * 1024 * DM, 1024, DM, 64, nullptr, MAP_ID, (bf16*)(W + WO_BR) + br * 1024, NABC, scr, r - br * I_BR, F.lane); continue; } r -= 3 * I_BR;
        if (r < I_OUT) { conv_item(ap->in[17] + (size_t)l * DM * DM, DM, DM, 64, nullptr, MAP_ID, (bf16*)(W + WO_OUT), DM, scr, r, F.lane); continue; } r -= I_OUT;
        if (r < I_UP) { conv_item(ap->in[20] + (size_t)l * DM * DFF, DM, DFF, 256, ap->in[18] + l * DM, MAP_ID, (bf16*)(W + WO_UP), DM, scr, r, F.lane); continue; } r -= I_UP;
        conv_item(ap->in[21] + (size_t)l * DFF * DM, DFF, DM, 64, nullptr, MAP_ID, (bf16*)(W + WO_DOWN), DFF, scr, r, F.lane);
    }
}
__device__ __forceinline__ void rms_row_to_bf16(const float* xrow, bf16* orow, int lane) {
    f32x4 v[8]; float s = 0.f;
#pragma unroll
    for (int j = 0; j < 4; ++j) { v[2 * j] = *(const GAS f32x4*)(xrow + j * 512 + lane * 8); v[2 * j + 1] = *(const GAS f32x4*)(xrow + j * 512 + lane * 8 + 4); }
#pragma unroll
    for (int j = 0; j < 8; ++j) s += (v[j][0] * v[j][0] + v[j][1] * v[j][1]) + (v[j][2] * v[j][2] + v[j][3] * v[j][3]);
    const float r = __builtin_amdgcn_rsqf(wave_sum(s, lane) * (1.f / DM) + EPS);
#pragma unroll
    for (int j = 0; j < 4; ++j) *(GAS v4u*)(orow + j * 512 + lane * 8) = epi::pack8(v[2 * j] * r, v[2 * j + 1] * r);
}
__device__ __forceinline__ void prologue(const Frame& F, KArgs ap, unsigned char* ws) {
    const int gw = F.vcu * NWAVES + F.wave, NGW = F.G * NWAVES;
    float* tab = (float*)(ws + WS_TAB);
    for (int e = blockIdx.x * 512 + F.tid; e < 8192 * 32; e += F.G * 512) {
        const int pos = e >> 5, i = e & 31;
        double rev = (double)pos * ROPE_REV[i]; rev -= floor(rev);
        const double q = rint(rev * 4.0); const double r = (rev - q * 0.25) * 6.283185307179586476925;
        const double r2 = r * r;
        const double sn = r * (1.0 + r2 * (-1.0 / 6 + r2 * (1.0 / 120 + r2 * (-1.0 / 5040 + r2 * (1.0 / 362880 - r2 * (1.0 / 39916800))))));
        const double cn = 1.0 + r2 * (-0.5 + r2 * (1.0 / 24 + r2 * (-1.0 / 720 + r2 * (1.0 / 40320 + r2 * (-1.0 / 3628800 + r2 * (1.0 / 479001600))))));
        const int qi = ((int)q) & 3;
        const double s_ = qi == 0 ? sn : qi == 1 ? cn : qi == 2 ? -sn : -cn;
        const double c_ = qi == 0 ? cn : qi == 1 ? -sn : qi == 2 ? -cn : sn;
        *(GAS f32x2*)(tab + (size_t)e * 2) = (f32x2){(float)c_, (float)s_};
    }
    float* rmem = (float*)(ws + WS_RMEM); bf16* memb = (bf16*)(ws + WS_MEMB);
    for (int m = gw; m < NMEMR; m += NGW) {
        const float* xrow = (m < 1024) ? ap->in[2] + (size_t)m * DM : ap->in[3] + (size_t)(m - 1024) * DM;
        f32x4 v[8]; float s = 0.f;
#pragma unroll
        for (int j = 0; j < 4; ++j) { v[2 * j] = *(const GAS f32x4*)(xrow + j * 512 + F.lane * 8); v[2 * j + 1] = *(const GAS f32x4*)(xrow + j * 512 + F.lane * 8 + 4); }
#pragma unroll
        for (int j = 0; j < 8; ++j) s += (v[j][0] * v[j][0] + v[j][1] * v[j][1]) + (v[j][2] * v[j][2] + v[j][3] * v[j][3]);
        const float r = __builtin_amdgcn_rsqf(wave_sum(s, F.lane) * (1.f / DM) + EPS);
        if (F.lane == 0) rmem[m] = r;
#pragma unroll
        for (int j = 0; j < 4; ++j) *(GAS v4u*)(memb + (size_t)m * DM + j * 512 + F.lane * 8) = epi::pack8(v[2 * j], v[2 * j + 1]);
    }
    bf16* xn = (bf16*)(ws + WS_XN);
    for (int m = gw; m < NTOK; m += NGW) {
        const float* xrow = (m < NPROMPT) ? ap->in[0] + (size_t)m * DM : ap->in[1] + (size_t)(m - NPROMPT) * DM;
        rms_row_to_bf16(xrow, xn + (size_t)m * DM, F.lane);
    }
    convert_layer(F, ap, 0, ws);
}
__device__ __forceinline__ void norm_pass(const Frame& F, KArgs ap, bool first, const float* gpost, unsigned char* ws) {
    const int gw = F.vcu * NWAVES + F.wave, NGW = F.G * NWAVES;
    const bf16* Y = (const bf16*)(ws + WS_Y); bf16* xn = (bf16*)(ws + WS_XN);
    f32x4 g[8];
#pragma unroll
    for (int j = 0; j < 4; ++j) { g[2 * j] = *(const GAS f32x4*)(gpost + j * 512 + F.lane * 8); g[2 * j + 1] = *(const GAS f32x4*)(gpost + j * 512 + F.lane * 8 + 4); }
    for (int m = gw; m < NTOK; m += NGW) {
        const float* xrow = first ? ((m < NPROMPT) ? ap->in[0] + (size_t)m * DM : ap->in[1] + (size_t)(m - NPROMPT) * DM) : ap->out + (size_t)m * DM;
        f32x4 x[8], y[8]; float s = 0.f;
#pragma unroll
        for (int j = 0; j < 4; ++j) { const v4u w = *(const GAS v4u*)(Y + (size_t)m * DM + j * 512 + F.lane * 8);
            y[2 * j] = (f32x4){bf_lo(w.x), bf_hi(w.x), bf_lo(w.y), bf_hi(w.y)}; y[2 * j + 1] = (f32x4){bf_lo(w.z), bf_hi(w.z), bf_lo(w.w), bf_hi(w.w)};
            x[2 * j] = *(const GAS f32x4*)(xrow + j * 512 + F.lane * 8); x[2 * j + 1] = *(const GAS f32x4*)(xrow + j * 512 + F.lane * 8 + 4); }
#pragma unroll
        for (int j = 0; j < 8; ++j) s += (y[j][0] * y[j][0] + y[j][1] * y[j][1]) + (y[j][2] * y[j][2] + y[j][3] * y[j][3]);
        const float r = __builtin_amdgcn_rsqf(wave_sum(s, F.lane) * (1.f / DM) + EPS);
        float s2 = 0.f;
#pragma unroll
        for (int j = 0; j < 8; ++j) { x[j] = x[j] + (y[j] * r) * g[j]; s2 += (x[j][0] * x[j][0] + x[j][1] * x[j][1]) + (x[j][2] * x[j][2] + x[j][3] * x[j][3]); }
        float* orow = ap->out + (size_t)m * DM;
#pragma unroll
        for (int j = 0; j < 4; ++j) { *(GAS f32x4*)(orow + j * 512 + F.lane * 8) = x[2 * j]; *(GAS f32x4*)(orow + j * 512 + F.lane * 8 + 4) = x[2 * j + 1]; }
        const float r2 = __builtin_amdgcn_rsqf(wave_sum(s2, F.lane) * (1.f / DM) + EPS);
#pragma unroll
        for (int j = 0; j < 4; ++j) *(GAS v4u*)(xn + (size_t)m * DM + j * 512 + F.lane * 8) = epi::pack8(x[2 * j] * r2, x[2 * j + 1] * r2);
    }
}

constexpr int PH_PER_LAYER = 9, N_PHASES = 1 + DEPTH * PH_PER_LAYER;
#ifndef PH_MASK
#define PH_MASK 0x3ff
#endif
#define PH_EN(k) ((PH_MASK >> (k)) & 1)
#ifndef SUB_MASK
#define SUB_MASK 7
#endif
#define SUB_EN(k) ((SUB_MASK >> (k)) & 1)
__global__ void __launch_bounds__(NWAVES * 64, 2) fwd(Args args_unused) {
    extern __shared__ __attribute__((aligned(16))) unsigned char lds_raw[];
    (void)args_unused;
    LAS unsigned char* lds0 = (LAS unsigned char*)lds_raw;
    const int wave0 = __builtin_amdgcn_readfirstlane((int)threadIdx.x >> 6);
    volatile LAS unsigned* MISC = (volatile LAS unsigned*)(lds0 + MISC_OFF);
    for (int u = threadIdx.x; u < (XCH_OFF - LDSCTL_OFF) / 4; u += NWAVES * 64) ((LAS unsigned*)(lds0 + LDSCTL_OFF))[u] = 0u;
    __syncthreads();
    int lo, hi; unsigned* barw;
    { KArgs ap = KARGS(); lo = ap->ph_lo; hi = ap->ph_hi; barw = (unsigned*)(ap->ws + WS_CTL) + CW_BAR; }
    XcdBarrier bar; bar.bar = barw; bar.x = 0; bar.st = nullptr;
    if ((hi - lo) > 1) bar = xcd_barrier_post(barw, MISC + 8);
#define IN(k) (lo <= (k) && (k) < hi)
#define SEAM(k) do { if (IN(k) && IN((k) + 1)) { int t_; asm volatile("v_mbcnt_lo_u32_b32 %0, -1, 0\n\tv_mbcnt_hi_u32_b32 %0, -1, %0" : "=v"(t_)); xcd_barrier(bar, wave0 * 64 + t_); } } while (0)
#define PHASE_BASE() KArgs ap = KARGS(); unsigned char* ws = ap->ws; (void)ws; int bx_ = (int)blockIdx.x, G_ = (int)gridDim.x, t_; asm volatile("v_mbcnt_lo_u32_b32 %0, -1, 0\n\tv_mbcnt_hi_u32_b32 %0, -1, %0" : "=v"(t_)); t_ += wave0 * 64; asm volatile("" : "+s"(bx_), "+s"(G_)); const int bx = bx_, G = G_; (void)bx; (void)G; Frame F; F.lds = (LAS unsigned char*)lds_raw; F.tid = t_; F.lane = t_ & 63; F.wave = __builtin_amdgcn_readfirstlane(t_ >> 6); F.G = G; F.vcu = (G % 8 == 0) ? (bx % 8) * (G / 8) + bx / 8 : bx; LAS unsigned char* ring = F.lds + RING_OFF; LAS unsigned char* xl = F.lds + XCH_OFF; (void)ring; (void)xl
#define WSP(T, off) ((T*)(ws + (off)))

    if (PH_EN(0) && IN(0)) { PHASE_BASE(); prologue(F, ap, ws); }
    SEAM(0);

    for (int l = 0; l < DEPTH; ++l) {
        const int p0 = 1 + l * PH_PER_LAYER;
        if (PH_EN(1) && IN(p0 + 0)) { PHASE_BASE();
            if (SUB_EN(0)) { pg8::Gemm g = pg8::plain_gemm(WSP(bf16, WS_XN), DM, ws + WS_W + WO_IN, DM, DM); pg8::StaticOrder S; S.init(NTOK / 256, NZ / 256, G, bx);
#ifdef DBG_PLAIN_Z
              epi::EpiStore<0> E{WSP(bf16, WS_Z), NZ, 0, nullptr}; pg8::gemm_phase<epi::EpiStore<0>, pg8::StaticOrder>(F.tid, ring, xl, g, S, E); }
#else
              epi::EpiZ E{WSP(bf16, WS_Z), WSP(float, WS_SSQ), WSP(const float, WS_TAB)}; pg8::gemm_phase<epi::EpiZ, pg8::StaticOrder>(F.tid, ring, xl, g, S, E); }
#endif
            if (SUB_EN(1)) { pg8::Gemm g = pg8::plain_gemm(WSP(bf16, WS_MEMB), DM, ws + WS_W + WO_MEM, DM, DM); pg8::StaticOrder S; S.init(NMEMR / 256, 4, G, (bx + G - 160 % G) % G);
              epi::EpiStore<1> E{WSP(bf16, WS_MEMK), 1024, 0, WSP(const float, WS_RMEM)}; pg8::gemm_phase<epi::EpiStore<1>, pg8::StaticOrder>(F.tid, ring, xl, g, S, E); }
            if (SUB_EN(2)) { pg8::Gemm g = pg8::plain_gemm(ws + WS_W + WO_MEM + (size_t)1024 * DM * 2, DM, WSP(bf16, WS_MEMB), DM, DM); pg8::StaticOrder S; S.init(4, NMEMR / 256, G, (bx + G - 180 % G) % G);
              epi::EpiStore<2> E{WSP(bf16, WS_MEMVT), NMEMR, 0, WSP(const float, WS_RMEM)}; pg8::gemm_phase<epi::EpiStore<2>, pg8::StaticOrder>(F.tid, ring, xl, g, S, E); }
        }
        SEAM(p0 + 0);
        if (PH_EN(2) && IN(p0 + 1)) { PHASE_BASE();
            if (SUB_EN(0)) { pg8::Gemm g = pg8::plain_gemm(WSP(bf16, WS_Z) + ZC_CQ, NZ, ws + WS_W + WO_UQ, 512, 512); pg8::StaticOrder S; S.init(NTOK / 256, NQC / 256, G, bx);
              epi::EpiLat<0> E{WSP(bf16, WS_Q), WSP(const float, WS_SSQ), WSP(const float, WS_TAB)}; pg8::gemm_phase<epi::EpiLat<0>, pg8::StaticOrder>(F.tid, ring, xl, g, S, E); }
            if (SUB_EN(1)) { pg8::Gemm g = pg8::plain_gemm(WSP(bf16, WS_Z) + ZC_CKV, NZ, ws + WS_W + WO_UKV, 512, 512); pg8::StaticOrder S; S.init(NTOK / 256, NKVC / 256, G, bx);
              epi::EpiLat<1> E{WSP(bf16, WS_KV), WSP(const float, WS_SSQ), WSP(const float, WS_TAB)}; pg8::gemm_phase<epi::EpiLat<1>, pg8::StaticOrder>(F.tid, ring, xl, g, S, E); }
            if (SUB_EN(2)) { pg8::Gemm g; g.A = (const char*)(WSP(bf16, WS_Z) + ZC_QM); g.B = (const char*)WSP(bf16, WS_MEMK); g.a_pm = (long)256 * NZ * 2; g.a_pn = 512; g.b_pn = 512; g.b_sq = (long)256 * 1024 * 2; g.lda = NZ; g.ldb = 1024; g.K = 256;
              pg8::StaticOrder S; S.init(NTOK / 256, 4, G, (bx + G - 64 % G) % G);
              epi::EpiSoftmax E{WSP(bf16, WS_PM)}; pg8::gemm_phase<epi::EpiSoftmax, pg8::StaticOrder>(F.tid, ring, xl, g, S, E); }
        }
        SEAM(p0 + 1);
        if (PH_EN(3) && IN(p0 + 2)) {
            if (SUB_EN(0)) { PHASE_BASE(); for (int n = F.vcu; n < 768; n += G) {
                const int i = n >> 8, v = n & 255, x = v >> 5, j = v & 31;
                int h, qm0, km0, NT;
                if (i < 2) { const int pair = 4 * x + 2 * i + (j >> 4), b = pair >> 3; h = pair & 7; qm0 = b * 4096 + (j & 15) * 256; km0 = b * 4096; NT = 64; }
                else { h = x; qm0 = NPROMPT + j * 256; km0 = NPROMPT; NT = 128; }
                att::Mask mk{0, 0.f};
                att::attn_unit<0>(WSP(bf16, WS_Q), WSP(bf16, WS_KV), WSP(bf16, WS_Z), WSP(bf16, WS_ABC), qm0, km0, NT, h, h * 128, -1.0e30f, 0.f, mk, (LAS char*)ring, F.tid);
            } }
            if (SUB_EN(1)) { PHASE_BASE(); const float* sink = ap->in[13] + l * 8;
              for (int n = F.vcu; n < 768; n += G) {
                const int qblk = n >> 3, h = n & 7;
                const int sstart = qblk < 64 ? (qblk >> 4) * 4096 : NPROMPT, SL = qblk < 64 ? 4096 : 8192;
                const int qm0 = qblk * 256, q0 = qm0 - sstart;
                const int klo = (q0 - 128) < 0 ? 0 : (q0 - 128), khi = (q0 + 384) > SL ? SL : (q0 + 384);
                att::Mask mk; mk.dq = (q0 + (F.tid >> 6) * 32 + (F.lane & 31)) - klo - 4 * (F.lane >> 5); mk.sl = LOG2E * __builtin_amdgcn_exp2f(-(float)(h + 1));
                att::attn_unit<1>(WSP(bf16, WS_Q), WSP(bf16, WS_KV), WSP(bf16, WS_Z), WSP(bf16, WS_ABC), qm0, sstart + klo, (khi - klo) >> 6, h, 1024 + h * 128, sink[h] * LOG2E, 1.f, mk, (LAS char*)ring, F.tid);
              } }
            if (SUB_EN(2)) { PHASE_BASE(); pg8::Gemm g; g.A = (const char*)WSP(bf16, WS_PM); g.B = (const char*)WSP(bf16, WS_MEMVT); g.a_pm = (long)256 * 1024 * 2; g.a_pn = 512; g.b_pn = (long)256 * NMEMR * 2; g.b_sq = 512; g.lda = 1024; g.ldb = NMEMR; g.K = 256;
              pg8::StaticOrder S; S.init(NTOK / 256, 4, G, bx);
              epi::EpiStore<0> E{WSP(bf16, WS_ABC), NABC, 2048, nullptr}; pg8::gemm_phase<epi::EpiStore<0>, pg8::StaticOrder>(F.tid, ring, xl, g, S, E); }
        }
        SEAM(p0 + 2);
        if (PH_EN(4) && IN(p0 + 3)) { PHASE_BASE();
            pg8::Gemm g = pg8::plain_gemm(WSP(bf16, WS_ABC), NABC, ws + WS_W + WO_BR, NABC, NABC); pg8::StaticOrder S; S.init(NTOK / 256, DM / 256, G, bx);
            epi::EpiBranch E{WSP(bf16, WS_MERGED), WSP(const bf16, WS_Z)}; pg8::gemm_phase<epi::EpiBranch, pg8::StaticOrder>(F.tid, ring, xl, g, S, E);
        }
        SEAM(p0 + 3);
        if (PH_EN(5) && IN(p0 + 4)) { PHASE_BASE();
            pg8::Gemm g = pg8::plain_gemm(WSP(bf16, WS_MERGED), DM, ws + WS_W + WO_OUT, DM, DM); pg8::StaticOrder S; S.init(NTOK / 256, DM / 256, G, bx);
            epi::EpiStore<0> E{WSP(bf16, WS_Y), DM, 0, nullptr}; pg8::gemm_phase<epi::EpiStore<0>, pg8::StaticOrder>(F.tid, ring, xl, g, S, E);
        }
        SEAM(p0 + 4);
        if (PH_EN(6) && IN(p0 + 5)) { PHASE_BASE(); norm_pass(F, ap, l == 0, ap->in[5] + l * DM, ws); }
        SEAM(p0 + 5);
        if (PH_EN(7) && IN(p0 + 6)) { PHASE_BASE();
            pg8::Gemm g = pg8::plain_gemm(WSP(bf16, WS_XN), DM, ws + WS_W + WO_UP, DM, DM); pg8::StaticOrder S; S.init(NTOK / 256, DFF / 256, G, bx);
            epi::EpiStore<3> E{WSP(bf16, WS_U), DFF, 0, nullptr}; pg8::gemm_phase<epi::EpiStore<3>, pg8::StaticOrder>(F.tid, ring, xl, g, S, E);
        }
        SEAM(p0 + 6);
        if (PH_EN(8) && IN(p0 + 7)) { PHASE_BASE();
            pg8::Gemm g = pg8::plain_gemm(WSP(bf16, WS_U), DFF, ws + WS_W + WO_DOWN, DFF, DFF); pg8::StaticOrder S; S.init(NTOK / 256, DM / 256, G, bx);
            epi::EpiStore<0> E{WSP(bf16, WS_Y), DM, 0, nullptr}; pg8::gemm_phase<epi::EpiStore<0>, pg8::StaticOrder>(F.tid, ring, xl, g, S, E);
        }
        SEAM(p0 + 7);
        if (PH_EN(9) && IN(p0 + 8)) { PHASE_BASE(); norm_pass(F, ap, false, ap->in[19] + l * DM, ws); if (l + 1 < DEPTH) convert_layer(F, ap, l + 1, ws); }
        SEAM(p0 + 8);
    }
#undef IN
#undef SEAM
}


#ifndef DBG_LAST
#define DBG_LAST -1
#endif
#ifndef DBG_DUMP_MASK
#define DBG_DUMP_MASK 0xff
#endif
#if DBG_LAST >= 0
__global__ void __launch_bounds__(256) dbg_dump(float* out, const unsigned char* ws) {
    const bf16* Z = (const bf16*)(ws + WS_Z); const bf16* Q = (const bf16*)(ws + WS_Q); const bf16* KV = (const bf16*)(ws + WS_KV); const bf16* PM = (const bf16*)(ws + WS_PM);
    const bf16* ABC = (const bf16*)(ws + WS_ABC); const bf16* MG = (const bf16*)(ws + WS_MERGED); const bf16* XN = (const bf16*)(ws + WS_XN); const bf16* Y = (const bf16*)(ws + WS_Y);
    for (size_t e = (size_t)blockIdx.x * 256 + threadIdx.x; e < (size_t)NTOK * DM; e += (size_t)gridDim.x * 256) {
        const size_t m = e / DM; const int c = (int)(e % DM); float v = 0.f;
        auto f = [](bf16 b) { return __uint_as_float((unsigned)b << 16); };
        if (DBG_DUMP_MASK & 1) v += f(XN[m * DM + c]);
        if (DBG_DUMP_MASK & 2) v += f(Z[m * NZ + c]) + f(Z[m * NZ + 2048 + (c % 1792)]);
        if (DBG_DUMP_MASK & 4) v += f(Z[m * NZ + ZC_G + c]) + f(Z[m * NZ + ZC_G + 2048 + c]) + f(Z[m * NZ + ZC_G + 4096 + c]);
        if (DBG_DUMP_MASK & 8) v += f(Q[m * NQC + (c % NQC)]) + f(KV[m * NKVC + c]);
        if (DBG_DUMP_MASK & 16) v += f(PM[m * 1024 + (c & 1023)]);
        if (DBG_DUMP_MASK & 32) v += f(ABC[m * NABC + c]) + f(ABC[m * NABC + 1024 + c]);
        if (DBG_DUMP_MASK & 64) v += f(MG[m * DM + c]);
        if (DBG_DUMP_MASK & 128) v += f(Y[m * DM + c]);
        if (DBG_DUMP_MASK & 256) v += f(((const bf16*)(ws + WS_W))[e]) + f(((const bf16*)(ws + WS_W))[e + 20000000]);
        out[e] = v;
    }
}
#endif

extern "C" void kernel_launch(void* const* d_in, const int* in_sizes, int n_in, void* d_out, int out_size, void* d_ws, size_t ws_size, hipStream_t stream) {
    static int grid = 0;
    if (grid == 0) {
        if (n_in != 22 || out_size != NTOK * DM || ws_size < WS_END) { fprintf(stderr, "kernel_launch: unexpected shapes (n_in %d out %d ws %zu)\n", n_in, out_size, ws_size); grid = -1; return; }
        int dev = 0, cus = 0, per_cu = 0;
        if (hipGetDevice(&dev) != hipSuccess || hipDeviceGetAttribute(&cus, hipDeviceAttributeMultiprocessorCount, dev) != hipSuccess) { grid = -1; return; }
        if (hipFuncSetAttribute((const void*)fwd, hipFuncAttributeMaxDynamicSharedMemorySize, LDS_BYTES) != hipSuccess) { fprintf(stderr, "kernel_launch: hipFuncSetAttribute failed\n"); grid = -1; return; }
        if (hipOccupancyMaxActiveBlocksPerMultiprocessor(&per_cu, (const void*)fwd, NWAVES * 64, LDS_BYTES) != hipSuccess || per_cu < 1)
            fprintf(stderr, "kernel_launch: note: occupancy query reports %d workgroups per CU\n", per_cu);
        (void)hipGetLastError();
        grid = cus;
    }
    if (grid < 0) return;
    (void)in_sizes;
    if (hipMemsetAsync((char*)d_ws + WS_CTL, 0, CTL_ZERO_BYTES, stream) != hipSuccess) return;
    Args a{};
    for (int i = 0; i < 22; ++i) a.in[i] = (const float*)d_in[i];
    a.out = (float*)d_out; a.ws = (unsigned char*)d_ws;
#if MK_N_LAUNCHES == 1
    a.ph_lo = 0; a.ph_hi = N_PHASES;
    hipLaunchKernelGGL(fwd, dim3(grid), dim3(NWAVES * 64), LDS_BYTES, stream, a);
#else
#if DBG_LAST >= 0
    for (int k = 0; k <= DBG_LAST; ++k) { a.ph_lo = k; a.ph_hi = k + 1; hipLaunchKernelGGL(fwd, dim3(grid), dim3(NWAVES * 64), LDS_BYTES, stream, a); }
    hipLaunchKernelGGL(dbg_dump, dim3(2048), dim3(256), 0, stream, (float*)d_out, (const unsigned char*)d_ws);
#else
    for (int k = 0; k < N_PHASES; ++k) { a.ph_lo = k; a.ph_hi = k + 1; hipLaunchKernelGGL(fwd, dim3(grid), dim3(NWAVES * 64), LDS_BYTES, stream, a); }
#endif
#endif
    const hipError_t le = hipPeekAtLastError();
    if (le != hipSuccess) fprintf(stderr, "kernel_launch: launch failed: %s\n", hipGetErrorName(le));
}
```

```cpp
#include <hip/hip_runtime.h>
#include <cstdio>
#include <cstdint>

#define DBG_LAST -1
#define DBG_DUMP_MASK 0x6

#ifndef MK_N_LAUNCHES
#define MK_N_LAUNCHES 1
#endif

constexpr int DM = 2048, NTOK = 24576, NPROMPT = 16384, DEPTH = 4, DFF = 8192;
constexpr int NZ = 9984, NZSRC = 9792;
constexpr int ZC_CQ = 0, ZC_CKV = 512, ZC_QW = 1024, ZC_KW = 2048, ZC_VW = 2304, ZC_QM = 2560, ZC_KR = 3584, ZC_G = 3840;
constexpr int NQC = 1536, NKVC = 2048, NMEMR = 1280, NABC = 3072;
constexpr float EPS = 1e-6f;
constexpr float LOG2E = 1.4426950408889634f;
constexpr float C_W = 0.088388347648318440f * LOG2E;
constexpr float C_M = 0.0625f * LOG2E;
constexpr float C_Q = 0.072168783648703220f * LOG2E;

constexpr size_t MiB = 1u << 20;
constexpr size_t WS_CTL = 0, CTL_ZERO_BYTES = 1 * MiB;
constexpr size_t WS_TAB = 2 * MiB;
constexpr size_t WS_RMEM = 4 * MiB;
constexpr size_t WS_SSQ = 6 * MiB;
constexpr size_t WS_MEMB = 8 * MiB;
constexpr size_t WS_MEMK = 13 * MiB;
constexpr size_t WS_MEMVT = 16 * MiB;
constexpr size_t WS_W = 32 * MiB;
constexpr size_t WO_IN = 0, WO_UQ = WO_IN + (size_t)NZ * DM * 2, WO_UKV = WO_UQ + (size_t)NQC * 512 * 2, WO_MEM = WO_UKV + (size_t)NKVC * 512 * 2,
                 WO_BR = WO_MEM + (size_t)2048 * DM * 2, WO_OUT = WO_BR + (size_t)DM * NABC * 2, WO_UP = WO_OUT + (size_t)DM * DM * 2,
                 WO_DOWN = WO_UP + (size_t)DFF * DM * 2, WO_END = WO_DOWN + (size_t)DM * DFF * 2;
static_assert(WO_END <= 136 * MiB, "weights region");
constexpr size_t WS_XN = 168 * MiB;
constexpr size_t WS_Z = 264 * MiB;
constexpr size_t WS_U = WS_Z;
constexpr size_t WS_Q = 732 * MiB;
constexpr size_t WS_KV = 804 * MiB;
constexpr size_t WS_PM = 900 * MiB;
constexpr size_t WS_ABC = 948 * MiB;
constexpr size_t WS_MERGED = 732 * MiB;
constexpr size_t WS_Y = 828 * MiB;
constexpr size_t WS_END = 1092 * MiB;
static_assert(WS_Z + (size_t)NTOK * NZ * 2 <= WS_Q && WS_MERGED + (size_t)NTOK * DM * 2 <= WS_Y && WS_Y + (size_t)NTOK * DM * 2 <= WS_ABC, "ws map");
constexpr int CW_TMO = 0, CW_BAR = 4096;

constexpr int RING_OFF = 0, RING_BYTES = 131072;
constexpr int LDSCTL_OFF = RING_BYTES, MISC_OFF = LDSCTL_OFF + 320;
constexpr int XCH_OFF = RING_BYTES + 1024;
constexpr int LDS_BYTES = 147456;
static_assert(XCH_OFF + 8192 <= LDS_BYTES, "LDS map");
constexpr int NWAVES = 8;

#define GAS __attribute__((address_space(1)))
#define LAS __attribute__((address_space(3)))
typedef unsigned short bf16;
typedef unsigned v4u __attribute__((ext_vector_type(4)));
typedef float f32x4 __attribute__((ext_vector_type(4)));
typedef float f32x2 __attribute__((ext_vector_type(2)));
typedef short bf16x8 __attribute__((ext_vector_type(8)));
typedef GAS unsigned gu32;
#define RLX_AGENT __ATOMIC_RELAXED, __HIP_MEMORY_SCOPE_AGENT
#define LDS_WAIT() asm volatile("s_waitcnt lgkmcnt(0)" ::: "memory")
#define VM_WAIT() asm volatile("s_waitcnt vmcnt(0)" ::: "memory")

typedef float f32x2_t __attribute__((ext_vector_type(2))); typedef __bf16 bf16x2_t __attribute__((ext_vector_type(2)));
__device__ __forceinline__ unsigned cvt_pk_bf16(float lo, float hi) { const f32x2_t v = {lo, hi}; const bf16x2_t b = __builtin_convertvector(v, bf16x2_t); return __builtin_bit_cast(unsigned, b); }
__device__ __forceinline__ float bf_lo(unsigned w) { return __uint_as_float(w << 16); }
__device__ __forceinline__ float bf_hi(unsigned w) { return __uint_as_float(w & 0xffff0000u); }
__device__ __forceinline__ float shfl_xor_l(float v, int m, int lane) { return __int_as_float(__builtin_amdgcn_ds_bpermute((lane ^ m) << 2, __float_as_int(v))); }
__device__ __forceinline__ int seq_pos(int m) { return m < NPROMPT ? (m & 4095) : (m - NPROMPT); }
__device__ __forceinline__ int seq_of_panel(int pm) { return pm < 64 ? (pm >> 4) : 4; }

namespace pg8 {
#define PG8_LAS __attribute__((address_space(3)))
typedef unsigned short bf16_t;
typedef short bf16x8 __attribute__((ext_vector_type(8)));
typedef float f32x4 __attribute__((ext_vector_type(4)));
typedef unsigned u32x4 __attribute__((ext_vector_type(4)));
constexpr int BM = 256, BK = 64, HALF = 128, HTB = HALF * BK * 2, STAGE_BYTES = 8 * HTB, NXCD = 8, WGM = 8;

__host__ __device__ __forceinline__ int lds_byte(int r, int c) { const int st = (r >> 4) * 2 + (c >> 5), rr = r & 15, cc = c & 31, ob = rr * 64 + cc * 2; return st * 1024 + (ob ^ (((ob >> 9) & 1) << 5)); }
__host__ __device__ __forceinline__ void stage_rc(int b, int& R, int& C) { const int st = b / 1024, sb = b % 1024, swz = sb ^ (((sb >> 9) & 1) << 5); R = (st >> 1) * 16 + swz / 64; C = (st & 1) * 32 + (swz % 64) / 2; }
__host__ __device__ __forceinline__ int perm32(int rho) { const int n = rho >> 4, i = rho & 15; return 8 * (i >> 2) + 4 * n + (i & 3); }

struct Unit { int pm, pn; };
struct Gemm { const char* A; const char* B; long a_pm, a_pn, b_pn, b_sq; int lda, ldb, K;
    __device__ __forceinline__ const char* aptr(const Unit& u) const { return A + (long)u.pm * a_pm + (long)u.pn * a_pn; }
    __device__ __forceinline__ const char* bptr(const Unit& u) const { return B + (long)u.pn * b_pn + (long)seq_of_panel(u.pm) * b_sq; } };
__device__ __forceinline__ Gemm plain_gemm(const void* A, int lda, const void* B, int ldb, int K) {
    Gemm g; g.A = (const char*)A; g.B = (const char*)B; g.a_pm = (long)BM * lda * 2; g.a_pn = 0; g.b_pn = (long)BM * ldb * 2; g.b_sq = 0; g.lda = lda; g.ldb = ldb; g.K = K; return g; }

struct StaticOrder {
    int nM, nN, nwg, G, c;
    __host__ __device__ void init(int nM_, int nN_, int G_, int c_) { nM = nM_; nN = nN_; nwg = nM * nN; G = G_; c = c_; }
    __host__ __device__ bool next(int i, Unit& u) const {
        const long L = (long)i * G + c; if (L >= nwg) return false;
        int wgid = (int)L; { const int q = nwg / NXCD, r = nwg % NXCD, xcd = wgid % NXCD, off = wgid / NXCD; wgid = (xcd < r ? xcd * (q + 1) : r * (q + 1) + (xcd - r) * q) + off; }
        const int nig = WGM * nN, gid = wgid / nig, fm = gid * WGM, gsz = (nM - fm) < WGM ? (nM - fm) : WGM;
        u.pm = fm + ((wgid % nig) % gsz); u.pn = (wgid % nig) / gsz; return true;
    }
};

typedef f32x4 Acc[2][2][4][2];

template <class Epi, class Sched, bool ALIGN_EPI = true, bool SP2 = true>
__device__ __forceinline__ void gemm_phase(int tid_in, PG8_LAS unsigned char* lds, PG8_LAS unsigned char* xlds, const Gemm g, const Sched& S, const Epi& E) {
    int tid_ = tid_in; asm volatile("" : "+v"(tid_));
    const int tid = tid_, wid = __builtin_amdgcn_readfirstlane(tid >> 6), lane = tid & 63, wr = wid >> 2, wc = wid & 3, fr = lane & 15, fq = lane >> 4;
    const int K = g.K, nt = K / BK;
    unsigned voffA[2], voffB[2];
#pragma unroll
    for (int i = 0; i < 2; ++i) { int R, C; stage_rc(tid * 16 + i * 8192, R, C); const int Rb = Epi::PERM ? ((R & ~31) + perm32(R & 31)) : R;
        voffA[i] = (unsigned)(R * g.lda + C) * 2u; voffB[i] = (unsigned)(Rb * g.ldb + C) * 2u; }
    const size_t kstep = (size_t)(BK * 2);
    const size_t hstepA = (size_t)HALF * g.lda * 2, hstepB = (size_t)HALF * g.ldb * 2;
    const unsigned ldsw = (unsigned)wid * 1024u;
    const int aoff = lds_byte(wr * 64 + fr, fq * 8), boff = lds_byte(wc * 32 + fr, fq * 8);
#define PG8_SA(b, h) (((b) * 2 + (h)) * HTB)
#define PG8_SB(b, h) ((4 + (b) * 2 + (h)) * HTB)
#define PG8_STAGE(bufoff, gbase, voff) do { _Pragma("unroll") for (int _i = 0; _i < 2; ++_i) \
        __builtin_amdgcn_global_load_lds((const unsigned*)((const char*)(gbase) + (voff)[_i]), (PG8_LAS unsigned*)(lds + (bufoff) + ldsw + _i * 8192), 16, 0, 0); } while (0)
#define PG8_LDA(dst, b, h) do { _Pragma("unroll") for (int m = 0; m < 4; ++m) _Pragma("unroll") for (int k = 0; k < 2; ++k) dst[m][k] = *(const PG8_LAS bf16x8*)(lds + PG8_SA(b, h) + aoff + m * 2048 + k * 1024); } while (0)
#define PG8_LDB(dst, b, h) do { _Pragma("unroll") for (int n = 0; n < 2; ++n) _Pragma("unroll") for (int k = 0; k < 2; ++k) dst[n][k] = *(const PG8_LAS bf16x8*)(lds + PG8_SB(b, h) + boff + n * 2048 + k * 1024); } while (0)
#define PG8_MMA(ai, bj, At, Bt) do { __builtin_amdgcn_s_setprio(1); _Pragma("unroll") for (int m = 0; m < 4; ++m) _Pragma("unroll") for (int n = 0; n < 2; ++n) _Pragma("unroll") for (int k = 0; k < 2; ++k) \
        acc[ai][bj][m][n] = __builtin_amdgcn_mfma_f32_16x16x32_bf16(Bt[n][k], At[m][k], acc[ai][bj][m][n], 0, 0, 0); __builtin_amdgcn_s_setprio(0); } while (0)
#define PG8_WAIT_V(n) asm volatile("s_waitcnt vmcnt(" #n ")" ::: "memory")
#define PG8_WAIT_L(n) asm volatile("s_waitcnt lgkmcnt(" #n ")" ::: "memory")
#define PG8_BAR __builtin_amdgcn_s_barrier()
#define PG8_SCHED __builtin_amdgcn_sched_barrier(0)
    Unit cur, nxt; int ui = 0;
    if (!S.next(0, cur)) return;
    f32x4 acc[2][2][4][2];
#pragma unroll
    for (int a = 0; a < 2; ++a)
#pragma unroll
        for (int b = 0; b < 2; ++b)
#pragma unroll
            for (int m = 0; m < 4; ++m)
#pragma unroll
                for (int n = 0; n < 2; ++n) acc[a][b][m][n] = (f32x4){0.f, 0.f, 0.f, 0.f};
    bf16x8 At[4][2], B0[2][2], B1[2][2];
    const char* cA = g.aptr(cur); const char* cB = g.bptr(cur);
    if constexpr (SP2) {
        PG8_STAGE(PG8_SB(0, 0), cB, voffB); PG8_STAGE(PG8_SB(0, 1), cB + hstepB, voffB); PG8_STAGE(PG8_SA(0, 0), cA, voffA); PG8_STAGE(PG8_SA(0, 1), cA + hstepA, voffA);
        if (wr == 1) PG8_BAR;
        PG8_WAIT_V(2); PG8_BAR;
        PG8_STAGE(PG8_SB(1, 0), cB + kstep, voffB); PG8_STAGE(PG8_SA(1, 0), cA + kstep, voffA); PG8_STAGE(PG8_SB(1, 1), cB + hstepB + kstep, voffB);
        PG8_WAIT_V(6); PG8_BAR;
    } else {
        PG8_STAGE(PG8_SB(0, 0), cB, voffB); PG8_STAGE(PG8_SA(0, 0), cA, voffA); PG8_STAGE(PG8_SB(0, 1), cB + hstepB, voffB); PG8_STAGE(PG8_SA(0, 1), cA + hstepA, voffA);
        if (wr == 1) PG8_BAR;
        PG8_WAIT_V(4); PG8_BAR;
        PG8_STAGE(PG8_SB(1, 0), cB + kstep, voffB); PG8_STAGE(PG8_SA(1, 0), cA + kstep, voffA); PG8_STAGE(PG8_SB(1, 1), cB + hstepB + kstep, voffB);
        PG8_WAIT_V(6); PG8_BAR;
    }
    for (;;) {
        const bool has_next = S.next(ui + 1, nxt);
        const char* nA = has_next ? g.aptr(nxt) : cA; const char* nB = has_next ? g.bptr(nxt) : cB;
        for (int t = 0; t < nt; t += 2) {
            const bool last = (t == nt - 2);
            if constexpr (Epi::HAS_MID) { if (t == Epi::MID1 || t == Epi::MID2) E.mid(acc, cur, t, wr, wc, fr, fq); }
            const char* a1 = cA + (size_t)(t + 1) * kstep;
            const char* a2 = last ? nA : cA + (size_t)(t + 2) * kstep; const char* b2 = last ? nB : cB + (size_t)(t + 2) * kstep;
            const char* a3 = a2 + kstep; const char* b3 = b2 + kstep;
            if constexpr (SP2) {
            PG8_LDB(B0, 0, 0); PG8_LDB(B1, 0, 1); PG8_SCHED; PG8_LDA(At, 0, 0); PG8_STAGE(PG8_SA(1, 1), a1 + hstepA, voffA);
            PG8_WAIT_V(8); PG8_WAIT_L(0); PG8_BAR; PG8_MMA(0, 0, At, B0); PG8_MMA(0, 1, At, B1); PG8_BAR; PG8_SCHED;
            PG8_LDA(At, 0, 1); PG8_STAGE(PG8_SB(0, 0), b2, voffB); PG8_STAGE(PG8_SB(0, 1), b2 + hstepB, voffB); PG8_STAGE(PG8_SA(0, 0), a2, voffA);
            PG8_WAIT_V(8); PG8_WAIT_L(0); PG8_BAR; PG8_MMA(1, 0, At, B0); PG8_MMA(1, 1, At, B1); PG8_BAR; PG8_SCHED;
            PG8_LDB(B0, 1, 0); PG8_LDB(B1, 1, 1); PG8_SCHED; PG8_LDA(At, 1, 0); PG8_STAGE(PG8_SA(0, 1), a2 + hstepA, voffA);
            PG8_WAIT_V(8); PG8_WAIT_L(0); PG8_BAR; PG8_MMA(0, 0, At, B0); PG8_MMA(0, 1, At, B1); PG8_BAR; PG8_SCHED;
            PG8_LDA(At, 1, 1); PG8_STAGE(PG8_SB(1, 0), b3, voffB); PG8_STAGE(PG8_SB(1, 1), b3 + hstepB, voffB); PG8_STAGE(PG8_SA(1, 0), a3, voffA);
            PG8_WAIT_V(8); PG8_WAIT_L(0); PG8_BAR; PG8_MMA(1, 0, At, B0); PG8_MMA(1, 1, At, B1); PG8_BAR; PG8_SCHED;
            } else {
            PG8_LDB(B0, 0, 0); PG8_SCHED; PG8_LDA(At, 0, 0); PG8_STAGE(PG8_SA(1, 1), a1 + hstepA, voffA);
            PG8_WAIT_L(8); PG8_BAR; PG8_WAIT_L(0); PG8_MMA(0, 0, At, B0); PG8_BAR; PG8_SCHED;
            PG8_LDB(B1, 0, 1); PG8_STAGE(PG8_SB(0, 0), b2, voffB);
            PG8_BAR; PG8_WAIT_L(0); PG8_MMA(0, 1, At, B1); PG8_BAR;
            PG8_LDA(At, 0, 1); PG8_STAGE(PG8_SA(0, 0), a2, voffA);
            PG8_BAR; PG8_WAIT_L(0); PG8_MMA(1, 0, At, B0); PG8_BAR; PG8_SCHED;
            PG8_STAGE(PG8_SB(0, 1), b2 + hstepB, voffB);
            PG8_WAIT_V(6); PG8_BAR; PG8_MMA(1, 1, At, B1); PG8_BAR;
            PG8_LDB(B0, 1, 0); PG8_SCHED; PG8_LDA(At, 1, 0); PG8_STAGE(PG8_SA(0, 1), a2 + hstepA, voffA);
            PG8_WAIT_L(8); PG8_BAR; PG8_WAIT_L(0); PG8_MMA(0, 0, At, B0); PG8_BAR; PG8_SCHED;
            PG8_LDB(B1, 1, 1); PG8_STAGE(PG8_SB(1, 0), b3, voffB);
            PG8_BAR; PG8_WAIT_L(0); PG8_MMA(0, 1, At, B1); PG8_BAR;
            PG8_LDA(At, 1, 1); PG8_STAGE(PG8_SA(1, 0), a3, voffA);
            PG8_BAR; PG8_WAIT_L(0); PG8_MMA(1, 0, At, B0); PG8_BAR; PG8_SCHED;
            PG8_STAGE(PG8_SB(1, 1), b3 + hstepB, voffB);
            PG8_WAIT_V(6); PG8_BAR; PG8_MMA(1, 1, At, B1); PG8_BAR;
            }
        }
        if constexpr (ALIGN_EPI) { if (wr == 0) PG8_BAR; }
        E(acc, cur, wr, wc, fr, fq, xlds, wid, lane);
        if (!has_next) break;
#pragma unroll
        for (int a = 0; a < 2; ++a)
#pragma unroll
            for (int b = 0; b < 2; ++b)
#pragma unroll
                for (int m = 0; m < 4; ++m)
#pragma unroll
                    for (int n = 0; n < 2; ++n) acc[a][b][m][n] = (f32x4){0.f, 0.f, 0.f, 0.f};
        cur = nxt; cA = nA; cB = nB; ++ui;
        if constexpr (ALIGN_EPI) { if (wr == 1) PG8_BAR; }
    }
    PG8_WAIT_V(0);
    if constexpr (!ALIGN_EPI) { if (wr == 0) PG8_BAR; }
    PG8_BAR;
#undef PG8_SA
#undef PG8_SB
#undef PG8_STAGE
#undef PG8_LDA
#undef PG8_LDB
#undef PG8_MMA
#undef PG8_WAIT_V
#undef PG8_WAIT_L
#undef PG8_BAR
#undef PG8_SCHED
}
}

namespace epi {
using pg8::Acc; using pg8::Unit; using pg8::HALF; using pg8::BM;
typedef float f32x2v __attribute__((ext_vector_type(2)));
#define EPI_COMMON static constexpr bool PERM = true;
#define EPI_PIN(a, b) asm volatile("" : "+v"(a), "+v"(b))
#define EPI_NOMID static constexpr bool HAS_MID = false; static constexpr int MID1 = -1, MID2 = -1;
__device__ __forceinline__ v4u pack8(const f32x4 v0, const f32x4 v1) { v4u w; w.x = cvt_pk_bf16(v0[0], v0[1]); w.y = cvt_pk_bf16(v0[2], v0[3]); w.z = cvt_pk_bf16(v1[0], v1[1]); w.w = cvt_pk_bf16(v1[2], v1[3]); return w; }
__device__ __forceinline__ void rope8(f32x4& v0, f32x4& v1, const f32x4 cs0, const f32x4 cs1, const f32x4 cs2, const f32x4 cs3) {
    (void)cs2; (void)cs3;
    const float a0 = v0[0] * cs0[0] - v0[1] * cs0[1], b0 = v0[0] * cs0[1] + v0[1] * cs0[0];
    const float a1 = v0[2] * cs0[2] - v0[3] * cs0[3], b1 = v0[2] * cs0[3] + v0[3] * cs0[2];
    const float a2 = v1[0] * cs1[0] - v1[1] * cs1[1], b2 = v1[0] * cs1[1] + v1[1] * cs1[0];
    const float a3 = v1[2] * cs1[2] - v1[3] * cs1[3], b3 = v1[2] * cs1[3] + v1[3] * cs1[2];
    v0 = (f32x4){a0, b0, a1, b1}; v1 = (f32x4){a2, b2, a3, b3};
}
__device__ __forceinline__ float sigmoidf_fast(float v) { return __builtin_amdgcn_rcpf(1.f + __builtin_amdgcn_exp2f(-LOG2E * v)); }

struct EpiZ { EPI_COMMON EPI_NOMID
    bf16* Z; float* SSQ; const float* tab;
    __device__ __forceinline__ void operator()(Acc& acc, const Unit& u, int wr, int wc, int fr, int fq, LAS unsigned char*, int, int lane) const {
        const int pn = u.pn; int row0 = u.pm * BM + wr * 64 + fr, col0 = pn * BM + wc * 32 + 8 * fq; EPI_PIN(row0, col0);
        if (pn >= 15) {
#pragma unroll
            for (int ai = 0; ai < 2; ++ai)
#pragma unroll
                for (int m = 0; m < 4; ++m) { bf16* rowp = Z + (size_t)(row0 + ai * HALF + m * 16) * NZ + col0;
#pragma unroll
                    for (int bj = 0; bj < 2; ++bj) { f32x4 v0 = acc[ai][bj][m][0], v1 = acc[ai][bj][m][1];
#pragma unroll
                        for (int j = 0; j < 4; ++j) { v0[j] = sigmoidf_fast(v0[j]); v1[j] = sigmoidf_fast(v1[j]); }
                        *(v4u*)(rowp + bj * HALF) = pack8(v0, v1); } }
        } else if (pn == 14) {
            const int i0 = 16 * (wc & 1) + 4 * fq;
#pragma unroll
            for (int ai = 0; ai < 2; ++ai)
#pragma unroll
                for (int m = 0; m < 4; ++m) { const int row = row0 + ai * HALF + m * 16; bf16* rowp = Z + (size_t)row * NZ + col0;
                    f32x4 v0 = acc[ai][0][m][0], v1 = acc[ai][0][m][1];
                    if (wc < 2) { const f32x4* cs = (const f32x4*)(tab + ((size_t)seq_pos(row) * 32 + i0) * 2); rope8(v0, v1, cs[0], cs[1], cs[0], cs[0]); }
                    *(v4u*)(rowp) = pack8(v0, v1);
                    *(v4u*)(rowp + HALF) = pack8(acc[ai][1][m][0], acc[ai][1][m][1]); }
        } else {
            const float sc = (pn >= 4 && pn < 8) ? C_W : ((pn >= 10) ? C_M : 1.f);
#pragma unroll
            for (int ai = 0; ai < 2; ++ai)
#pragma unroll
                for (int m = 0; m < 4; ++m) { const int row = row0 + ai * HALF + m * 16; bf16* rowp = Z + (size_t)row * NZ + col0; float ss = 0.f;
#pragma unroll
                    for (int bj = 0; bj < 2; ++bj) { const f32x4 v0 = acc[ai][bj][m][0] * sc, v1 = acc[ai][bj][m][1] * sc;
                        ss += (v0[0] * v0[0] + v0[1] * v0[1]) + (v0[2] * v0[2] + v0[3] * v0[3]) + (v1[0] * v1[0] + v1[1] * v1[1]) + (v1[2] * v1[2] + v1[3] * v1[3]);
                        *(v4u*)(rowp + bj * HALF) = pack8(v0, v1); }
                    if (pn < 4) { ss += shfl_xor_l(ss, 16, lane); ss += shfl_xor_l(ss, 32, lane); if (fq == 0) SSQ[(size_t)row * 16 + pn * 4 + wc] = ss; } }
        }
    }
};
template <int WHICH  > struct EpiLat { EPI_COMMON EPI_NOMID
    bf16* O; const float* SSQ; const float* tab;
    __device__ __forceinline__ void operator()(Acc& acc, const Unit& u, int wr, int wc, int fr, int fq, LAS unsigned char*, int, int) const {
        constexpr int LDC = WHICH == 0 ? NQC : NKVC;
        const int pn = u.pn; int row0 = u.pm * BM + wr * 64 + fr, col0 = pn * BM + wc * 32 + 8 * fq; EPI_PIN(row0, col0);
        const int i0 = 16 * (wc & 1) + 4 * fq;
#pragma unroll
        for (int ai = 0; ai < 2; ++ai)
#pragma unroll
            for (int m = 0; m < 4; ++m) { const int row = row0 + ai * HALF + m * 16; bf16* rowp = O + (size_t)row * LDC + col0;
                const f32x4* sp = (const f32x4*)(SSQ + (size_t)row * 16 + WHICH * 8); const f32x4 s0 = sp[0], s1 = sp[1];
                const float ssum = ((s0[0] + s0[1]) + (s0[2] + s0[3])) + ((s1[0] + s1[1]) + (s1[2] + s1[3]));
                const float rs = __builtin_amdgcn_rsqf(ssum * (1.f / 512.f) + EPS) * (WHICH == 0 ? C_Q : 1.f);
#pragma unroll
                for (int bj = 0; bj < 2; ++bj) { f32x4 v0 = acc[ai][bj][m][0] * rs, v1 = acc[ai][bj][m][1] * rs;
                    if (WHICH == 0 && pn >= 4) { const f32x4* cs = (const f32x4*)(tab + ((size_t)seq_pos(row) * 32 + i0) * 2); rope8(v0, v1, cs[0], cs[1], cs[0], cs[0]); }
                    *(v4u*)(rowp + bj * HALF) = pack8(v0, v1); } }
    }
};
template <int MODE> struct EpiStore { EPI_COMMON EPI_NOMID
    bf16* O; int ldc; int col_off; const float* rs;
    __device__ __forceinline__ void operator()(Acc& acc, const Unit& u, int wr, int wc, int fr, int fq, LAS unsigned char*, int, int) const {
        int row0 = u.pm * BM + wr * 64 + fr, ct = u.pn * BM + wc * 32 + 8 * fq; EPI_PIN(row0, ct); const int col0 = col_off + ct;
        f32x4 cs[2][2];
        if (MODE == 2) {
#pragma unroll
            for (int bj = 0; bj < 2; ++bj) { cs[bj][0] = *(const f32x4*)(rs + ct + bj * HALF); cs[bj][1] = *(const f32x4*)(rs + ct + bj * HALF + 4); } }
#pragma unroll
        for (int ai = 0; ai < 2; ++ai)
#pragma unroll
            for (int m = 0; m < 4; ++m) { const int row = row0 + ai * HALF + m * 16; bf16* rowp = O + (size_t)row * ldc + col0;
                float r = 1.f; if (MODE == 1) r = rs[row];
#pragma unroll
                for (int bj = 0; bj < 2; ++bj) { f32x4 v0 = acc[ai][bj][m][0], v1 = acc[ai][bj][m][1];
                    if (MODE == 1) { v0 = v0 * r; v1 = v1 * r; }
                    if (MODE == 2) { v0 = v0 * cs[bj][0]; v1 = v1 * cs[bj][1]; }
                    if (MODE == 3) {
#pragma unroll
                        for (int j = 0; j < 4; ++j) { const float a = fmaxf(v0[j], 0.f), b = fmaxf(v1[j], 0.f); v0[j] = a * a; v1[j] = b * b; } }
                    *(v4u*)(rowp + bj * HALF) = pack8(v0, v1); } }
    }
};
struct EpiSoftmax { EPI_COMMON EPI_NOMID
    bf16* O;
    __device__ __forceinline__ void operator()(Acc& acc, const Unit& u, int wr, int wc, int fr, int fq, LAS unsigned char* xl, int, int lane) const {
        LAS float* MX = (LAS float*)xl; LAS float* SM = (LAS float*)(xl + 4096);
        int row0 = u.pm * BM + wr * 64 + fr, col0 = u.pn * BM + wc * 32 + 8 * fq; EPI_PIN(row0, col0);
#pragma unroll
        for (int ai = 0; ai < 2; ++ai)
#pragma unroll
            for (int m = 0; m < 4; ++m) { float mx = -3.0e38f;
#pragma unroll
                for (int bj = 0; bj < 2; ++bj)
#pragma unroll
                    for (int n = 0; n < 2; ++n) { const f32x4 x = acc[ai][bj][m][n]; mx = fmaxf(mx, fmaxf(fmaxf(x[0], x[1]), fmaxf(x[2], x[3]))); }
                mx = fmaxf(mx, shfl_xor_l(mx, 16, lane)); mx = fmaxf(mx, shfl_xor_l(mx, 32, lane));
                if (fq == 0) MX[(ai * HALF + wr * 64 + m * 16 + fr) * 4 + wc] = mx; }
        asm volatile("s_waitcnt lgkmcnt(0)" ::: "memory"); __builtin_amdgcn_s_barrier(); asm volatile("" ::: "memory");
#pragma unroll
        for (int ai = 0; ai < 2; ++ai)
#pragma unroll
            for (int m = 0; m < 4; ++m) { const int lr = ai * HALF + wr * 64 + m * 16 + fr; const f32x4 q = *(LAS f32x4*)(MX + lr * 4);
                const float mx = fmaxf(fmaxf(q[0], q[1]), fmaxf(q[2], q[3])); float s = 0.f;
#pragma unroll
                for (int bj = 0; bj < 2; ++bj)
#pragma unroll
                    for (int n = 0; n < 2; ++n) { f32x4 x = acc[ai][bj][m][n];
#pragma unroll
                        for (int j = 0; j < 4; ++j) { x[j] = __builtin_amdgcn_exp2f(x[j] - mx); s += x[j]; }
                        acc[ai][bj][m][n] = x; }
                s += shfl_xor_l(s, 16, lane); s += shfl_xor_l(s, 32, lane);
                if (fq == 0) SM[lr * 4 + wc] = s; }
        asm volatile("s_waitcnt lgkmcnt(0)" ::: "memory"); __builtin_amdgcn_s_barrier(); asm volatile("" ::: "memory");
#pragma unroll
        for (int ai = 0; ai < 2; ++ai)
#pragma unroll
            for (int m = 0; m < 4; ++m) { const int lr = ai * HALF + wr * 64 + m * 16 + fr; const f32x4 q = *(LAS f32x4*)(SM + lr * 4);
                const float inv = __builtin_amdgcn_rcpf((q[0] + q[1]) + (q[2] + q[3]));
                bf16* rowp = O + (size_t)(row0 + ai * HALF + m * 16) * 1024 + col0;
#pragma unroll
                for (int bj = 0; bj < 2; ++bj) *(v4u*)(rowp + bj * HALF) = pack8(acc[ai][bj][m][0] * inv, acc[ai][bj][m][1] * inv); }
    }
};
struct EpiBranch { EPI_COMMON
    static constexpr bool HAS_MID = true; static constexpr int MID1 = 16, MID2 = 32;
    bf16* O; const bf16* Z;
    __device__ __forceinline__ void mid(Acc& acc, const Unit& u, int t, int wr, int wc, int fr, int fq) const {
        int row0 = u.pm * BM + wr * 64 + fr, col0 = u.pn * BM + wc * 32 + 8 * fq; EPI_PIN(row0, col0);
        const int gx = ZC_G + (t == MID1 ? 0 : 2048) + col0, gy = gx + 2048;
#pragma unroll
        for (int ai = 0; ai < 2; ++ai) {
            v4u a[4][2], b[4][2];
#pragma unroll
            for (int m = 0; m < 4; ++m) { const bf16* zr = Z + (size_t)(row0 + ai * HALF + m * 16) * NZ;
#pragma unroll
                for (int bj = 0; bj < 2; ++bj) { a[m][bj] = *(const v4u*)(zr + gx + bj * HALF); b[m][bj] = *(const v4u*)(zr + gy + bj * HALF); } }
            __builtin_amdgcn_sched_barrier(0);
#pragma unroll
            for (int m = 0; m < 4; ++m)
#pragma unroll
                for (int bj = 0; bj < 2; ++bj) { const v4u x = a[m][bj], y = b[m][bj]; f32x4 r0, r1;
                    r0[0] = bf_lo(x.x) * __builtin_amdgcn_rcpf(bf_lo(y.x)); r0[1] = bf_hi(x.x) * __builtin_amdgcn_rcpf(bf_hi(y.x));
                    r0[2] = bf_lo(x.y) * __builtin_amdgcn_rcpf(bf_lo(y.y)); r0[3] = bf_hi(x.y) * __builtin_amdgcn_rcpf(bf_hi(y.y));
                    r1[0] = bf_lo(x.z) * __builtin_amdgcn_rcpf(bf_lo(y.z)); r1[1] = bf_hi(x.z) * __builtin_amdgcn_rcpf(bf_hi(y.z));
                    r1[2] = bf_lo(x.w) * __builtin_amdgcn_rcpf(bf_lo(y.w)); r1[3] = bf_hi(x.w) * __builtin_amdgcn_rcpf(bf_hi(y.w));
                    acc[ai][bj][m][0] *= r0; acc[ai][bj][m][1] *= r1; }
            __builtin_amdgcn_sched_barrier(0);
        }
    }
    __device__ __forceinline__ void operator()(Acc& acc, const Unit& u, int wr, int wc, int fr, int fq, LAS unsigned char*, int, int) const {
        int row0 = u.pm * BM + wr * 64 + fr, col0 = u.pn * BM + wc * 32 + 8 * fq; EPI_PIN(row0, col0);
#pragma unroll
        for (int ai = 0; ai < 2; ++ai) {
            v4u a[4][2];
#pragma unroll
            for (int m = 0; m < 4; ++m) { const bf16* zr = Z + (size_t)(row0 + ai * HALF + m * 16) * NZ + ZC_G + 4096 + col0;
#pragma unroll
                for (int bj = 0; bj < 2; ++bj) a[m][bj] = *(const v4u*)(zr + bj * HALF); }
            __builtin_amdgcn_sched_barrier(0);
#pragma unroll
            for (int m = 0; m < 4; ++m) { bf16* rowp = O + (size_t)(row0 + ai * HALF + m * 16) * DM + col0;
#pragma unroll
                for (int bj = 0; bj < 2; ++bj) { const v4u x = a[m][bj];
                    const f32x4 g0 = {bf_lo(x.x), bf_hi(x.x), bf_lo(x.y), bf_hi(x.y)}, g1 = {bf_lo(x.z), bf_hi(x.z), bf_lo(x.w), bf_hi(x.w)};
                    *(v4u*)(rowp + bj * HALF) = pack8(acc[ai][bj][m][0] * g0, acc[ai][bj][m][1] * g1); } }
            __builtin_amdgcn_sched_barrier(0);
        }
    }
};
}

namespace att {
using s16x4 = __attribute__((ext_vector_type(4))) short;
using f32x16 = __attribute__((ext_vector_type(16))) float;
using u32x4 = __attribute__((ext_vector_type(4))) unsigned;
constexpr int NW = 8, QBLK = 32, KVBLK = 64;
constexpr float THR2 = 8.f;
constexpr float NEGBIG = -1.0e30f;
#define SBAR() __builtin_amdgcn_sched_barrier(0)
__device__ __forceinline__ int crow(int r, int hi) { return (r & 3) + 8 * (r >> 2) + 4 * hi; }
template <int KROWB> __device__ __forceinline__ int kswz(int row, int colB) { return row * KROWB + (colB ^ ((KROWB == 384 ? ((row >> 1) & 7) : (row & 15)) << 4)); }

struct Mask { int dq; float sl; };

template <bool WIN>
__device__ __forceinline__ void partialSM(f32x16& p0, f32x16& p1, float& m_reg, float& mn, float& alpha, const Mask& mk, int kt) {
  if (WIN) {
    const float fd = (float)(mk.dq - kt * KVBLK);
#pragma unroll
    for (int r = 0; r < 16; ++r) { const float d0 = fd - (float)((r & 3) + 8 * (r >> 2)), d1 = d0 - 32.f; const float a0 = fabsf(d0), a1 = fabsf(d1);
      const float t0 = p0[r] - mk.sl * a0, t1 = p1[r] - mk.sl * a1; p0[r] = (a0 <= 128.f) ? t0 : NEGBIG; p1[r] = (a1 <= 128.f) ? t1 : NEGBIG; }
  }
  float pmax = p0[0];
#pragma unroll
  for (int r = 1; r < 16; ++r) pmax = fmaxf(pmax, p0[r]);
#pragma unroll
  for (int r = 0; r < 16; ++r) pmax = fmaxf(pmax, p1[r]);
  { auto rr = __builtin_amdgcn_permlane32_swap(__float_as_uint(pmax), __float_as_uint(pmax), false, false);
    pmax = fmaxf(__uint_as_float(rr[0]), __uint_as_float(rr[1])); }
  if (__builtin_expect(__all(pmax - m_reg <= THR2), 1)) { mn = m_reg; alpha = 1.f; }
  else { mn = fmaxf(m_reg, pmax); alpha = __builtin_amdgcn_exp2f(m_reg - mn); m_reg = mn; }
#pragma unroll
  for (int r = 0; r < 16; ++r) p0[r] = p0[r] - mn;
#pragma unroll
  for (int r = 0; r < 16; ++r) p1[r] = p1[r] - mn;
#pragma unroll
  for (int r = 0; r < 16; ++r) p0[r] = __builtin_amdgcn_exp2f(p0[r]);
}
__device__ __forceinline__ void finishSM(f32x16& p0, f32x16& p1, float alpha, float& l_reg, bf16x8& pa0, bf16x8& pa1, bf16x8& pa2, bf16x8& pa3) {
#pragma unroll
  for (int r = 0; r < 16; ++r) p1[r] = __builtin_amdgcn_exp2f(p1[r]);
  float ps = 0;
#pragma unroll
  for (int r = 0; r < 16; ++r) ps += p0[r];
#pragma unroll
  for (int r = 0; r < 16; ++r) ps += p1[r];
  { auto rr = __builtin_amdgcn_permlane32_swap(__float_as_uint(ps), __float_as_uint(ps), false, false);
    ps = __uint_as_float(rr[0]) + __uint_as_float(rr[1]); }
  l_reg = l_reg * alpha + ps;
#define PK4(P, BASE, OUT) do { unsigned a0 = cvt_pk_bf16(P[BASE + 0], P[BASE + 1]), a1 = cvt_pk_bf16(P[BASE + 2], P[BASE + 3]);   \
    unsigned b0 = cvt_pk_bf16(P[BASE + 4], P[BASE + 5]), b1 = cvt_pk_bf16(P[BASE + 6], P[BASE + 7]);                              \
    auto r0 = __builtin_amdgcn_permlane32_swap(a0, b0, false, false); auto r1 = __builtin_amdgcn_permlane32_swap(a1, b1, false, false); \
    u32x4 w = {r0[0], r1[0], r0[1], r1[1]}; OUT = *reinterpret_cast<bf16x8*>(&w); } while (0)
  PK4(p0, 0, pa0); PK4(p0, 8, pa1); PK4(p1, 0, pa2); PK4(p1, 8, pa3);
#undef PK4
}
template <int NQF, int KROWB>
__device__ __forceinline__ void qkt(f32x16& p0, f32x16& p1, const LAS char* Ks, const bf16x8* qr, int r32, int hi) {
  p0 = f32x16{}; p1 = f32x16{};
#pragma unroll
  for (int d0 = 0; d0 < NQF; ++d0) { const int cb = (d0 * 16 + hi * 8) * 2;
    bf16x8 b0 = *(const LAS bf16x8*)(Ks + kswz<KROWB>(r32, cb));
    bf16x8 b1 = *(const LAS bf16x8*)(Ks + kswz<KROWB>(32 + r32, cb));
    p0 = __builtin_amdgcn_mfma_f32_32x32x16_bf16(b0, qr[d0], p0, 0, 0, 0);
    p1 = __builtin_amdgcn_mfma_f32_32x32x16_bf16(b1, qr[d0], p1, 0, 0, 0); }
}
__device__ __forceinline__ int v_st(int k, int c) { const int kk = (k & ~0xC) | ((k & 4) << 1) | ((k & 8) >> 1); return ((kk >> 3) * 4 + (c >> 5)) * 512 + ((kk & 7) * 32 + (c & 31)) * 2; }
__device__ __forceinline__ int v_rd_base(int lane) { return ((lane & 3) << 3) | (((lane >> 2) & 3) << 6) | (((lane >> 4) & 1) << 5) | (((lane >> 5) & 1) << 8); }
constexpr int v_rd_off(int d0, int ks, int half) { return d0 * 512 + ks * 4096 + half * 2048; }
template <int OFF> __device__ __forceinline__ s16x4 tr_read(int vb) {
  s16x4 r; asm volatile("ds_read_b64_tr_b16 %0, %1 offset:%2" : "=&v"(r) : "v"(vb), "i"(OFF) : "memory"); return r;
}
template <int D0> __device__ __forceinline__ void pv_one(f32x16& od, int vb, bf16x8 pa0, bf16x8 pa1, bf16x8 pa2, bf16x8 pa3) {
  const s16x4 l0 = tr_read<v_rd_off(D0, 0, 0)>(vb), h0 = tr_read<v_rd_off(D0, 0, 1)>(vb), l1 = tr_read<v_rd_off(D0, 1, 0)>(vb), h1 = tr_read<v_rd_off(D0, 1, 1)>(vb);
  const s16x4 l2 = tr_read<v_rd_off(D0, 2, 0)>(vb), h2 = tr_read<v_rd_off(D0, 2, 1)>(vb), l3 = tr_read<v_rd_off(D0, 3, 0)>(vb), h3 = tr_read<v_rd_off(D0, 3, 1)>(vb);
  asm volatile("s_waitcnt lgkmcnt(0)" ::: "memory"); SBAR();
#define PK(L, H) (bf16x8){L[0], L[1], L[2], L[3], H[0], H[1], H[2], H[3]}
  od = __builtin_amdgcn_mfma_f32_32x32x16_bf16(pa0, PK(l0, h0), od, 0, 0, 0);
  od = __builtin_amdgcn_mfma_f32_32x32x16_bf16(pa1, PK(l1, h1), od, 0, 0, 0);
  od = __builtin_amdgcn_mfma_f32_32x32x16_bf16(pa2, PK(l2, h2), od, 0, 0, 0);
  od = __builtin_amdgcn_mfma_f32_32x32x16_bf16(pa3, PK(l3, h3), od, 0, 0, 0);
#undef PK
}
__device__ __forceinline__ void pv_d0(f32x16* o, int vb, bf16x8 pa0, bf16x8 pa1, bf16x8 pa2, bf16x8 pa3) {
  pv_one<0>(o[0], vb, pa0, pa1, pa2, pa3); pv_one<1>(o[1], vb, pa0, pa1, pa2, pa3); pv_one<2>(o[2], vb, pa0, pa1, pa2, pa3); pv_one<3>(o[3], vb, pa0, pa1, pa2, pa3);
}

template <int KIND>
__device__ __forceinline__ void attn_unit(const bf16* __restrict__ Qb, const bf16* __restrict__ KVb, const bf16* __restrict__ Zb, bf16* __restrict__ Ob,
                                          int qm0, int km0, int NT, int h, int ocol, float m0, float l0, Mask mk, LAS char* lds, int tid_in) {
  constexpr int NQF = KIND == 0 ? 12 : 8, KROWB = KIND == 0 ? 384 : 256;
  constexpr int SHM_V = KVBLK * 128 * 2, SHM_K = KVBLK * KROWB;
  int tid_; asm volatile("v_mbcnt_lo_u32_b32 %0, -1, 0\n\tv_mbcnt_hi_u32_b32 %0, -1, %0" : "=v"(tid_)); tid_ += tid_in;
  const int tid = tid_, wid = tid >> 6, lane = tid & 63, r32 = lane & 31, hi = lane >> 5;
  LAS char* V_lds = lds; LAS char* K_lds = lds + 2 * SHM_V;
  LAS float* ws = (LAS float*)(lds + 2 * SHM_V + 2 * SHM_K) + wid * 64; LAS float* li_l = ws; LAS float* al_l = ws + 32;
  float m_reg = m0, l_reg = l0; f32x16 o[4] = {}; bf16x8 qr[NQF];
  mk.dq += wid * QBLK + r32 - 4 * hi;
  const int kvh = h >> 2;
  { const long qrow = (long)(qm0 + wid * QBLK + r32);
    if (KIND == 0) {
      const bf16* Qn = Qb + qrow * NQC + h * 128 + hi * 8; const bf16* Qr = Qb + qrow * NQC + 1024 + h * 64 + hi * 8;
#pragma unroll
      for (int d0 = 0; d0 < 8; ++d0) qr[d0] = *reinterpret_cast<const bf16x8*>(Qn + d0 * 16);
#pragma unroll
      for (int d0 = 8; d0 < NQF; ++d0) qr[d0] = *reinterpret_cast<const bf16x8*>(Qr + (d0 - 8) * 16);
    } else {
      const bf16* Qn = Zb + qrow * NZ + ZC_QW + h * 128 + hi * 8;
#pragma unroll
      for (int d0 = 0; d0 < 8; ++d0) qr[d0] = *reinterpret_cast<const bf16x8*>(Qn + d0 * 16);
    } }
  const int sr = tid >> 4, sc = (tid & 15) * 8, vst0 = v_st(sr, sc), vst1 = v_st(32 + sr, sc);
  const int rr_ = tid >> 3, rc_ = (tid & 7) * 8;
  const int vb0 = (int)(uintptr_t)V_lds + v_rd_base(lane);
  constexpr long kld = KIND == 0 ? NKVC : NZ;
  const char* Kbase = KIND == 0 ? (const char*)(KVb + (long)km0 * NKVC + h * 256) : (const char*)(Zb + (long)km0 * NZ + ZC_KW + kvh * 128);
  const char* Vbase = KIND == 0 ? Kbase + 256 : (const char*)(Zb + (long)km0 * NZ + ZC_VW + kvh * 128);
  const char* Rbase = (const char*)(Zb + (long)km0 * NZ + ZC_KR);
  const unsigned koff = (unsigned)((sr * kld + sc) * 2), roff = (unsigned)((rr_ * NZ + rc_) * 2);
  bf16x8 s_v0, s_v1, s_k0, s_k1, s_kr;
#define SLOAD(k0) do { const size_t o_ = (size_t)(k0) * kld * 2; const char* vb_ = Vbase + o_; const char* kb_ = Kbase + o_; \
    s_v0 = *reinterpret_cast<const bf16x8*>(vb_ + koff); s_v1 = *reinterpret_cast<const bf16x8*>(vb_ + 32 * kld * 2 + koff); \
    s_k0 = *reinterpret_cast<const bf16x8*>(kb_ + koff); s_k1 = *reinterpret_cast<const bf16x8*>(kb_ + 32 * kld * 2 + koff); \
    if (KIND == 0) s_kr = *reinterpret_cast<const bf16x8*>(Rbase + (size_t)(k0) * NZ * 2 + roff); } while (0)
#define SWRITE(b) do { *(LAS bf16x8*)(V_lds + (b) * SHM_V + vst0) = s_v0; *(LAS bf16x8*)(V_lds + (b) * SHM_V + vst1) = s_v1; const int kc = sc * 2; \
    *(LAS bf16x8*)(K_lds + (b) * SHM_K + kswz<KROWB>(sr, kc)) = s_k0; *(LAS bf16x8*)(K_lds + (b) * SHM_K + kswz<KROWB>(32 + sr, kc)) = s_k1; \
    if (KIND == 0) *(LAS bf16x8*)(K_lds + (b) * SHM_K + kswz<KROWB>(rr_, 256 + rc_ * 2)) = s_kr; } while (0)
#define SWAIT() asm volatile("s_waitcnt vmcnt(0)" ::: "memory")
#define RESC(a) do { if (__any((a) < 1.f)) { if (hi == 0) al_l[r32] = (a); asm volatile("s_waitcnt lgkmcnt(0)" ::: "memory"); \
    _Pragma("unroll") for (int d = 0; d < 4; ++d) _Pragma("unroll") for (int r = 0; r < 16; ++r) o[d][r] *= al_l[crow(r, hi)]; } } while (0)
  f32x16 pA0, pA1, pB0, pB1; float mnA, mnB, alA, alB; bf16x8 pa0, pa1, pa2, pa3;
  constexpr bool WIN = KIND == 1;
  SLOAD(0); SWAIT(); SWRITE(0); __syncthreads();
  qkt<NQF, KROWB>(pA0, pA1, K_lds, qr, r32, hi); partialSM<WIN>(pA0, pA1, m_reg, mnA, alA, mk, 0);
  SLOAD(KVBLK);
  SWAIT(); SWRITE(1); __syncthreads();
  for (int j = 1; j + 1 < NT; j += 2) {
    SBAR(); qkt<NQF, KROWB>(pB0, pB1, K_lds + SHM_K, qr, r32, hi);
    finishSM(pA0, pA1, alA, l_reg, pa0, pa1, pa2, pa3); SBAR();
    SLOAD((j + 1) * KVBLK); SBAR();
    pv_d0(o, vb0, pa0, pa1, pa2, pa3); partialSM<WIN>(pB0, pB1, m_reg, mnB, alB, mk, j);
    __syncthreads(); SWAIT(); SWRITE(0);
    RESC(alB); __syncthreads();
    SBAR(); qkt<NQF, KROWB>(pA0, pA1, K_lds, qr, r32, hi);
    finishSM(pB0, pB1, alB, l_reg, pa0, pa1, pa2, pa3); SBAR();
    SLOAD((j + 2) * KVBLK); SBAR();
    pv_d0(o, vb0 + SHM_V, pa0, pa1, pa2, pa3); partialSM<WIN>(pA0, pA1, m_reg, mnA, alA, mk, j + 1);
    __syncthreads(); SWAIT(); SWRITE(1);
    RESC(alA); __syncthreads();
  }
  SBAR(); qkt<NQF, KROWB>(pB0, pB1, K_lds + SHM_K, qr, r32, hi);
  finishSM(pA0, pA1, alA, l_reg, pa0, pa1, pa2, pa3); SBAR();
  pv_d0(o, vb0, pa0, pa1, pa2, pa3); partialSM<WIN>(pB0, pB1, m_reg, mnB, alB, mk, NT - 1);
  __syncthreads(); RESC(alB);
  finishSM(pB0, pB1, alB, l_reg, pa0, pa1, pa2, pa3); SBAR();
  pv_d0(o, vb0 + SHM_V, pa0, pa1, pa2, pa3);
  if (hi == 0) li_l[r32] = l_reg; asm volatile("s_waitcnt lgkmcnt(0)" ::: "memory");
  float rli[16];
#pragma unroll
  for (int r = 0; r < 16; ++r) rli[r] = __builtin_amdgcn_rcpf(li_l[crow(r, hi)]);
  bf16* Ow = Ob + (long)(qm0 + wid * QBLK) * NABC + ocol;
#pragma unroll
  for (int r = 0; r < 16; ++r) { const int orow = crow(r, hi);
#pragma unroll
    for (int d0 = 0; d0 < 4; ++d0) { const float v = o[d0][r] * rli[r]; Ow[(long)orow * NABC + d0 * 32 + r32] = (bf16)(cvt_pk_bf16(v, v) & 0xffffu); } }
  __syncthreads();
#undef SLOAD
#undef SWRITE
#undef SWAIT
#undef RESC
}
#undef SBAR
}

#define XB_TMO      128
#define XB_XCNT(j)  (256  + 64 * (j))
#define XB_XSUB(j)  (1280 + 64 * (j))
#define XB_XGEN(j)  (2304 + 64 * (j))
#define XB_TOP      3328
#define XB_TOPGEN   3392
#define XCD_BAR_WORDS 3456
#define XB_SPIN_CAP (1u << 18)

__device__ __forceinline__ unsigned xb_ld(unsigned* p)              { return __hip_atomic_load(p, __ATOMIC_RELAXED, __HIP_MEMORY_SCOPE_AGENT); }
__device__ __forceinline__ unsigned xb_add(unsigned* p, unsigned v) { return __hip_atomic_fetch_add(p, v, __ATOMIC_RELAXED, __HIP_MEMORY_SCOPE_AGENT); }
__device__ __forceinline__ unsigned xb_xcc_id() { return (unsigned)__builtin_amdgcn_s_getreg((3 << 11) | 20) & 0xFu; }
#define XB_SPIN(cond, bar) do { unsigned _sp = 0; while (cond) { __builtin_amdgcn_s_sleep(1); \
    if ((++_sp & 255u) == 0u) { if (xb_ld(&(bar)[XB_TMO])) break; if (_sp > XB_SPIN_CAP) { atomicAdd(&(bar)[XB_TMO], 1u); break; } } } } while (0)

struct XcdBarrier { unsigned* bar; unsigned x; volatile LAS unsigned* st; };

__device__ __forceinline__ XcdBarrier xcd_barrier_post(unsigned* bar, volatile LAS unsigned* st) {
    XcdBarrier b; b.bar = bar; b.x = xb_xcc_id(); b.st = st;
    if (threadIdx.x == 0) (void)xb_add(&bar[XB_XCNT(b.x)], 1u);
    return b;
}
__device__ __forceinline__ void xcd_barrier_complete(unsigned* bar, unsigned x, unsigned& nloc, unsigned& nx) {
    const unsigned G = gridDim.x * gridDim.y * gridDim.z;
    unsigned sum, cnt, mine, sp = 0u;
    for (;;) {
        sum = 0u; cnt = 0u; mine = 0u;
#pragma unroll
        for (unsigned j = 0; j < 16; ++j) { const unsigned c = xb_ld(&bar[XB_XCNT(j)]); sum += c; cnt += (c > 0u) ? 1u : 0u; mine = (j == x) ? c : mine; }
        if (sum == G) break;
        __builtin_amdgcn_s_sleep(1);
        if ((++sp & 255u) == 0u) { if (xb_ld(&bar[XB_TMO])) break; if (sp > XB_SPIN_CAP) { atomicAdd(&bar[XB_TMO], 1u); break; } }
    }
    nloc = mine > 0u ? mine : 1u; nx = cnt > 0u ? cnt : 1u;
}
__device__ __forceinline__ void xcd_barrier(const XcdBarrier& b, const int tid  ) {
    asm volatile("s_waitcnt vmcnt(0)" ::: "memory");
    __syncthreads();
    if (tid == 0) {
        unsigned* bar = b.bar;
        __builtin_amdgcn_s_waitcnt(0);
        unsigned nloc = b.st[0], nx = b.st[1];
        if (nloc == 0u) { xcd_barrier_complete(bar, b.x, nloc, nx); b.st[0] = nloc; b.st[1] = nx; }
        const unsigned old = xb_add(&bar[XB_XSUB(b.x)], 1u);
        const unsigned gen = old / nloc;
        if (old + 1u == (gen + 1u) * nloc) {
            __builtin_amdgcn_fence(__ATOMIC_RELEASE, "agent");
            asm volatile("s_waitcnt vmcnt(0)" ::: "memory");
            const unsigned og = xb_add(&bar[XB_TOP], 1u);
            const unsigned tg = og / nx;
            if (og + 1u == (tg + 1u) * nx) xb_add(&bar[XB_TOPGEN], 1u);
            else XB_SPIN(xb_ld(&bar[XB_TOPGEN]) == tg, bar);
            __builtin_amdgcn_fence(__ATOMIC_ACQUIRE, "agent");
            xb_add(&bar[XB_XGEN(b.x)], 1u);
            asm volatile("s_waitcnt vmcnt(0)" ::: "memory");
        } else {
            XB_SPIN(xb_ld(&bar[XB_XGEN(b.x)]) == gen, bar);
            __builtin_amdgcn_fence(__ATOMIC_ACQUIRE, "agent");
            asm volatile("s_waitcnt vmcnt(0)" ::: "memory");
        }
    }
    __syncthreads();
}

struct Args { const float* in[22]; float* out; unsigned char* ws; int ph_lo, ph_hi; };
typedef const __attribute__((address_space(4))) Args* KArgs;
#define KARGS() ({ KArgs p_ = (KArgs)__builtin_amdgcn_kernarg_segment_ptr(); asm volatile("" : "+s"(p_)); p_; })
struct Frame { LAS unsigned char* lds; int tid, lane, wave, vcu, G; };

__device__ __forceinline__ float wave_sum(float v, int lane) {
#pragma unroll
    for (int o = 1; o < 64; o <<= 1) v += shfl_xor_l(v, o, lane);
    return v;
}
__device__ const double ROPE_REV[32] = {
    1.59154943091895346e-01, 1.19349370211248862e-01, 8.94994016088910133e-02, 6.71150830052272551e-02, 5.03292121044870353e-02, 3.77415847174197711e-02, 2.83021958306233987e-02, 2.12236527647776604e-02,
    1.59154943091895339e-02, 1.19349370211248862e-02, 8.94994016088910237e-03, 6.71150830052272534e-03, 5.03292121044870370e-03, 3.77415847174197719e-03, 2.83021958306233987e-03, 2.12236527647776622e-03,
    1.59154943091895356e-03, 1.19349370211248849e-03, 8.94994016088910237e-04, 6.71150830052272599e-04, 5.03292121044870326e-04, 3.77415847174197741e-04, 2.83021958306233954e-04, 2.12236527647776605e-04,
    1.59154943091895351e-04, 1.19349370211248862e-04, 8.94994016088910182e-05, 6.71150830052272545e-05, 5.03292121044870354e-05, 3.77415847174197768e-05, 2.83021958306233961e-05, 2.12236527647776592e-05};

enum { MAP_ID = 0, MAP_WIN = 1, MAP_WUQ = 2 };
__device__ __forceinline__ int map_col(int mode, int n) {
    if (mode == MAP_ID) return n;
    if (mode == MAP_WIN) {
        if (n < 1024) return n;
        if (n < ZC_KR) return n + 64;
        if (n < ZC_KR + 64) { const int p = n - ZC_KR, i = p >> 1; return 1024 + ((p & 1) ? i + 32 : i); }
        if (n < ZC_G) return -1;
        return n - ZC_G + 3648;
    }
    if (n < 1024) return (n >> 7) * 192 + (n & 127);
    { const int r = n - 1024, h = r >> 6, p = r & 63, i = p >> 1; return h * 192 + 128 + ((p & 1) ? i + 32 : i); }
}
__device__ __forceinline__ void conv_item(const float* W, int K, int Nsrc, int nblk, const float* g, int mode, bf16* dst, int dst_ld, LAS float* scr, int item, int lane) {
    const int kb = item / nblk, nb = item % nblk, k0 = 64 * kb, n0 = 32 * nb;
    const int src = map_col(mode, n0 + (lane & 31));
#pragma unroll 8
    for (int i = 0; i < 32; ++i) { const int kk = 2 * i + (lane >> 5); float v = 0.f;
        if (src >= 0) { v = W[(size_t)(k0 + kk) * Nsrc + src]; if (g) v *= g[k0 + kk]; }
        scr[kk * 33 + (lane & 31)] = v; }
    LDS_WAIT(); asm volatile("" ::: "memory");
    const int c = lane & 7;
#pragma unroll
    for (int j = 0; j < 4; ++j) { const int n = (lane >> 3) + 8 * j; const LAS float* s = scr + (8 * c) * 33 + n;
        v4u o; o.x = cvt_pk_bf16(s[0 * 33], s[1 * 33]); o.y = cvt_pk_bf16(s[2 * 33], s[3 * 33]); o.z = cvt_pk_bf16(s[4 * 33], s[5 * 33]); o.w = cvt_pk_bf16(s[6 * 33], s[7 * 33]);
        *(GAS v4u*)(dst + (size_t)(n0 + n) * dst_ld + k0 + 8 * c) = o; }
    LDS_WAIT(); asm volatile("" ::: "memory");
}
__device__ __forceinline__ void convert_layer(const Frame& F, KArgs ap, int l, unsigned char* ws) {
    LAS float* scr = (LAS float*)(F.lds + RING_OFF + F.wave * 16384);
    const int gw = F.vcu * NWAVES + F.wave, NGW = F.G * NWAVES;
    unsigned char* W = ws + WS_W;
    constexpr int I_IN = 32 * (NZ / 32), I_UQ = 8 * (NQC / 32), I_UKV = 8 * (NKVC / 32), I_MEM = 32 * 64, I_BR = 16 * 64, I_OUT = 32 * 64, I_UP = 32 * 256, I_DOWN = 128 * 64;
    constexpr int NITEMS = I_IN + I_UQ + I_UKV + I_MEM + 3 * I_BR + I_OUT + I_UP + I_DOWN;
    for (int it = gw; it < NITEMS; it += NGW) {
        int r = it;
        if (r < I_IN) { conv_item(ap->in[6] + (size_t)l * DM * NZSRC, DM, NZSRC, NZ / 32, ap->in[4] + l * DM, MAP_WIN, (bf16*)(W + WO_IN), DM, scr, r, F.lane); continue; } r -= I_IN;
        if (r < I_UQ) { conv_item(ap->in[9] + (size_t)l * 512 * NQC, 512, NQC, NQC / 32, ap->in[7] + l * 512, MAP_WUQ, (bf16*)(W + WO_UQ), 512, scr, r, F.lane); continue; } r -= I_UQ;
        if (r < I_UKV) { conv_item(ap->in[10] + (size_t)l * 512 * NKVC, 512, NKVC, NKVC / 32, ap->in[8] + l * 512, MAP_ID, (bf16*)(W + WO_UKV), 512, scr, r, F.lane); continue; } r -= I_UKV;
        if (r < I_MEM) { conv_item(ap->in[12] + (size_t)l * DM * 2048, DM, 2048, 64, ap->in[11] + l * DM, MAP_ID, (bf16*)(W + WO_MEM), DM, scr, r, F.lane); continue; } r -= I_MEM;
        if (r < 3 * I_BR) { const int br = r / I_BR; conv_item(ap->in[14 + br] + (size_t)l * 1024 * DM, 1024, DM, 64, nullptr, MAP_ID, (bf16*)(W + WO_BR) + br * 1024, NABC, scr, r - br * I_BR, F.lane); continue; } r -= 3 * I_BR;
        if (r < I_OUT) { conv_item(ap->in[17] + (size_t)l * DM * DM, DM, DM, 64, nullptr, MAP_ID, (bf16*)(W + WO_OUT), DM, scr, r, F.lane); continue; } r -= I_OUT;
        if (r < I_UP) { conv_item(ap->in[20] + (size_t)l * DM * DFF, DM, DFF, 256, ap->in[18] + l * DM, MAP_ID, (bf16*)(W + WO_UP), DM, scr, r, F.lane); continue; } r -= I_UP;
        conv_item(ap->in[21] + (size_t)l * DFF * DM, DFF, DM, 64, nullptr, MAP_ID, (bf16*)(W + WO_DOWN), DFF, scr, r, F.lane);
    }
}
__device__ __forceinline__ void rms_row_to_bf16(const float* xrow, bf16* orow, int lane) {
    f32x4 v[8]; float s = 0.f;
#pragma unroll
    for (int j = 0; j < 4; ++j) { v[2 * j] = *(const GAS f32x4*)(xrow + j * 512 + lane * 8); v[2 * j + 1] = *(const GAS f32x4*)(xrow + j * 512 + lane * 8 + 4); }
#pragma unroll
    for (int j = 0; j < 8; ++j) s += (v[j][0] * v[j][0] + v[j][1] * v[j][1]) + (v[j][2] * v[j][2] + v[j][3] * v[j][3]);
    const float r = __builtin_amdgcn_rsqf(wave_sum(s, lane) * (1.f / DM) + EPS);
#pragma unroll
    for (int j = 0; j < 4; ++j) *(GAS v4u*)(orow + j * 512 + lane * 8) = epi::pack8(v[2 * j] * r, v[2 * j + 1] * r);
}
__device__ __forceinline__ void prologue(const Frame& F, KArgs ap, unsigned char* ws) {
    const int gw = F.vcu * NWAVES + F.wave, NGW = F.G * NWAVES;
    float* tab = (float*)(ws + WS_TAB);
    for (int e = blockIdx.x * 512 + F.tid; e < 8192 * 32; e += F.G * 512) {
        const int pos = e >> 5, i = e & 31;
        double rev = (double)pos * ROPE_REV[i]; rev -= floor(rev);
        const double q = rint(rev * 4.0); const double r = (rev - q * 0.25) * 6.283185307179586476925;
        const double r2 = r * r;
        const double sn = r * (1.0 + r2 * (-1.0 / 6 + r2 * (1.0 / 120 + r2 * (-1.0 / 5040 + r2 * (1.0 / 362880 - r2 * (1.0 / 39916800))))));
        const double cn = 1.0 + r2 * (-0.5 + r2 * (1.0 / 24 + r2 * (-1.0 / 720 + r2 * (1.0 / 40320 + r2 * (-1.0 / 3628800 + r2 * (1.0 / 479001600))))));
        const int qi = ((int)q) & 3;
        const double s_ = qi == 0 ? sn : qi == 1 ? cn : qi == 2 ? -sn : -cn;
        const double c_ = qi == 0 ? cn : qi == 1 ? -sn : qi == 2 ? -cn : sn;
        *(GAS f32x2*)(tab + (size_t)e * 2) = (f32x2){(float)c_, (float)s_};
    }
    float* rmem = (float*)(ws + WS_RMEM); bf16* memb = (bf16*)(ws + WS_MEMB);
    for (int m = gw; m < NMEMR; m += NGW) {
        const float* xrow = (m < 1024) ? ap->in[2] + (size_t)m * DM : ap->in[3] + (size_t)(m - 1024) * DM;
        f32x4 v[8]; float s = 0.f;
#pragma unroll
        for (int j = 0; j < 4; ++j) { v[2 * j] = *(const GAS f32x4*)(xrow + j * 512 + F.lane * 8); v[2 * j + 1] = *(const GAS f32x4*)(xrow + j * 512 + F.lane * 8 + 4); }
#pragma unroll
        for (int j = 0; j < 8; ++j) s += (v[j][0] * v[j][0] + v[j][1] * v[j][1]) + (v[j][2] * v[j][2] + v[j][3] * v[j][3]);
        const float r = __builtin_amdgcn_rsqf(wave_sum(s, F.lane) * (1.f / DM) + EPS);
        if (F.lane == 0) rmem[m] = r;
#pragma unroll
        for (int j = 0; j < 4; ++j) *(GAS v4u*)(memb + (size_t)m * DM + j * 512 + F.lane * 8) = epi::pack8(v[2 * j], v[2 * j + 1]);
    }
    bf16* xn = (bf16*)(ws + WS_XN);
    for (int m = gw; m < NTOK; m += NGW) {
        const float* xrow = (m < NPROMPT) ? ap->in[0] + (size_t)m * DM : ap->in[1] + (size_t)(m - NPROMPT) * DM;
        rms_row_to_bf16(xrow, xn + (size_t)m * DM, F.lane);
    }
    convert_layer(F, ap, 0, ws);
}
__device__ __forceinline__ void norm_pass(const Frame& F, KArgs ap, bool first, const float* gpost, unsigned char* ws, bool dummy = false) {
    const int gw = F.vcu * NWAVES + F.wave, NGW = F.G * NWAVES;
    const bf16* Y = (const bf16*)(ws + WS_Y); bf16* xn = dummy ? (bf16*)(ws + WS_Z + 192 * MiB) : (bf16*)(ws + WS_XN);
    float* xout = dummy ? (float*)(ws + WS_Z) : ap->out;
    f32x4 g[8];
#pragma unroll
    for (int j = 0; j < 4; ++j) { g[2 * j] = *(const GAS f32x4*)(gpost + j * 512 + F.lane * 8); g[2 * j + 1] = *(const GAS f32x4*)(gpost + j * 512 + F.lane * 8 + 4); }
    for (int m = gw; m < NTOK; m += NGW) {
        const float* xrow = first ? ((m < NPROMPT) ? ap->in[0] + (size_t)m * DM : ap->in[1] + (size_t)(m - NPROMPT) * DM) : ap->out + (size_t)m * DM;
        f32x4 x[8], y[8]; float s = 0.f;
#pragma unroll
        for (int j = 0; j < 4; ++j) { const v4u w = *(const GAS v4u*)(Y + (size_t)m * DM + j * 512 + F.lane * 8);
            y[2 * j] = (f32x4){bf_lo(w.x), bf_hi(w.x), bf_lo(w.y), bf_hi(w.y)}; y[2 * j + 1] = (f32x4){bf_lo(w.z), bf_hi(w.z), bf_lo(w.w), bf_hi(w.w)};
            x[2 * j] = *(const GAS f32x4*)(xrow + j * 512 + F.lane * 8); x[2 * j + 1] = *(const GAS f32x4*)(xrow + j * 512 + F.lane * 8 + 4); }
#pragma unroll
        for (int j = 0; j < 8; ++j) s += (y[j][0] * y[j][0] + y[j][1] * y[j][1]) + (y[j][2] * y[j][2] + y[j][3] * y[j][3]);
        const float r = __builtin_amdgcn_rsqf(wave_sum(s, F.lane) * (1.f / DM) + EPS);
        float s2 = 0.f;
#pragma unroll
        for (int j = 0; j < 8; ++j) { x[j] = x[j] + (y[j] * r) * g[j]; s2 += (x[j][0] * x[j][0] + x[j][1] * x[j][1]) + (x[j][2] * x[j][2] + x[j][3] * x[j][3]); }
        float* orow = xout + (size_t)m * DM;
#pragma unroll
        for (int j = 0; j < 4; ++j) { *(GAS f32x4*)(orow + j * 512 + F.lane * 8) = x[2 * j]; *(GAS f32x4*)(orow + j * 512 + F.lane * 8 + 4) = x[2 * j + 1]; }
        const float r2 = __builtin_amdgcn_rsqf(wave_sum(s2, F.lane) * (1.f / DM) + EPS);
#pragma unroll
        for (int j = 0; j < 4; ++j) *(GAS v4u*)(xn + (size_t)m * DM + j * 512 + F.lane * 8) = epi::pack8(x[2 * j] * r2, x[2 * j + 1] * r2);
    }
}

constexpr int PH_PER_LAYER = 9, N_PHASES = 1 + DEPTH * PH_PER_LAYER;
#ifndef PH_MASK
#define PH_MASK 0x3ff
#endif
#define PH_EN(k) ((PH_MASK >> (k)) & 1)
#ifndef SUB_MASK
#define SUB_MASK 7
#endif
#define SUB_EN(k) ((SUB_MASK >> (k)) & 1)
#ifndef DUP_MASK
#define DUP_MASK 0
#endif
#define DUP_EN(k) ((DUP_MASK >> (k)) & 1)
__global__ void __launch_bounds__(NWAVES * 64, 2) fwd(Args args_unused) {
    extern __shared__ __attribute__((aligned(16))) unsigned char lds_raw[];
    (void)args_unused;
    LAS unsigned char* lds0 = (LAS unsigned char*)lds_raw;
    const int wave0 = __builtin_amdgcn_readfirstlane((int)threadIdx.x >> 6);
    volatile LAS unsigned* MISC = (volatile LAS unsigned*)(lds0 + MISC_OFF);
    for (int u = threadIdx.x; u < (XCH_OFF - LDSCTL_OFF) / 4; u += NWAVES * 64) ((LAS unsigned*)(lds0 + LDSCTL_OFF))[u] = 0u;
    __syncthreads();
    int lo, hi; unsigned* barw;
    { KArgs ap = KARGS(); lo = ap->ph_lo; hi = ap->ph_hi; barw = (unsigned*)(ap->ws + WS_CTL) + CW_BAR; }
    XcdBarrier bar; bar.bar = barw; bar.x = 0; bar.st = nullptr;
    if ((hi - lo) > 1) bar = xcd_barrier_post(barw, MISC + 8);
#define IN(k) (lo <= (k) && (k) < hi)
#define BARRIER_NOW() do { int t_; asm volatile("v_mbcnt_lo_u32_b32 %0, -1, 0\n\tv_mbcnt_hi_u32_b32 %0, -1, %0" : "=v"(t_)); xcd_barrier(bar, wave0 * 64 + t_); } while (0)
#define SEAM(k) do { if (IN(k) && IN((k) + 1)) { int t_; asm volatile("v_mbcnt_lo_u32_b32 %0, -1, 0\n\tv_mbcnt_hi_u32_b32 %0, -1, %0" : "=v"(t_)); xcd_barrier(bar, wave0 * 64 + t_); } } while (0)
#define PHASE_BASE() KArgs ap = KARGS(); unsigned char* ws = ap->ws; (void)ws; int bx_ = (int)blockIdx.x, G_ = (int)gridDim.x, t_; asm volatile("v_mbcnt_lo_u32_b32 %0, -1, 0\n\tv_mbcnt_hi_u32_b32 %0, -1, %0" : "=v"(t_)); t_ += wave0 * 64; asm volatile("" : "+s"(bx_), "+s"(G_)); const int bx = bx_, G = G_; (void)bx; (void)G; Frame F; F.lds = (LAS unsigned char*)lds_raw; F.tid = t_; F.lane = t_ & 63; F.wave = __builtin_amdgcn_readfirstlane(t_ >> 6); F.G = G; F.vcu = (G % 8 == 0) ? (bx % 8) * (G / 8) + bx / 8 : bx; LAS unsigned char* ring = F.lds + RING_OFF; LAS unsigned char* xl = F.lds + XCH_OFF; (void)ring; (void)xl
#define WSP(T, off) ((T*)(ws + (off)))

    if (PH_EN(0) && IN(0)) { PHASE_BASE(); prologue(F, ap, ws); }
    SEAM(0);

    for (int l = 0; l < DEPTH; ++l) {
        const int p0 = 1 + l * PH_PER_LAYER;
        for (int rep_ = 0; rep_ <= DUP_EN(1); ++rep_) { if (rep_) BARRIER_NOW();
        if (PH_EN(1) && IN(p0 + 0)) { PHASE_BASE();
            if (SUB_EN(0)) { pg8::Gemm g = pg8::plain_gemm(WSP(bf16, WS_XN), DM, ws + WS_W + WO_IN, DM, DM); pg8::StaticOrder S; S.init(NTOK / 256, NZ / 256, G, bx);
#ifdef DBG_PLAIN_Z
              epi::EpiStore<0> E{WSP(bf16, WS_Z), NZ, 0, nullptr}; pg8::gemm_phase<epi::EpiStore<0>, pg8::StaticOrder>(F.tid, ring, xl, g, S, E); }
#else
              epi::EpiZ E{WSP(bf16, WS_Z), WSP(float, WS_SSQ), WSP(const float, WS_TAB)}; pg8::gemm_phase<epi::EpiZ, pg8::StaticOrder>(F.tid, ring, xl, g, S, E); }
#endif
            if (SUB_EN(1)) { pg8::Gemm g = pg8::plain_gemm(WSP(bf16, WS_MEMB), DM, ws + WS_W + WO_MEM, DM, DM); pg8::StaticOrder S; S.init(NMEMR / 256, 4, G, (bx + G - 160 % G) % G);
              epi::EpiStore<1> E{WSP(bf16, WS_MEMK), 1024, 0, WSP(const float, WS_RMEM)}; pg8::gemm_phase<epi::EpiStore<1>, pg8::StaticOrder>(F.tid, ring, xl, g, S, E); }
            if (SUB_EN(2)) { pg8::Gemm g = pg8::plain_gemm(ws + WS_W + WO_MEM + (size_t)1024 * DM * 2, DM, WSP(bf16, WS_MEMB), DM, DM); pg8::StaticOrder S; S.init(4, NMEMR / 256, G, (bx + G - 180 % G) % G);
              epi::EpiStore<2> E{WSP(bf16, WS_MEMVT), NMEMR, 0, WSP(const float, WS_RMEM)}; pg8::gemm_phase<epi::EpiStore<2>, pg8::StaticOrder>(F.tid, ring, xl, g, S, E); }
        }
        }
        SEAM(p0 + 0);
        for (int rep_ = 0; rep_ <= DUP_EN(2); ++rep_) { if (rep_) BARRIER_NOW();
        if (PH_EN(2) && IN(p0 + 1)) { PHASE_BASE();
            if (SUB_EN(0)) { pg8::Gemm g = pg8::plain_gemm(WSP(bf16, WS_Z) + ZC_CQ, NZ, ws + WS_W + WO_UQ, 512, 512); pg8::StaticOrder S; S.init(NTOK / 256, NQC / 256, G, bx);
              epi::EpiLat<0> E{WSP(bf16, WS_Q), WSP(const float, WS_SSQ), WSP(const float, WS_TAB)}; pg8::gemm_phase<epi::EpiLat<0>, pg8::StaticOrder>(F.tid, ring, xl, g, S, E); }
            if (SUB_EN(1)) { pg8::Gemm g = pg8::plain_gemm(WSP(bf16, WS_Z) + ZC_CKV, NZ, ws + WS_W + WO_UKV, 512, 512); pg8::StaticOrder S; S.init(NTOK / 256, NKVC / 256, G, bx);
              epi::EpiLat<1> E{WSP(bf16, WS_KV), WSP(const float, WS_SSQ), WSP(const float, WS_TAB)}; pg8::gemm_phase<epi::EpiLat<1>, pg8::StaticOrder>(F.tid, ring, xl, g, S, E); }
            if (SUB_EN(2)) { pg8::Gemm g; g.A = (const char*)(WSP(bf16, WS_Z) + ZC_QM); g.B = (const char*)WSP(bf16, WS_MEMK); g.a_pm = (long)256 * NZ * 2; g.a_pn = 512; g.b_pn = 512; g.b_sq = (long)256 * 1024 * 2; g.lda = NZ; g.ldb = 1024; g.K = 256;
              pg8::StaticOrder S; S.init(NTOK / 256, 4, G, (bx + G - 64 % G) % G);
              epi::EpiSoftmax E{WSP(bf16, WS_PM)}; pg8::gemm_phase<epi::EpiSoftmax, pg8::StaticOrder>(F.tid, ring, xl, g, S, E); }
        }
        }
        SEAM(p0 + 1);
        for (int rep_ = 0; rep_ <= DUP_EN(3); ++rep_) { if (rep_) BARRIER_NOW();
        if (PH_EN(3) && IN(p0 + 2)) {
            if (SUB_EN(0)) { PHASE_BASE(); for (int n = F.vcu; n < 768; n += G) {
                const int i = n >> 8, v = n & 255, x = v >> 5, j = v & 31;
                int h, qm0, km0, NT;
                if (i < 2) { const int pair = 4 * x + 2 * i + (j >> 4), b = pair >> 3; h = pair & 7; qm0 = b * 4096 + (j & 15) * 256; km0 = b * 4096; NT = 64; }
                else { h = x; qm0 = NPROMPT + j * 256; km0 = NPROMPT; NT = 128; }
                att::Mask mk{0, 0.f};
                att::attn_unit<0>(WSP(bf16, WS_Q), WSP(bf16, WS_KV), WSP(bf16, WS_Z), WSP(bf16, WS_ABC), qm0, km0, NT, h, h * 128, -1.0e30f, 0.f, mk, (LAS char*)ring, wave0 * 64);
            } }
            if (SUB_EN(1)) { PHASE_BASE(); const float* sink = ap->in[13] + l * 8;
              for (int n = F.vcu; n < 768; n += G) {
                const int qblk = n >> 3, h = n & 7;
                const int sstart = qblk < 64 ? (qblk >> 4) * 4096 : NPROMPT, SL = qblk < 64 ? 4096 : 8192;
                const int qm0 = qblk * 256, q0 = qm0 - sstart;
                const int klo = (q0 - 128) < 0 ? 0 : (q0 - 128), khi = (q0 + 384) > SL ? SL : (q0 + 384);
                att::Mask mk; mk.dq = q0 - klo; mk.sl = LOG2E * __builtin_amdgcn_exp2f(-(float)(h + 1));
                att::attn_unit<1>(WSP(bf16, WS_Q), WSP(bf16, WS_KV), WSP(bf16, WS_Z), WSP(bf16, WS_ABC), qm0, sstart + klo, (khi - klo) >> 6, h, 1024 + h * 128, sink[h] * LOG2E, 1.f, mk, (LAS char*)ring, wave0 * 64);
              } }
            if (SUB_EN(2)) { PHASE_BASE(); pg8::Gemm g; g.A = (const char*)WSP(bf16, WS_PM); g.B = (const char*)WSP(bf16, WS_MEMVT); g.a_pm = (long)256 * 1024 * 2; g.a_pn = 512; g.b_pn = (long)256 * NMEMR * 2; g.b_sq = 512; g.lda = 1024; g.ldb = NMEMR; g.K = 256;
              pg8::StaticOrder S; S.init(NTOK / 256, 4, G, bx);
              epi::EpiStore<0> E{WSP(bf16, WS_ABC), NABC, 2048, nullptr}; pg8::gemm_phase<epi::EpiStore<0>, pg8::StaticOrder>(F.tid, ring, xl, g, S, E); }
        }
        }
        SEAM(p0 + 2);
        for (int rep_ = 0; rep_ <= DUP_EN(4); ++rep_) { if (rep_) BARRIER_NOW();
        if (PH_EN(4) && IN(p0 + 3)) { PHASE_BASE();
            pg8::Gemm g = pg8::plain_gemm(WSP(bf16, WS_ABC), NABC, ws + WS_W + WO_BR, NABC, NABC); pg8::StaticOrder S; S.init(NTOK / 256, DM / 256, G, bx);
            epi::EpiBranch E{WSP(bf16, WS_MERGED), WSP(const bf16, WS_Z)}; pg8::gemm_phase<epi::EpiBranch, pg8::StaticOrder>(F.tid, ring, xl, g, S, E);
        }
        }
        SEAM(p0 + 3);
        for (int rep_ = 0; rep_ <= DUP_EN(5); ++rep_) { if (rep_) BARRIER_NOW();
        if (PH_EN(5) && IN(p0 + 4)) { PHASE_BASE();
            pg8::Gemm g = pg8::plain_gemm(WSP(bf16, WS_MERGED), DM, ws + WS_W + WO_OUT, DM, DM); pg8::StaticOrder S; S.init(NTOK / 256, DM / 256, G, bx);
            epi::EpiStore<0> E{WSP(bf16, WS_Y), DM, 0, nullptr}; pg8::gemm_phase<epi::EpiStore<0>, pg8::StaticOrder>(F.tid, ring, xl, g, S, E);
        }
        }
        SEAM(p0 + 4);
        if (PH_EN(6) && IN(p0 + 5)) { PHASE_BASE(); if (DUP_EN(6)) norm_pass(F, ap, l == 0, ap->in[5] + l * DM, ws, true); norm_pass(F, ap, l == 0, ap->in[5] + l * DM, ws); }
        SEAM(p0 + 5);
        for (int rep_ = 0; rep_ <= DUP_EN(7); ++rep_) { if (rep_) BARRIER_NOW();
        if (PH_EN(7) && IN(p0 + 6)) { PHASE_BASE();
            pg8::Gemm g = pg8::plain_gemm(WSP(bf16, WS_XN), DM, ws + WS_W + WO_UP, DM, DM); pg8::StaticOrder S; S.init(NTOK / 256, DFF / 256, G, bx);
            epi::EpiStore<3> E{WSP(bf16, WS_U), DFF, 0, nullptr}; pg8::gemm_phase<epi::EpiStore<3>, pg8::StaticOrder>(F.tid, ring, xl, g, S, E);
        }
        }
        SEAM(p0 + 6);
        for (int rep_ = 0; rep_ <= DUP_EN(8); ++rep_) { if (rep_) BARRIER_NOW();
        if (PH_EN(8) && IN(p0 + 7)) { PHASE_BASE();
            pg8::Gemm g = pg8::plain_gemm(WSP(bf16, WS_U), DFF, ws + WS_W + WO_DOWN, DFF, DFF); pg8::StaticOrder S; S.init(NTOK / 256, DM / 256, G, bx);
            epi::EpiStore<0> E{WSP(bf16, WS_Y), DM, 0, nullptr}; pg8::gemm_phase<epi::EpiStore<0>, pg8::StaticOrder>(F.tid, ring, xl, g, S, E);
        }
        }
        SEAM(p0 + 7);
        if (PH_EN(9) && IN(p0 + 8)) { PHASE_BASE(); norm_pass(F, ap, false, ap->in[19] + l * DM, ws); if (l + 1 < DEPTH) { convert_layer(F, ap, l + 1, ws); if (DUP_EN(9)) convert_layer(F, ap, l + 1, ws); } }
        SEAM(p0 + 8);
    }
#undef IN
#undef SEAM
}


#ifndef DBG_LAST
#define DBG_LAST -1
#endif
#ifndef DBG_DUMP_MASK
#define DBG_DUMP_MASK 0xff
#endif
#if DBG_LAST >= 0
__global__ void __launch_bounds__(256) dbg_dump(float* out, const unsigned char* ws) {
    const bf16* Z = (const bf16*)(ws + WS_Z); const bf16* Q = (const bf16*)(ws + WS_Q); const bf16* KV = (const bf16*)(ws + WS_KV); const bf16* PM = (const bf16*)(ws + WS_PM);
    const bf16* ABC = (const bf16*)(ws + WS_ABC); const bf16* MG = (const bf16*)(ws + WS_MERGED); const bf16* XN = (const bf16*)(ws + WS_XN); const bf16* Y = (const bf16*)(ws + WS_Y);
    for (size_t e = (size_t)blockIdx.x * 256 + threadIdx.x; e < (size_t)NTOK * DM; e += (size_t)gridDim.x * 256) {
        const size_t m = e / DM; const int c = (int)(e % DM); float v = 0.f;
        auto f = [](bf16 b) { return __uint_as_float((unsigned)b << 16); };
        if (DBG_DUMP_MASK & 1) v += f(XN[m * DM + c]);
        if (DBG_DUMP_MASK & 2) v += f(Z[m * NZ + c]) + f(Z[m * NZ + 2048 + (c % 1792)]);
        if (DBG_DUMP_MASK & 4) v += f(Z[m * NZ + ZC_G + c]) + f(Z[m * NZ + ZC_G + 2048 + c]) + f(Z[m * NZ + ZC_G + 4096 + c]);
        if (DBG_DUMP_MASK & 8) v += f(Q[m * NQC + (c % NQC)]) + f(KV[m * NKVC + c]);
        if (DBG_DUMP_MASK & 16) v += f(PM[m * 1024 + (c & 1023)]);
        if (DBG_DUMP_MASK & 32) v += f(ABC[m * NABC + c]) + f(ABC[m * NABC + 1024 + c]);
        if (DBG_DUMP_MASK & 64) v += f(MG[m * DM + c]);
        if (DBG_DUMP_MASK & 128) v += f(Y[m * DM + c]);
        if (DBG_DUMP_MASK & 256) v += f(((const bf16*)(ws + WS_W))[e]) + f(((const bf16*)(ws + WS_W))[e + 20000000]);
        out[e] = v;
    }
}
#endif

extern "C" void kernel_launch(void* const* d_in, const int* in_sizes, int n_in, void* d_out, int out_size, void* d_ws, size_t ws_size, hipStream_t stream) {
    static int grid = 0;
    if (grid == 0) {
        if (n_in != 22 || out_size != NTOK * DM || ws_size < WS_END) { fprintf(stderr, "kernel_launch: unexpected shapes (n_in %d out %d ws %zu)\n", n_in, out_size, ws_size); grid = -1; return; }
        int dev = 0, cus = 0, per_cu = 0;
        if (hipGetDevice(&dev) != hipSuccess || hipDeviceGetAttribute(&cus, hipDeviceAttributeMultiprocessorCount, dev) != hipSuccess) { grid = -1; return; }
        if (hipFuncSetAttribute((const void*)fwd, hipFuncAttributeMaxDynamicSharedMemorySize, LDS_BYTES) != hipSuccess) { fprintf(stderr, "kernel_launch: hipFuncSetAttribute failed\n"); grid = -1; return; }
        if (hipOccupancyMaxActiveBlocksPerMultiprocessor(&per_cu, (const void*)fwd, NWAVES * 64, LDS_BYTES) != hipSuccess || per_cu < 1)
            fprintf(stderr, "kernel_launch: note: occupancy query reports %d workgroups per CU\n", per_cu);
        (void)hipGetLastError();
        grid = cus;
    }
    if (grid < 0) return;
    (void)in_sizes;
    if (hipMemsetAsync((char*)d_ws + WS_CTL, 0, CTL_ZERO_BYTES, stream) != hipSuccess) return;
    Args a{};
    for (int i = 0; i < 22; ++i) a.in[i] = (const float*)d_in[i];
    a.out = (float*)d_out; a.ws = (unsigned char*)d_ws;
#if MK_N_LAUNCHES == 1
    a.ph_lo = 0; a.ph_hi = N_PHASES;
    hipLaunchKernelGGL(fwd, dim3(grid), dim3(NWAVES * 64), LDS_BYTES, stream, a);
#else
#if DBG_LAST >= 0
    for (int k = 0; k <= DBG_LAST; ++k) { a.ph_lo = k; a.ph_hi = k + 1; hipLaunchKernelGGL(fwd, dim3(grid), dim3(NWAVES * 64), LDS_BYTES, stream, a); }
    hipLaunchKernelGGL(dbg_dump, dim3(2048), dim3(256), 0, stream, (float*)d_out, (const unsigned char*)d_ws);
#else
    for (int k = 0; k < N_PHASES; ++k) { a.ph_lo = k; a.ph_hi = k + 1; hipLaunchKernelGGL(fwd, dim3(grid), dim3(NWAVES * 64), LDS_BYTES, stream, a); }
#endif
#endif
    const hipError_t le = hipPeekAtLastError();
    if (le != hipSuccess) fprintf(stderr, "kernel_launch: launch failed: %s\n", hipGetErrorName(le));
}
```

```cpp
#include <hip/hip_runtime.h>
#include <cstdio>
#include <cstdint>

#define DBG_LAST -1
#define DBG_DUMP_MASK 0x6

#define PROBE_XBAR 0
#define PROBE_WAIT 0
#ifndef MK_N_LAUNCHES
#define MK_N_LAUNCHES 1
#endif

constexpr int DM = 2048, NTOK = 24576, NPROMPT = 16384, DEPTH = 4, DFF = 8192;
constexpr int NZW = 9984, NZ = 3840, NZSRC = 9792;
constexpr int ZC_CQ = 0, ZC_CKV = 512, ZC_QW = 1024, ZC_KW = 2048, ZC_VW = 2304, ZC_QM = 2560, ZC_KR = 3584, ZC_G = 3840;
constexpr int NQC = 1536, NKVC = 2048, NMEMR = 1280, NABC = 3072;
constexpr float EPS = 1e-6f;
constexpr float LOG2E = 1.4426950408889634f;
constexpr float C_W = 0.088388347648318440f * LOG2E;
constexpr float C_M = 0.0625f * LOG2E;
constexpr float C_Q = 0.072168783648703220f * LOG2E;

constexpr size_t MiB = 1u << 20;
constexpr size_t WS_CTL = 0, CTL_ZERO_BYTES = 1 * MiB;
constexpr size_t WS_TAB = 2 * MiB;
constexpr size_t WS_RMEM = 4 * MiB;
constexpr size_t WS_RS = 5 * MiB;
constexpr size_t WS_SSQ = 6 * MiB;
constexpr size_t WS_MEMB = 8 * MiB;
constexpr size_t WS_MEMK = 13 * MiB;
constexpr size_t WS_MEMVT = 16 * MiB;
constexpr size_t WS_W = 32 * MiB;
constexpr size_t WO_IN = 0, WO_UQ = WO_IN + (size_t)NZW * DM * 2, WO_UKV = WO_UQ + (size_t)NQC * 512 * 2, WO_MEM = WO_UKV + (size_t)NKVC * 512 * 2,
                 WO_BR = WO_MEM + (size_t)2048 * DM * 2, WO_OUT = WO_BR + (size_t)DM * NABC * 2, WO_UP = WO_OUT + (size_t)DM * DM * 2,
                 WO_DOWN = WO_UP + (size_t)DFF * DM * 2, WO_END = WO_DOWN + (size_t)DM * DFF * 2;
static_assert(WO_END <= 136 * MiB, "weights region");
constexpr size_t WS_XN = 168 * MiB;
constexpr size_t WS_Z = 264 * MiB;
constexpr size_t WS_GT = 444 * MiB;
constexpr size_t WS_U = WS_Z;
constexpr size_t WS_Q = 732 * MiB;
constexpr size_t WS_KV = 804 * MiB;
constexpr size_t WS_PM = 900 * MiB;
constexpr size_t WS_ABC = 948 * MiB;
constexpr size_t WS_MERGED = 732 * MiB;
constexpr size_t WS_Y = 828 * MiB;
constexpr size_t WS_END = 1092 * MiB;
static_assert(WS_Z + (size_t)NTOK * NZ * 2 <= WS_GT && WS_GT + (size_t)3 * 96 * 8 * 131072 <= WS_Q && WS_MERGED + (size_t)NTOK * DM * 2 <= WS_Y && WS_Y + (size_t)NTOK * DM * 2 <= WS_ABC, "ws map");
constexpr int CW_TMO = 0, CW_BAR = 4096, CW_RANK = 16384;

constexpr int RING_OFF = 0, RING_BYTES = 131072;
constexpr int LDSCTL_OFF = RING_BYTES, MISC_OFF = LDSCTL_OFF + 320;
constexpr int XCH_OFF = RING_BYTES + 1024;
constexpr int LDS_BYTES = 147456;
static_assert(XCH_OFF + 8192 <= LDS_BYTES, "LDS map");
constexpr int NWAVES = 8;

#define GAS __attribute__((address_space(1)))
#define LAS __attribute__((address_space(3)))
typedef unsigned short bf16;
typedef unsigned v4u __attribute__((ext_vector_type(4)));
typedef float f32x4 __attribute__((ext_vector_type(4)));
typedef float f32x2 __attribute__((ext_vector_type(2)));
typedef short bf16x8 __attribute__((ext_vector_type(8)));
typedef GAS unsigned gu32;
#define RLX_AGENT __ATOMIC_RELAXED, __HIP_MEMORY_SCOPE_AGENT
#define LDS_WAIT() asm volatile("s_waitcnt lgkmcnt(0)" ::: "memory")
#define VM_WAIT() asm volatile("s_waitcnt vmcnt(0)" ::: "memory")

typedef float f32x2_t __attribute__((ext_vector_type(2))); typedef __bf16 bf16x2_t __attribute__((ext_vector_type(2)));
__device__ __forceinline__ unsigned cvt_pk_bf16(float lo, float hi) { const f32x2_t v = {lo, hi}; const bf16x2_t b = __builtin_convertvector(v, bf16x2_t); return __builtin_bit_cast(unsigned, b); }
__device__ __forceinline__ float bf_lo(unsigned w) { return __uint_as_float(w << 16); }
__device__ __forceinline__ float bf_hi(unsigned w) { return __uint_as_float(w & 0xffff0000u); }
__device__ __forceinline__ float shfl_xor_l(float v, int m, int lane) { return __int_as_float(__builtin_amdgcn_ds_bpermute((lane ^ m) << 2, __float_as_int(v))); }
__device__ __forceinline__ int seq_pos(int m) { return m < NPROMPT ? (m & 4095) : (m - NPROMPT); }
__device__ __forceinline__ int seq_of_panel(int pm) { return pm < 64 ? (pm >> 4) : 4; }

#ifndef PG8_BALANCED
#define PG8_BALANCED 1
#endif
namespace pg8 {
#define PG8_LAS __attribute__((address_space(3)))
typedef unsigned short bf16_t;
typedef short bf16x8 __attribute__((ext_vector_type(8)));
typedef float f32x4 __attribute__((ext_vector_type(4)));
typedef unsigned u32x4 __attribute__((ext_vector_type(4)));
constexpr int BM = 256, BK = 64, HALF = 128, HTB = HALF * BK * 2, STAGE_BYTES = 8 * HTB, NXCD = 8, WGM = 4;

__host__ __device__ __forceinline__ int lds_byte(int r, int c) { const int st = (r >> 4) * 2 + (c >> 5), rr = r & 15, cc = c & 31, ob = rr * 64 + cc * 2; return st * 1024 + (ob ^ (((ob >> 9) & 1) << 5)); }
__host__ __device__ __forceinline__ void stage_rc(int b, int& R, int& C) { const int st = b / 1024, sb = b % 1024, swz = sb ^ (((sb >> 9) & 1) << 5); R = (st >> 1) * 16 + swz / 64; C = (st & 1) * 32 + (swz % 64) / 2; }
__host__ __device__ __forceinline__ int perm32(int rho) { const int n = rho >> 4, i = rho & 15; return 8 * (i >> 2) + 4 * n + (i & 3); }

struct Unit { int pm, pn; };
struct Gemm { const char* A; const char* B; long a_pm, a_pn, b_pn, b_sq; int lda, ldb, K; bool b_tiled;
    __device__ __forceinline__ const char* aptr(const Unit& u) const { return A + (long)u.pm * a_pm + (long)u.pn * a_pn; }
    __device__ __forceinline__ const char* bptr(const Unit& u) const { return B + (long)u.pn * b_pn + (long)seq_of_panel(u.pm) * b_sq; } };
__device__ __forceinline__ Gemm plain_gemm(const void* A, int lda, const void* B, int ldb, int K, bool b_tiled = false) {
    Gemm g; g.A = (const char*)A; g.B = (const char*)B; g.a_pm = (long)BM * lda * 2; g.a_pn = 0; g.b_pn = b_tiled ? (long)(ldb / BK) * 32768 : (long)BM * ldb * 2; g.b_sq = 0; g.lda = lda; g.ldb = ldb; g.K = K; g.b_tiled = b_tiled; return g; }

struct StaticOrder {
    int nM, nN, nwg, G, c;
    __host__ __device__ void init(int nM_, int nN_, int G_, int c_) { nM = nM_; nN = nN_; nwg = nM * nN; G = G_; c = c_; }
    __host__ __device__ bool next(int i, Unit& u) const {
        const int L = i * G + c; if (L >= nwg) return false;
        int wgid = L; { const int q = nwg / NXCD, r = nwg % NXCD, xcd = wgid % NXCD, off = wgid / NXCD; wgid = (xcd < r ? xcd * (q + 1) : r * (q + 1) + (xcd - r) * q) + off; }
        const int nig = WGM * nN, gid = wgid / nig, fm = gid * WGM, gsz = (nM - fm) < WGM ? (nM - fm) : WGM;
        u.pm = fm + ((wgid % nig) % gsz); u.pn = (wgid % nig) / gsz; return true;
    }
};

typedef f32x4 Acc[2][2][4][2];

template <class Epi, class Sched, bool ALIGN_EPI = true, bool SP2 = true>
__device__ __forceinline__ void gemm_phase(int tid_in, PG8_LAS unsigned char* lds, PG8_LAS unsigned char* xlds, const Gemm g, const Sched& S, const Epi& E) {
    int tid_ = tid_in; asm volatile("" : "+v"(tid_));
    const int tid = tid_, wid = __builtin_amdgcn_readfirstlane(tid >> 6), lane = tid & 63, wr = wid >> 2, wc = wid & 3, fr = lane & 15, fq = lane >> 4;
    const int K = g.K, nt = K / BK;
    unsigned voffA[2], voffB[2];
#pragma unroll
    for (int i = 0; i < 2; ++i) { int R, C; stage_rc(tid * 16 + i * 8192, R, C); const int Rb = Epi::PERM ? ((R & ~31) + perm32(R & 31)) : R;
        voffA[i] = (unsigned)(R * g.lda + C) * 2u; voffB[i] = g.b_tiled ? (unsigned)(tid * 16 + i * 8192) : (unsigned)(Rb * g.ldb + C) * 2u; }
    const size_t kstep = (size_t)(BK * 2), kstepB = g.b_tiled ? (size_t)32768 : (size_t)(BK * 2);
    const size_t hstepA = (size_t)HALF * g.lda * 2, hstepB = g.b_tiled ? (size_t)16384 : (size_t)HALF * g.ldb * 2;
    const unsigned ldsw = (unsigned)wid * 1024u;
    const int aoff = lds_byte(wr * 64 + fr, fq * 8), boff = lds_byte(wc * 32 + fr, fq * 8);
#define PG8_SA(b, h) (((b) * 2 + (h)) * HTB)
#define PG8_SB(b, h) ((4 + (b) * 2 + (h)) * HTB)
#define PG8_STAGE(bufoff, gbase, voff) do { _Pragma("unroll") for (int _i = 0; _i < 2; ++_i) \
        __builtin_amdgcn_global_load_lds((const unsigned*)((const char*)(gbase) + (voff)[_i]), (PG8_LAS unsigned*)(lds + (bufoff) + ldsw + _i * 8192), 16, 0, 0); } while (0)
#define PG8_LDA(dst, b, h) do { _Pragma("unroll") for (int m = 0; m < 4; ++m) _Pragma("unroll") for (int k = 0; k < 2; ++k) dst[m][k] = *(const PG8_LAS bf16x8*)(lds + PG8_SA(b, h) + aoff + m * 2048 + k * 1024); } while (0)
#define PG8_LDB(dst, b, h) do { _Pragma("unroll") for (int n = 0; n < 2; ++n) _Pragma("unroll") for (int k = 0; k < 2; ++k) dst[n][k] = *(const PG8_LAS bf16x8*)(lds + PG8_SB(b, h) + boff + n * 2048 + k * 1024); } while (0)
#define PG8_MMA(ai, bj, At, Bt) do { __builtin_amdgcn_s_setprio(1); _Pragma("unroll") for (int m = 0; m < 4; ++m) _Pragma("unroll") for (int n = 0; n < 2; ++n) _Pragma("unroll") for (int k = 0; k < 2; ++k) \
        acc[ai][bj][m][n] = __builtin_amdgcn_mfma_f32_16x16x32_bf16(Bt[n][k], At[m][k], acc[ai][bj][m][n], 0, 0, 0); __builtin_amdgcn_s_setprio(0); } while (0)
#define PG8_WAIT_V(n) asm volatile("s_waitcnt vmcnt(" #n ")" ::: "memory")
#define PG8_WAIT_L(n) asm volatile("s_waitcnt lgkmcnt(" #n ")" ::: "memory")
#define PG8_BAR __builtin_amdgcn_s_barrier()
#define PG8_SCHED __builtin_amdgcn_sched_barrier(0)
    Unit cur, nxt; int ui = 0;
    if (!S.next(0, cur)) return;
    f32x4 acc[2][2][4][2];
#pragma unroll
    for (int a = 0; a < 2; ++a)
#pragma unroll
        for (int b = 0; b < 2; ++b)
#pragma unroll
            for (int m = 0; m < 4; ++m)
#pragma unroll
                for (int n = 0; n < 2; ++n) acc[a][b][m][n] = (f32x4){0.f, 0.f, 0.f, 0.f};
    bf16x8 At[4][2], B0[2][2], B1[2][2];
    const char* cA = g.aptr(cur); const char* cB = g.bptr(cur);
    if constexpr (SP2 && PG8_BALANCED) {
        PG8_STAGE(PG8_SB(0, 0), cB, voffB); PG8_STAGE(PG8_SB(0, 1), cB + hstepB, voffB); PG8_STAGE(PG8_SA(0, 0), cA, voffA); PG8_STAGE(PG8_SA(0, 1), cA + hstepA, voffA);
        if (wr == 1) PG8_BAR;
        PG8_WAIT_V(2); PG8_BAR;
        PG8_STAGE(PG8_SB(1, 0), cB + kstepB, voffB); PG8_STAGE(PG8_SB(1, 1), cB + hstepB + kstepB, voffB);
        PG8_WAIT_V(4); PG8_BAR;
    } else if constexpr (SP2) {
        PG8_STAGE(PG8_SB(0, 0), cB, voffB); PG8_STAGE(PG8_SB(0, 1), cB + hstepB, voffB); PG8_STAGE(PG8_SA(0, 0), cA, voffA); PG8_STAGE(PG8_SA(0, 1), cA + hstepA, voffA);
        if (wr == 1) PG8_BAR;
        PG8_WAIT_V(2); PG8_BAR;
        PG8_STAGE(PG8_SB(1, 0), cB + kstepB, voffB); PG8_STAGE(PG8_SA(1, 0), cA + kstep, voffA); PG8_STAGE(PG8_SB(1, 1), cB + hstepB + kstepB, voffB);
        PG8_WAIT_V(6); PG8_BAR;
    } else {
        PG8_STAGE(PG8_SB(0, 0), cB, voffB); PG8_STAGE(PG8_SA(0, 0), cA, voffA); PG8_STAGE(PG8_SB(0, 1), cB + hstepB, voffB); PG8_STAGE(PG8_SA(0, 1), cA + hstepA, voffA);
        if (wr == 1) PG8_BAR;
        PG8_WAIT_V(4); PG8_BAR;
        PG8_STAGE(PG8_SB(1, 0), cB + kstepB, voffB); PG8_STAGE(PG8_SA(1, 0), cA + kstep, voffA); PG8_STAGE(PG8_SB(1, 1), cB + hstepB + kstepB, voffB);
        PG8_WAIT_V(6); PG8_BAR;
    }
    for (;;) {
        const bool has_next = S.next(ui + 1, nxt);
        const char* nA = has_next ? g.aptr(nxt) : cA; const char* nB = has_next ? g.bptr(nxt) : cB;
        for (int t = 0; t < nt; t += 2) {
            const bool last = (t == nt - 2);
            if constexpr (Epi::HAS_MID) { if (t == Epi::MID1 || t == Epi::MID2) E.mid(acc, cur, t, wr, wc, fr, fq); }
            const char* a1 = cA + (size_t)(t + 1) * kstep;
            const char* a2 = last ? nA : cA + (size_t)(t + 2) * kstep; const char* b2 = last ? nB : cB + (size_t)(t + 2) * kstepB;
            const char* a3 = a2 + kstep; const char* b3 = b2 + kstepB;
            if constexpr (SP2 && PG8_BALANCED) {
            PG8_LDB(B0, 0, 0); PG8_LDB(B1, 0, 1); PG8_SCHED; PG8_LDA(At, 0, 0); PG8_STAGE(PG8_SA(1, 0), a1, voffA); PG8_STAGE(PG8_SA(1, 1), a1 + hstepA, voffA);
            PG8_WAIT_V(8); PG8_WAIT_L(0); PG8_BAR; PG8_MMA(0, 0, At, B0); PG8_MMA(0, 1, At, B1); PG8_BAR; PG8_SCHED;
            PG8_LDA(At, 0, 1); PG8_STAGE(PG8_SB(0, 0), b2, voffB); PG8_STAGE(PG8_SB(0, 1), b2 + hstepB, voffB);
            PG8_WAIT_V(6); PG8_WAIT_L(0); PG8_BAR; PG8_MMA(1, 0, At, B0); PG8_MMA(1, 1, At, B1); PG8_BAR; PG8_SCHED;
            PG8_LDB(B0, 1, 0); PG8_LDB(B1, 1, 1); PG8_SCHED; PG8_LDA(At, 1, 0); PG8_STAGE(PG8_SA(0, 0), a2, voffA); PG8_STAGE(PG8_SA(0, 1), a2 + hstepA, voffA);
            PG8_WAIT_V(8); PG8_WAIT_L(0); PG8_BAR; PG8_MMA(0, 0, At, B0); PG8_MMA(0, 1, At, B1); PG8_BAR; PG8_SCHED;
            PG8_LDA(At, 1, 1); PG8_STAGE(PG8_SB(1, 0), b3, voffB); PG8_STAGE(PG8_SB(1, 1), b3 + hstepB, voffB);
            PG8_WAIT_V(6); PG8_WAIT_L(0); PG8_BAR; PG8_MMA(1, 0, At, B0); PG8_MMA(1, 1, At, B1); PG8_BAR; PG8_SCHED;
            } else if constexpr (SP2) {
            PG8_LDB(B0, 0, 0); PG8_LDB(B1, 0, 1); PG8_SCHED; PG8_LDA(At, 0, 0); PG8_STAGE(PG8_SA(1, 1), a1 + hstepA, voffA);
            PG8_WAIT_V(8); PG8_WAIT_L(0); PG8_BAR; PG8_MMA(0, 0, At, B0); PG8_MMA(0, 1, At, B1); PG8_BAR; PG8_SCHED;
            PG8_LDA(At, 0, 1); PG8_STAGE(PG8_SB(0, 0), b2, voffB); PG8_STAGE(PG8_SB(0, 1), b2 + hstepB, voffB); PG8_STAGE(PG8_SA(0, 0), a2, voffA);
            PG8_WAIT_V(8); PG8_WAIT_L(0); PG8_BAR; PG8_MMA(1, 0, At, B0); PG8_MMA(1, 1, At, B1); PG8_BAR; PG8_SCHED;
            PG8_LDB(B0, 1, 0); PG8_LDB(B1, 1, 1); PG8_SCHED; PG8_LDA(At, 1, 0); PG8_STAGE(PG8_SA(0, 1), a2 + hstepA, voffA);
            PG8_WAIT_V(8); PG8_WAIT_L(0); PG8_BAR; PG8_MMA(0, 0, At, B0); PG8_MMA(0, 1, At, B1); PG8_BAR; PG8_SCHED;
            PG8_LDA(At, 1, 1); PG8_STAGE(PG8_SB(1, 0), b3, voffB); PG8_STAGE(PG8_SB(1, 1), b3 + hstepB, voffB); PG8_STAGE(PG8_SA(1, 0), a3, voffA);
            PG8_WAIT_V(8); PG8_WAIT_L(0); PG8_BAR; PG8_MMA(1, 0, At, B0); PG8_MMA(1, 1, At, B1); PG8_BAR; PG8_SCHED;
            } else {
            PG8_LDB(B0, 0, 0); PG8_SCHED; PG8_LDA(At, 0, 0); PG8_STAGE(PG8_SA(1, 1), a1 + hstepA, voffA);
            PG8_WAIT_L(8); PG8_BAR; PG8_WAIT_L(0); PG8_MMA(0, 0, At, B0); PG8_BAR; PG8_SCHED;
            PG8_LDB(B1, 0, 1); PG8_STAGE(PG8_SB(0, 0), b2, voffB);
            PG8_BAR; PG8_WAIT_L(0); PG8_MMA(0, 1, At, B1); PG8_BAR;
            PG8_LDA(At, 0, 1); PG8_STAGE(PG8_SA(0, 0), a2, voffA);
            PG8_BAR; PG8_WAIT_L(0); PG8_MMA(1, 0, At, B0); PG8_BAR; PG8_SCHED;
            PG8_STAGE(PG8_SB(0, 1), b2 + hstepB, voffB);
            PG8_WAIT_V(6); PG8_BAR; PG8_MMA(1, 1, At, B1); PG8_BAR;
            PG8_LDB(B0, 1, 0); PG8_SCHED; PG8_LDA(At, 1, 0); PG8_STAGE(PG8_SA(0, 1), a2 + hstepA, voffA);
            PG8_WAIT_L(8); PG8_BAR; PG8_WAIT_L(0); PG8_MMA(0, 0, At, B0); PG8_BAR; PG8_SCHED;
            PG8_LDB(B1, 1, 1); PG8_STAGE(PG8_SB(1, 0), b3, voffB);
            PG8_BAR; PG8_WAIT_L(0); PG8_MMA(0, 1, At, B1); PG8_BAR;
            PG8_LDA(At, 1, 1); PG8_STAGE(PG8_SA(1, 0), a3, voffA);
            PG8_BAR; PG8_WAIT_L(0); PG8_MMA(1, 0, At, B0); PG8_BAR; PG8_SCHED;
            PG8_STAGE(PG8_SB(1, 1), b3 + hstepB, voffB);
            PG8_WAIT_V(6); PG8_BAR; PG8_MMA(1, 1, At, B1); PG8_BAR;
            }
        }
        if constexpr (ALIGN_EPI) { if (wr == 0) PG8_BAR; }
        E(acc, cur, wr, wc, fr, fq, xlds, wid, lane);
        if (!has_next) break;
#pragma unroll
        for (int a = 0; a < 2; ++a)
#pragma unroll
            for (int b = 0; b < 2; ++b)
#pragma unroll
                for (int m = 0; m < 4; ++m)
#pragma unroll
                    for (int n = 0; n < 2; ++n) acc[a][b][m][n] = (f32x4){0.f, 0.f, 0.f, 0.f};
        cur = nxt; cA = nA; cB = nB; ++ui;
        if constexpr (ALIGN_EPI) { if (wr == 1) PG8_BAR; }
    }
    PG8_WAIT_V(0);
    if constexpr (!ALIGN_EPI) { if (wr == 0) PG8_BAR; }
    PG8_BAR;
#undef PG8_SA
#undef PG8_SB
#undef PG8_STAGE
#undef PG8_LDA
#undef PG8_LDB
#undef PG8_MMA
#undef PG8_WAIT_V
#undef PG8_WAIT_L
#undef PG8_BAR
#undef PG8_SCHED
}
}

namespace epi {
using pg8::Acc; using pg8::Unit; using pg8::HALF; using pg8::BM;
typedef float f32x2v __attribute__((ext_vector_type(2)));
#define EPI_COMMON static constexpr bool PERM = true;
#define EPI_PIN(a, b) asm volatile("" : "+v"(a), "+v"(b))
#define EPI_NOMID static constexpr bool HAS_MID = false; static constexpr int MID1 = -1, MID2 = -1;
__device__ __forceinline__ v4u pack8(const f32x4 v0, const f32x4 v1) { v4u w; w.x = cvt_pk_bf16(v0[0], v0[1]); w.y = cvt_pk_bf16(v0[2], v0[3]); w.z = cvt_pk_bf16(v1[0], v1[1]); w.w = cvt_pk_bf16(v1[2], v1[3]); return w; }
__device__ __forceinline__ void rope8(f32x4& v0, f32x4& v1, const f32x4 cs0, const f32x4 cs1, const f32x4 cs2, const f32x4 cs3) {
    (void)cs2; (void)cs3;
    const float a0 = v0[0] * cs0[0] - v0[1] * cs0[1], b0 = v0[0] * cs0[1] + v0[1] * cs0[0];
    const float a1 = v0[2] * cs0[2] - v0[3] * cs0[3], b1 = v0[2] * cs0[3] + v0[3] * cs0[2];
    const float a2 = v1[0] * cs1[0] - v1[1] * cs1[1], b2 = v1[0] * cs1[1] + v1[1] * cs1[0];
    const float a3 = v1[2] * cs1[2] - v1[3] * cs1[3], b3 = v1[2] * cs1[3] + v1[3] * cs1[2];
    v0 = (f32x4){a0, b0, a1, b1}; v1 = (f32x4){a2, b2, a3, b3};
}
__device__ __forceinline__ float sigmoidf_fast(float v) { return __builtin_amdgcn_rcpf(1.f + __builtin_amdgcn_exp2f(-LOG2E * v)); }

struct EpiZ { EPI_COMMON EPI_NOMID
    bf16* Z; float* SSQ; const float* tab; unsigned char* GT;
    __device__ __forceinline__ void operator()(Acc& acc, const Unit& u, int wr, int wc, int fr, int fq, LAS unsigned char*, int, int lane) const {
        const int pn = u.pn; int row0 = u.pm * BM + wr * 64 + fr, col0 = pn * BM + wc * 32 + 8 * fq; EPI_PIN(row0, col0);
        if (pn >= 15) {
            const int gi = pn - 15; unsigned char* blk = GT + ((size_t)((gi >> 3) * 96 + u.pm) * 8 + (gi & 7)) * 131072 + (size_t)(wr * 4 + wc) * 16384 + lane * 16;
#pragma unroll
            for (int ai = 0; ai < 2; ++ai)
#pragma unroll
                for (int m = 0; m < 4; ++m)
#pragma unroll
                    for (int bj = 0; bj < 2; ++bj) { f32x4 v0 = acc[ai][bj][m][0], v1 = acc[ai][bj][m][1];
#pragma unroll
                        for (int j = 0; j < 4; ++j) { v0[j] = sigmoidf_fast(v0[j]); v1[j] = sigmoidf_fast(v1[j]); }
                        *(v4u*)(blk + ((ai * 4 + m) * 2 + bj) * 1024) = pack8(v0, v1); }
        } else if (pn == 14) {
            const int i0 = 16 * (wc & 1) + 4 * fq;
#pragma unroll
            for (int ai = 0; ai < 2; ++ai)
#pragma unroll
                for (int m = 0; m < 4; ++m) { const int row = row0 + ai * HALF + m * 16; bf16* rowp = Z + (size_t)row * NZ + col0;
                    f32x4 v0 = acc[ai][0][m][0], v1 = acc[ai][0][m][1];
                    if (wc < 2) { const f32x4* cs = (const f32x4*)(tab + ((size_t)seq_pos(row) * 32 + i0) * 2); rope8(v0, v1, cs[0], cs[1], cs[0], cs[0]); }
                    *(v4u*)(rowp) = pack8(v0, v1);
                    *(v4u*)(rowp + HALF) = pack8(acc[ai][1][m][0], acc[ai][1][m][1]); }
        } else {
            const float sc = (pn >= 4 && pn < 8) ? C_W : ((pn >= 10) ? C_M : 1.f);
#pragma unroll
            for (int ai = 0; ai < 2; ++ai)
#pragma unroll
                for (int m = 0; m < 4; ++m) { const int row = row0 + ai * HALF + m * 16; bf16* rowp = Z + (size_t)row * NZ + col0; float ss = 0.f;
#pragma unroll
                    for (int bj = 0; bj < 2; ++bj) { const f32x4 v0 = acc[ai][bj][m][0] * sc, v1 = acc[ai][bj][m][1] * sc;
                        ss += (v0[0] * v0[0] + v0[1] * v0[1]) + (v0[2] * v0[2] + v0[3] * v0[3]) + (v1[0] * v1[0] + v1[1] * v1[1]) + (v1[2] * v1[2] + v1[3] * v1[3]);
                        *(v4u*)(rowp + bj * HALF) = pack8(v0, v1); }
                    if (pn < 4) { ss += shfl_xor_l(ss, 16, lane); ss += shfl_xor_l(ss, 32, lane); if (fq == 0) SSQ[(size_t)row * 16 + pn * 4 + wc] = ss; } }
        }
    }
};
template <int WHICH  > struct EpiLat { EPI_COMMON EPI_NOMID
    bf16* O; const float* SSQ; const float* tab;
    __device__ __forceinline__ void operator()(Acc& acc, const Unit& u, int wr, int wc, int fr, int fq, LAS unsigned char*, int, int) const {
        constexpr int LDC = WHICH == 0 ? NQC : NKVC;
        const int pn = u.pn; int row0 = u.pm * BM + wr * 64 + fr, col0 = pn * BM + wc * 32 + 8 * fq; EPI_PIN(row0, col0);
        const int i0 = 16 * (wc & 1) + 4 * fq;
        float rs[2][4];
#pragma unroll
        for (int ai = 0; ai < 2; ++ai) { f32x4 sa[4][2];
#pragma unroll
            for (int m = 0; m < 4; ++m) { const f32x4* sp = (const f32x4*)(SSQ + (size_t)(row0 + ai * HALF + m * 16) * 16 + WHICH * 8); sa[m][0] = sp[0]; sa[m][1] = sp[1]; }
            __builtin_amdgcn_sched_barrier(0);
#pragma unroll
            for (int m = 0; m < 4; ++m) { const f32x4 s0 = sa[m][0], s1 = sa[m][1];
                const float ssum = ((s0[0] + s0[1]) + (s0[2] + s0[3])) + ((s1[0] + s1[1]) + (s1[2] + s1[3]));
                rs[ai][m] = __builtin_amdgcn_rsqf(ssum * (1.f / 512.f) + EPS) * (WHICH == 0 ? C_Q : 1.f); }
            __builtin_amdgcn_sched_barrier(0); }
        if (WHICH == 0 && pn >= 4) {
#pragma unroll
            for (int ai = 0; ai < 2; ++ai) { f32x4 cs[4][2];
#pragma unroll
                for (int m = 0; m < 4; ++m) { const f32x4* cp = (const f32x4*)(tab + ((size_t)seq_pos(row0 + ai * HALF + m * 16) * 32 + i0) * 2); cs[m][0] = cp[0]; cs[m][1] = cp[1]; }
                __builtin_amdgcn_sched_barrier(0);
#pragma unroll
                for (int m = 0; m < 4; ++m) { bf16* rowp = O + (size_t)(row0 + ai * HALF + m * 16) * LDC + col0;
#pragma unroll
                    for (int bj = 0; bj < 2; ++bj) { f32x4 v0 = acc[ai][bj][m][0] * rs[ai][m], v1 = acc[ai][bj][m][1] * rs[ai][m];
                        rope8(v0, v1, cs[m][0], cs[m][1], cs[m][0], cs[m][0]);
                        *(v4u*)(rowp + bj * HALF) = pack8(v0, v1); } }
                __builtin_amdgcn_sched_barrier(0); }
        } else {
#pragma unroll
            for (int ai = 0; ai < 2; ++ai)
#pragma unroll
                for (int m = 0; m < 4; ++m) { bf16* rowp = O + (size_t)(row0 + ai * HALF + m * 16) * LDC + col0;
#pragma unroll
                    for (int bj = 0; bj < 2; ++bj) *(v4u*)(rowp + bj * HALF) = pack8(acc[ai][bj][m][0] * rs[ai][m], acc[ai][bj][m][1] * rs[ai][m]); }
        }
    }
};
template <int MODE> struct EpiStore { EPI_COMMON EPI_NOMID
    bf16* O; int ldc; int col_off; const float* rs;
    __device__ __forceinline__ void operator()(Acc& acc, const Unit& u, int wr, int wc, int fr, int fq, LAS unsigned char*, int, int) const {
        int row0 = u.pm * BM + wr * 64 + fr, ct = u.pn * BM + wc * 32 + 8 * fq; EPI_PIN(row0, ct); const int col0 = col_off + ct;
        f32x4 cs[2][2]; float rr[2][4];
#pragma unroll
        for (int ai = 0; ai < 2; ++ai)
#pragma unroll
            for (int m = 0; m < 4; ++m) rr[ai][m] = (MODE == 1 || MODE == 5) ? rs[row0 + ai * HALF + m * 16] : 1.f;
        if (MODE == 2) {
#pragma unroll
            for (int bj = 0; bj < 2; ++bj) { cs[bj][0] = *(const f32x4*)(rs + ct + bj * HALF); cs[bj][1] = *(const f32x4*)(rs + ct + bj * HALF + 4); } }
#pragma unroll
        for (int ai = 0; ai < 2; ++ai)
#pragma unroll
            for (int m = 0; m < 4; ++m) { const int row = row0 + ai * HALF + m * 16; bf16* rowp = O + (size_t)row * ldc + col0;
                const float r = rr[ai][m];
#pragma unroll
                for (int bj = 0; bj < 2; ++bj) { f32x4 v0 = acc[ai][bj][m][0], v1 = acc[ai][bj][m][1];
                    if (MODE == 1 || MODE == 5) { v0 = v0 * r; v1 = v1 * r; }
                    if (MODE == 2) { v0 = v0 * cs[bj][0]; v1 = v1 * cs[bj][1]; }
                    if (MODE == 3 || MODE == 5) {
#pragma unroll
                        for (int j = 0; j < 4; ++j) { const float a = fmaxf(v0[j], 0.f), b = fmaxf(v1[j], 0.f); v0[j] = a * a; v1[j] = b * b; } }
                    *(v4u*)(rowp + bj * HALF) = pack8(v0, v1); } }
    }
};
struct EpiSoftmax { EPI_COMMON EPI_NOMID
    bf16* O;
    __device__ __forceinline__ void operator()(Acc& acc, const Unit& u, int wr, int wc, int fr, int fq, LAS unsigned char* xl, int, int lane) const {
        LAS float* MX = (LAS float*)xl; LAS float* SM = (LAS float*)(xl + 4096);
        int row0 = u.pm * BM + wr * 64 + fr, col0 = u.pn * BM + wc * 32 + 8 * fq; EPI_PIN(row0, col0);
#pragma unroll
        for (int ai = 0; ai < 2; ++ai)
#pragma unroll
            for (int m = 0; m < 4; ++m) { float mx = -3.0e38f;
#pragma unroll
                for (int bj = 0; bj < 2; ++bj)
#pragma unroll
                    for (int n = 0; n < 2; ++n) { const f32x4 x = acc[ai][bj][m][n]; mx = fmaxf(mx, fmaxf(fmaxf(x[0], x[1]), fmaxf(x[2], x[3]))); }
                mx = fmaxf(mx, shfl_xor_l(mx, 16, lane)); mx = fmaxf(mx, shfl_xor_l(mx, 32, lane));
                if (fq == 0) MX[(ai * HALF + wr * 64 + m * 16 + fr) * 4 + wc] = mx; }
        asm volatile("s_waitcnt lgkmcnt(0)" ::: "memory"); __builtin_amdgcn_s_barrier(); asm volatile("" ::: "memory");
#pragma unroll
        for (int ai = 0; ai < 2; ++ai)
#pragma unroll
            for (int m = 0; m < 4; ++m) { const int lr = ai * HALF + wr * 64 + m * 16 + fr; const f32x4 q = *(LAS f32x4*)(MX + lr * 4);
                const float mx = fmaxf(fmaxf(q[0], q[1]), fmaxf(q[2], q[3])); float s = 0.f;
#pragma unroll
                for (int bj = 0; bj < 2; ++bj)
#pragma unroll
                    for (int n = 0; n < 2; ++n) { f32x4 x = acc[ai][bj][m][n];
#pragma unroll
                        for (int j = 0; j < 4; ++j) { x[j] = __builtin_amdgcn_exp2f(x[j] - mx); s += x[j]; }
                        acc[ai][bj][m][n] = x; }
                s += shfl_xor_l(s, 16, lane); s += shfl_xor_l(s, 32, lane);
                if (fq == 0) SM[lr * 4 + wc] = s; }
        asm volatile("s_waitcnt lgkmcnt(0)" ::: "memory"); __builtin_amdgcn_s_barrier(); asm volatile("" ::: "memory");
#pragma unroll
        for (int ai = 0; ai < 2; ++ai)
#pragma unroll
            for (int m = 0; m < 4; ++m) { const int lr = ai * HALF + wr * 64 + m * 16 + fr; const f32x4 q = *(LAS f32x4*)(SM + lr * 4);
                const float inv = __builtin_amdgcn_rcpf((q[0] + q[1]) + (q[2] + q[3]));
                bf16* rowp = O + (size_t)(row0 + ai * HALF + m * 16) * 1024 + col0;
#pragma unroll
                for (int bj = 0; bj < 2; ++bj) *(v4u*)(rowp + bj * HALF) = pack8(acc[ai][bj][m][0] * inv, acc[ai][bj][m][1] * inv); }
    }
};
struct EpiBranch { EPI_COMMON
    static constexpr bool HAS_MID = true; static constexpr int MID1 = 16, MID2 = 32;
    bf16* O; const unsigned char* GT;
    __device__ __forceinline__ const unsigned char* gblk(const Unit& u, int g, int wr, int wc, int fr, int fq) const {
        return GT + ((size_t)(g * 96 + u.pm) * 8 + u.pn) * 131072 + (size_t)(wr * 4 + wc) * 16384 + (fq * 16 + fr) * 16; }
    __device__ __forceinline__ void mid(Acc& acc, const Unit& u, int t, int wr, int wc, int fr, int fq) const {
        const int gxi = (t == MID1) ? 0 : 1;
        const unsigned char* px = gblk(u, gxi, wr, wc, fr, fq); const unsigned char* py = gblk(u, gxi + 1, wr, wc, fr, fq);
#pragma unroll
        for (int ai = 0; ai < 2; ++ai) {
            v4u a[4][2], b[4][2];
#pragma unroll
            for (int m = 0; m < 4; ++m)
#pragma unroll
                for (int bj = 0; bj < 2; ++bj) { a[m][bj] = *(const v4u*)(px + ((ai * 4 + m) * 2 + bj) * 1024); b[m][bj] = *(const v4u*)(py + ((ai * 4 + m) * 2 + bj) * 1024); }
            __builtin_amdgcn_sched_barrier(0);
#pragma unroll
            for (int m = 0; m < 4; ++m)
#pragma unroll
                for (int bj = 0; bj < 2; ++bj) { const v4u x = a[m][bj], y = b[m][bj]; f32x4 r0, r1;
                    r0[0] = bf_lo(x.x) * __builtin_amdgcn_rcpf(bf_lo(y.x)); r0[1] = bf_hi(x.x) * __builtin_amdgcn_rcpf(bf_hi(y.x));
                    r0[2] = bf_lo(x.y) * __builtin_amdgcn_rcpf(bf_lo(y.y)); r0[3] = bf_hi(x.y) * __builtin_amdgcn_rcpf(bf_hi(y.y));
                    r1[0] = bf_lo(x.z) * __builtin_amdgcn_rcpf(bf_lo(y.z)); r1[1] = bf_hi(x.z) * __builtin_amdgcn_rcpf(bf_hi(y.z));
                    r1[2] = bf_lo(x.w) * __builtin_amdgcn_rcpf(bf_lo(y.w)); r1[3] = bf_hi(x.w) * __builtin_amdgcn_rcpf(bf_hi(y.w));
                    acc[ai][bj][m][0] *= r0; acc[ai][bj][m][1] *= r1; }
            __builtin_amdgcn_sched_barrier(0);
        }
    }
    __device__ __forceinline__ void operator()(Acc& acc, const Unit& u, int wr, int wc, int fr, int fq, LAS unsigned char*, int, int) const {
        int row0 = u.pm * BM + wr * 64 + fr, col0 = u.pn * BM + wc * 32 + 8 * fq; EPI_PIN(row0, col0);
        const unsigned char* pz = gblk(u, 2, wr, wc, fr, fq);
#pragma unroll
        for (int ai = 0; ai < 2; ++ai) {
            v4u a[4][2];
#pragma unroll
            for (int m = 0; m < 4; ++m)
#pragma unroll
                for (int bj = 0; bj < 2; ++bj) a[m][bj] = *(const v4u*)(pz + ((ai * 4 + m) * 2 + bj) * 1024);
            __builtin_amdgcn_sched_barrier(0);
#pragma unroll
            for (int m = 0; m < 4; ++m) { bf16* rowp = O + (size_t)(row0 + ai * HALF + m * 16) * DM + col0;
#pragma unroll
                for (int bj = 0; bj < 2; ++bj) { const v4u x = a[m][bj];
                    const f32x4 g0 = {bf_lo(x.x), bf_hi(x.x), bf_lo(x.y), bf_hi(x.y)}, g1 = {bf_lo(x.z), bf_hi(x.z), bf_lo(x.w), bf_hi(x.w)};
                    *(v4u*)(rowp + bj * HALF) = pack8(acc[ai][bj][m][0] * g0, acc[ai][bj][m][1] * g1); } }
            __builtin_amdgcn_sched_barrier(0);
        }
    }
};
}

namespace att {
using s16x4 = __attribute__((ext_vector_type(4))) short;
using f32x16 = __attribute__((ext_vector_type(16))) float;
using u32x4 = __attribute__((ext_vector_type(4))) unsigned;
constexpr int NW = 8, QBLK = 32, KVBLK = 64;
constexpr float THR2 = 8.f;
constexpr float NEGBIG = -1.0e30f;
#define SBAR() __builtin_amdgcn_sched_barrier(0)
__device__ __forceinline__ int crow(int r, int hi) { return (r & 3) + 8 * (r >> 2) + 4 * hi; }
template <int KROWB> __device__ __forceinline__ int kswz(int row, int colB) { return row * KROWB + (colB ^ ((KROWB == 384 ? ((row >> 1) & 7) : (row & 15)) << 4)); }

struct Mask { int dq; float sl; };

template <bool WIN>
__device__ __forceinline__ void partialSM(f32x16& p0, f32x16& p1, float& m_reg, float& mn, float& alpha, const Mask& mk, int kt) {
  if (WIN) {
    const float fd = (float)(mk.dq - kt * KVBLK);
#pragma unroll
    for (int r = 0; r < 16; ++r) { const float d0 = fd - (float)((r & 3) + 8 * (r >> 2)), d1 = d0 - 32.f; const float a0 = fabsf(d0), a1 = fabsf(d1);
      const float t0 = p0[r] - mk.sl * a0, t1 = p1[r] - mk.sl * a1; p0[r] = (a0 <= 128.f) ? t0 : NEGBIG; p1[r] = (a1 <= 128.f) ? t1 : NEGBIG; }
  }
  float pmax = p0[0];
#pragma unroll
  for (int r = 1; r < 16; ++r) pmax = fmaxf(pmax, p0[r]);
#pragma unroll
  for (int r = 0; r < 16; ++r) pmax = fmaxf(pmax, p1[r]);
  { auto rr = __builtin_amdgcn_permlane32_swap(__float_as_uint(pmax), __float_as_uint(pmax), false, false);
    pmax = fmaxf(__uint_as_float(rr[0]), __uint_as_float(rr[1])); }
  if (__builtin_expect(__all(pmax - m_reg <= THR2), 1)) { mn = m_reg; alpha = 1.f; }
  else { mn = fmaxf(m_reg, pmax); alpha = __builtin_amdgcn_exp2f(m_reg - mn); m_reg = mn; }
#pragma unroll
  for (int r = 0; r < 16; ++r) p0[r] = p0[r] - mn;
#pragma unroll
  for (int r = 0; r < 16; ++r) p1[r] = p1[r] - mn;
#pragma unroll
  for (int r = 0; r < 16; ++r) p0[r] = __builtin_amdgcn_exp2f(p0[r]);
}
__device__ __forceinline__ void finishSM(f32x16& p0, f32x16& p1, float alpha, float& l_reg, bf16x8& pa0, bf16x8& pa1, bf16x8& pa2, bf16x8& pa3) {
#pragma unroll
  for (int r = 0; r < 16; ++r) p1[r] = __builtin_amdgcn_exp2f(p1[r]);
  float ps = 0;
#pragma unroll
  for (int r = 0; r < 16; ++r) ps += p0[r];
#pragma unroll
  for (int r = 0; r < 16; ++r) ps += p1[r];
  { auto rr = __builtin_amdgcn_permlane32_swap(__float_as_uint(ps), __float_as_uint(ps), false, false);
    ps = __uint_as_float(rr[0]) + __uint_as_float(rr[1]); }
  l_reg = l_reg * alpha + ps;
#define PK4(P, BASE, OUT) do { unsigned a0 = cvt_pk_bf16(P[BASE + 0], P[BASE + 1]), a1 = cvt_pk_bf16(P[BASE + 2], P[BASE + 3]);   \
    unsigned b0 = cvt_pk_bf16(P[BASE + 4], P[BASE + 5]), b1 = cvt_pk_bf16(P[BASE + 6], P[BASE + 7]);                              \
    auto r0 = __builtin_amdgcn_permlane32_swap(a0, b0, false, false); auto r1 = __builtin_amdgcn_permlane32_swap(a1, b1, false, false); \
    u32x4 w = {r0[0], r1[0], r0[1], r1[1]}; OUT = *reinterpret_cast<bf16x8*>(&w); } while (0)
  PK4(p0, 0, pa0); PK4(p0, 8, pa1); PK4(p1, 0, pa2); PK4(p1, 8, pa3);
#undef PK4
}
template <int NQF, int KROWB>
__device__ __forceinline__ void qkt(f32x16& p0, f32x16& p1, const LAS char* Ks, const bf16x8* qr, int r32, int hi) {
  p0 = f32x16{}; p1 = f32x16{};
#pragma unroll
  for (int d0 = 0; d0 < NQF; ++d0) { const int cb = (d0 * 16 + hi * 8) * 2;
    bf16x8 b0 = *(const LAS bf16x8*)(Ks + kswz<KROWB>(r32, cb));
    bf16x8 b1 = *(const LAS bf16x8*)(Ks + kswz<KROWB>(32 + r32, cb));
    p0 = __builtin_amdgcn_mfma_f32_32x32x16_bf16(b0, qr[d0], p0, 0, 0, 0);
    p1 = __builtin_amdgcn_mfma_f32_32x32x16_bf16(b1, qr[d0], p1, 0, 0, 0); }
}
__device__ __forceinline__ int v_st(int k, int c) { const int kk = (k & ~0xC) | ((k & 4) << 1) | ((k & 8) >> 1); return ((kk >> 3) * 4 + (c >> 5)) * 512 + ((kk & 7) * 32 + (c & 31)) * 2; }
__device__ __forceinline__ int v_rd_base(int lane) { return ((lane & 3) << 3) | (((lane >> 2) & 3) << 6) | (((lane >> 4) & 1) << 5) | (((lane >> 5) & 1) << 8); }
constexpr int v_rd_off(int d0, int ks, int half) { return d0 * 512 + ks * 4096 + half * 2048; }
template <int OFF> __device__ __forceinline__ s16x4 tr_read(int vb) {
  s16x4 r; asm volatile("ds_read_b64_tr_b16 %0, %1 offset:%2" : "=&v"(r) : "v"(vb), "i"(OFF) : "memory"); return r;
}
template <int D0> __device__ __forceinline__ void pv_one(f32x16& od, int vb, bf16x8 pa0, bf16x8 pa1, bf16x8 pa2, bf16x8 pa3) {
  const s16x4 l0 = tr_read<v_rd_off(D0, 0, 0)>(vb), h0 = tr_read<v_rd_off(D0, 0, 1)>(vb), l1 = tr_read<v_rd_off(D0, 1, 0)>(vb), h1 = tr_read<v_rd_off(D0, 1, 1)>(vb);
  const s16x4 l2 = tr_read<v_rd_off(D0, 2, 0)>(vb), h2 = tr_read<v_rd_off(D0, 2, 1)>(vb), l3 = tr_read<v_rd_off(D0, 3, 0)>(vb), h3 = tr_read<v_rd_off(D0, 3, 1)>(vb);
  asm volatile("s_waitcnt lgkmcnt(0)" ::: "memory"); SBAR();
#define PK(L, H) (bf16x8){L[0], L[1], L[2], L[3], H[0], H[1], H[2], H[3]}
  od = __builtin_amdgcn_mfma_f32_32x32x16_bf16(pa0, PK(l0, h0), od, 0, 0, 0);
  od = __builtin_amdgcn_mfma_f32_32x32x16_bf16(pa1, PK(l1, h1), od, 0, 0, 0);
  od = __builtin_amdgcn_mfma_f32_32x32x16_bf16(pa2, PK(l2, h2), od, 0, 0, 0);
  od = __builtin_amdgcn_mfma_f32_32x32x16_bf16(pa3, PK(l3, h3), od, 0, 0, 0);
#undef PK
}
__device__ __forceinline__ void pv_d0(f32x16* o, int vb, bf16x8 pa0, bf16x8 pa1, bf16x8 pa2, bf16x8 pa3) {
  pv_one<0>(o[0], vb, pa0, pa1, pa2, pa3); pv_one<1>(o[1], vb, pa0, pa1, pa2, pa3); pv_one<2>(o[2], vb, pa0, pa1, pa2, pa3); pv_one<3>(o[3], vb, pa0, pa1, pa2, pa3);
}

template <int KIND>
__device__ __forceinline__ void attn_unit(const bf16* __restrict__ Qb, const bf16* __restrict__ KVb, const bf16* __restrict__ Zb, bf16* __restrict__ Ob,
                                          int qm0, int km0, int NT, int h, int ocol, float m0, float l0, Mask mk, LAS char* lds, int tid_in) {
  constexpr int NQF = KIND == 0 ? 12 : 8, KROWB = KIND == 0 ? 384 : 256;
  constexpr int SHM_V = KVBLK * 128 * 2, SHM_K = KVBLK * KROWB;
  int tid_; asm volatile("v_mbcnt_lo_u32_b32 %0, -1, 0\n\tv_mbcnt_hi_u32_b32 %0, -1, %0" : "=v"(tid_)); tid_ += tid_in;
  const int tid = tid_, wid = tid >> 6, lane = tid & 63, r32 = lane & 31, hi = lane >> 5;
  LAS char* V_lds = lds; LAS char* K_lds = lds + 2 * SHM_V;
  LAS float* ws = (LAS float*)(lds + 2 * SHM_V + 2 * SHM_K) + wid * 64; LAS float* li_l = ws; LAS float* al_l = ws + 32;
  float m_reg = m0, l_reg = l0; f32x16 o[4] = {}; bf16x8 qr[NQF];
  mk.dq += wid * QBLK + r32 - 4 * hi;
  const int kvh = h >> 2;
  { const long qrow = (long)(qm0 + wid * QBLK + r32);
    if (KIND == 0) {
      const bf16* Qn = Qb + qrow * NQC + h * 128 + hi * 8; const bf16* Qr = Qb + qrow * NQC + 1024 + h * 64 + hi * 8;
#pragma unroll
      for (int d0 = 0; d0 < 8; ++d0) qr[d0] = *reinterpret_cast<const bf16x8*>(Qn + d0 * 16);
#pragma unroll
      for (int d0 = 8; d0 < NQF; ++d0) qr[d0] = *reinterpret_cast<const bf16x8*>(Qr + (d0 - 8) * 16);
    } else {
      const bf16* Qn = Zb + qrow * NZ + ZC_QW + h * 128 + hi * 8;
#pragma unroll
      for (int d0 = 0; d0 < 8; ++d0) qr[d0] = *reinterpret_cast<const bf16x8*>(Qn + d0 * 16);
    } }
  const int sr = tid >> 4, sc = (tid & 15) * 8, vst0 = v_st(sr, sc), vst1 = v_st(32 + sr, sc);
  const int rr_ = tid >> 3, rc_ = (tid & 7) * 8;
  const int vb0 = (int)(uintptr_t)V_lds + v_rd_base(lane);
  constexpr long kld = KIND == 0 ? NKVC : NZ;
  const char* Kbase = KIND == 0 ? (const char*)(KVb + (long)km0 * NKVC + h * 256) : (const char*)(Zb + (long)km0 * NZ + ZC_KW + kvh * 128);
  const char* Vbase = KIND == 0 ? Kbase + 256 : (const char*)(Zb + (long)km0 * NZ + ZC_VW + kvh * 128);
  const char* Rbase = (const char*)(Zb + (long)km0 * NZ + ZC_KR);
  const unsigned koff = (unsigned)((sr * kld + sc) * 2), roff = (unsigned)((rr_ * NZ + rc_) * 2);
  bf16x8 s_v0, s_v1, s_k0, s_k1, s_kr;
#define SLOAD(k0) do { const size_t o_ = (size_t)(k0) * kld * 2; const char* vb_ = Vbase + o_; const char* kb_ = Kbase + o_; \
    s_v0 = *reinterpret_cast<const bf16x8*>(vb_ + koff); s_v1 = *reinterpret_cast<const bf16x8*>(vb_ + 32 * kld * 2 + koff); \
    s_k0 = *reinterpret_cast<const bf16x8*>(kb_ + koff); s_k1 = *reinterpret_cast<const bf16x8*>(kb_ + 32 * kld * 2 + koff); \
    if (KIND == 0) s_kr = *reinterpret_cast<const bf16x8*>(Rbase + (size_t)(k0) * NZ * 2 + roff); } while (0)
#define SWRITE(b) do { *(LAS bf16x8*)(V_lds + (b) * SHM_V + vst0) = s_v0; *(LAS bf16x8*)(V_lds + (b) * SHM_V + vst1) = s_v1; const int kc = sc * 2; \
    *(LAS bf16x8*)(K_lds + (b) * SHM_K + kswz<KROWB>(sr, kc)) = s_k0; *(LAS bf16x8*)(K_lds + (b) * SHM_K + kswz<KROWB>(32 + sr, kc)) = s_k1; \
    if (KIND == 0) *(LAS bf16x8*)(K_lds + (b) * SHM_K + kswz<KROWB>(rr_, 256 + rc_ * 2)) = s_kr; } while (0)
#define SWAIT() asm volatile("s_waitcnt vmcnt(0)" ::: "memory")
#define RESC(a) do { if (__any((a) < 1.f)) { if (hi == 0) al_l[r32] = (a); asm volatile("s_waitcnt lgkmcnt(0)" ::: "memory"); \
    _Pragma("unroll") for (int d = 0; d < 4; ++d) _Pragma("unroll") for (int r = 0; r < 16; ++r) o[d][r] *= al_l[crow(r, hi)]; } } while (0)
  f32x16 pA0, pA1, pB0, pB1; float mnA, mnB, alA, alB; bf16x8 pa0, pa1, pa2, pa3;
  constexpr bool WIN = KIND == 1;
  SLOAD(0); SWAIT(); SWRITE(0); __syncthreads();
  qkt<NQF, KROWB>(pA0, pA1, K_lds, qr, r32, hi); partialSM<WIN>(pA0, pA1, m_reg, mnA, alA, mk, 0);
  SLOAD(KVBLK);
  SWAIT(); SWRITE(1); __syncthreads();
  for (int j = 1; j + 1 < NT; j += 2) {
    SBAR(); qkt<NQF, KROWB>(pB0, pB1, K_lds + SHM_K, qr, r32, hi);
    finishSM(pA0, pA1, alA, l_reg, pa0, pa1, pa2, pa3); SBAR();
    SLOAD((j + 1) * KVBLK); SBAR();
    pv_d0(o, vb0, pa0, pa1, pa2, pa3); partialSM<WIN>(pB0, pB1, m_reg, mnB, alB, mk, j);
    __syncthreads(); SWAIT(); SWRITE(0);
    RESC(alB); __syncthreads();
    SBAR(); qkt<NQF, KROWB>(pA0, pA1, K_lds, qr, r32, hi);
    finishSM(pB0, pB1, alB, l_reg, pa0, pa1, pa2, pa3); SBAR();
    SLOAD((j + 2) * KVBLK); SBAR();
    pv_d0(o, vb0 + SHM_V, pa0, pa1, pa2, pa3); partialSM<WIN>(pA0, pA1, m_reg, mnA, alA, mk, j + 1);
    __syncthreads(); SWAIT(); SWRITE(1);
    RESC(alA); __syncthreads();
  }
  SBAR(); qkt<NQF, KROWB>(pB0, pB1, K_lds + SHM_K, qr, r32, hi);
  finishSM(pA0, pA1, alA, l_reg, pa0, pa1, pa2, pa3); SBAR();
  pv_d0(o, vb0, pa0, pa1, pa2, pa3); partialSM<WIN>(pB0, pB1, m_reg, mnB, alB, mk, NT - 1);
  __syncthreads(); RESC(alB);
  finishSM(pB0, pB1, alB, l_reg, pa0, pa1, pa2, pa3); SBAR();
  pv_d0(o, vb0 + SHM_V, pa0, pa1, pa2, pa3);
  if (hi == 0) li_l[r32] = l_reg; asm volatile("s_waitcnt lgkmcnt(0)" ::: "memory");
  float rli[16];
#pragma unroll
  for (int r = 0; r < 16; ++r) rli[r] = __builtin_amdgcn_rcpf(li_l[crow(r, hi)]);
  __syncthreads();
  { LAS bf16* stg = (LAS bf16*)(lds + wid * 8192);
#pragma unroll
    for (int r = 0; r < 16; ++r) { const int orow = crow(r, hi);
#pragma unroll
      for (int d0 = 0; d0 < 4; ++d0) { const float v = o[d0][r] * rli[r]; stg[orow * 128 + d0 * 32 + r32] = (bf16)(cvt_pk_bf16(v, v) & 0xffffu); } }
    asm volatile("s_waitcnt lgkmcnt(0)" ::: "memory");
    bf16* Ow = Ob + (long)(qm0 + wid * QBLK) * NABC + ocol;
#pragma unroll
    for (int i = 0; i < 8; ++i) { const int row = i * 4 + (lane >> 4), ch = lane & 15; const v4u v = *(const LAS v4u*)(stg + row * 128 + ch * 8); *(v4u*)(Ow + (long)row * NABC + ch * 8) = v; } }
  __syncthreads();
#undef SLOAD
#undef SWRITE
#undef SWAIT
#undef RESC
}
#undef SBAR
}

#define XB_TMO      128
#define XB_XCNT(j)  (256  + 64 * (j))
#define XB_XSUB(j)  (1280 + 64 * (j))
#define XB_XGEN(j)  (2304 + 64 * (j))
#define XB_TOP      3328
#define XB_TOPGEN   3392
#define XCD_BAR_WORDS 3456
#define XB_SPIN_CAP (1u << 18)

__device__ __forceinline__ unsigned xb_ld(unsigned* p)              { return __hip_atomic_load(p, __ATOMIC_RELAXED, __HIP_MEMORY_SCOPE_AGENT); }
__device__ __forceinline__ unsigned xb_add(unsigned* p, unsigned v) { return __hip_atomic_fetch_add(p, v, __ATOMIC_RELAXED, __HIP_MEMORY_SCOPE_AGENT); }
__device__ __forceinline__ unsigned xb_xcc_id() { return (unsigned)__builtin_amdgcn_s_getreg((3 << 11) | 20) & 0xFu; }
#define XB_SPIN(cond, bar) do { unsigned _sp = 0; while (cond) { __builtin_amdgcn_s_sleep(1); \
    if ((++_sp & 255u) == 0u) { if (xb_ld(&(bar)[XB_TMO])) break; if (_sp > XB_SPIN_CAP) { atomicAdd(&(bar)[XB_TMO], 1u); break; } } } } while (0)

struct XcdBarrier { unsigned* bar; unsigned x; volatile LAS unsigned* st; };

__device__ __forceinline__ XcdBarrier xcd_barrier_post(unsigned* bar, volatile LAS unsigned* st) {
    XcdBarrier b; b.bar = bar; b.x = xb_xcc_id(); b.st = st;
    if (threadIdx.x == 0) (void)xb_add(&bar[XB_XCNT(b.x)], 1u);
    return b;
}
__device__ __forceinline__ void xcd_barrier_complete(unsigned* bar, unsigned x, unsigned& nloc, unsigned& nx) {
    const unsigned G = gridDim.x * gridDim.y * gridDim.z;
    unsigned sum, cnt, mine, sp = 0u;
    for (;;) {
        sum = 0u; cnt = 0u; mine = 0u;
#pragma unroll
        for (unsigned j = 0; j < 16; ++j) { const unsigned c = xb_ld(&bar[XB_XCNT(j)]); sum += c; cnt += (c > 0u) ? 1u : 0u; mine = (j == x) ? c : mine; }
        if (sum == G) break;
        __builtin_amdgcn_s_sleep(1);
        if ((++sp & 255u) == 0u) { if (xb_ld(&bar[XB_TMO])) break; if (sp > XB_SPIN_CAP) { atomicAdd(&bar[XB_TMO], 1u); break; } }
    }
    nloc = mine > 0u ? mine : 1u; nx = cnt > 0u ? cnt : 1u;
}
__device__ __forceinline__ void xcd_barrier(const XcdBarrier& b, const int tid  ) {
    asm volatile("s_waitcnt vmcnt(0)" ::: "memory");
    __syncthreads();
    if (tid == 0) {
        unsigned* bar = b.bar;
        __builtin_amdgcn_s_waitcnt(0);
        unsigned nloc = b.st[0], nx = b.st[1];
        if (nloc == 0u) { xcd_barrier_complete(bar, b.x, nloc, nx); b.st[0] = nloc; b.st[1] = nx; }
        const unsigned old = xb_add(&bar[XB_XSUB(b.x)], 1u);
        const unsigned gen = old / nloc;
        if (old + 1u == (gen + 1u) * nloc) {
            __builtin_amdgcn_fence(__ATOMIC_RELEASE, "agent");
            asm volatile("s_waitcnt vmcnt(0)" ::: "memory");
            const unsigned og = xb_add(&bar[XB_TOP], 1u);
            const unsigned tg = og / nx;
            if (og + 1u == (tg + 1u) * nx) xb_add(&bar[XB_TOPGEN], 1u);
            else XB_SPIN(xb_ld(&bar[XB_TOPGEN]) == tg, bar);
            __builtin_amdgcn_fence(__ATOMIC_ACQUIRE, "agent");
            xb_add(&bar[XB_XGEN(b.x)], 1u);
            asm volatile("s_waitcnt vmcnt(0)" ::: "memory");
        } else {
            XB_SPIN(xb_ld(&bar[XB_XGEN(b.x)]) == gen, bar);
            __builtin_amdgcn_fence(__ATOMIC_ACQUIRE, "agent");
            asm volatile("s_waitcnt vmcnt(0)" ::: "memory");
        }
    }
    __syncthreads();
}

struct Args { const float* in[22]; float* out; unsigned char* ws; int ph_lo, ph_hi; };
typedef const __attribute__((address_space(4))) Args* KArgs;
#define KARGS() ({ KArgs p_ = (KArgs)__builtin_amdgcn_kernarg_segment_ptr(); asm volatile("" : "+s"(p_)); p_; })
struct Frame { LAS unsigned char* lds; int tid, lane, wave, vcu, G; };

__device__ __forceinline__ float wave_sum(float v, int lane) {
#pragma unroll
    for (int o = 1; o < 64; o <<= 1) v += shfl_xor_l(v, o, lane);
    return v;
}
__device__ const double ROPE_REV[32] = {
    1.59154943091895346e-01, 1.19349370211248862e-01, 8.94994016088910133e-02, 6.71150830052272551e-02, 5.03292121044870353e-02, 3.77415847174197711e-02, 2.83021958306233987e-02, 2.12236527647776604e-02,
    1.59154943091895339e-02, 1.19349370211248862e-02, 8.94994016088910237e-03, 6.71150830052272534e-03, 5.03292121044870370e-03, 3.77415847174197719e-03, 2.83021958306233987e-03, 2.12236527647776622e-03,
    1.59154943091895356e-03, 1.19349370211248849e-03, 8.94994016088910237e-04, 6.71150830052272599e-04, 5.03292121044870326e-04, 3.77415847174197741e-04, 2.83021958306233954e-04, 2.12236527647776605e-04,
    1.59154943091895351e-04, 1.19349370211248862e-04, 8.94994016088910182e-05, 6.71150830052272545e-05, 5.03292121044870354e-05, 3.77415847174197768e-05, 2.83021958306233961e-05, 2.12236527647776592e-05};

enum { MAP_ID = 0, MAP_WIN = 1, MAP_WUQ = 2 };
__device__ __forceinline__ int map_col(int mode, int n) {
    if (mode == MAP_ID) return n;
    if (mode == MAP_WIN) {
        if (n < 1024) return n;
        if (n < ZC_KR) return n + 64;
        if (n < ZC_KR + 64) { const int p = n - ZC_KR, i = p >> 1; return 1024 + ((p & 1) ? i + 32 : i); }
        if (n < ZC_G) return -1;
        return n - ZC_G + 3648;
    }
    if (n < 1024) return (n >> 7) * 192 + (n & 127);
    { const int r = n - 1024, h = r >> 6, p = r & 63, i = p >> 1; return h * 192 + 128 + ((p & 1) ? i + 32 : i); }
}
__device__ __forceinline__ void conv_item(const float* W, int K, int Nsrc, int nblk, const float* g, int mode, bf16* dst, int dst_ld, LAS float* scr, int item, int lane, bool tiled = false, int koff = 0) {
    const int kb = item / nblk, nb = item % nblk, k0 = 64 * kb, n0 = 32 * nb;
    const int s0 = map_col(mode, n0), s31 = map_col(mode, n0 + 31);
    if (s0 >= 0 && s31 == s0 + 31) {
        const int ks = lane >> 3, n4 = (lane & 7) * 4;
        f32x4 v[8]; float gk[8];
#pragma unroll
        for (int i = 0; i < 8; ++i) v[i] = *(const GAS f32x4*)(W + (size_t)(k0 + 8 * i + ks) * Nsrc + s0 + n4);
#pragma unroll
        for (int i = 0; i < 8; ++i) gk[i] = g ? g[k0 + 8 * i + ks] : 1.f;
#pragma unroll
        for (int i = 0; i < 8; ++i) { LAS float* p = scr + (8 * i + ks) * 33 + n4; const f32x4 x = v[i] * gk[i]; p[0] = x[0]; p[1] = x[1]; p[2] = x[2]; p[3] = x[3]; }
    } else {
        const int src = map_col(mode, n0 + (lane & 31));
#pragma unroll 8
        for (int i = 0; i < 32; ++i) { const int kk = 2 * i + (lane >> 5); float v = 0.f;
            if (src >= 0) { v = W[(size_t)(k0 + kk) * Nsrc + src]; if (g) v *= g[k0 + kk]; }
            scr[kk * 33 + (lane & 31)] = v; }
    }
    LDS_WAIT(); asm volatile("" ::: "memory");
    const int c = lane & 7;
#pragma unroll
    for (int j = 0; j < 4; ++j) { const int n = (lane >> 3) + 8 * j; const LAS float* s = scr + (8 * c) * 33 + n;
        v4u o; o.x = cvt_pk_bf16(s[0 * 33], s[1 * 33]); o.y = cvt_pk_bf16(s[2 * 33], s[3 * 33]); o.z = cvt_pk_bf16(s[4 * 33], s[5 * 33]); o.w = cvt_pk_bf16(s[6 * 33], s[7 * 33]);
        if (!tiled) *(GAS v4u*)(dst + (size_t)(n0 + n) * dst_ld + k0 + 8 * c) = o;
        else {
            const int nn = n0 + n, pn = nn >> 8, nt_ = nn & 255, h = nt_ >> 7, rr = nt_ & 127, w = rr & 31, slot = (rr & ~31) + 16 * ((w >> 2) & 1) + 4 * (w >> 3) + (w & 3);
            const int kk = koff + k0, kt = kk >> 6;
            *(GAS v4u*)((unsigned char*)dst + ((size_t)(pn * (dst_ld >> 6) + kt) * 2 + h) * 16384 + pg8::lds_byte(slot, 8 * c)) = o; } }
    LDS_WAIT(); asm volatile("" ::: "memory");
}
__device__ __forceinline__ void convert_layer(const Frame& F, KArgs ap, int l, unsigned char* ws) {
    LAS float* scr = (LAS float*)(F.lds + RING_OFF + F.wave * 16384);
    const int gw = F.vcu * NWAVES + F.wave, NGW = F.G * NWAVES;
    unsigned char* W = ws + WS_W;
    constexpr int I_IN = 32 * (NZW / 32), I_UQ = 8 * (NQC / 32), I_UKV = 8 * (NKVC / 32), I_MEM = 32 * 64, I_BR = 16 * 64, I_OUT = 32 * 64, I_UP = 32 * 256, I_DOWN = 128 * 64;
    constexpr int NITEMS = I_IN + I_UQ + I_UKV + I_MEM + 3 * I_BR + I_OUT + I_UP + I_DOWN;
    for (int it = gw; it < NITEMS; it += NGW) {
        int r = it;
        if (r < I_IN) { conv_item(ap->in[6] + (size_t)l * DM * NZSRC, DM, NZSRC, NZW / 32, ap->in[4] + l * DM, MAP_WIN, (bf16*)(W + WO_IN), DM, scr, r, F.lane, true); continue; } r -= I_IN;
        if (r < I_UQ) { conv_item(ap->in[9] + (size_t)l * 512 * NQC, 512, NQC, NQC / 32, ap->in[7] + l * 512, MAP_WUQ, (bf16*)(W + WO_UQ), 512, scr, r, F.lane, true); continue; } r -= I_UQ;
        if (r < I_UKV) { conv_item(ap->in[10] + (size_t)l * 512 * NKVC, 512, NKVC, NKVC / 32, ap->in[8] + l * 512, MAP_ID, (bf16*)(W + WO_UKV), 512, scr, r, F.lane, true); continue; } r -= I_UKV;
        if (r < I_MEM) { conv_item(ap->in[12] + (size_t)l * DM * 2048, DM, 2048, 64, ap->in[11] + l * DM, MAP_ID, (bf16*)(W + WO_MEM), DM, scr, r, F.lane); continue; } r -= I_MEM;
        if (r < 3 * I_BR) { const int br = r / I_BR; conv_item(ap->in[14 + br] + (size_t)l * 1024 * DM, 1024, DM, 64, nullptr, MAP_ID, (bf16*)(W + WO_BR), NABC, scr, r - br * I_BR, F.lane, true, br * 1024); continue; } r -= 3 * I_BR;
        if (r < I_OUT) { conv_item(ap->in[17] + (size_t)l * DM * DM, DM, DM, 64, nullptr, MAP_ID, (bf16*)(W + WO_OUT), DM, scr, r, F.lane, true); continue; } r -= I_OUT;
        if (r < I_UP) { conv_item(ap->in[20] + (size_t)l * DM * DFF, DM, DFF, 256, ap->in[18] + l * DM, MAP_ID, (bf16*)(W + WO_UP), DM, scr, r, F.lane, true); continue; } r -= I_UP;
        conv_item(ap->in[21] + (size_t)l * DFF * DM, DFF, DM, 64, nullptr, MAP_ID, (bf16*)(W + WO_DOWN), DFF, scr, r, F.lane, true);
    }
}
__device__ __forceinline__ void rms_row_to_bf16(const float* xrow, bf16* orow, float* rs_out, int lane) {
    f32x4 v[8]; float s = 0.f;
#pragma unroll
    for (int j = 0; j < 4; ++j) { v[2 * j] = *(const GAS f32x4*)(xrow + j * 512 + lane * 8); v[2 * j + 1] = *(const GAS f32x4*)(xrow + j * 512 + lane * 8 + 4); }
#pragma unroll
    for (int j = 0; j < 8; ++j) s += (v[j][0] * v[j][0] + v[j][1] * v[j][1]) + (v[j][2] * v[j][2] + v[j][3] * v[j][3]);
    const float ms = wave_sum(s, lane) * (1.f / DM) + EPS, r = __builtin_amdgcn_rsqf(ms);
    if (lane == 0) *rs_out = ms * r;
#pragma unroll
    for (int j = 0; j < 4; ++j) *(GAS v4u*)(orow + j * 512 + lane * 8) = epi::pack8(v[2 * j] * r, v[2 * j + 1] * r);
}
__device__ __forceinline__ void prologue(const Frame& F, KArgs ap, unsigned char* ws) {
    const int gw = F.vcu * NWAVES + F.wave, NGW = F.G * NWAVES;
    float* tab = (float*)(ws + WS_TAB);
    for (int e = blockIdx.x * 512 + F.tid; e < 8192 * 32; e += F.G * 512) {
        const int pos = e >> 5, i = e & 31;
        double rev = (double)pos * ROPE_REV[i]; rev -= floor(rev);
        const double q = rint(rev * 4.0); const double r = (rev - q * 0.25) * 6.283185307179586476925;
        const double r2 = r * r;
        const double sn = r * (1.0 + r2 * (-1.0 / 6 + r2 * (1.0 / 120 + r2 * (-1.0 / 5040 + r2 * (1.0 / 362880 - r2 * (1.0 / 39916800))))));
        const double cn = 1.0 + r2 * (-0.5 + r2 * (1.0 / 24 + r2 * (-1.0 / 720 + r2 * (1.0 / 40320 + r2 * (-1.0 / 3628800 + r2 * (1.0 / 479001600))))));
        const int qi = ((int)q) & 3;
        const double s_ = qi == 0 ? sn : qi == 1 ? cn : qi == 2 ? -sn : -cn;
        const double c_ = qi == 0 ? cn : qi == 1 ? -sn : qi == 2 ? -cn : sn;
        *(GAS f32x2*)(tab + (size_t)e * 2) = (f32x2){(float)c_, (float)s_};
    }
    float* rmem = (float*)(ws + WS_RMEM); bf16* memb = (bf16*)(ws + WS_MEMB);
    for (int m = gw; m < NMEMR; m += NGW) {
        const float* xrow = (m < 1024) ? ap->in[2] + (size_t)m * DM : ap->in[3] + (size_t)(m - 1024) * DM;
        f32x4 v[8]; float s = 0.f;
#pragma unroll
        for (int j = 0; j < 4; ++j) { v[2 * j] = *(const GAS f32x4*)(xrow + j * 512 + F.lane * 8); v[2 * j + 1] = *(const GAS f32x4*)(xrow + j * 512 + F.lane * 8 + 4); }
#pragma unroll
        for (int j = 0; j < 8; ++j) s += (v[j][0] * v[j][0] + v[j][1] * v[j][1]) + (v[j][2] * v[j][2] + v[j][3] * v[j][3]);
        const float r = __builtin_amdgcn_rsqf(wave_sum(s, F.lane) * (1.f / DM) + EPS);
        if (F.lane == 0) rmem[m] = r;
#pragma unroll
        for (int j = 0; j < 4; ++j) *(GAS v4u*)(memb + (size_t)m * DM + j * 512 + F.lane * 8) = epi::pack8(v[2 * j], v[2 * j + 1]);
    }
    bf16* xn = (bf16*)(ws + WS_XN);
    for (int m = gw; m < NTOK; m += NGW) {
        const float* xrow = (m < NPROMPT) ? ap->in[0] + (size_t)m * DM : ap->in[1] + (size_t)(m - NPROMPT) * DM;
        rms_row_to_bf16(xrow, xn + (size_t)m * DM, (float*)(ws + WS_RS) + m, F.lane);
    }
    convert_layer(F, ap, 0, ws);
}
__device__ __forceinline__ void norm_pass(const Frame& F, KArgs ap, bool first, bool last, const float* gpost, unsigned char* ws, bool dummy = false) {
    const int gw = F.vcu * NWAVES + F.wave, NGW = F.G * NWAVES;
    const bf16* Y = (const bf16*)(ws + WS_Y); bf16* xb = (bf16*)(ws + WS_XN); float* rsv = (float*)(ws + WS_RS);
    bf16* xbo = dummy ? (bf16*)(ws + WS_Z + 192 * MiB) : xb; float* rso = dummy ? (float*)(ws + WS_Z + 300 * MiB) : rsv; float* xout = dummy ? (float*)(ws + WS_Z) : ap->out;
    f32x4 g[8];
#pragma unroll
    for (int j = 0; j < 4; ++j) { g[2 * j] = *(const GAS f32x4*)(gpost + j * 512 + F.lane * 8); g[2 * j + 1] = *(const GAS f32x4*)(gpost + j * 512 + F.lane * 8 + 4); }
    for (int m = gw; m < NTOK; m += NGW) {
        f32x4 x[8], y[8]; float s = 0.f;
#pragma unroll
        for (int j = 0; j < 4; ++j) { const v4u w = *(const GAS v4u*)(Y + (size_t)m * DM + j * 512 + F.lane * 8);
            y[2 * j] = (f32x4){bf_lo(w.x), bf_hi(w.x), bf_lo(w.y), bf_hi(w.y)}; y[2 * j + 1] = (f32x4){bf_lo(w.z), bf_hi(w.z), bf_lo(w.w), bf_hi(w.w)}; }
        if (first) { const float* xrow = (m < NPROMPT) ? ap->in[0] + (size_t)m * DM : ap->in[1] + (size_t)(m - NPROMPT) * DM;
#pragma unroll
            for (int j = 0; j < 4; ++j) { x[2 * j] = *(const GAS f32x4*)(xrow + j * 512 + F.lane * 8); x[2 * j + 1] = *(const GAS f32x4*)(xrow + j * 512 + F.lane * 8 + 4); }
        } else {
            const float rms = rsv[m];
#pragma unroll
            for (int j = 0; j < 4; ++j) { const v4u w = *(const GAS v4u*)(xb + (size_t)m * DM + j * 512 + F.lane * 8);
                x[2 * j] = (f32x4){bf_lo(w.x), bf_hi(w.x), bf_lo(w.y), bf_hi(w.y)} * rms; x[2 * j + 1] = (f32x4){bf_lo(w.z), bf_hi(w.z), bf_lo(w.w), bf_hi(w.w)} * rms; }
        }
#pragma unroll
        for (int j = 0; j < 8; ++j) s += (y[j][0] * y[j][0] + y[j][1] * y[j][1]) + (y[j][2] * y[j][2] + y[j][3] * y[j][3]);
        const float r = __builtin_amdgcn_rsqf(wave_sum(s, F.lane) * (1.f / DM) + EPS);
        float s2 = 0.f;
#pragma unroll
        for (int j = 0; j < 8; ++j) { x[j] = x[j] + (y[j] * r) * g[j]; s2 += (x[j][0] * x[j][0] + x[j][1] * x[j][1]) + (x[j][2] * x[j][2] + x[j][3] * x[j][3]); }
        if (last) { float* orow = xout + (size_t)m * DM;
#pragma unroll
            for (int j = 0; j < 4; ++j) { *(GAS f32x4*)(orow + j * 512 + F.lane * 8) = x[2 * j]; *(GAS f32x4*)(orow + j * 512 + F.lane * 8 + 4) = x[2 * j + 1]; }
        } else {
            const float ms2 = wave_sum(s2, F.lane) * (1.f / DM) + EPS, r2 = __builtin_amdgcn_rsqf(ms2);
            if (F.lane == 0) rso[m] = ms2 * r2;
#pragma unroll
            for (int j = 0; j < 4; ++j) *(GAS v4u*)(xbo + (size_t)m * DM + j * 512 + F.lane * 8) = epi::pack8(x[2 * j] * r2, x[2 * j + 1] * r2);
        }
    }
}

constexpr int PH_PER_LAYER = 9, N_PHASES = 1 + DEPTH * PH_PER_LAYER;
#ifndef PH_MASK
#define PH_MASK 0x3ff
#endif
#define PH_EN(k) ((PH_MASK >> (k)) & 1)
#ifndef SUB_MASK
#define SUB_MASK 7
#endif
#define SUB_EN(k) ((SUB_MASK >> (k)) & 1)
#ifndef DUP_MASK
#define DUP_MASK 0
#endif
#define DUP_EN(k) ((DUP_MASK >> (k)) & 1)
__global__ void __launch_bounds__(NWAVES * 64, 2) fwd(Args args_unused) {
    extern __shared__ __attribute__((aligned(16))) unsigned char lds_raw[];
    (void)args_unused;
    LAS unsigned char* lds0 = (LAS unsigned char*)lds_raw;
    const int wave0 = __builtin_amdgcn_readfirstlane((int)threadIdx.x >> 6);
    volatile LAS unsigned* MISC = (volatile LAS unsigned*)(lds0 + MISC_OFF);
    for (int u = threadIdx.x; u < (XCH_OFF - LDSCTL_OFF) / 4; u += NWAVES * 64) ((LAS unsigned*)(lds0 + LDSCTL_OFF))[u] = 0u;
    __syncthreads();
#ifdef PROBE_CLOCK
    if (blockIdx.x == 0 && threadIdx.x == 0) { KArgs ap = KARGS(); unsigned long long* p = (unsigned long long*)(ap->ws + 512 * 1024); p[0] = __builtin_amdgcn_s_memtime(); p[1] = __builtin_amdgcn_s_memrealtime(); }
#endif
    int lo, hi; unsigned* barw;
    { KArgs ap = KARGS(); lo = ap->ph_lo; hi = ap->ph_hi; barw = (unsigned*)(ap->ws + WS_CTL) + CW_BAR; }
    if (MK_N_LAUNCHES == 1 || (hi - lo) > 1) (void)xcd_barrier_post(barw, MISC + 8);
    if (threadIdx.x == 0) { unsigned r = 0u; const unsigned x = xb_xcc_id();
        if (MK_N_LAUNCHES == 1) { KArgs ap_ = KARGS(); r = xb_add((unsigned*)(ap_->ws + WS_CTL) + CW_RANK + 64 * x, 1u); }
        MISC[20] = x; MISC[21] = r; MISC[22] = blockIdx.x; }
    __syncthreads();
#if MK_N_LAUNCHES == 1
#define IN(k) true
#else
#define IN(k) (lo <= (k) && (k) < hi)
#endif
#if defined(PROBE_WAIT) && PROBE_WAIT
#define PROBE_WAIT_BEGIN() do { if (wave0 * 64 + t_ == 0) { const unsigned long long r_ = __builtin_amdgcn_s_memrealtime(); MISC[16] = (unsigned)r_; } } while (0)
#define PROBE_WAIT_END() do { int t2_; asm volatile("v_mbcnt_lo_u32_b32 %0, -1, 0\n\tv_mbcnt_hi_u32_b32 %0, -1, %0" : "=v"(t2_)); if (wave0 * 64 + t2_ == 0) { const unsigned long long r_ = __builtin_amdgcn_s_memrealtime(); MISC[17] = MISC[17] + ((unsigned)r_ - MISC[16]); } } while (0)
#else
#define PROBE_WAIT_BEGIN() do {} while (0)
#define PROBE_WAIT_END() do {} while (0)
#endif
#define LOCAL_BAR() XcdBarrier bar; { KArgs ap_ = KARGS(); bar.bar = (unsigned*)(ap_->ws + WS_CTL) + CW_BAR; bar.x = xb_xcc_id(); bar.st = (volatile LAS unsigned*)((LAS unsigned char*)lds_raw + MISC_OFF) + 8; }
#define BARRIER_NOW() do { int t_; asm volatile("v_mbcnt_lo_u32_b32 %0, -1, 0\n\tv_mbcnt_hi_u32_b32 %0, -1, %0" : "=v"(t_)); LOCAL_BAR(); xcd_barrier(bar, wave0 * 64 + t_); } while (0)
#define SEAM(k) do { if (IN(k) && IN((k) + 1)) { int t_; asm volatile("v_mbcnt_lo_u32_b32 %0, -1, 0\n\tv_mbcnt_hi_u32_b32 %0, -1, %0" : "=v"(t_)); PROBE_WAIT_BEGIN(); LOCAL_BAR(); xcd_barrier(bar, wave0 * 64 + t_); PROBE_WAIT_END(); if (PROBE_XBAR) { xcd_barrier(bar, wave0 * 64 + t_); xcd_barrier(bar, wave0 * 64 + t_); } } } while (0)
#define PHASE_BASE() KArgs ap = KARGS(); unsigned char* ws = ap->ws; (void)ws; int bx_ = (int)((volatile LAS unsigned*)((LAS unsigned char*)lds_raw + MISC_OFF))[22], G_ = (int)gridDim.x, t_; asm volatile("v_mbcnt_lo_u32_b32 %0, -1, 0\n\tv_mbcnt_hi_u32_b32 %0, -1, %0" : "=v"(t_)); t_ += wave0 * 64; bx_ = __builtin_amdgcn_readfirstlane(bx_); asm volatile("" : "+s"(bx_), "+s"(G_)); const int bx = bx_, G = G_; (void)bx; (void)G; Frame F; F.lds = (LAS unsigned char*)lds_raw; F.tid = t_; F.lane = t_ & 63; F.wave = __builtin_amdgcn_readfirstlane(t_ >> 6); F.G = G; F.vcu = (G % 8 == 0) ? (bx % 8) * (G / 8) + bx / 8 : bx; LAS unsigned char* ring = F.lds + RING_OFF; LAS unsigned char* xl = F.lds + XCH_OFF; (void)ring; (void)xl
#define WSP(T, off) ((T*)(ws + (off)))

    if (PH_EN(0) && IN(0)) { PHASE_BASE(); prologue(F, ap, ws); }
    SEAM(0);
    if (MK_N_LAUNCHES == 1) {
        if (threadIdx.x == 0) { KArgs ap_ = KARGS(); unsigned* bw = (unsigned*)(ap_->ws + WS_CTL) + CW_BAR; const unsigned G = gridDim.x; bool even = (G % 8u) == 0u; unsigned npop = 0u;
            for (unsigned j = 0; j < 16; ++j) { const unsigned c = xb_ld(&bw[XB_XCNT(j)]); if (c) { ++npop; even = even && (c == G / 8u) && (j < 8u); } }
            if (even && npop == 8u && MISC[21] < G / 8u) MISC[22] = MISC[20] + 8u * MISC[21]; }
        __syncthreads();
    }

    for (int l = 0; l < DEPTH; ++l) {
        const int p0 = 1 + l * PH_PER_LAYER;
        for (int rep_ = 0; rep_ <= DUP_EN(1); ++rep_) { if (rep_) BARRIER_NOW();
        if (PH_EN(1) && IN(p0 + 0)) { PHASE_BASE();
            if (SUB_EN(0)) { pg8::Gemm g = pg8::plain_gemm(WSP(bf16, WS_XN), DM, ws + WS_W + WO_IN, DM, DM, true); pg8::StaticOrder S; S.init(NTOK / 256, NZW / 256, G, bx);
              epi::EpiZ E{WSP(bf16, WS_Z), WSP(float, WS_SSQ), WSP(const float, WS_TAB), ws + WS_GT}; pg8::gemm_phase<epi::EpiZ, pg8::StaticOrder>(F.tid, ring, xl, g, S, E); }
            if (SUB_EN(1)) { pg8::Gemm g = pg8::plain_gemm(WSP(bf16, WS_MEMB), DM, ws + WS_W + WO_MEM, DM, DM); pg8::StaticOrder S; S.init(NMEMR / 256, 4, G, (bx + G - 160 % G) % G);
              epi::EpiStore<1> E{WSP(bf16, WS_MEMK), 1024, 0, WSP(const float, WS_RMEM)}; pg8::gemm_phase<epi::EpiStore<1>, pg8::StaticOrder>(F.tid, ring, xl, g, S, E); }
            if (SUB_EN(2)) { pg8::Gemm g = pg8::plain_gemm(ws + WS_W + WO_MEM + (size_t)1024 * DM * 2, DM, WSP(bf16, WS_MEMB), DM, DM); pg8::StaticOrder S; S.init(4, NMEMR / 256, G, (bx + G - 180 % G) % G);
              epi::EpiStore<2> E{WSP(bf16, WS_MEMVT), NMEMR, 0, WSP(const float, WS_RMEM)}; pg8::gemm_phase<epi::EpiStore<2>, pg8::StaticOrder>(F.tid, ring, xl, g, S, E); }
        }
        }
        SEAM(p0 + 0);
        for (int rep_ = 0; rep_ <= DUP_EN(2); ++rep_) { if (rep_) BARRIER_NOW();
        if (PH_EN(2) && IN(p0 + 1)) { PHASE_BASE();
            if (SUB_EN(0)) { pg8::Gemm g = pg8::plain_gemm(WSP(bf16, WS_Z) + ZC_CQ, NZ, ws + WS_W + WO_UQ, 512, 512, true); pg8::StaticOrder S; S.init(NTOK / 256, NQC / 256, G, bx);
              epi::EpiLat<0> E{WSP(bf16, WS_Q), WSP(const float, WS_SSQ), WSP(const float, WS_TAB)}; pg8::gemm_phase<epi::EpiLat<0>, pg8::StaticOrder>(F.tid, ring, xl, g, S, E); }
            if (SUB_EN(1)) { pg8::Gemm g = pg8::plain_gemm(WSP(bf16, WS_Z) + ZC_CKV, NZ, ws + WS_W + WO_UKV, 512, 512, true); pg8::StaticOrder S; S.init(NTOK / 256, NKVC / 256, G, bx);
              epi::EpiLat<1> E{WSP(bf16, WS_KV), WSP(const float, WS_SSQ), WSP(const float, WS_TAB)}; pg8::gemm_phase<epi::EpiLat<1>, pg8::StaticOrder>(F.tid, ring, xl, g, S, E); }
            if (SUB_EN(2)) { pg8::Gemm g; g.A = (const char*)(WSP(bf16, WS_Z) + ZC_QM); g.B = (const char*)WSP(bf16, WS_MEMK); g.a_pm = (long)256 * NZ * 2; g.a_pn = 512; g.b_pn = 512; g.b_sq = (long)256 * 1024 * 2; g.lda = NZ; g.ldb = 1024; g.K = 256; g.b_tiled = false;
              pg8::StaticOrder S; S.init(NTOK / 256, 4, G, (bx + G - 64 % G) % G);
              epi::EpiSoftmax E{WSP(bf16, WS_PM)}; pg8::gemm_phase<epi::EpiSoftmax, pg8::StaticOrder>(F.tid, ring, xl, g, S, E); }
        }
        }
        SEAM(p0 + 1);
        for (int rep_ = 0; rep_ <= DUP_EN(3); ++rep_) { if (rep_) BARRIER_NOW();
        if (PH_EN(3) && IN(p0 + 2)) {
            if (SUB_EN(0)) { PHASE_BASE(); for (int n = F.vcu; n < 768; n += G) {
                const int i = n >> 8, v = n & 255, x = v >> 5, j = v & 31;
                int h, qm0, km0, NT;
                if (i < 2) { const int pair = 4 * x + 2 * i + (j >> 4), b = pair >> 3; h = pair & 7; qm0 = b * 4096 + (j & 15) * 256; km0 = b * 4096; NT = 64; }
                else { h = x; qm0 = NPROMPT + j * 256; km0 = NPROMPT; NT = 128; }
                att::Mask mk{0, 0.f};
                att::attn_unit<0>(WSP(bf16, WS_Q), WSP(bf16, WS_KV), WSP(bf16, WS_Z), WSP(bf16, WS_ABC), qm0, km0, NT, h, h * 128, -1.0e30f, 0.f, mk, (LAS char*)ring, wave0 * 64);
            } }
            if (SUB_EN(1)) { PHASE_BASE(); const float* sink = ap->in[13] + l * 8;
              for (int n = F.vcu; n < 768; n += G) {
                const int qblk = n >> 3, h = n & 7;
                const int sstart = qblk < 64 ? (qblk >> 4) * 4096 : NPROMPT, SL = qblk < 64 ? 4096 : 8192;
                const int qm0 = qblk * 256, q0 = qm0 - sstart;
                const int klo = (q0 - 128) < 0 ? 0 : (q0 - 128), khi = (q0 + 384) > SL ? SL : (q0 + 384);
                att::Mask mk; mk.dq = q0 - klo; mk.sl = LOG2E * __builtin_amdgcn_exp2f(-(float)(h + 1));
                att::attn_unit<1>(WSP(bf16, WS_Q), WSP(bf16, WS_KV), WSP(bf16, WS_Z), WSP(bf16, WS_ABC), qm0, sstart + klo, (khi - klo) >> 6, h, 1024 + h * 128, sink[h] * LOG2E, 1.f, mk, (LAS char*)ring, wave0 * 64);
              } }
            if (SUB_EN(2)) { PHASE_BASE(); pg8::Gemm g; g.A = (const char*)WSP(bf16, WS_PM); g.B = (const char*)WSP(bf16, WS_MEMVT); g.a_pm = (long)256 * 1024 * 2; g.a_pn = 512; g.b_pn = (long)256 * NMEMR * 2; g.b_sq = 512; g.lda = 1024; g.ldb = NMEMR; g.K = 256; g.b_tiled = false;
              pg8::StaticOrder S; S.init(NTOK / 256, 4, G, bx);
              epi::EpiStore<0> E{WSP(bf16, WS_ABC), NABC, 2048, nullptr}; pg8::gemm_phase<epi::EpiStore<0>, pg8::StaticOrder>(F.tid, ring, xl, g, S, E); }
        }
        }
        SEAM(p0 + 2);
        for (int rep_ = 0; rep_ <= DUP_EN(4); ++rep_) { if (rep_) BARRIER_NOW();
        if (PH_EN(4) && IN(p0 + 3)) { PHASE_BASE();
            pg8::Gemm g = pg8::plain_gemm(WSP(bf16, WS_ABC), NABC, ws + WS_W + WO_BR, NABC, NABC, true); pg8::StaticOrder S; S.init(NTOK / 256, DM / 256, G, bx);
            epi::EpiBranch E{WSP(bf16, WS_MERGED), ws + WS_GT}; pg8::gemm_phase<epi::EpiBranch, pg8::StaticOrder>(F.tid, ring, xl, g, S, E);
        }
        }
        SEAM(p0 + 3);
        for (int rep_ = 0; rep_ <= DUP_EN(5); ++rep_) { if (rep_) BARRIER_NOW();
        if (PH_EN(5) && IN(p0 + 4)) { PHASE_BASE();
            pg8::Gemm g = pg8::plain_gemm(WSP(bf16, WS_MERGED), DM, ws + WS_W + WO_OUT, DM, DM, true); pg8::StaticOrder S; S.init(NTOK / 256, DM / 256, G, bx);
            epi::EpiStore<0> E{WSP(bf16, WS_Y), DM, 0, nullptr}; pg8::gemm_phase<epi::EpiStore<0>, pg8::StaticOrder>(F.tid, ring, xl, g, S, E);
        }
        }
        SEAM(p0 + 4);
        if (PH_EN(6) && IN(p0 + 5)) { PHASE_BASE(); if (DUP_EN(6)) norm_pass(F, ap, l == 0, false, ap->in[5] + l * DM, ws, true); norm_pass(F, ap, l == 0, false, ap->in[5] + l * DM, ws); }
        SEAM(p0 + 5);
        for (int rep_ = 0; rep_ <= DUP_EN(7); ++rep_) { if (rep_) BARRIER_NOW();
        if (PH_EN(7) && IN(p0 + 6)) { PHASE_BASE();
            pg8::Gemm g = pg8::plain_gemm(WSP(bf16, WS_XN), DM, ws + WS_W + WO_UP, DM, DM, true); pg8::StaticOrder S; S.init(NTOK / 256, DFF / 256, G, bx);
            epi::EpiStore<3> E{WSP(bf16, WS_U), DFF, 0, nullptr}; pg8::gemm_phase<epi::EpiStore<3>, pg8::StaticOrder>(F.tid, ring, xl, g, S, E);
        }
        }
        SEAM(p0 + 6);
        for (int rep_ = 0; rep_ <= DUP_EN(8); ++rep_) { if (rep_) BARRIER_NOW();
        if (PH_EN(8) && IN(p0 + 7)) { PHASE_BASE();
            pg8::Gemm g = pg8::plain_gemm(WSP(bf16, WS_U), DFF, ws + WS_W + WO_DOWN, DFF, DFF, true); pg8::StaticOrder S; S.init(NTOK / 256, DM / 256, G, bx);
            epi::EpiStore<0> E{WSP(bf16, WS_Y), DM, 0, nullptr}; pg8::gemm_phase<epi::EpiStore<0>, pg8::StaticOrder>(F.tid, ring, xl, g, S, E);
        }
        }
        SEAM(p0 + 7);
        if (PH_EN(9) && IN(p0 + 8)) { PHASE_BASE(); norm_pass(F, ap, false, l + 1 == DEPTH, ap->in[19] + l * DM, ws); if (l + 1 < DEPTH) { convert_layer(F, ap, l + 1, ws); if (DUP_EN(9)) convert_layer(F, ap, l + 1, ws); } }
        SEAM(p0 + 8);
    }
#if defined(PROBE_WAIT) && PROBE_WAIT
    { KArgs ap = KARGS(); unsigned* pw = (unsigned*)(ap->ws + 512 * 1024 + 256);
      if (threadIdx.x == 0) { const unsigned w = MISC[17]; atomicMax(pw + 0, w); atomicMin(pw + 64, 0xffffffffu - w); atomicAdd(pw + 128, w / 256u); }
      BARRIER_NOW();
      if (blockIdx.x == 0 && threadIdx.x == 0) { const unsigned v = PROBE_WAIT == 1 ? __hip_atomic_load(pw + 0, RLX_AGENT) : PROBE_WAIT == 2 ? 0xffffffffu - __hip_atomic_load(pw + 64, RLX_AGENT) : __hip_atomic_load(pw + 128, RLX_AGENT);
        const unsigned long long r1 = __builtin_amdgcn_s_memrealtime(); while (__builtin_amdgcn_s_memrealtime() - r1 < (unsigned long long)v) __builtin_amdgcn_s_sleep(32); } }
#endif
#ifdef PROBE_CLOCK
    { BARRIER_NOW(); if (blockIdx.x == 0 && threadIdx.x == 0) { const unsigned long long ck1 = __builtin_amdgcn_s_memtime(), rt1 = __builtin_amdgcn_s_memrealtime(); KArgs ap = KARGS(); const unsigned long long* p = (const unsigned long long*)(ap->ws + 512 * 1024);
        const unsigned long long mhz = (ck1 - p[0]) * 100ull / (rt1 - p[1]);
        while (__builtin_amdgcn_s_memrealtime() - rt1 < mhz * 100ull) __builtin_amdgcn_s_sleep(32); } }
#endif
#undef IN
#undef SEAM
}


#ifndef DBG_LAST
#define DBG_LAST -1
#endif
#ifndef DBG_DUMP_MASK
#define DBG_DUMP_MASK 0xff
#endif
#if DBG_LAST >= 0
__global__ void __launch_bounds__(256) dbg_dump(float* out, const unsigned char* ws) {
    const bf16* Z = (const bf16*)(ws + WS_Z); const bf16* Q = (const bf16*)(ws + WS_Q); const bf16* KV = (const bf16*)(ws + WS_KV); const bf16* PM = (const bf16*)(ws + WS_PM);
    const bf16* ABC = (const bf16*)(ws + WS_ABC); const bf16* MG = (const bf16*)(ws + WS_MERGED); const bf16* XN = (const bf16*)(ws + WS_XN); const bf16* Y = (const bf16*)(ws + WS_Y);
    for (size_t e = (size_t)blockIdx.x * 256 + threadIdx.x; e < (size_t)NTOK * DM; e += (size_t)gridDim.x * 256) {
        const size_t m = e / DM; const int c = (int)(e % DM); float v = 0.f;
        auto f = [](bf16 b) { return __uint_as_float((unsigned)b << 16); };
        if (DBG_DUMP_MASK & 1) v += f(XN[m * DM + c]);
        if (DBG_DUMP_MASK & 2) v += f(Z[m * NZ + c]) + f(Z[m * NZ + 2048 + (c % 1792)]);
        if (DBG_DUMP_MASK & 8) v += f(Q[m * NQC + (c % NQC)]) + f(KV[m * NKVC + c]);
        if (DBG_DUMP_MASK & 16) v += f(PM[m * 1024 + (c & 1023)]);
        if (DBG_DUMP_MASK & 32) v += f(ABC[m * NABC + c]) + f(ABC[m * NABC + 1024 + c]);
        if (DBG_DUMP_MASK & 64) v += f(MG[m * DM + c]);
        if (DBG_DUMP_MASK & 128) v += f(Y[m * DM + c]);
        if (DBG_DUMP_MASK & 256) v += f(((const bf16*)(ws + WS_W))[e]) + f(((const bf16*)(ws + WS_W))[e + 20000000]);
        out[e] = v;
    }
}
#endif

extern "C" void kernel_launch(void* const* d_in, const int* in_sizes, int n_in, void* d_out, int out_size, void* d_ws, size_t ws_size, hipStream_t stream) {
    static int grid = 0;
    if (grid == 0) {
        if (n_in != 22 || out_size != NTOK * DM || ws_size < WS_END) { fprintf(stderr, "kernel_launch: unexpected shapes (n_in %d out %d ws %zu)\n", n_in, out_size, ws_size); grid = -1; return; }
        int dev = 0, cus = 0, per_cu = 0;
        if (hipGetDevice(&dev) != hipSuccess || hipDeviceGetAttribute(&cus, hipDeviceAttributeMultiprocessorCount, dev) != hipSuccess) { grid = -1; return; }
        if (hipFuncSetAttribute((const void*)fwd, hipFuncAttributeMaxDynamicSharedMemorySize, LDS_BYTES) != hipSuccess) { fprintf(stderr, "kernel_launch: hipFuncSetAttribute failed\n"); grid = -1; return; }
        if (hipOccupancyMaxActiveBlocksPerMultiprocessor(&per_cu, (const void*)fwd, NWAVES * 64, LDS_BYTES) != hipSuccess || per_cu < 1)
            fprintf(stderr, "kernel_launch: note: occupancy query reports %d workgroups per CU\n", per_cu);
        (void)hipGetLastError();
        grid = cus;
    }
    if (grid < 0) return;
    (void)in_sizes;
    if (hipMemsetAsync((char*)d_ws + WS_CTL, 0, CTL_ZERO_BYTES, stream) != hipSuccess) return;
    Args a{};
    for (int i = 0; i < 22; ++i) a.in[i] = (const float*)d_in[i];
    a.out = (float*)d_out; a.ws = (unsigned char*)d_ws;
#if MK_N_LAUNCHES == 1
    a.ph_lo = 0; a.ph_hi = N_PHASES;
    hipLaunchKernelGGL(fwd, dim3(grid), dim3(NWAVES * 64), LDS_BYTES, stream, a);
#else
#if DBG_LAST >= 0
    for (int k = 0; k <= DBG_LAST; ++k) { a.ph_lo = k; a.ph_hi = k + 1; hipLaunchKernelGGL(fwd, dim3(grid), dim3(NWAVES * 64), LDS_BYTES, stream, a); }
    hipLaunchKernelGGL(dbg_dump, dim3(2048), dim3(256), 0, stream, (float*)d_out, (const unsigned char*)d_ws);
#else
    for (int k = 0; k < N_PHASES; ++k) { a.ph_lo = k; a.ph_hi = k + 1; hipLaunchKernelGGL(fwd, dim3(grid), dim3(NWAVES * 64), LDS_BYTES, stream, a); }
#endif
#endif
    const hipError_t le = hipPeekAtLastError();
    if (le != hipSuccess) fprintf(stderr, "kernel_launch: launch failed: %s\n", hipGetErrorName(le));
}
```

```cpp
#include <hip/hip_runtime.h>
#include <cstdio>
#include <cstdint>

#define DBG_LAST -1
#define DBG_DUMP_MASK 0x6

#define PROBE_XBAR 0
#define PROBE_WAIT 0
#ifndef MK_N_LAUNCHES
#define MK_N_LAUNCHES 1
#endif

constexpr int DM = 2048, NTOK = 24576, NPROMPT = 16384, DEPTH = 4, DFF = 8192;
constexpr int NZW = 9984, NZ = 3840, NZSRC = 9792;
constexpr int ZC_CQ = 0, ZC_CKV = 512, ZC_QW = 1024, ZC_KW = 2048, ZC_VW = 2304, ZC_QM = 2560, ZC_KR = 3584, ZC_G = 3840;
constexpr int NQC = 1536, NKVC = 2048, NMEMR = 1280, NABC = 3072;
constexpr float EPS = 1e-6f;
constexpr float LOG2E = 1.4426950408889634f;
constexpr float C_W = 0.088388347648318440f * LOG2E;
constexpr float C_M = 0.0625f * LOG2E;
constexpr float C_Q = 0.072168783648703220f * LOG2E;

constexpr size_t MiB = 1u << 20;
constexpr size_t WS_CTL = 0, CTL_ZERO_BYTES = 1 * MiB;
constexpr size_t WS_TAB = 2 * MiB;
constexpr size_t WS_RMEM = 4 * MiB;
constexpr size_t WS_RS = 5 * MiB;
constexpr size_t WS_SSQ = 6 * MiB;
constexpr size_t WS_MEMB = 8 * MiB;
constexpr size_t WS_MEMK = 13 * MiB;
constexpr size_t WS_MEMVT = 16 * MiB;
constexpr size_t WS_W = 32 * MiB;
constexpr size_t WO_IN = 0, WO_UQ = WO_IN + (size_t)NZW * DM * 2, WO_UKV = WO_UQ + (size_t)NQC * 512 * 2, WO_MEM = WO_UKV + (size_t)NKVC * 512 * 2,
                 WO_BR = WO_MEM + (size_t)2048 * DM * 2, WO_OUT = WO_BR + (size_t)DM * NABC * 2, WO_UP = WO_OUT + (size_t)DM * DM * 2,
                 WO_DOWN = WO_UP + (size_t)DFF * DM * 2, WO_END = WO_DOWN + (size_t)DM * DFF * 2;
static_assert(WO_END <= 136 * MiB, "weights region");
constexpr size_t WS_XN = 168 * MiB;
constexpr size_t WS_Z = 264 * MiB;
constexpr size_t WS_GT = 444 * MiB;
constexpr size_t WS_U = WS_Z;
constexpr size_t WS_Q = 732 * MiB;
constexpr size_t WS_KV = 804 * MiB;
constexpr size_t WS_PM = 900 * MiB;
constexpr size_t WS_ABC = 948 * MiB;
constexpr size_t WS_MERGED = 732 * MiB;
constexpr size_t WS_Y = 828 * MiB;
constexpr size_t WS_END = 1092 * MiB;
static_assert(WS_Z + (size_t)NTOK * NZ * 2 <= WS_GT && WS_GT + (size_t)3 * 96 * 8 * 131072 <= WS_Q && WS_MERGED + (size_t)NTOK * DM * 2 <= WS_Y && WS_Y + (size_t)NTOK * DM * 2 <= WS_ABC, "ws map");
constexpr int CW_TMO = 0, CW_BAR = 4096, CW_RANK = 16384;

constexpr int RING_OFF = 0, RING_BYTES = 131072;
constexpr int LDSCTL_OFF = RING_BYTES, MISC_OFF = LDSCTL_OFF + 320;
constexpr int XCH_OFF = RING_BYTES + 1024;
constexpr int LDS_BYTES = 147456;
static_assert(XCH_OFF + 8192 <= LDS_BYTES, "LDS map");
constexpr int NWAVES = 8;

#define GAS __attribute__((address_space(1)))
#define LAS __attribute__((address_space(3)))
typedef unsigned short bf16;
typedef unsigned v4u __attribute__((ext_vector_type(4)));
typedef float f32x4 __attribute__((ext_vector_type(4)));
typedef float f32x2 __attribute__((ext_vector_type(2)));
typedef short bf16x8 __attribute__((ext_vector_type(8)));
typedef GAS unsigned gu32;
#define RLX_AGENT __ATOMIC_RELAXED, __HIP_MEMORY_SCOPE_AGENT
#define LDS_WAIT() asm volatile("s_waitcnt lgkmcnt(0)" ::: "memory")
#define VM_WAIT() asm volatile("s_waitcnt vmcnt(0)" ::: "memory")

typedef float f32x2_t __attribute__((ext_vector_type(2))); typedef __bf16 bf16x2_t __attribute__((ext_vector_type(2)));
__device__ __forceinline__ unsigned cvt_pk_bf16(float lo, float hi) { const f32x2_t v = {lo, hi}; const bf16x2_t b = __builtin_convertvector(v, bf16x2_t); return __builtin_bit_cast(unsigned, b); }
__device__ __forceinline__ float bf_lo(unsigned w) { return __uint_as_float(w << 16); }
__device__ __forceinline__ float bf_hi(unsigned w) { return __uint_as_float(w & 0xffff0000u); }
__device__ __forceinline__ float shfl_xor_l(float v, int m, int lane) { return __int_as_float(__builtin_amdgcn_ds_bpermute((lane ^ m) << 2, __float_as_int(v))); }
__device__ __forceinline__ int seq_pos(int m) { return m < NPROMPT ? (m & 4095) : (m - NPROMPT); }
__device__ __forceinline__ int seq_of_panel(int pm) { return pm < 64 ? (pm >> 4) : 4; }

#ifndef PG8_BALANCED
#define PG8_BALANCED 1
#endif
namespace pg8 {
#define PG8_LAS __attribute__((address_space(3)))
typedef unsigned short bf16_t;
typedef short bf16x8 __attribute__((ext_vector_type(8)));
typedef float f32x4 __attribute__((ext_vector_type(4)));
typedef unsigned u32x4 __attribute__((ext_vector_type(4)));
constexpr int BM = 256, BK = 64, HALF = 128, HTB = HALF * BK * 2, STAGE_BYTES = 8 * HTB, NXCD = 8, WGM = 4;

__host__ __device__ __forceinline__ int lds_byte(int r, int c) { const int st = (r >> 4) * 2 + (c >> 5), rr = r & 15, cc = c & 31, ob = rr * 64 + cc * 2; return st * 1024 + (ob ^ (((ob >> 9) & 1) << 5)); }
__host__ __device__ __forceinline__ void stage_rc(int b, int& R, int& C) { const int st = b / 1024, sb = b % 1024, swz = sb ^ (((sb >> 9) & 1) << 5); R = (st >> 1) * 16 + swz / 64; C = (st & 1) * 32 + (swz % 64) / 2; }
__host__ __device__ __forceinline__ int perm32(int rho) { const int n = rho >> 4, i = rho & 15; return 8 * (i >> 2) + 4 * n + (i & 3); }

struct Unit { int pm, pn; };
struct Gemm { const char* A; const char* B; long a_pm, a_pn, b_pn, b_sq; int lda, ldb, K; bool b_tiled;
    __device__ __forceinline__ const char* aptr(const Unit& u) const { return A + (long)u.pm * a_pm + (long)u.pn * a_pn; }
    __device__ __forceinline__ const char* bptr(const Unit& u) const { return B + (long)u.pn * b_pn + (long)seq_of_panel(u.pm) * b_sq; } };
__device__ __forceinline__ Gemm plain_gemm(const void* A, int lda, const void* B, int ldb, int K, bool b_tiled = false) {
    Gemm g; g.A = (const char*)A; g.B = (const char*)B; g.a_pm = (long)BM * lda * 2; g.a_pn = 0; g.b_pn = b_tiled ? (long)(ldb / BK) * 32768 : (long)BM * ldb * 2; g.b_sq = 0; g.lda = lda; g.ldb = ldb; g.K = K; g.b_tiled = b_tiled; return g; }

struct StaticOrder {
    int nM, nN, nwg, G, c;
    __host__ __device__ void init(int nM_, int nN_, int G_, int c_) { nM = nM_; nN = nN_; nwg = nM * nN; G = G_; c = c_; }
    __host__ __device__ bool next(int i, Unit& u) const {
        const int L = i * G + c; if (L >= nwg) return false;
        int wgid = L; { const int q = nwg / NXCD, r = nwg % NXCD, xcd = wgid % NXCD, off = wgid / NXCD; wgid = (xcd < r ? xcd * (q + 1) : r * (q + 1) + (xcd - r) * q) + off; }
        const int nig = WGM * nN, gid = wgid / nig, fm = gid * WGM, gsz = (nM - fm) < WGM ? (nM - fm) : WGM;
        u.pm = fm + ((wgid % nig) % gsz); u.pn = (wgid % nig) / gsz; return true;
    }
};

typedef f32x4 Acc[2][2][4][2];

template <class Epi, class Sched, bool ALIGN_EPI = true, bool SP2 = true>
__device__ __forceinline__ void gemm_phase(int tid_in, PG8_LAS unsigned char* lds, PG8_LAS unsigned char* xlds, const Gemm g, const Sched& S, const Epi& E) {
    int tid_ = tid_in; asm volatile("" : "+v"(tid_));
    const int tid = tid_, wid = __builtin_amdgcn_readfirstlane(tid >> 6), lane = tid & 63, wr = wid >> 2, wc = wid & 3, fr = lane & 15, fq = lane >> 4;
    const int K = g.K, nt = K / BK;
    unsigned voffA[2], voffB[2];
#pragma unroll
    for (int i = 0; i < 2; ++i) { int R, C; stage_rc(tid * 16 + i * 8192, R, C); const int Rb = Epi::PERM ? ((R & ~31) + perm32(R & 31)) : R;
        voffA[i] = (unsigned)(R * g.lda + C) * 2u; voffB[i] = g.b_tiled ? (unsigned)(tid * 16 + i * 8192) : (unsigned)(Rb * g.ldb + C) * 2u; }
    const size_t kstep = (size_t)(BK * 2), kstepB = g.b_tiled ? (size_t)32768 : (size_t)(BK * 2);
    const size_t hstepA = (size_t)HALF * g.lda * 2, hstepB = g.b_tiled ? (size_t)16384 : (size_t)HALF * g.ldb * 2;
    const unsigned ldsw = (unsigned)wid * 1024u;
    const int aoff = lds_byte(wr * 64 + fr, fq * 8), boff = lds_byte(wc * 32 + fr, fq * 8);
#define PG8_SA(b, h) (((b) * 2 + (h)) * HTB)
#define PG8_SB(b, h) ((4 + (b) * 2 + (h)) * HTB)
#define PG8_STAGE(bufoff, gbase, voff) do { _Pragma("unroll") for (int _i = 0; _i < 2; ++_i) \
        __builtin_amdgcn_global_load_lds((const unsigned*)((const char*)(gbase) + (voff)[_i]), (PG8_LAS unsigned*)(lds + (bufoff) + ldsw + _i * 8192), 16, 0, 0); } while (0)
#define PG8_LDA(dst, b, h) do { _Pragma("unroll") for (int m = 0; m < 4; ++m) _Pragma("unroll") for (int k = 0; k < 2; ++k) dst[m][k] = *(const PG8_LAS bf16x8*)(lds + PG8_SA(b, h) + aoff + m * 2048 + k * 1024); } while (0)
#define PG8_LDB(dst, b, h) do { _Pragma("unroll") for (int n = 0; n < 2; ++n) _Pragma("unroll") for (int k = 0; k < 2; ++k) dst[n][k] = *(const PG8_LAS bf16x8*)(lds + PG8_SB(b, h) + boff + n * 2048 + k * 1024); } while (0)
#define PG8_MMA(ai, bj, At, Bt) do { __builtin_amdgcn_s_setprio(1); _Pragma("unroll") for (int m = 0; m < 4; ++m) _Pragma("unroll") for (int n = 0; n < 2; ++n) _Pragma("unroll") for (int k = 0; k < 2; ++k) \
        acc[ai][bj][m][n] = __builtin_amdgcn_mfma_f32_16x16x32_bf16(Bt[n][k], At[m][k], acc[ai][bj][m][n], 0, 0, 0); __builtin_amdgcn_s_setprio(0); } while (0)
#define PG8_WAIT_V(n) asm volatile("s_waitcnt vmcnt(" #n ")" ::: "memory")
#define PG8_WAIT_L(n) asm volatile("s_waitcnt lgkmcnt(" #n ")" ::: "memory")
#define PG8_BAR __builtin_amdgcn_s_barrier()
#define PG8_SCHED __builtin_amdgcn_sched_barrier(0)
    Unit cur, nxt; int ui = 0;
    if (!S.next(0, cur)) return;
    f32x4 acc[2][2][4][2];
#pragma unroll
    for (int a = 0; a < 2; ++a)
#pragma unroll
        for (int b = 0; b < 2; ++b)
#pragma unroll
            for (int m = 0; m < 4; ++m)
#pragma unroll
                for (int n = 0; n < 2; ++n) acc[a][b][m][n] = (f32x4){0.f, 0.f, 0.f, 0.f};
    bf16x8 At[4][2], B0[2][2], B1[2][2];
    const char* cA = g.aptr(cur); const char* cB = g.bptr(cur);
    if constexpr (SP2 && PG8_BALANCED) {
        PG8_STAGE(PG8_SB(0, 0), cB, voffB); PG8_STAGE(PG8_SB(0, 1), cB + hstepB, voffB); PG8_STAGE(PG8_SA(0, 0), cA, voffA); PG8_STAGE(PG8_SA(0, 1), cA + hstepA, voffA);
        if (wr == 1) PG8_BAR;
        PG8_WAIT_V(2); PG8_BAR;
        PG8_STAGE(PG8_SB(1, 0), cB + kstepB, voffB); PG8_STAGE(PG8_SB(1, 1), cB + hstepB + kstepB, voffB);
        PG8_WAIT_V(4); PG8_BAR;
    } else if constexpr (SP2) {
        PG8_STAGE(PG8_SB(0, 0), cB, voffB); PG8_STAGE(PG8_SB(0, 1), cB + hstepB, voffB); PG8_STAGE(PG8_SA(0, 0), cA, voffA); PG8_STAGE(PG8_SA(0, 1), cA + hstepA, voffA);
        if (wr == 1) PG8_BAR;
        PG8_WAIT_V(2); PG8_BAR;
        PG8_STAGE(PG8_SB(1, 0), cB + kstepB, voffB); PG8_STAGE(PG8_SA(1, 0), cA + kstep, voffA); PG8_STAGE(PG8_SB(1, 1), cB + hstepB + kstepB, voffB);
        PG8_WAIT_V(6); PG8_BAR;
    } else {
        PG8_STAGE(PG8_SB(0, 0), cB, voffB); PG8_STAGE(PG8_SA(0, 0), cA, voffA); PG8_STAGE(PG8_SB(0, 1), cB + hstepB, voffB); PG8_STAGE(PG8_SA(0, 1), cA + hstepA, voffA);
        if (wr == 1) PG8_BAR;
        PG8_WAIT_V(4); PG8_BAR;
        PG8_STAGE(PG8_SB(1, 0), cB + kstepB, voffB); PG8_STAGE(PG8_SA(1, 0), cA + kstep, voffA); PG8_STAGE(PG8_SB(1, 1), cB + hstepB + kstepB, voffB);
        PG8_WAIT_V(6); PG8_BAR;
    }
    for (;;) {
        const bool has_next = S.next(ui + 1, nxt);
        const char* nA = has_next ? g.aptr(nxt) : cA; const char* nB = has_next ? g.bptr(nxt) : cB;
        for (int t = 0; t < nt; t += 2) {
            const bool last = (t == nt - 2);
            if constexpr (Epi::HAS_MID) { if (t == Epi::MID1 || t == Epi::MID2) E.mid(acc, cur, t, wr, wc, fr, fq); }
            const char* a1 = cA + (size_t)(t + 1) * kstep;
            const char* a2 = last ? nA : cA + (size_t)(t + 2) * kstep; const char* b2 = last ? nB : cB + (size_t)(t + 2) * kstepB;
            const char* a3 = a2 + kstep; const char* b3 = b2 + kstepB;
            if constexpr (SP2 && PG8_BALANCED) {
            PG8_LDB(B0, 0, 0); PG8_LDB(B1, 0, 1); PG8_SCHED; PG8_LDA(At, 0, 0); PG8_STAGE(PG8_SA(1, 0), a1, voffA); PG8_STAGE(PG8_SA(1, 1), a1 + hstepA, voffA);
            PG8_WAIT_V(8); PG8_WAIT_L(0); PG8_BAR; PG8_MMA(0, 0, At, B0); PG8_MMA(0, 1, At, B1); PG8_BAR; PG8_SCHED;
            PG8_LDA(At, 0, 1); PG8_STAGE(PG8_SB(0, 0), b2, voffB); PG8_STAGE(PG8_SB(0, 1), b2 + hstepB, voffB);
            PG8_WAIT_V(6); PG8_WAIT_L(0); PG8_BAR; PG8_MMA(1, 0, At, B0); PG8_MMA(1, 1, At, B1); PG8_BAR; PG8_SCHED;
            PG8_LDB(B0, 1, 0); PG8_LDB(B1, 1, 1); PG8_SCHED; PG8_LDA(At, 1, 0); PG8_STAGE(PG8_SA(0, 0), a2, voffA); PG8_STAGE(PG8_SA(0, 1), a2 + hstepA, voffA);
            PG8_WAIT_V(8); PG8_WAIT_L(0); PG8_BAR; PG8_MMA(0, 0, At, B0); PG8_MMA(0, 1, At, B1); PG8_BAR; PG8_SCHED;
            PG8_LDA(At, 1, 1); PG8_STAGE(PG8_SB(1, 0), b3, voffB); PG8_STAGE(PG8_SB(1, 1), b3 + hstepB, voffB);
            PG8_WAIT_V(6); PG8_WAIT_L(0); PG8_BAR; PG8_MMA(1, 0, At, B0); PG8_MMA(1, 1, At, B1); PG8_BAR; PG8_SCHED;
            } else if constexpr (SP2) {
            PG8_LDB(B0, 0, 0); PG8_LDB(B1, 0, 1); PG8_SCHED; PG8_LDA(At, 0, 0); PG8_STAGE(PG8_SA(1, 1), a1 + hstepA, voffA);
            PG8_WAIT_V(8); PG8_WAIT_L(0); PG8_BAR; PG8_MMA(0, 0, At, B0); PG8_MMA(0, 1, At, B1); PG8_BAR; PG8_SCHED;
            PG8_LDA(At, 0, 1); PG8_STAGE(PG8_SB(0, 0), b2, voffB); PG8_STAGE(PG8_SB(0, 1), b2 + hstepB, voffB); PG8_STAGE(PG8_SA(0, 0), a2, voffA);
            PG8_WAIT_V(8); PG8_WAIT_L(0); PG8_BAR; PG8_MMA(1, 0, At, B0); PG8_MMA(1, 1, At, B1); PG8_BAR; PG8_SCHED;
            PG8_LDB(B0, 1, 0); PG8_LDB(B1, 1, 1); PG8_SCHED; PG8_LDA(At, 1, 0); PG8_STAGE(PG8_SA(0, 1), a2 + hstepA, voffA);
            PG8_WAIT_V(8); PG8_WAIT_L(0); PG8_BAR; PG8_MMA(0, 0, At, B0); PG8_MMA(0, 1, At, B1); PG8_BAR; PG8_SCHED;
            PG8_LDA(At, 1, 1); PG8_STAGE(PG8_SB(1, 0), b3, voffB); PG8_STAGE(PG8_SB(1, 1), b3 + hstepB, voffB); PG8_STAGE(PG8_SA(1, 0), a3, voffA);
            PG8_WAIT_V(8); PG8_WAIT_L(0); PG8_BAR; PG8_MMA(1, 0, At, B0); PG8_MMA(1, 1, At, B1); PG8_BAR; PG8_SCHED;
            } else {
            PG8_LDB(B0, 0, 0); PG8_SCHED; PG8_LDA(At, 0, 0); PG8_STAGE(PG8_SA(1, 1), a1 + hstepA, voffA);
            PG8_WAIT_L(8); PG8_BAR; PG8_WAIT_L(0); PG8_MMA(0, 0, At, B0); PG8_BAR; PG8_SCHED;
            PG8_LDB(B1, 0, 1); PG8_STAGE(PG8_SB(0, 0), b2, voffB);
            PG8_BAR; PG8_WAIT_L(0); PG8_MMA(0, 1, At, B1); PG8_BAR;
            PG8_LDA(At, 0, 1); PG8_STAGE(PG8_SA(0, 0), a2, voffA);
            PG8_BAR; PG8_WAIT_L(0); PG8_MMA(1, 0, At, B0); PG8_BAR; PG8_SCHED;
            PG8_STAGE(PG8_SB(0, 1), b2 + hstepB, voffB);
            PG8_WAIT_V(6); PG8_BAR; PG8_MMA(1, 1, At, B1); PG8_BAR;
            PG8_LDB(B0, 1, 0); PG8_SCHED; PG8_LDA(At, 1, 0); PG8_STAGE(PG8_SA(0, 1), a2 + hstepA, voffA);
            PG8_WAIT_L(8); PG8_BAR; PG8_WAIT_L(0); PG8_MMA(0, 0, At, B0); PG8_BAR; PG8_SCHED;
            PG8_LDB(B1, 1, 1); PG8_STAGE(PG8_SB(1, 0), b3, voffB);
            PG8_BAR; PG8_WAIT_L(0); PG8_MMA(0, 1, At, B1); PG8_BAR;
            PG8_LDA(At, 1, 1); PG8_STAGE(PG8_SA(1, 0), a3, voffA);
            PG8_BAR; PG8_WAIT_L(0); PG8_MMA(1, 0, At, B0); PG8_BAR; PG8_SCHED;
            PG8_STAGE(PG8_SB(1, 1), b3 + hstepB, voffB);
            PG8_WAIT_V(6); PG8_BAR; PG8_MMA(1, 1, At, B1); PG8_BAR;
            }
        }
        if constexpr (ALIGN_EPI) { if (wr == 0) PG8_BAR; }
        E(acc, cur, wr, wc, fr, fq, xlds, wid, lane);
        if (!has_next) break;
#pragma unroll
        for (int a = 0; a < 2; ++a)
#pragma unroll
            for (int b = 0; b < 2; ++b)
#pragma unroll
                for (int m = 0; m < 4; ++m)
#pragma unroll
                    for (int n = 0; n < 2; ++n) acc[a][b][m][n] = (f32x4){0.f, 0.f, 0.f, 0.f};
        cur = nxt; cA = nA; cB = nB; ++ui;
        if constexpr (ALIGN_EPI) { if (wr == 1) PG8_BAR; }
    }
    PG8_WAIT_V(0);
    if constexpr (!ALIGN_EPI) { if (wr == 0) PG8_BAR; }
    PG8_BAR;
#undef PG8_SA
#undef PG8_SB
#undef PG8_STAGE
#undef PG8_LDA
#undef PG8_LDB
#undef PG8_MMA
#undef PG8_WAIT_V
#undef PG8_WAIT_L
#undef PG8_BAR
#undef PG8_SCHED
}
}

namespace epi {
using pg8::Acc; using pg8::Unit; using pg8::HALF; using pg8::BM;
typedef float f32x2v __attribute__((ext_vector_type(2)));
#define EPI_COMMON static constexpr bool PERM = true;
#define EPI_PIN(a, b) asm volatile("" : "+v"(a), "+v"(b))
#define EPI_NOMID static constexpr bool HAS_MID = false; static constexpr int MID1 = -1, MID2 = -1;
__device__ __forceinline__ v4u pack8(const f32x4 v0, const f32x4 v1) { v4u w; w.x = cvt_pk_bf16(v0[0], v0[1]); w.y = cvt_pk_bf16(v0[2], v0[3]); w.z = cvt_pk_bf16(v1[0], v1[1]); w.w = cvt_pk_bf16(v1[2], v1[3]); return w; }
__device__ __forceinline__ void rope8(f32x4& v0, f32x4& v1, const f32x4 cs0, const f32x4 cs1, const f32x4 cs2, const f32x4 cs3) {
    (void)cs2; (void)cs3;
    const float a0 = v0[0] * cs0[0] - v0[1] * cs0[1], b0 = v0[0] * cs0[1] + v0[1] * cs0[0];
    const float a1 = v0[2] * cs0[2] - v0[3] * cs0[3], b1 = v0[2] * cs0[3] + v0[3] * cs0[2];
    const float a2 = v1[0] * cs1[0] - v1[1] * cs1[1], b2 = v1[0] * cs1[1] + v1[1] * cs1[0];
    const float a3 = v1[2] * cs1[2] - v1[3] * cs1[3], b3 = v1[2] * cs1[3] + v1[3] * cs1[2];
    v0 = (f32x4){a0, b0, a1, b1}; v1 = (f32x4){a2, b2, a3, b3};
}
__device__ __forceinline__ float sigmoidf_fast(float v) { return __builtin_amdgcn_rcpf(1.f + __builtin_amdgcn_exp2f(-LOG2E * v)); }

struct EpiZ { EPI_COMMON EPI_NOMID
    bf16* Z; float* SSQ; const float* tab; unsigned char* GT;
    __device__ __forceinline__ void operator()(Acc& acc, const Unit& u, int wr, int wc, int fr, int fq, LAS unsigned char*, int, int lane) const {
        const int pn = u.pn; int row0 = u.pm * BM + wr * 64 + fr, col0 = pn * BM + wc * 32 + 8 * fq; EPI_PIN(row0, col0);
        if (pn >= 15) {
            const int gi = pn - 15; unsigned char* blk = GT + ((size_t)((gi >> 3) * 96 + u.pm) * 8 + (gi & 7)) * 131072 + (size_t)(wr * 4 + wc) * 16384 + lane * 16;
#pragma unroll
            for (int ai = 0; ai < 2; ++ai)
#pragma unroll
                for (int m = 0; m < 4; ++m)
#pragma unroll
                    for (int bj = 0; bj < 2; ++bj) { f32x4 v0 = acc[ai][bj][m][0], v1 = acc[ai][bj][m][1];
#pragma unroll
                        for (int j = 0; j < 4; ++j) { v0[j] = sigmoidf_fast(v0[j]); v1[j] = sigmoidf_fast(v1[j]); }
                        *(v4u*)(blk + ((ai * 4 + m) * 2 + bj) * 1024) = pack8(v0, v1); }
        } else if (pn == 14) {
            const int i0 = 16 * (wc & 1) + 4 * fq;
#pragma unroll
            for (int ai = 0; ai < 2; ++ai)
#pragma unroll
                for (int m = 0; m < 4; ++m) { const int row = row0 + ai * HALF + m * 16; bf16* rowp = Z + (size_t)row * NZ + col0;
                    f32x4 v0 = acc[ai][0][m][0], v1 = acc[ai][0][m][1];
                    if (wc < 2) { const f32x4* cs = (const f32x4*)(tab + ((size_t)seq_pos(row) * 32 + i0) * 2); rope8(v0, v1, cs[0], cs[1], cs[0], cs[0]); }
                    *(v4u*)(rowp) = pack8(v0, v1);
                    *(v4u*)(rowp + HALF) = pack8(acc[ai][1][m][0], acc[ai][1][m][1]); }
        } else {
            const float sc = (pn >= 4 && pn < 8) ? C_W : ((pn >= 10) ? C_M : 1.f);
#pragma unroll
            for (int ai = 0; ai < 2; ++ai)
#pragma unroll
                for (int m = 0; m < 4; ++m) { const int row = row0 + ai * HALF + m * 16; bf16* rowp = Z + (size_t)row * NZ + col0; float ss = 0.f;
#pragma unroll
                    for (int bj = 0; bj < 2; ++bj) { const f32x4 v0 = acc[ai][bj][m][0] * sc, v1 = acc[ai][bj][m][1] * sc;
                        ss += (v0[0] * v0[0] + v0[1] * v0[1]) + (v0[2] * v0[2] + v0[3] * v0[3]) + (v1[0] * v1[0] + v1[1] * v1[1]) + (v1[2] * v1[2] + v1[3] * v1[3]);
                        *(v4u*)(rowp + bj * HALF) = pack8(v0, v1); }
                    if (pn < 4) { ss += shfl_xor_l(ss, 16, lane); ss += shfl_xor_l(ss, 32, lane); if (fq == 0) SSQ[(size_t)row * 16 + pn * 4 + wc] = ss; } }
        }
    }
};
template <int WHICH  > struct EpiLat { EPI_COMMON EPI_NOMID
    bf16* O; const float* SSQ; const float* tab;
    __device__ __forceinline__ void operator()(Acc& acc, const Unit& u, int wr, int wc, int fr, int fq, LAS unsigned char*, int, int) const {
        constexpr int LDC = WHICH == 0 ? NQC : NKVC;
        const int pn = u.pn; int row0 = u.pm * BM + wr * 64 + fr, col0 = pn * BM + wc * 32 + 8 * fq; EPI_PIN(row0, col0);
        const int i0 = 16 * (wc & 1) + 4 * fq;
#pragma unroll
        for (int ai = 0; ai < 2; ++ai)
#pragma unroll
            for (int m = 0; m < 4; ++m) { const int row = row0 + ai * HALF + m * 16; bf16* rowp = O + (size_t)row * LDC + col0;
                const f32x4* sp = (const f32x4*)(SSQ + (size_t)row * 16 + WHICH * 8); const f32x4 s0 = sp[0], s1 = sp[1];
                const float ssum = ((s0[0] + s0[1]) + (s0[2] + s0[3])) + ((s1[0] + s1[1]) + (s1[2] + s1[3]));
                const float rs = __builtin_amdgcn_rsqf(ssum * (1.f / 512.f) + EPS) * (WHICH == 0 ? C_Q : 1.f);
#pragma unroll
                for (int bj = 0; bj < 2; ++bj) { f32x4 v0 = acc[ai][bj][m][0] * rs, v1 = acc[ai][bj][m][1] * rs;
                    if (WHICH == 0 && pn >= 4) { const f32x4* cs = (const f32x4*)(tab + ((size_t)seq_pos(row) * 32 + i0) * 2); rope8(v0, v1, cs[0], cs[1], cs[0], cs[0]); }
                    *(v4u*)(rowp + bj * HALF) = pack8(v0, v1); } }
    }
};
template <int MODE> struct EpiStore { EPI_COMMON EPI_NOMID
    bf16* O; int ldc; int col_off; const float* rs;
    __device__ __forceinline__ void operator()(Acc& acc, const Unit& u, int wr, int wc, int fr, int fq, LAS unsigned char*, int, int) const {
        int row0 = u.pm * BM + wr * 64 + fr, ct = u.pn * BM + wc * 32 + 8 * fq; EPI_PIN(row0, ct); const int col0 = col_off + ct;
        f32x4 cs[2][2]; float rr[2][4];
#pragma unroll
        for (int ai = 0; ai < 2; ++ai)
#pragma unroll
            for (int m = 0; m < 4; ++m) rr[ai][m] = (MODE == 1 || MODE == 5) ? rs[row0 + ai * HALF + m * 16] : 1.f;
        if (MODE == 2) {
#pragma unroll
            for (int bj = 0; bj < 2; ++bj) { cs[bj][0] = *(const f32x4*)(rs + ct + bj * HALF); cs[bj][1] = *(const f32x4*)(rs + ct + bj * HALF + 4); } }
#pragma unroll
        for (int ai = 0; ai < 2; ++ai)
#pragma unroll
            for (int m = 0; m < 4; ++m) { const int row = row0 + ai * HALF + m * 16; bf16* rowp = O + (size_t)row * ldc + col0;
                const float r = rr[ai][m];
#pragma unroll
                for (int bj = 0; bj < 2; ++bj) { f32x4 v0 = acc[ai][bj][m][0], v1 = acc[ai][bj][m][1];
                    if (MODE == 1 || MODE == 5) { v0 = v0 * r; v1 = v1 * r; }
                    if (MODE == 2) { v0 = v0 * cs[bj][0]; v1 = v1 * cs[bj][1]; }
                    if (MODE == 3 || MODE == 5) {
#pragma unroll
                        for (int j = 0; j < 4; ++j) { const float a = fmaxf(v0[j], 0.f), b = fmaxf(v1[j], 0.f); v0[j] = a * a; v1[j] = b * b; } }
                    *(v4u*)(rowp + bj * HALF) = pack8(v0, v1); } }
    }
};
struct EpiSoftmax { EPI_COMMON EPI_NOMID
    bf16* O;
    __device__ __forceinline__ void operator()(Acc& acc, const Unit& u, int wr, int wc, int fr, int fq, LAS unsigned char* xl, int, int lane) const {
        LAS float* MX = (LAS float*)xl; LAS float* SM = (LAS float*)(xl + 4096);
        int row0 = u.pm * BM + wr * 64 + fr, col0 = u.pn * BM + wc * 32 + 8 * fq; EPI_PIN(row0, col0);
#pragma unroll
        for (int ai = 0; ai < 2; ++ai)
#pragma unroll
            for (int m = 0; m < 4; ++m) { float mx = -3.0e38f;
#pragma unroll
                for (int bj = 0; bj < 2; ++bj)
#pragma unroll
                    for (int n = 0; n < 2; ++n) { const f32x4 x = acc[ai][bj][m][n]; mx = fmaxf(mx, fmaxf(fmaxf(x[0], x[1]), fmaxf(x[2], x[3]))); }
                mx = fmaxf(mx, shfl_xor_l(mx, 16, lane)); mx = fmaxf(mx, shfl_xor_l(mx, 32, lane));
                if (fq == 0) MX[(ai * HALF + wr * 64 + m * 16 + fr) * 4 + wc] = mx; }
        asm volatile("s_waitcnt lgkmcnt(0)" ::: "memory"); __builtin_amdgcn_s_barrier(); asm volatile("" ::: "memory");
#pragma unroll
        for (int ai = 0; ai < 2; ++ai)
#pragma unroll
            for (int m = 0; m < 4; ++m) { const int lr = ai * HALF + wr * 64 + m * 16 + fr; const f32x4 q = *(LAS f32x4*)(MX + lr * 4);
                const float mx = fmaxf(fmaxf(q[0], q[1]), fmaxf(q[2], q[3])); float s = 0.f;
#pragma unroll
                for (int bj = 0; bj < 2; ++bj)
#pragma unroll
                    for (int n = 0; n < 2; ++n) { f32x4 x = acc[ai][bj][m][n];
#pragma unroll
                        for (int j = 0; j < 4; ++j) { x[j] = __builtin_amdgcn_exp2f(x[j] - mx); s += x[j]; }
                        acc[ai][bj][m][n] = x; }
                s += shfl_xor_l(s, 16, lane); s += shfl_xor_l(s, 32, lane);
                if (fq == 0) SM[lr * 4 + wc] = s; }
        asm volatile("s_waitcnt lgkmcnt(0)" ::: "memory"); __builtin_amdgcn_s_barrier(); asm volatile("" ::: "memory");
#pragma unroll
        for (int ai = 0; ai < 2; ++ai)
#pragma unroll
            for (int m = 0; m < 4; ++m) { const int lr = ai * HALF + wr * 64 + m * 16 + fr; const f32x4 q = *(LAS f32x4*)(SM + lr * 4);
                const float inv = __builtin_amdgcn_rcpf((q[0] + q[1]) + (q[2] + q[3]));
                bf16* rowp = O + (size_t)(row0 + ai * HALF + m * 16) * 1024 + col0;
#pragma unroll
                for (int bj = 0; bj < 2; ++bj) *(v4u*)(rowp + bj * HALF) = pack8(acc[ai][bj][m][0] * inv, acc[ai][bj][m][1] * inv); }
    }
};
struct EpiBranch { EPI_COMMON
    static constexpr bool HAS_MID = true; static constexpr int MID1 = 16, MID2 = 32;
    bf16* O; const unsigned char* GT;
    __device__ __forceinline__ const unsigned char* gblk(const Unit& u, int g, int wr, int wc, int fr, int fq) const {
        return GT + ((size_t)(g * 96 + u.pm) * 8 + u.pn) * 131072 + (size_t)(wr * 4 + wc) * 16384 + (fq * 16 + fr) * 16; }
    __device__ __forceinline__ void mid(Acc& acc, const Unit& u, int t, int wr, int wc, int fr, int fq) const {
        const int gxi = (t == MID1) ? 0 : 1;
        const unsigned char* px = gblk(u, gxi, wr, wc, fr, fq); const unsigned char* py = gblk(u, gxi + 1, wr, wc, fr, fq);
#pragma unroll
        for (int ai = 0; ai < 2; ++ai) {
            v4u a[4][2], b[4][2];
#pragma unroll
            for (int m = 0; m < 4; ++m)
#pragma unroll
                for (int bj = 0; bj < 2; ++bj) { a[m][bj] = *(const v4u*)(px + ((ai * 4 + m) * 2 + bj) * 1024); b[m][bj] = *(const v4u*)(py + ((ai * 4 + m) * 2 + bj) * 1024); }
            __builtin_amdgcn_sched_barrier(0);
#pragma unroll
            for (int m = 0; m < 4; ++m)
#pragma unroll
                for (int bj = 0; bj < 2; ++bj) { const v4u x = a[m][bj], y = b[m][bj]; f32x4 r0, r1;
                    r0[0] = bf_lo(x.x) * __builtin_amdgcn_rcpf(bf_lo(y.x)); r0[1] = bf_hi(x.x) * __builtin_amdgcn_rcpf(bf_hi(y.x));
                    r0[2] = bf_lo(x.y) * __builtin_amdgcn_rcpf(bf_lo(y.y)); r0[3] = bf_hi(x.y) * __builtin_amdgcn_rcpf(bf_hi(y.y));
                    r1[0] = bf_lo(x.z) * __builtin_amdgcn_rcpf(bf_lo(y.z)); r1[1] = bf_hi(x.z) * __builtin_amdgcn_rcpf(bf_hi(y.z));
                    r1[2] = bf_lo(x.w) * __builtin_amdgcn_rcpf(bf_lo(y.w)); r1[3] = bf_hi(x.w) * __builtin_amdgcn_rcpf(bf_hi(y.w));
                    acc[ai][bj][m][0] *= r0; acc[ai][bj][m][1] *= r1; }
            __builtin_amdgcn_sched_barrier(0);
        }
    }
    __device__ __forceinline__ void operator()(Acc& acc, const Unit& u, int wr, int wc, int fr, int fq, LAS unsigned char*, int, int) const {
        int row0 = u.pm * BM + wr * 64 + fr, col0 = u.pn * BM + wc * 32 + 8 * fq; EPI_PIN(row0, col0);
        const unsigned char* pz = gblk(u, 2, wr, wc, fr, fq);
#pragma unroll
        for (int ai = 0; ai < 2; ++ai) {
            v4u a[4][2];
#pragma unroll
            for (int m = 0; m < 4; ++m)
#pragma unroll
                for (int bj = 0; bj < 2; ++bj) a[m][bj] = *(const v4u*)(pz + ((ai * 4 + m) * 2 + bj) * 1024);
            __builtin_amdgcn_sched_barrier(0);
#pragma unroll
            for (int m = 0; m < 4; ++m) { bf16* rowp = O + (size_t)(row0 + ai * HALF + m * 16) * DM + col0;
#pragma unroll
                for (int bj = 0; bj < 2; ++bj) { const v4u x = a[m][bj];
                    const f32x4 g0 = {bf_lo(x.x), bf_hi(x.x), bf_lo(x.y), bf_hi(x.y)}, g1 = {bf_lo(x.z), bf_hi(x.z), bf_lo(x.w), bf_hi(x.w)};
                    *(v4u*)(rowp + bj * HALF) = pack8(acc[ai][bj][m][0] * g0, acc[ai][bj][m][1] * g1); } }
            __builtin_amdgcn_sched_barrier(0);
        }
    }
};
}

namespace att {
using s16x4 = __attribute__((ext_vector_type(4))) short;
using f32x16 = __attribute__((ext_vector_type(16))) float;
using u32x4 = __attribute__((ext_vector_type(4))) unsigned;
constexpr int NW = 8, QBLK = 32, KVBLK = 64;
constexpr float THR2 = 8.f;
constexpr float NEGBIG = -1.0e30f;
#define SBAR() __builtin_amdgcn_sched_barrier(0)
__device__ __forceinline__ int crow(int r, int hi) { return (r & 3) + 8 * (r >> 2) + 4 * hi; }
template <int KROWB> __device__ __forceinline__ int kswz(int row, int colB) { return row * KROWB + (colB ^ ((KROWB == 384 ? ((row >> 1) & 7) : (row & 15)) << 4)); }

struct Mask { int dq; float sl; };

template <bool WIN>
__device__ __forceinline__ void partialSM(f32x16& p0, f32x16& p1, float& m_reg, float& mn, float& alpha, const Mask& mk, int kt) {
  if (WIN) {
    const float fd = (float)(mk.dq - kt * KVBLK);
#pragma unroll
    for (int r = 0; r < 16; ++r) { const float d0 = fd - (float)((r & 3) + 8 * (r >> 2)), d1 = d0 - 32.f; const float a0 = fabsf(d0), a1 = fabsf(d1);
      const float t0 = p0[r] - mk.sl * a0, t1 = p1[r] - mk.sl * a1; p0[r] = (a0 <= 128.f) ? t0 : NEGBIG; p1[r] = (a1 <= 128.f) ? t1 : NEGBIG; }
  }
  float pmax = p0[0];
#pragma unroll
  for (int r = 1; r < 16; ++r) pmax = fmaxf(pmax, p0[r]);
#pragma unroll
  for (int r = 0; r < 16; ++r) pmax = fmaxf(pmax, p1[r]);
  { auto rr = __builtin_amdgcn_permlane32_swap(__float_as_uint(pmax), __float_as_uint(pmax), false, false);
    pmax = fmaxf(__uint_as_float(rr[0]), __uint_as_float(rr[1])); }
  if (__builtin_expect(__all(pmax - m_reg <= THR2), 1)) { mn = m_reg; alpha = 1.f; }
  else { mn = fmaxf(m_reg, pmax); alpha = __builtin_amdgcn_exp2f(m_reg - mn); m_reg = mn; }
#pragma unroll
  for (int r = 0; r < 16; ++r) p0[r] = p0[r] - mn;
#pragma unroll
  for (int r = 0; r < 16; ++r) p1[r] = p1[r] - mn;
#pragma unroll
  for (int r = 0; r < 16; ++r) p0[r] = __builtin_amdgcn_exp2f(p0[r]);
}
__device__ __forceinline__ void finishSM(f32x16& p0, f32x16& p1, float alpha, float& l_reg, bf16x8& pa0, bf16x8& pa1, bf16x8& pa2, bf16x8& pa3) {
#pragma unroll
  for (int r = 0; r < 16; ++r) p1[r] = __builtin_amdgcn_exp2f(p1[r]);
  float ps = 0;
#pragma unroll
  for (int r = 0; r < 16; ++r) ps += p0[r];
#pragma unroll
  for (int r = 0; r < 16; ++r) ps += p1[r];
  { auto rr = __builtin_amdgcn_permlane32_swap(__float_as_uint(ps), __float_as_uint(ps), false, false);
    ps = __uint_as_float(rr[0]) + __uint_as_float(rr[1]); }
  l_reg = l_reg * alpha + ps;
#define PK4(P, BASE, OUT) do { unsigned a0 = cvt_pk_bf16(P[BASE + 0], P[BASE + 1]), a1 = cvt_pk_bf16(P[BASE + 2], P[BASE + 3]);   \
    unsigned b0 = cvt_pk_bf16(P[BASE + 4], P[BASE + 5]), b1 = cvt_pk_bf16(P[BASE + 6], P[BASE + 7]);                              \
    auto r0 = __builtin_amdgcn_permlane32_swap(a0, b0, false, false); auto r1 = __builtin_amdgcn_permlane32_swap(a1, b1, false, false); \
    u32x4 w = {r0[0], r1[0], r0[1], r1[1]}; OUT = *reinterpret_cast<bf16x8*>(&w); } while (0)
  PK4(p0, 0, pa0); PK4(p0, 8, pa1); PK4(p1, 0, pa2); PK4(p1, 8, pa3);
#undef PK4
}
template <int NQF, int KROWB>
__device__ __forceinline__ void qkt(f32x16& p0, f32x16& p1, const LAS char* Ks, const bf16x8* qr, int r32, int hi) {
  p0 = f32x16{}; p1 = f32x16{};
#pragma unroll
  for (int d0 = 0; d0 < NQF; ++d0) { const int cb = (d0 * 16 + hi * 8) * 2;
    bf16x8 b0 = *(const LAS bf16x8*)(Ks + kswz<KROWB>(r32, cb));
    bf16x8 b1 = *(const LAS bf16x8*)(Ks + kswz<KROWB>(32 + r32, cb));
    p0 = __builtin_amdgcn_mfma_f32_32x32x16_bf16(b0, qr[d0], p0, 0, 0, 0);
    p1 = __builtin_amdgcn_mfma_f32_32x32x16_bf16(b1, qr[d0], p1, 0, 0, 0); }
}
__device__ __forceinline__ int v_st(int k, int c) { const int kk = (k & ~0xC) | ((k & 4) << 1) | ((k & 8) >> 1); return ((kk >> 3) * 4 + (c >> 5)) * 512 + ((kk & 7) * 32 + (c & 31)) * 2; }
__device__ __forceinline__ int v_rd_base(int lane) { return ((lane & 3) << 3) | (((lane >> 2) & 3) << 6) | (((lane >> 4) & 1) << 5) | (((lane >> 5) & 1) << 8); }
constexpr int v_rd_off(int d0, int ks, int half) { return d0 * 512 + ks * 4096 + half * 2048; }
template <int OFF> __device__ __forceinline__ s16x4 tr_read(int vb) {
  s16x4 r; asm volatile("ds_read_b64_tr_b16 %0, %1 offset:%2" : "=&v"(r) : "v"(vb), "i"(OFF) : "memory"); return r;
}
template <int D0> __device__ __forceinline__ void pv_one(f32x16& od, int vb, bf16x8 pa0, bf16x8 pa1, bf16x8 pa2, bf16x8 pa3) {
  const s16x4 l0 = tr_read<v_rd_off(D0, 0, 0)>(vb), h0 = tr_read<v_rd_off(D0, 0, 1)>(vb), l1 = tr_read<v_rd_off(D0, 1, 0)>(vb), h1 = tr_read<v_rd_off(D0, 1, 1)>(vb);
  const s16x4 l2 = tr_read<v_rd_off(D0, 2, 0)>(vb), h2 = tr_read<v_rd_off(D0, 2, 1)>(vb), l3 = tr_read<v_rd_off(D0, 3, 0)>(vb), h3 = tr_read<v_rd_off(D0, 3, 1)>(vb);
  asm volatile("s_waitcnt lgkmcnt(0)" ::: "memory"); SBAR();
#define PK(L, H) (bf16x8){L[0], L[1], L[2], L[3], H[0], H[1], H[2], H[3]}
  od = __builtin_amdgcn_mfma_f32_32x32x16_bf16(pa0, PK(l0, h0), od, 0, 0, 0);
  od = __builtin_amdgcn_mfma_f32_32x32x16_bf16(pa1, PK(l1, h1), od, 0, 0, 0);
  od = __builtin_amdgcn_mfma_f32_32x32x16_bf16(pa2, PK(l2, h2), od, 0, 0, 0);
  od = __builtin_amdgcn_mfma_f32_32x32x16_bf16(pa3, PK(l3, h3), od, 0, 0, 0);
#undef PK
}
__device__ __forceinline__ void pv_d0(f32x16* o, int vb, bf16x8 pa0, bf16x8 pa1, bf16x8 pa2, bf16x8 pa3) {
  pv_one<0>(o[0], vb, pa0, pa1, pa2, pa3); pv_one<1>(o[1], vb, pa0, pa1, pa2, pa3); pv_one<2>(o[2], vb, pa0, pa1, pa2, pa3); pv_one<3>(o[3], vb, pa0, pa1, pa2, pa3);
}

template <int KIND>
__device__ __forceinline__ void attn_unit(const bf16* __restrict__ Qb, const bf16* __restrict__ KVb, const bf16* __restrict__ Zb, bf16* __restrict__ Ob,
                                          int qm0, int km0, int NT, int h, int ocol, float m0, float l0, Mask mk, LAS char* lds, int tid_in) {
  constexpr int NQF = KIND == 0 ? 12 : 8, KROWB = KIND == 0 ? 384 : 256;
  constexpr int SHM_V = KVBLK * 128 * 2, SHM_K = KVBLK * KROWB;
  int tid_; asm volatile("v_mbcnt_lo_u32_b32 %0, -1, 0\n\tv_mbcnt_hi_u32_b32 %0, -1, %0" : "=v"(tid_)); tid_ += tid_in;
  const int tid = tid_, wid = tid >> 6, lane = tid & 63, r32 = lane & 31, hi = lane >> 5;
  LAS char* V_lds = lds; LAS char* K_lds = lds + 2 * SHM_V;
  LAS float* ws = (LAS float*)(lds + 2 * SHM_V + 2 * SHM_K) + wid * 64; LAS float* li_l = ws; LAS float* al_l = ws + 32;
  float m_reg = m0, l_reg = l0; f32x16 o[4] = {}; bf16x8 qr[NQF];
  mk.dq += wid * QBLK + r32 - 4 * hi;
  const int kvh = h >> 2;
  { const long qrow = (long)(qm0 + wid * QBLK + r32);
    if (KIND == 0) {
      const bf16* Qn = Qb + qrow * NQC + h * 128 + hi * 8; const bf16* Qr = Qb + qrow * NQC + 1024 + h * 64 + hi * 8;
#pragma unroll
      for (int d0 = 0; d0 < 8; ++d0) qr[d0] = *reinterpret_cast<const bf16x8*>(Qn + d0 * 16);
#pragma unroll
      for (int d0 = 8; d0 < NQF; ++d0) qr[d0] = *reinterpret_cast<const bf16x8*>(Qr + (d0 - 8) * 16);
    } else {
      const bf16* Qn = Zb + qrow * NZ + ZC_QW + h * 128 + hi * 8;
#pragma unroll
      for (int d0 = 0; d0 < 8; ++d0) qr[d0] = *reinterpret_cast<const bf16x8*>(Qn + d0 * 16);
    } }
  const int sr = tid >> 4, sc = (tid & 15) * 8, vst0 = v_st(sr, sc), vst1 = v_st(32 + sr, sc);
  const int rr_ = tid >> 3, rc_ = (tid & 7) * 8;
  const int vb0 = (int)(uintptr_t)V_lds + v_rd_base(lane);
  constexpr long kld = KIND == 0 ? NKVC : NZ;
  const char* Kbase = KIND == 0 ? (const char*)(KVb + (long)km0 * NKVC + h * 256) : (const char*)(Zb + (long)km0 * NZ + ZC_KW + kvh * 128);
  const char* Vbase = KIND == 0 ? Kbase + 256 : (const char*)(Zb + (long)km0 * NZ + ZC_VW + kvh * 128);
  const char* Rbase = (const char*)(Zb + (long)km0 * NZ + ZC_KR);
  const unsigned koff = (unsigned)((sr * kld + sc) * 2), roff = (unsigned)((rr_ * NZ + rc_) * 2);
  bf16x8 s_v0, s_v1, s_k0, s_k1, s_kr;
#define SLOAD(k0) do { const size_t o_ = (size_t)(k0) * kld * 2; const char* vb_ = Vbase + o_; const char* kb_ = Kbase + o_; \
    s_v0 = *reinterpret_cast<const bf16x8*>(vb_ + koff); s_v1 = *reinterpret_cast<const bf16x8*>(vb_ + 32 * kld * 2 + koff); \
    s_k0 = *reinterpret_cast<const bf16x8*>(kb_ + koff); s_k1 = *reinterpret_cast<const bf16x8*>(kb_ + 32 * kld * 2 + koff); \
    if (KIND == 0) s_kr = *reinterpret_cast<const bf16x8*>(Rbase + (size_t)(k0) * NZ * 2 + roff); } while (0)
#define SWRITE(b) do { *(LAS bf16x8*)(V_lds + (b) * SHM_V + vst0) = s_v0; *(LAS bf16x8*)(V_lds + (b) * SHM_V + vst1) = s_v1; const int kc = sc * 2; \
    *(LAS bf16x8*)(K_lds + (b) * SHM_K + kswz<KROWB>(sr, kc)) = s_k0; *(LAS bf16x8*)(K_lds + (b) * SHM_K + kswz<KROWB>(32 + sr, kc)) = s_k1; \
    if (KIND == 0) *(LAS bf16x8*)(K_lds + (b) * SHM_K + kswz<KROWB>(rr_, 256 + rc_ * 2)) = s_kr; } while (0)
#define SWAIT() asm volatile("s_waitcnt vmcnt(0)" ::: "memory")
#define RESC(a) do { if (__any((a) < 1.f)) { if (hi == 0) al_l[r32] = (a); asm volatile("s_waitcnt lgkmcnt(0)" ::: "memory"); \
    _Pragma("unroll") for (int d = 0; d < 4; ++d) _Pragma("unroll") for (int r = 0; r < 16; ++r) o[d][r] *= al_l[crow(r, hi)]; } } while (0)
  f32x16 pA0, pA1, pB0, pB1; float mnA, mnB, alA, alB; bf16x8 pa0, pa1, pa2, pa3;
  constexpr bool WIN = KIND == 1;
  SLOAD(0); SWAIT(); SWRITE(0); __syncthreads();
  qkt<NQF, KROWB>(pA0, pA1, K_lds, qr, r32, hi); partialSM<WIN>(pA0, pA1, m_reg, mnA, alA, mk, 0);
  SLOAD(KVBLK);
  SWAIT(); SWRITE(1); __syncthreads();
  for (int j = 1; j + 1 < NT; j += 2) {
    SBAR(); qkt<NQF, KROWB>(pB0, pB1, K_lds + SHM_K, qr, r32, hi);
    finishSM(pA0, pA1, alA, l_reg, pa0, pa1, pa2, pa3); SBAR();
    SLOAD((j + 1) * KVBLK); SBAR();
    pv_d0(o, vb0, pa0, pa1, pa2, pa3); partialSM<WIN>(pB0, pB1, m_reg, mnB, alB, mk, j);
    __syncthreads(); SWAIT(); SWRITE(0);
    RESC(alB); __syncthreads();
    SBAR(); qkt<NQF, KROWB>(pA0, pA1, K_lds, qr, r32, hi);
    finishSM(pB0, pB1, alB, l_reg, pa0, pa1, pa2, pa3); SBAR();
    SLOAD((j + 2) * KVBLK); SBAR();
    pv_d0(o, vb0 + SHM_V, pa0, pa1, pa2, pa3); partialSM<WIN>(pA0, pA1, m_reg, mnA, alA, mk, j + 1);
    __syncthreads(); SWAIT(); SWRITE(1);
    RESC(alA); __syncthreads();
  }
  SBAR(); qkt<NQF, KROWB>(pB0, pB1, K_lds + SHM_K, qr, r32, hi);
  finishSM(pA0, pA1, alA, l_reg, pa0, pa1, pa2, pa3); SBAR();
  pv_d0(o, vb0, pa0, pa1, pa2, pa3); partialSM<WIN>(pB0, pB1, m_reg, mnB, alB, mk, NT - 1);
  __syncthreads(); RESC(alB);
  finishSM(pB0, pB1, alB, l_reg, pa0, pa1, pa2, pa3); SBAR();
  pv_d0(o, vb0 + SHM_V, pa0, pa1, pa2, pa3);
  if (hi == 0) li_l[r32] = l_reg; asm volatile("s_waitcnt lgkmcnt(0)" ::: "memory");
  float rli[16];
#pragma unroll
  for (int r = 0; r < 16; ++r) rli[r] = __builtin_amdgcn_rcpf(li_l[crow(r, hi)]);
  __syncthreads();
  { LAS bf16* stg = (LAS bf16*)(lds + wid * 8192);
#pragma unroll
    for (int r = 0; r < 16; ++r) { const int orow = crow(r, hi);
#pragma unroll
      for (int d0 = 0; d0 < 4; ++d0) { const float v = o[d0][r] * rli[r]; stg[orow * 128 + d0 * 32 + r32] = (bf16)(cvt_pk_bf16(v, v) & 0xffffu); } }
    asm volatile("s_waitcnt lgkmcnt(0)" ::: "memory");
    bf16* Ow = Ob + (long)(qm0 + wid * QBLK) * NABC + ocol;
#pragma unroll
    for (int i = 0; i < 8; ++i) { const int row = i * 4 + (lane >> 4), ch = lane & 15; const v4u v = *(const LAS v4u*)(stg + row * 128 + ch * 8); *(v4u*)(Ow + (long)row * NABC + ch * 8) = v; } }
  __syncthreads();
#undef SLOAD
#undef SWRITE
#undef SWAIT
#undef RESC
}
#undef SBAR
}

#define XB_TMO      128
#define XB_XCNT(j)  (256  + 64 * (j))
#define XB_XSUB(j)  (1280 + 64 * (j))
#define XB_XGEN(j)  (2304 + 64 * (j))
#define XB_TOP      3328
#define XB_TOPGEN   3392
#define XCD_BAR_WORDS 3456
#define XB_SPIN_CAP (1u << 18)

__device__ __forceinline__ unsigned xb_ld(unsigned* p)              { return __hip_atomic_load(p, __ATOMIC_RELAXED, __HIP_MEMORY_SCOPE_AGENT); }
__device__ __forceinline__ unsigned xb_add(unsigned* p, unsigned v) { return __hip_atomic_fetch_add(p, v, __ATOMIC_RELAXED, __HIP_MEMORY_SCOPE_AGENT); }
__device__ __forceinline__ unsigned xb_xcc_id() { return (unsigned)__builtin_amdgcn_s_getreg((3 << 11) | 20) & 0xFu; }
#define XB_SPIN(cond, bar) do { unsigned _sp = 0; while (cond) { __builtin_amdgcn_s_sleep(1); \
    if ((++_sp & 255u) == 0u) { if (xb_ld(&(bar)[XB_TMO])) break; if (_sp > XB_SPIN_CAP) { atomicAdd(&(bar)[XB_TMO], 1u); break; } } } } while (0)

struct XcdBarrier { unsigned* bar; unsigned x; volatile LAS unsigned* st; };

__device__ __forceinline__ XcdBarrier xcd_barrier_post(unsigned* bar, volatile LAS unsigned* st) {
    XcdBarrier b; b.bar = bar; b.x = xb_xcc_id(); b.st = st;
    if (threadIdx.x == 0) (void)xb_add(&bar[XB_XCNT(b.x)], 1u);
    return b;
}
__device__ __forceinline__ void xcd_barrier_complete(unsigned* bar, unsigned x, unsigned& nloc, unsigned& nx) {
    const unsigned G = gridDim.x * gridDim.y * gridDim.z;
    unsigned sum, cnt, mine, sp = 0u;
    for (;;) {
        sum = 0u; cnt = 0u; mine = 0u;
#pragma unroll
        for (unsigned j = 0; j < 16; ++j) { const unsigned c = xb_ld(&bar[XB_XCNT(j)]); sum += c; cnt += (c > 0u) ? 1u : 0u; mine = (j == x) ? c : mine; }
        if (sum == G) break;
        __builtin_amdgcn_s_sleep(1);
        if ((++sp & 255u) == 0u) { if (xb_ld(&bar[XB_TMO])) break; if (sp > XB_SPIN_CAP) { atomicAdd(&bar[XB_TMO], 1u); break; } }
    }
    nloc = mine > 0u ? mine : 1u; nx = cnt > 0u ? cnt : 1u;
}
__device__ __forceinline__ void xcd_barrier(const XcdBarrier& b, const int tid  ) {
    asm volatile("s_waitcnt vmcnt(0)" ::: "memory");
    __syncthreads();
    if (tid == 0) {
        unsigned* bar = b.bar;
        __builtin_amdgcn_s_waitcnt(0);
        unsigned nloc = b.st[0], nx = b.st[1];
        if (nloc == 0u) { xcd_barrier_complete(bar, b.x, nloc, nx); b.st[0] = nloc; b.st[1] = nx; }
        const unsigned old = xb_add(&bar[XB_XSUB(b.x)], 1u);
        const unsigned gen = old / nloc;
        if (old + 1u == (gen + 1u) * nloc) {
            __builtin_amdgcn_fence(__ATOMIC_RELEASE, "agent");
            asm volatile("s_waitcnt vmcnt(0)" ::: "memory");
            const unsigned og = xb_add(&bar[XB_TOP], 1u);
            const unsigned tg = og / nx;
            if (og + 1u == (tg + 1u) * nx) xb_add(&bar[XB_TOPGEN], 1u);
            else XB_SPIN(xb_ld(&bar[XB_TOPGEN]) == tg, bar);
            __builtin_amdgcn_fence(__ATOMIC_ACQUIRE, "agent");
            xb_add(&bar[XB_XGEN(b.x)], 1u);
            asm volatile("s_waitcnt vmcnt(0)" ::: "memory");
        } else {
            XB_SPIN(xb_ld(&bar[XB_XGEN(b.x)]) == gen, bar);
            __builtin_amdgcn_fence(__ATOMIC_ACQUIRE, "agent");
            asm volatile("s_waitcnt vmcnt(0)" ::: "memory");
        }
    }
    __syncthreads();
}

struct Args { const float* in[22]; float* out; unsigned char* ws; int ph_lo, ph_hi; };
typedef const __attribute__((address_space(4))) Args* KArgs;
#define KARGS() ({ KArgs p_ = (KArgs)__builtin_amdgcn_kernarg_segment_ptr(); asm volatile("" : "+s"(p_)); p_; })
struct Frame { LAS unsigned char* lds; int tid, lane, wave, vcu, G; };

__device__ __forceinline__ float wave_sum(float v, int lane) {
#pragma unroll
    for (int o = 1; o < 64; o <<= 1) v += shfl_xor_l(v, o, lane);
    return v;
}
__device__ const double ROPE_REV[32] = {
    1.59154943091895346e-01, 1.19349370211248862e-01, 8.94994016088910133e-02, 6.71150830052272551e-02, 5.03292121044870353e-02, 3.77415847174197711e-02, 2.83021958306233987e-02, 2.12236527647776604e-02,
    1.59154943091895339e-02, 1.19349370211248862e-02, 8.94994016088910237e-03, 6.71150830052272534e-03, 5.03292121044870370e-03, 3.77415847174197719e-03, 2.83021958306233987e-03, 2.12236527647776622e-03,
    1.59154943091895356e-03, 1.19349370211248849e-03, 8.94994016088910237e-04, 6.71150830052272599e-04, 5.03292121044870326e-04, 3.77415847174197741e-04, 2.83021958306233954e-04, 2.12236527647776605e-04,
    1.59154943091895351e-04, 1.19349370211248862e-04, 8.94994016088910182e-05, 6.71150830052272545e-05, 5.03292121044870354e-05, 3.77415847174197768e-05, 2.83021958306233961e-05, 2.12236527647776592e-05};

enum { MAP_ID = 0, MAP_WIN = 1, MAP_WUQ = 2 };
__device__ __forceinline__ int map_col(int mode, int n) {
    if (mode == MAP_ID) return n;
    if (mode == MAP_WIN) {
        if (n < 1024) return n;
        if (n < ZC_KR) return n + 64;
        if (n < ZC_KR + 64) { const int p = n - ZC_KR, i = p >> 1; return 1024 + ((p & 1) ? i + 32 : i); }
        if (n < ZC_G) return -1;
        return n - ZC_G + 3648;
    }
    if (n < 1024) return (n >> 7) * 192 + (n & 127);
    { const int r = n - 1024, h = r >> 6, p = r & 63, i = p >> 1; return h * 192 + 128 + ((p & 1) ? i + 32 : i); }
}
__device__ __forceinline__ void conv_item(const float* W, int K, int Nsrc, int nblk, const float* g, int mode, bf16* dst, int dst_ld, LAS float* scr, int item, int lane, bool tiled = false, int koff = 0) {
    const int kb = item / nblk, nb = item % nblk, k0 = 64 * kb, n0 = 32 * nb;
    const int s0 = map_col(mode, n0), s31 = map_col(mode, n0 + 31);
    if (s0 >= 0 && s31 == s0 + 31) {
        const int ks = lane >> 3, n4 = (lane & 7) * 4;
        f32x4 v[8]; float gk[8];
#pragma unroll
        for (int i = 0; i < 8; ++i) v[i] = *(const GAS f32x4*)(W + (size_t)(k0 + 8 * i + ks) * Nsrc + s0 + n4);
#pragma unroll
        for (int i = 0; i < 8; ++i) gk[i] = g ? g[k0 + 8 * i + ks] : 1.f;
#pragma unroll
        for (int i = 0; i < 8; ++i) { LAS float* p = scr + (8 * i + ks) * 33 + n4; const f32x4 x = v[i] * gk[i]; p[0] = x[0]; p[1] = x[1]; p[2] = x[2]; p[3] = x[3]; }
    } else {
        const int src = map_col(mode, n0 + (lane & 31));
#pragma unroll 8
        for (int i = 0; i < 32; ++i) { const int kk = 2 * i + (lane >> 5); float v = 0.f;
            if (src >= 0) { v = W[(size_t)(k0 + kk) * Nsrc + src]; if (g) v *= g[k0 + kk]; }
            scr[kk * 33 + (lane & 31)] = v; }
    }
    LDS_WAIT(); asm volatile("" ::: "memory");
    const int c = lane & 7;
#pragma unroll
    for (int j = 0; j < 4; ++j) { const int n = (lane >> 3) + 8 * j; const LAS float* s = scr + (8 * c) * 33 + n;
        v4u o; o.x = cvt_pk_bf16(s[0 * 33], s[1 * 33]); o.y = cvt_pk_bf16(s[2 * 33], s[3 * 33]); o.z = cvt_pk_bf16(s[4 * 33], s[5 * 33]); o.w = cvt_pk_bf16(s[6 * 33], s[7 * 33]);
        if (!tiled) *(GAS v4u*)(dst + (size_t)(n0 + n) * dst_ld + k0 + 8 * c) = o;
        else {
            const int nn = n0 + n, pn = nn >> 8, nt_ = nn & 255, h = nt_ >> 7, rr = nt_ & 127, w = rr & 31, slot = (rr & ~31) + 16 * ((w >> 2) & 1) + 4 * (w >> 3) + (w & 3);
            const int kk = koff + k0, kt = kk >> 6;
            *(GAS v4u*)((unsigned char*)dst + ((size_t)(pn * (dst_ld >> 6) + kt) * 2 + h) * 16384 + pg8::lds_byte(slot, 8 * c)) = o; } }
    LDS_WAIT(); asm volatile("" ::: "memory");
}
__device__ __forceinline__ void convert_layer(const Frame& F, KArgs ap, int l, unsigned char* ws) {
    LAS float* scr = (LAS float*)(F.lds + RING_OFF + F.wave * 16384);
    const int gw = F.vcu * NWAVES + F.wave, NGW = F.G * NWAVES;
    unsigned char* W = ws + WS_W;
    constexpr int I_IN = 32 * (NZW / 32), I_UQ = 8 * (NQC / 32), I_UKV = 8 * (NKVC / 32), I_MEM = 32 * 64, I_BR = 16 * 64, I_OUT = 32 * 64, I_UP = 32 * 256, I_DOWN = 128 * 64;
    constexpr int NITEMS = I_IN + I_UQ + I_UKV + I_MEM + 3 * I_BR + I_OUT + I_UP + I_DOWN;
    for (int it = gw; it < NITEMS; it += NGW) {
        int r = it;
        if (r < I_IN) { conv_item(ap->in[6] + (size_t)l * DM * NZSRC, DM, NZSRC, NZW / 32, ap->in[4] + l * DM, MAP_WIN, (bf16*)(W + WO_IN), DM, scr, r, F.lane, true); continue; } r -= I_IN;
        if (r < I_UQ) { conv_item(ap->in[9] + (size_t)l * 512 * NQC, 512, NQC, NQC / 32, ap->in[7] + l * 512, MAP_WUQ, (bf16*)(W + WO_UQ), 512, scr, r, F.lane, true); continue; } r -= I_UQ;
        if (r < I_UKV) { conv_item(ap->in[10] + (size_t)l * 512 * NKVC, 512, NKVC, NKVC / 32, ap->in[8] + l * 512, MAP_ID, (bf16*)(W + WO_UKV), 512, scr, r, F.lane, true); continue; } r -= I_UKV;
        if (r < I_MEM) { conv_item(ap->in[12] + (size_t)l * DM * 2048, DM, 2048, 64, ap->in[11] + l * DM, MAP_ID, (bf16*)(W + WO_MEM), DM, scr, r, F.lane); continue; } r -= I_MEM;
        if (r < 3 * I_BR) { const int br = r / I_BR; conv_item(ap->in[14 + br] + (size_t)l * 1024 * DM, 1024, DM, 64, nullptr, MAP_ID, (bf16*)(W + WO_BR), NABC, scr, r - br * I_BR, F.lane, true, br * 1024); continue; } r -= 3 * I_BR;
        if (r < I_OUT) { conv_item(ap->in[17] + (size_t)l * DM * DM, DM, DM, 64, nullptr, MAP_ID, (bf16*)(W + WO_OUT), DM, scr, r, F.lane, true); continue; } r -= I_OUT;
        if (r < I_UP) { conv_item(ap->in[20] + (size_t)l * DM * DFF, DM, DFF, 256, ap->in[18] + l * DM, MAP_ID, (bf16*)(W + WO_UP), DM, scr, r, F.lane, true); continue; } r -= I_UP;
        conv_item(ap->in[21] + (size_t)l * DFF * DM, DFF, DM, 64, nullptr, MAP_ID, (bf16*)(W + WO_DOWN), DFF, scr, r, F.lane, true);
    }
}
__device__ __forceinline__ void rms_row_to_bf16(const float* xrow, bf16* orow, float* rs_out, int lane) {
    f32x4 v[8]; float s = 0.f;
#pragma unroll
    for (int j = 0; j < 4; ++j) { v[2 * j] = *(const GAS f32x4*)(xrow + j * 512 + lane * 8); v[2 * j + 1] = *(const GAS f32x4*)(xrow + j * 512 + lane * 8 + 4); }
#pragma unroll
    for (int j = 0; j < 8; ++j) s += (v[j][0] * v[j][0] + v[j][1] * v[j][1]) + (v[j][2] * v[j][2] + v[j][3] * v[j][3]);
    const float ms = wave_sum(s, lane) * (1.f / DM) + EPS, r = __builtin_amdgcn_rsqf(ms);
    if (lane == 0) *rs_out = ms * r;
#pragma unroll
    for (int j = 0; j < 4; ++j) *(GAS v4u*)(orow + j * 512 + lane * 8) = epi::pack8(v[2 * j] * r, v[2 * j + 1] * r);
}
__device__ __forceinline__ void prologue(const Frame& F, KArgs ap, unsigned char* ws) {
    const int gw = F.vcu * NWAVES + F.wave, NGW = F.G * NWAVES;
    float* tab = (float*)(ws + WS_TAB);
    for (int e = blockIdx.x * 512 + F.tid; e < 8192 * 32; e += F.G * 512) {
        const int pos = e >> 5, i = e & 31;
        double rev = (double)pos * ROPE_REV[i]; rev -= floor(rev);
        const double q = rint(rev * 4.0); const double r = (rev - q * 0.25) * 6.283185307179586476925;
        const double r2 = r * r;
        const double sn = r * (1.0 + r2 * (-1.0 / 6 + r2 * (1.0 / 120 + r2 * (-1.0 / 5040 + r2 * (1.0 / 362880 - r2 * (1.0 / 39916800))))));
        const double cn = 1.0 + r2 * (-0.5 + r2 * (1.0 / 24 + r2 * (-1.0 / 720 + r2 * (1.0 / 40320 + r2 * (-1.0 / 3628800 + r2 * (1.0 / 479001600))))));
        const int qi = ((int)q) & 3;
        const double s_ = qi == 0 ? sn : qi == 1 ? cn : qi == 2 ? -sn : -cn;
        const double c_ = qi == 0 ? cn : qi == 1 ? -sn : qi == 2 ? -cn : sn;
        *(GAS f32x2*)(tab + (size_t)e * 2) = (f32x2){(float)c_, (float)s_};
    }
    float* rmem = (float*)(ws + WS_RMEM); bf16* memb = (bf16*)(ws + WS_MEMB);
    for (int m = gw; m < NMEMR; m += NGW) {
        const float* xrow = (m < 1024) ? ap->in[2] + (size_t)m * DM : ap->in[3] + (size_t)(m - 1024) * DM;
        f32x4 v[8]; float s = 0.f;
#pragma unroll
        for (int j = 0; j < 4; ++j) { v[2 * j] = *(const GAS f32x4*)(xrow + j * 512 + F.lane * 8); v[2 * j + 1] = *(const GAS f32x4*)(xrow + j * 512 + F.lane * 8 + 4); }
#pragma unroll
        for (int j = 0; j < 8; ++j) s += (v[j][0] * v[j][0] + v[j][1] * v[j][1]) + (v[j][2] * v[j][2] + v[j][3] * v[j][3]);
        const float r = __builtin_amdgcn_rsqf(wave_sum(s, F.lane) * (1.f / DM) + EPS);
        if (F.lane == 0) rmem[m] = r;
#pragma unroll
        for (int j = 0; j < 4; ++j) *(GAS v4u*)(memb + (size_t)m * DM + j * 512 + F.lane * 8) = epi::pack8(v[2 * j], v[2 * j + 1]);
    }
    bf16* xn = (bf16*)(ws + WS_XN);
    for (int m = gw; m < NTOK; m += NGW) {
        const float* xrow = (m < NPROMPT) ? ap->in[0] + (size_t)m * DM : ap->in[1] + (size_t)(m - NPROMPT) * DM;
        rms_row_to_bf16(xrow, xn + (size_t)m * DM, (float*)(ws + WS_RS) + m, F.lane);
    }
    convert_layer(F, ap, 0, ws);
}
__device__ __forceinline__ void norm_pass(const Frame& F, KArgs ap, bool first, bool last, const float* gpost, unsigned char* ws, bool dummy = false) {
    const int gw = F.vcu * NWAVES + F.wave, NGW = F.G * NWAVES;
    const bf16* Y = (const bf16*)(ws + WS_Y); bf16* xb = (bf16*)(ws + WS_XN); float* rsv = (float*)(ws + WS_RS);
    bf16* xbo = dummy ? (bf16*)(ws + WS_Z + 192 * MiB) : xb; float* rso = dummy ? (float*)(ws + WS_Z + 300 * MiB) : rsv; float* xout = dummy ? (float*)(ws + WS_Z) : ap->out;
    f32x4 g[8];
#pragma unroll
    for (int j = 0; j < 4; ++j) { g[2 * j] = *(const GAS f32x4*)(gpost + j * 512 + F.lane * 8); g[2 * j + 1] = *(const GAS f32x4*)(gpost + j * 512 + F.lane * 8 + 4); }
    for (int m = gw; m < NTOK; m += NGW) {
        f32x4 x[8], y[8]; float s = 0.f;
#pragma unroll
        for (int j = 0; j < 4; ++j) { const v4u w = *(const GAS v4u*)(Y + (size_t)m * DM + j * 512 + F.lane * 8);
            y[2 * j] = (f32x4){bf_lo(w.x), bf_hi(w.x), bf_lo(w.y), bf_hi(w.y)}; y[2 * j + 1] = (f32x4){bf_lo(w.z), bf_hi(w.z), bf_lo(w.w), bf_hi(w.w)}; }
        if (first) { const float* xrow = (m < NPROMPT) ? ap->in[0] + (size_t)m * DM : ap->in[1] + (size_t)(m - NPROMPT) * DM;
#pragma unroll
            for (int j = 0; j < 4; ++j) { x[2 * j] = *(const GAS f32x4*)(xrow + j * 512 + F.lane * 8); x[2 * j + 1] = *(const GAS f32x4*)(xrow + j * 512 + F.lane * 8 + 4); }
        } else {
            const float rms = rsv[m];
#pragma unroll
            for (int j = 0; j < 4; ++j) { const v4u w = *(const GAS v4u*)(xb + (size_t)m * DM + j * 512 + F.lane * 8);
                x[2 * j] = (f32x4){bf_lo(w.x), bf_hi(w.x), bf_lo(w.y), bf_hi(w.y)} * rms; x[2 * j + 1] = (f32x4){bf_lo(w.z), bf_hi(w.z), bf_lo(w.w), bf_hi(w.w)} * rms; }
        }
#pragma unroll
        for (int j = 0; j < 8; ++j) s += (y[j][0] * y[j][0] + y[j][1] * y[j][1]) + (y[j][2] * y[j][2] + y[j][3] * y[j][3]);
        const float r = __builtin_amdgcn_rsqf(wave_sum(s, F.lane) * (1.f / DM) + EPS);
        float s2 = 0.f;
#pragma unroll
        for (int j = 0; j < 8; ++j) { x[j] = x[j] + (y[j] * r) * g[j]; s2 += (x[j][0] * x[j][0] + x[j][1] * x[j][1]) + (x[j][2] * x[j][2] + x[j][3] * x[j][3]); }
        if (last) { float* orow = xout + (size_t)m * DM;
#pragma unroll
            for (int j = 0; j < 4; ++j) { *(GAS f32x4*)(orow + j * 512 + F.lane * 8) = x[2 * j]; *(GAS f32x4*)(orow + j * 512 + F.lane * 8 + 4) = x[2 * j + 1]; }
        } else {
            const float ms2 = wave_sum(s2, F.lane) * (1.f / DM) + EPS, r2 = __builtin_amdgcn_rsqf(ms2);
            if (F.lane == 0) rso[m] = ms2 * r2;
#pragma unroll
            for (int j = 0; j < 4; ++j) *(GAS v4u*)(xbo + (size_t)m * DM + j * 512 + F.lane * 8) = epi::pack8(x[2 * j] * r2, x[2 * j + 1] * r2);
        }
    }
}

constexpr int PH_PER_LAYER = 9, N_PHASES = 1 + DEPTH * PH_PER_LAYER;
#ifndef PH_MASK
#define PH_MASK 0x3ff
#endif
#define PH_EN(k) ((PH_MASK >> (k)) & 1)
#ifndef SUB_MASK
#define SUB_MASK 7
#endif
#define SUB_EN(k) ((SUB_MASK >> (k)) & 1)
#ifndef DUP_MASK
#define DUP_MASK 0
#endif
#define DUP_EN(k) ((DUP_MASK >> (k)) & 1)
__global__ void __launch_bounds__(NWAVES * 64, 2) fwd(Args args_unused) {
    extern __shared__ __attribute__((aligned(16))) unsigned char lds_raw[];
    (void)args_unused;
    LAS unsigned char* lds0 = (LAS unsigned char*)lds_raw;
    const int wave0 = __builtin_amdgcn_readfirstlane((int)threadIdx.x >> 6);
    volatile LAS unsigned* MISC = (volatile LAS unsigned*)(lds0 + MISC_OFF);
    for (int u = threadIdx.x; u < (XCH_OFF - LDSCTL_OFF) / 4; u += NWAVES * 64) ((LAS unsigned*)(lds0 + LDSCTL_OFF))[u] = 0u;
    __syncthreads();
#ifdef PROBE_CLOCK
    if (blockIdx.x == 0 && threadIdx.x == 0) { KArgs ap = KARGS(); unsigned long long* p = (unsigned long long*)(ap->ws + 512 * 1024); p[0] = __builtin_amdgcn_s_memtime(); p[1] = __builtin_amdgcn_s_memrealtime(); }
#endif
    int lo, hi; unsigned* barw;
    { KArgs ap = KARGS(); lo = ap->ph_lo; hi = ap->ph_hi; barw = (unsigned*)(ap->ws + WS_CTL) + CW_BAR; }
    if (MK_N_LAUNCHES == 1 || (hi - lo) > 1) (void)xcd_barrier_post(barw, MISC + 8);
    if (threadIdx.x == 0) { unsigned r = 0u; const unsigned x = xb_xcc_id();
        if (MK_N_LAUNCHES == 1) { KArgs ap_ = KARGS(); r = xb_add((unsigned*)(ap_->ws + WS_CTL) + CW_RANK + 64 * x, 1u); }
        MISC[20] = x; MISC[21] = r; MISC[22] = blockIdx.x; }
    __syncthreads();
#if MK_N_LAUNCHES == 1
#define IN(k) true
#else
#define IN(k) (lo <= (k) && (k) < hi)
#endif
#if defined(PROBE_WAIT) && PROBE_WAIT
#define PROBE_WAIT_BEGIN() do { if (wave0 * 64 + t_ == 0) { const unsigned long long r_ = __builtin_amdgcn_s_memrealtime(); MISC[16] = (unsigned)r_; } } while (0)
#define PROBE_WAIT_END() do { int t2_; asm volatile("v_mbcnt_lo_u32_b32 %0, -1, 0\n\tv_mbcnt_hi_u32_b32 %0, -1, %0" : "=v"(t2_)); if (wave0 * 64 + t2_ == 0) { const unsigned long long r_ = __builtin_amdgcn_s_memrealtime(); MISC[17] = MISC[17] + ((unsigned)r_ - MISC[16]); } } while (0)
#else
#define PROBE_WAIT_BEGIN() do {} while (0)
#define PROBE_WAIT_END() do {} while (0)
#endif
#define LOCAL_BAR() XcdBarrier bar; { KArgs ap_ = KARGS(); bar.bar = (unsigned*)(ap_->ws + WS_CTL) + CW_BAR; bar.x = xb_xcc_id(); bar.st = (volatile LAS unsigned*)((LAS unsigned char*)lds_raw + MISC_OFF) + 8; }
#define BARRIER_NOW() do { int t_; asm volatile("v_mbcnt_lo_u32_b32 %0, -1, 0\n\tv_mbcnt_hi_u32_b32 %0, -1, %0" : "=v"(t_)); LOCAL_BAR(); xcd_barrier(bar, wave0 * 64 + t_); } while (0)
#define SEAM(k) do { if (IN(k) && IN((k) + 1)) { int t_; asm volatile("v_mbcnt_lo_u32_b32 %0, -1, 0\n\tv_mbcnt_hi_u32_b32 %0, -1, %0" : "=v"(t_)); PROBE_WAIT_BEGIN(); LOCAL_BAR(); xcd_barrier(bar, wave0 * 64 + t_); PROBE_WAIT_END(); if (PROBE_XBAR) { xcd_barrier(bar, wave0 * 64 + t_); xcd_barrier(bar, wave0 * 64 + t_); } } } while (0)
#define PHASE_BASE() KArgs ap = KARGS(); unsigned char* ws = ap->ws; (void)ws; int bx_ = (int)((volatile LAS unsigned*)((LAS unsigned char*)lds_raw + MISC_OFF))[22], G_ = (int)gridDim.x, t_; asm volatile("v_mbcnt_lo_u32_b32 %0, -1, 0\n\tv_mbcnt_hi_u32_b32 %0, -1, %0" : "=v"(t_)); t_ += wave0 * 64; bx_ = __builtin_amdgcn_readfirstlane(bx_); asm volatile("" : "+s"(bx_), "+s"(G_)); const int bx = bx_, G = G_; (void)bx; (void)G; Frame F; F.lds = (LAS unsigned char*)lds_raw; F.tid = t_; F.lane = t_ & 63; F.wave = __builtin_amdgcn_readfirstlane(t_ >> 6); F.G = G; F.vcu = (G % 8 == 0) ? (bx % 8) * (G / 8) + bx / 8 : bx; LAS unsigned char* ring = F.lds + RING_OFF; LAS unsigned char* xl = F.lds + XCH_OFF; (void)ring; (void)xl
#define WSP(T, off) ((T*)(ws + (off)))

    if (PH_EN(0) && IN(0)) { PHASE_BASE(); prologue(F, ap, ws); }
    SEAM(0);
    if (MK_N_LAUNCHES == 1) {
        if (threadIdx.x == 0) { KArgs ap_ = KARGS(); unsigned* bw = (unsigned*)(ap_->ws + WS_CTL) + CW_BAR; const unsigned G = gridDim.x; bool even = (G % 8u) == 0u; unsigned npop = 0u;
            for (unsigned j = 0; j < 16; ++j) { const unsigned c = xb_ld(&bw[XB_XCNT(j)]); if (c) { ++npop; even = even && (c == G / 8u) && (j < 8u); } }
            if (even && npop == 8u && MISC[21] < G / 8u) MISC[22] = MISC[20] + 8u * MISC[21]; }
        __syncthreads();
    }

    for (int l = 0; l < DEPTH; ++l) {
        const int p0 = 1 + l * PH_PER_LAYER;
        for (int rep_ = 0; rep_ <= DUP_EN(1); ++rep_) { if (rep_) BARRIER_NOW();
        if (PH_EN(1) && IN(p0 + 0)) { PHASE_BASE();
            if (SUB_EN(0)) { pg8::Gemm g = pg8::plain_gemm(WSP(bf16, WS_XN), DM, ws + WS_W + WO_IN, DM, DM, true); pg8::StaticOrder S; S.init(NTOK / 256, NZW / 256, G, bx);
              epi::EpiZ E{WSP(bf16, WS_Z), WSP(float, WS_SSQ), WSP(const float, WS_TAB), ws + WS_GT}; pg8::gemm_phase<epi::EpiZ, pg8::StaticOrder>(F.tid, ring, xl, g, S, E); }
            if (SUB_EN(1)) { pg8::Gemm g = pg8::plain_gemm(WSP(bf16, WS_MEMB), DM, ws + WS_W + WO_MEM, DM, DM); pg8::StaticOrder S; S.init(NMEMR / 256, 4, G, (bx + G - 160 % G) % G);
              epi::EpiStore<1> E{WSP(bf16, WS_MEMK), 1024, 0, WSP(const float, WS_RMEM)}; pg8::gemm_phase<epi::EpiStore<1>, pg8::StaticOrder>(F.tid, ring, xl, g, S, E); }
            if (SUB_EN(2)) { pg8::Gemm g = pg8::plain_gemm(ws + WS_W + WO_MEM + (size_t)1024 * DM * 2, DM, WSP(bf16, WS_MEMB), DM, DM); pg8::StaticOrder S; S.init(4, NMEMR / 256, G, (bx + G - 180 % G) % G);
              epi::EpiStore<2> E{WSP(bf16, WS_MEMVT), NMEMR, 0, WSP(const float, WS_RMEM)}; pg8::gemm_phase<epi::EpiStore<2>, pg8::StaticOrder>(F.tid, ring, xl, g, S, E); }
        }
        }
        SEAM(p0 + 0);
        for (int rep_ = 0; rep_ <= DUP_EN(2); ++rep_) { if (rep_) BARRIER_NOW();
        if (PH_EN(2) && IN(p0 + 1)) { PHASE_BASE();
            if (SUB_EN(0)) { pg8::Gemm g = pg8::plain_gemm(WSP(bf16, WS_Z) + ZC_CQ, NZ, ws + WS_W + WO_UQ, 512, 512, true); pg8::StaticOrder S; S.init(NTOK / 256, NQC / 256, G, bx);
              epi::EpiLat<0> E{WSP(bf16, WS_Q), WSP(const float, WS_SSQ), WSP(const float, WS_TAB)}; pg8::gemm_phase<epi::EpiLat<0>, pg8::StaticOrder>(F.tid, ring, xl, g, S, E); }
            if (SUB_EN(1)) { pg8::Gemm g = pg8::plain_gemm(WSP(bf16, WS_Z) + ZC_CKV, NZ, ws + WS_W + WO_UKV, 512, 512, true); pg8::StaticOrder S; S.init(NTOK / 256, NKVC / 256, G, bx);
              epi::EpiLat<1> E{WSP(bf16, WS_KV), WSP(const float, WS_SSQ), WSP(const float, WS_TAB)}; pg8::gemm_phase<epi::EpiLat<1>, pg8::StaticOrder>(F.tid, ring, xl, g, S, E); }
            if (SUB_EN(2)) { pg8::Gemm g; g.A = (const char*)(WSP(bf16, WS_Z) + ZC_QM); g.B = (const char*)WSP(bf16, WS_MEMK); g.a_pm = (long)256 * NZ * 2; g.a_pn = 512; g.b_pn = 512; g.b_sq = (long)256 * 1024 * 2; g.lda = NZ; g.ldb = 1024; g.K = 256; g.b_tiled = false;
              pg8::StaticOrder S; S.init(NTOK / 256, 4, G, (bx + G - 64 % G) % G);
              epi::EpiSoftmax E{WSP(bf16, WS_PM)}; pg8::gemm_phase<epi::EpiSoftmax, pg8::StaticOrder>(F.tid, ring, xl, g, S, E); }
        }
        }
        SEAM(p0 + 1);
        for (int rep_ = 0; rep_ <= DUP_EN(3); ++rep_) { if (rep_) BARRIER_NOW();
        if (PH_EN(3) && IN(p0 + 2)) {
            if (SUB_EN(0)) { PHASE_BASE(); for (int n = F.vcu; n < 768; n += G) {
                const int i = n >> 8, v = n & 255, x = v >> 5, j = v & 31;
                int h, qm0, km0, NT;
                if (i < 2) { const int pair = 4 * x + 2 * i + (j >> 4), b = pair >> 3; h = pair & 7; qm0 = b * 4096 + (j & 15) * 256; km0 = b * 4096; NT = 64; }
                else { h = x; qm0 = NPROMPT + j * 256; km0 = NPROMPT; NT = 128; }
                att::Mask mk{0, 0.f};
                att::attn_unit<0>(WSP(bf16, WS_Q), WSP(bf16, WS_KV), WSP(bf16, WS_Z), WSP(bf16, WS_ABC), qm0, km0, NT, h, h * 128, -1.0e30f, 0.f, mk, (LAS char*)ring, wave0 * 64);
            } }
            if (SUB_EN(1)) { PHASE_BASE(); const float* sink = ap->in[13] + l * 8;
              for (int n = F.vcu; n < 768; n += G) {
                const int qblk = n >> 3, h = n & 7;
                const int sstart = qblk < 64 ? (qblk >> 4) * 4096 : NPROMPT, SL = qblk < 64 ? 4096 : 8192;
                const int qm0 = qblk * 256, q0 = qm0 - sstart;
                const int klo = (q0 - 128) < 0 ? 0 : (q0 - 128), khi = (q0 + 384) > SL ? SL : (q0 + 384);
                att::Mask mk; mk.dq = q0 - klo; mk.sl = LOG2E * __builtin_amdgcn_exp2f(-(float)(h + 1));
                att::attn_unit<1>(WSP(bf16, WS_Q), WSP(bf16, WS_KV), WSP(bf16, WS_Z), WSP(bf16, WS_ABC), qm0, sstart + klo, (khi - klo) >> 6, h, 1024 + h * 128, sink[h] * LOG2E, 1.f, mk, (LAS char*)ring, wave0 * 64);
              } }
            if (SUB_EN(2)) { PHASE_BASE(); pg8::Gemm g; g.A = (const char*)WSP(bf16, WS_PM); g.B = (const char*)WSP(bf16, WS_MEMVT); g.a_pm = (long)256 * 1024 * 2; g.a_pn = 512; g.b_pn = (long)256 * NMEMR * 2; g.b_sq = 512; g.lda = 1024; g.ldb = NMEMR; g.K = 256; g.b_tiled = false;
              pg8::StaticOrder S; S.init(NTOK / 256, 4, G, bx);
              epi::EpiStore<0> E{WSP(bf16, WS_ABC), NABC, 2048, nullptr}; pg8::gemm_phase<epi::EpiStore<0>, pg8::StaticOrder>(F.tid, ring, xl, g, S, E); }
        }
        }
        SEAM(p0 + 2);
        for (int rep_ = 0; rep_ <= DUP_EN(4); ++rep_) { if (rep_) BARRIER_NOW();
        if (PH_EN(4) && IN(p0 + 3)) { PHASE_BASE();
            pg8::Gemm g = pg8::plain_gemm(WSP(bf16, WS_ABC), NABC, ws + WS_W + WO_BR, NABC, NABC, true); pg8::StaticOrder S; S.init(NTOK / 256, DM / 256, G, bx);
            epi::EpiBranch E{WSP(bf16, WS_MERGED), ws + WS_GT}; pg8::gemm_phase<epi::EpiBranch, pg8::StaticOrder>(F.tid, ring, xl, g, S, E);
        }
        }
        SEAM(p0 + 3);
        for (int rep_ = 0; rep_ <= DUP_EN(5); ++rep_) { if (rep_) BARRIER_NOW();
        if (PH_EN(5) && IN(p0 + 4)) { PHASE_BASE();
            pg8::Gemm g = pg8::plain_gemm(WSP(bf16, WS_MERGED), DM, ws + WS_W + WO_OUT, DM, DM, true); pg8::StaticOrder S; S.init(NTOK / 256, DM / 256, G, bx);
            epi::EpiStore<0> E{WSP(bf16, WS_Y), DM, 0, nullptr}; pg8::gemm_phase<epi::EpiStore<0>, pg8::StaticOrder>(F.tid, ring, xl, g, S, E);
        }
        }
        SEAM(p0 + 4);
        if (PH_EN(6) && IN(p0 + 5)) { PHASE_BASE(); if (DUP_EN(6)) norm_pass(F, ap, l == 0, false, ap->in[5] + l * DM, ws, true); norm_pass(F, ap, l == 0, false, ap->in[5] + l * DM, ws); }
        SEAM(p0 + 5);
        for (int rep_ = 0; rep_ <= DUP_EN(7); ++rep_) { if (rep_) BARRIER_NOW();
        if (PH_EN(7) && IN(p0 + 6)) { PHASE_BASE();
            pg8::Gemm g = pg8::plain_gemm(WSP(bf16, WS_XN), DM, ws + WS_W + WO_UP, DM, DM, true); pg8::StaticOrder S; S.init(NTOK / 256, DFF / 256, G, bx);
            epi::EpiStore<3> E{WSP(bf16, WS_U), DFF, 0, nullptr}; pg8::gemm_phase<epi::EpiStore<3>, pg8::StaticOrder>(F.tid, ring, xl, g, S, E);
        }
        }
        SEAM(p0 + 6);
        for (int rep_ = 0; rep_ <= DUP_EN(8); ++rep_) { if (rep_) BARRIER_NOW();
        if (PH_EN(8) && IN(p0 + 7)) { PHASE_BASE();
            pg8::Gemm g = pg8::plain_gemm(WSP(bf16, WS_U), DFF, ws + WS_W + WO_DOWN, DFF, DFF, true); pg8::StaticOrder S; S.init(NTOK / 256, DM / 256, G, bx);
            epi::EpiStore<0> E{WSP(bf16, WS_Y), DM, 0, nullptr}; pg8::gemm_phase<epi::EpiStore<0>, pg8::StaticOrder>(F.tid, ring, xl, g, S, E);
        }
        }
        SEAM(p0 + 7);
        if (PH_EN(9) && IN(p0 + 8)) { PHASE_BASE(); norm_pass(F, ap, false, l + 1 == DEPTH, ap->in[19] + l * DM, ws); if (l + 1 < DEPTH) { convert_layer(F, ap, l + 1, ws); if (DUP_EN(9)) convert_layer(F, ap, l + 1, ws); } }
        SEAM(p0 + 8);
    }
#if defined(PROBE_WAIT) && PROBE_WAIT
    { KArgs ap = KARGS(); unsigned* pw = (unsigned*)(ap->ws + 512 * 1024 + 256);
      if (threadIdx.x == 0) { const unsigned w = MISC[17]; atomicMax(pw + 0, w); atomicMin(pw + 64, 0xffffffffu - w); atomicAdd(pw + 128, w / 256u); }
      BARRIER_NOW();
      if (blockIdx.x == 0 && threadIdx.x == 0) { const unsigned v = PROBE_WAIT == 1 ? __hip_atomic_load(pw + 0, RLX_AGENT) : PROBE_WAIT == 2 ? 0xffffffffu - __hip_atomic_load(pw + 64, RLX_AGENT) : __hip_atomic_load(pw + 128, RLX_AGENT);
        const unsigned long long r1 = __builtin_amdgcn_s_memrealtime(); while (__builtin_amdgcn_s_memrealtime() - r1 < (unsigned long long)v) __builtin_amdgcn_s_sleep(32); } }
#endif
#ifdef PROBE_CLOCK
    { BARRIER_NOW(); if (blockIdx.x == 0 && threadIdx.x == 0) { const unsigned long long ck1 = __builtin_amdgcn_s_memtime(), rt1 = __builtin_amdgcn_s_memrealtime(); KArgs ap = KARGS(); const unsigned long long* p = (const unsigned long long*)(ap->ws + 512 * 1024);
        const unsigned long long mhz = (ck1 - p[0]) * 100ull / (rt1 - p[1]);
        while (__builtin_amdgcn_s_memrealtime() - rt1 < mhz * 100ull) __builtin_amdgcn_s_sleep(32); } }
#endif
#undef IN
#undef SEAM
}


#ifndef DBG_LAST
#define DBG_LAST -1
#endif
#ifndef DBG_DUMP_MASK
#define DBG_DUMP_MASK 0xff
#endif
#if DBG_LAST >= 0
__global__ void __launch_bounds__(256) dbg_dump(float* out, const unsigned char* ws) {
    const bf16* Z = (const bf16*)(ws + WS_Z); const bf16* Q = (const bf16*)(ws + WS_Q); const bf16* KV = (const bf16*)(ws + WS_KV); const bf16* PM = (const bf16*)(ws + WS_PM);
    const bf16* ABC = (const bf16*)(ws + WS_ABC); const bf16* MG = (const bf16*)(ws + WS_MERGED); const bf16* XN = (const bf16*)(ws + WS_XN); const bf16* Y = (const bf16*)(ws + WS_Y);
    for (size_t e = (size_t)blockIdx.x * 256 + threadIdx.x; e < (size_t)NTOK * DM; e += (size_t)gridDim.x * 256) {
        const size_t m = e / DM; const int c = (int)(e % DM); float v = 0.f;
        auto f = [](bf16 b) { return __uint_as_float((unsigned)b << 16); };
        if (DBG_DUMP_MASK & 1) v += f(XN[m * DM + c]);
        if (DBG_DUMP_MASK & 2) v += f(Z[m * NZ + c]) + f(Z[m * NZ + 2048 + (c % 1792)]);
        if (DBG_DUMP_MASK & 8) v += f(Q[m * NQC + (c % NQC)]) + f(KV[m * NKVC + c]);
        if (DBG_DUMP_MASK & 16) v += f(PM[m * 1024 + (c & 1023)]);
        if (DBG_DUMP_MASK & 32) v += f(ABC[m * NABC + c]) + f(ABC[m * NABC + 1024 + c]);
        if (DBG_DUMP_MASK & 64) v += f(MG[m * DM + c]);
        if (DBG_DUMP_MASK & 128) v += f(Y[m * DM + c]);
        if (DBG_DUMP_MASK & 256) v += f(((const bf16*)(ws + WS_W))[e]) + f(((const bf16*)(ws + WS_W))[e + 20000000]);
        out[e] = v;
    }
}
#endif

extern "C" void kernel_launch(void* const* d_in, const int* in_sizes, int n_in, void* d_out, int out_size, void* d_ws, size_t ws_size, hipStream_t stream) {
    static int grid = 0;
    if (grid == 0) {
        if (n_in != 22 || out_size != NTOK * DM || ws_size < WS_END) { fprintf(stderr, "kernel_launch: unexpected shapes (n_in %d out %d ws %zu)\n", n_in, out_size, ws_size); grid = -1; return; }
        int dev = 0, cus = 0, per_cu = 0;
        if (hipGetDevice(&dev) != hipSuccess || hipDeviceGetAttribute(&cus, hipDeviceAttributeMultiprocessorCount, dev) != hipSuccess) { grid = -1; return; }
        if (hipFuncSetAttribute((const void*)fwd, hipFuncAttributeMaxDynamicSharedMemorySize, LDS_BYTES) != hipSuccess) { fprintf(stderr, "kernel_launch: hipFuncSetAttribute failed\n"); grid = -1; return; }
        if (hipOccupancyMaxActiveBlocksPerMultiprocessor(&per_cu, (const void*)fwd, NWAVES * 64, LDS_BYTES) != hipSuccess || per_cu < 1)
            fprintf(stderr, "kernel_launch: note: occupancy query reports %d workgroups per CU\n", per_cu);
        (void)hipGetLastError();
        grid = cus;
    }
    if (grid < 0) return;
    (void)in_sizes;
    if (hipMemsetAsync((char*)d_ws + WS_CTL, 0, CTL_ZERO_BYTES, stream) != hipSuccess) return;
    Args a{};
    for (int i = 0; i < 22; ++i) a.in[i] = (const float*)d_in[i];
    a.out = (float*)d_out; a.ws = (unsigned char*)d_ws;
#if MK_N_LAUNCHES == 1
    a.ph_lo = 0; a.ph_hi = N_PHASES;
    hipLaunchKernelGGL(fwd, dim3(grid), dim3(NWAVES * 64), LDS_BYTES, stream, a);
#else
#if DBG_LAST >= 0
    for (int k = 0; k <= DBG_LAST; ++k) { a.ph_lo = k; a.ph_hi = k + 1; hipLaunchKernelGGL(fwd, dim3(grid), dim3(NWAVES * 64), LDS_BYTES, stream, a); }
    hipLaunchKernelGGL(dbg_dump, dim3(2048), dim3(256), 0, stream, (float*)d_out, (const unsigned char*)d_ws);
#else
    for (int k = 0; k < N_PHASES; ++k) { a.ph_lo = k; a.ph_hi = k + 1; hipLaunchKernelGGL(fwd, dim3(grid), dim3(NWAVES * 64), LDS_BYTES, stream, a); }
#endif
#endif
    const hipError_t le = hipPeekAtLastError();
    if (le != hipSuccess) fprintf(stderr, "kernel_launch: launch failed: %s\n", hipGetErrorName(le));
}
```

```cpp
#include <hip/hip_runtime.h>
#include <cstdio>
#include <cstdint>

#define DBG_LAST -1
#define DBG_DUMP_MASK 0x6

#define PROBE_XBAR 0
#define PROBE_WAIT 0
#ifndef MK_N_LAUNCHES
#define MK_N_LAUNCHES 1
#endif

constexpr int DM = 2048, NTOK = 24576, NPROMPT = 16384, DEPTH = 4, DFF = 8192;
constexpr int NZW = 9984, NZ = 3840, NZSRC = 9792;
constexpr int ZC_CQ = 0, ZC_CKV = 512, ZC_QW = 1024, ZC_KW = 2048, ZC_VW = 2304, ZC_QM = 2560, ZC_KR = 3584, ZC_G = 3840;
constexpr int NQC = 1536, NKVC = 2048, NMEMR = 1280, NABC = 3072;
constexpr float EPS = 1e-6f;
constexpr float LOG2E = 1.4426950408889634f;
constexpr float C_W = 0.088388347648318440f * LOG2E;
constexpr float C_M = 0.0625f * LOG2E;
constexpr float C_Q = 0.072168783648703220f * LOG2E;

constexpr size_t MiB = 1u << 20;
constexpr size_t WS_CTL = 0, CTL_ZERO_BYTES = 1 * MiB;
constexpr size_t WS_TAB = 2 * MiB;
constexpr size_t WS_RMEM = 4 * MiB;
constexpr size_t WS_RS = 5 * MiB;
constexpr size_t WS_SSQ = 6 * MiB;
constexpr size_t WS_MEMB = 8 * MiB;
constexpr size_t WS_MEMK = 13 * MiB;
constexpr size_t WS_MEMVT = 16 * MiB;
constexpr size_t WS_W = 32 * MiB;
constexpr size_t WO_IN = 0, WO_UQ = WO_IN + (size_t)NZW * DM * 2, WO_UKV = WO_UQ + (size_t)NQC * 512 * 2, WO_MEM = WO_UKV + (size_t)NKVC * 512 * 2,
                 WO_BR = WO_MEM + (size_t)2048 * DM * 2, WO_OUT = WO_BR + (size_t)DM * NABC * 2, WO_UP = WO_OUT + (size_t)DM * DM * 2,
                 WO_DOWN = WO_UP + (size_t)DFF * DM * 2, WO_END = WO_DOWN + (size_t)DM * DFF * 2;
static_assert(WO_END <= 136 * MiB, "weights region");
constexpr size_t WS_XN = 168 * MiB;
constexpr size_t WS_Z = 264 * MiB;
constexpr size_t WS_GT = 444 * MiB;
constexpr size_t WS_U = WS_Z;
constexpr size_t WS_Q = 732 * MiB;
constexpr size_t WS_KV = 804 * MiB;
constexpr size_t WS_PM = 900 * MiB;
constexpr size_t WS_ABC = 948 * MiB;
constexpr size_t WS_MERGED = 732 * MiB;
constexpr size_t WS_Y = 828 * MiB;
constexpr size_t WS_END = 1092 * MiB;
static_assert(WS_Z + (size_t)NTOK * NZ * 2 <= WS_GT && WS_GT + (size_t)3 * 96 * 8 * 131072 <= WS_Q && WS_MERGED + (size_t)NTOK * DM * 2 <= WS_Y && WS_Y + (size_t)NTOK * DM * 2 <= WS_ABC, "ws map");
constexpr int CW_TMO = 0, CW_BAR = 4096, CW_RANK = 16384;

constexpr int RING_OFF = 0, RING_BYTES = 131072;
constexpr int LDSCTL_OFF = RING_BYTES, MISC_OFF = LDSCTL_OFF + 320;
constexpr int XCH_OFF = RING_BYTES + 1024;
constexpr int LDS_BYTES = 147456;
static_assert(XCH_OFF + 8192 <= LDS_BYTES, "LDS map");
constexpr int NWAVES = 8;

#define GAS __attribute__((address_space(1)))
#define LAS __attribute__((address_space(3)))
typedef unsigned short bf16;
typedef unsigned v4u __attribute__((ext_vector_type(4)));
typedef float f32x4 __attribute__((ext_vector_type(4)));
typedef float f32x2 __attribute__((ext_vector_type(2)));
typedef short bf16x8 __attribute__((ext_vector_type(8)));
typedef GAS unsigned gu32;
#define RLX_AGENT __ATOMIC_RELAXED, __HIP_MEMORY_SCOPE_AGENT
#define LDS_WAIT() asm volatile("s_waitcnt lgkmcnt(0)" ::: "memory")
#define VM_WAIT() asm volatile("s_waitcnt vmcnt(0)" ::: "memory")

typedef float f32x2_t __attribute__((ext_vector_type(2))); typedef __bf16 bf16x2_t __attribute__((ext_vector_type(2)));
__device__ __forceinline__ unsigned cvt_pk_bf16(float lo, float hi) { const f32x2_t v = {lo, hi}; const bf16x2_t b = __builtin_convertvector(v, bf16x2_t); return __builtin_bit_cast(unsigned, b); }
__device__ __forceinline__ float bf_lo(unsigned w) { return __uint_as_float(w << 16); }
__device__ __forceinline__ float bf_hi(unsigned w) { return __uint_as_float(w & 0xffff0000u); }
__device__ __forceinline__ float shfl_xor_l(float v, int m, int lane) { return __int_as_float(__builtin_amdgcn_ds_bpermute((lane ^ m) << 2, __float_as_int(v))); }
__device__ __forceinline__ int seq_pos(int m) { return m < NPROMPT ? (m & 4095) : (m - NPROMPT); }
__device__ __forceinline__ int seq_of_panel(int pm) { return pm < 64 ? (pm >> 4) : 4; }

#ifndef PG8_BALANCED
#define PG8_BALANCED 1
#endif
namespace pg8 {
#define PG8_LAS __attribute__((address_space(3)))
typedef unsigned short bf16_t;
typedef short bf16x8 __attribute__((ext_vector_type(8)));
typedef float f32x4 __attribute__((ext_vector_type(4)));
typedef unsigned u32x4 __attribute__((ext_vector_type(4)));
constexpr int BM = 256, BK = 64, HALF = 128, HTB = HALF * BK * 2, STAGE_BYTES = 8 * HTB, NXCD = 8, WGM = 4;

__host__ __device__ __forceinline__ int lds_byte(int r, int c) { const int st = (r >> 4) * 2 + (c >> 5), rr = r & 15, cc = c & 31, ob = rr * 64 + cc * 2; return st * 1024 + (ob ^ (((ob >> 9) & 1) << 5)); }
__host__ __device__ __forceinline__ void stage_rc(int b, int& R, int& C) { const int st = b / 1024, sb = b % 1024, swz = sb ^ (((sb >> 9) & 1) << 5); R = (st >> 1) * 16 + swz / 64; C = (st & 1) * 32 + (swz % 64) / 2; }
__host__ __device__ __forceinline__ int perm32(int rho) { const int n = rho >> 4, i = rho & 15; return 8 * (i >> 2) + 4 * n + (i & 3); }

struct Unit { int pm, pn; };
struct Gemm { const char* A; const char* B; long a_pm, a_pn, b_pn, b_sq; int lda, ldb, K; bool b_tiled;
    __device__ __forceinline__ const char* aptr(const Unit& u) const { return A + (long)u.pm * a_pm + (long)u.pn * a_pn; }
    __device__ __forceinline__ const char* bptr(const Unit& u) const { return B + (long)u.pn * b_pn + (long)seq_of_panel(u.pm) * b_sq; } };
__device__ __forceinline__ Gemm plain_gemm(const void* A, int lda, const void* B, int ldb, int K, bool b_tiled = false) {
    Gemm g; g.A = (const char*)A; g.B = (const char*)B; g.a_pm = (long)BM * lda * 2; g.a_pn = 0; g.b_pn = b_tiled ? (long)(ldb / BK) * 32768 : (long)BM * ldb * 2; g.b_sq = 0; g.lda = lda; g.ldb = ldb; g.K = K; g.b_tiled = b_tiled; return g; }

struct StaticOrder {
    int nM, nN, nwg, G, c;
    __host__ __device__ void init(int nM_, int nN_, int G_, int c_) { nM = nM_; nN = nN_; nwg = nM * nN; G = G_; c = c_; }
    __host__ __device__ bool next(int i, Unit& u) const {
        const int L = i * G + c; if (L >= nwg) return false;
        int wgid = L; { const int q = nwg / NXCD, r = nwg % NXCD, xcd = wgid % NXCD, off = wgid / NXCD; wgid = (xcd < r ? xcd * (q + 1) : r * (q + 1) + (xcd - r) * q) + off; }
        const int nig = WGM * nN, gid = wgid / nig, fm = gid * WGM, gsz = (nM - fm) < WGM ? (nM - fm) : WGM;
        u.pm = fm + ((wgid % nig) % gsz); u.pn = (wgid % nig) / gsz; return true;
    }
};

typedef f32x4 Acc[2][2][4][2];

template <class Epi, class Sched, bool ALIGN_EPI = true, bool SP2 = true>
__device__ __forceinline__ void gemm_phase(int tid_in, PG8_LAS unsigned char* lds, PG8_LAS unsigned char* xlds, const Gemm g, const Sched& S, const Epi& E) {
    int tid_ = tid_in; asm volatile("" : "+v"(tid_));
    const int tid = tid_, wid = __builtin_amdgcn_readfirstlane(tid >> 6), lane = tid & 63, wr = wid >> 2, wc = wid & 3, fr = lane & 15, fq = lane >> 4;
    const int K = g.K, nt = K / BK;
    unsigned voffA[2], voffB[2];
#pragma unroll
    for (int i = 0; i < 2; ++i) { int R, C; stage_rc(tid * 16 + i * 8192, R, C); const int Rb = Epi::PERM ? ((R & ~31) + perm32(R & 31)) : R;
        voffA[i] = (unsigned)(R * g.lda + C) * 2u; voffB[i] = g.b_tiled ? (unsigned)(tid * 16 + i * 8192) : (unsigned)(Rb * g.ldb + C) * 2u; }
    const size_t kstep = (size_t)(BK * 2), kstepB = g.b_tiled ? (size_t)32768 : (size_t)(BK * 2);
    const size_t hstepA = (size_t)HALF * g.lda * 2, hstepB = g.b_tiled ? (size_t)16384 : (size_t)HALF * g.ldb * 2;
    const unsigned ldsw = (unsigned)wid * 1024u;
    const int aoff = lds_byte(wr * 64 + fr, fq * 8), boff = lds_byte(wc * 32 + fr, fq * 8);
#define PG8_SA(b, h) (((b) * 2 + (h)) * HTB)
#define PG8_SB(b, h) ((4 + (b) * 2 + (h)) * HTB)
#define PG8_STAGE(bufoff, gbase, voff) do { _Pragma("unroll") for (int _i = 0; _i < 2; ++_i) \
        __builtin_amdgcn_global_load_lds((const unsigned*)((const char*)(gbase) + (voff)[_i]), (PG8_LAS unsigned*)(lds + (bufoff) + ldsw + _i * 8192), 16, 0, 0); } while (0)
#define PG8_LDA(dst, b, h) do { _Pragma("unroll") for (int m = 0; m < 4; ++m) _Pragma("unroll") for (int k = 0; k < 2; ++k) dst[m][k] = *(const PG8_LAS bf16x8*)(lds + PG8_SA(b, h) + aoff + m * 2048 + k * 1024); } while (0)
#define PG8_LDB(dst, b, h) do { _Pragma("unroll") for (int n = 0; n < 2; ++n) _Pragma("unroll") for (int k = 0; k < 2; ++k) dst[n][k] = *(const PG8_LAS bf16x8*)(lds + PG8_SB(b, h) + boff + n * 2048 + k * 1024); } while (0)
#define PG8_MMA(ai, bj, At, Bt) do { __builtin_amdgcn_s_setprio(1); _Pragma("unroll") for (int m = 0; m < 4; ++m) _Pragma("unroll") for (int n = 0; n < 2; ++n) _Pragma("unroll") for (int k = 0; k < 2; ++k) \
        acc[ai][bj][m][n] = __builtin_amdgcn_mfma_f32_16x16x32_bf16(Bt[n][k], At[m][k], acc[ai][bj][m][n], 0, 0, 0); __builtin_amdgcn_s_setprio(0); } while (0)
#define PG8_WAIT_V(n) asm volatile("s_waitcnt vmcnt(" #n ")" ::: "memory")
#define PG8_WAIT_L(n) asm volatile("s_waitcnt lgkmcnt(" #n ")" ::: "memory")
#define PG8_BAR __builtin_amdgcn_s_barrier()
#define PG8_SCHED __builtin_amdgcn_sched_barrier(0)
    Unit cur, nxt; int ui = 0;
    if (!S.next(0, cur)) return;
    f32x4 acc[2][2][4][2];
#pragma unroll
    for (int a = 0; a < 2; ++a)
#pragma unroll
        for (int b = 0; b < 2; ++b)
#pragma unroll
            for (int m = 0; m < 4; ++m)
#pragma unroll
                for (int n = 0; n < 2; ++n) acc[a][b][m][n] = (f32x4){0.f, 0.f, 0.f, 0.f};
    bf16x8 At[4][2], B0[2][2], B1[2][2];
    const char* cA = g.aptr(cur); const char* cB = g.bptr(cur);
    if constexpr (SP2 && PG8_BALANCED) {
        PG8_STAGE(PG8_SB(0, 0), cB, voffB); PG8_STAGE(PG8_SB(0, 1), cB + hstepB, voffB); PG8_STAGE(PG8_SA(0, 0), cA, voffA); PG8_STAGE(PG8_SA(0, 1), cA + hstepA, voffA);
        if (wr == 1) PG8_BAR;
        PG8_WAIT_V(2); PG8_BAR;
        PG8_STAGE(PG8_SB(1, 0), cB + kstepB, voffB); PG8_STAGE(PG8_SB(1, 1), cB + hstepB + kstepB, voffB);
        PG8_WAIT_V(4); PG8_BAR;
    } else if constexpr (SP2) {
        PG8_STAGE(PG8_SB(0, 0), cB, voffB); PG8_STAGE(PG8_SB(0, 1), cB + hstepB, voffB); PG8_STAGE(PG8_SA(0, 0), cA, voffA); PG8_STAGE(PG8_SA(0, 1), cA + hstepA, voffA);
        if (wr == 1) PG8_BAR;
        PG8_WAIT_V(2); PG8_BAR;
        PG8_STAGE(PG8_SB(1, 0), cB + kstepB, voffB); PG8_STAGE(PG8_SA(1, 0), cA + kstep, voffA); PG8_STAGE(PG8_SB(1, 1), cB + hstepB + kstepB, voffB);
        PG8_WAIT_V(6); PG8_BAR;
    } else {
        PG8_STAGE(PG8_SB(0, 0), cB, voffB); PG8_STAGE(PG8_SA(0, 0), cA, voffA); PG8_STAGE(PG8_SB(0, 1), cB + hstepB, voffB); PG8_STAGE(PG8_SA(0, 1), cA + hstepA, voffA);
        if (wr == 1) PG8_BAR;
        PG8_WAIT_V(4); PG8_BAR;
        PG8_STAGE(PG8_SB(1, 0), cB + kstepB, voffB); PG8_STAGE(PG8_SA(1, 0), cA + kstep, voffA); PG8_STAGE(PG8_SB(1, 1), cB + hstepB + kstepB, voffB);
        PG8_WAIT_V(6); PG8_BAR;
    }
    for (;;) {
        const bool has_next = S.next(ui + 1, nxt);
        const char* nA = has_next ? g.aptr(nxt) : cA; const char* nB = has_next ? g.bptr(nxt) : cB;
        for (int t = 0; t < nt; t += 2) {
            const bool last = (t == nt - 2);
            if constexpr (Epi::HAS_MID) { if (t == Epi::MID1 || t == Epi::MID2) E.mid(acc, cur, t, wr, wc, fr, fq); }
            const char* a1 = cA + (size_t)(t + 1) * kstep;
            const char* a2 = last ? nA : cA + (size_t)(t + 2) * kstep; const char* b2 = last ? nB : cB + (size_t)(t + 2) * kstepB;
            const char* a3 = a2 + kstep; const char* b3 = b2 + kstepB;
            if constexpr (SP2 && PG8_BALANCED) {
            PG8_LDB(B0, 0, 0); PG8_LDB(B1, 0, 1); PG8_SCHED; PG8_LDA(At, 0, 0); PG8_STAGE(PG8_SA(1, 0), a1, voffA); PG8_STAGE(PG8_SA(1, 1), a1 + hstepA, voffA);
            PG8_WAIT_V(8); PG8_WAIT_L(0); PG8_BAR; PG8_MMA(0, 0, At, B0); PG8_MMA(0, 1, At, B1); PG8_BAR; PG8_SCHED;
            PG8_LDA(At, 0, 1); PG8_STAGE(PG8_SB(0, 0), b2, voffB); PG8_STAGE(PG8_SB(0, 1), b2 + hstepB, voffB);
            PG8_WAIT_V(6); PG8_WAIT_L(0); PG8_BAR; PG8_MMA(1, 0, At, B0); PG8_MMA(1, 1, At, B1); PG8_BAR; PG8_SCHED;
            PG8_LDB(B0, 1, 0); PG8_LDB(B1, 1, 1); PG8_SCHED; PG8_LDA(At, 1, 0); PG8_STAGE(PG8_SA(0, 0), a2, voffA); PG8_STAGE(PG8_SA(0, 1), a2 + hstepA, voffA);
            PG8_WAIT_V(8); PG8_WAIT_L(0); PG8_BAR; PG8_MMA(0, 0, At, B0); PG8_MMA(0, 1, At, B1); PG8_BAR; PG8_SCHED;
            PG8_LDA(At, 1, 1); PG8_STAGE(PG8_SB(1, 0), b3, voffB); PG8_STAGE(PG8_SB(1, 1), b3 + hstepB, voffB);
            PG8_WAIT_V(6); PG8_WAIT_L(0); PG8_BAR; PG8_MMA(1, 0, At, B0); PG8_MMA(1, 1, At, B1); PG8_BAR; PG8_SCHED;
            } else if constexpr (SP2) {
            PG8_LDB(B0, 0, 0); PG8_LDB(B1, 0, 1); PG8_SCHED; PG8_LDA(At, 0, 0); PG8_STAGE(PG8_SA(1, 1), a1 + hstepA, voffA);
            PG8_WAIT_V(8); PG8_WAIT_L(0); PG8_BAR; PG8_MMA(0, 0, At, B0); PG8_MMA(0, 1, At, B1); PG8_BAR; PG8_SCHED;
            PG8_LDA(At, 0, 1); PG8_STAGE(PG8_SB(0, 0), b2, voffB); PG8_STAGE(PG8_SB(0, 1), b2 + hstepB, voffB); PG8_STAGE(PG8_SA(0, 0), a2, voffA);
            PG8_WAIT_V(8); PG8_WAIT_L(0); PG8_BAR; PG8_MMA(1, 0, At, B0); PG8_MMA(1, 1, At, B1); PG8_BAR; PG8_SCHED;
            PG8_LDB(B0, 1, 0); PG8_LDB(B1, 1, 1); PG8_SCHED; PG8_LDA(At, 1, 0); PG8_STAGE(PG8_SA(0, 1), a2 + hstepA, voffA);
            PG8_WAIT_V(8); PG8_WAIT_L(0); PG8_BAR; PG8_MMA(0, 0, At, B0); PG8_MMA(0, 1, At, B1); PG8_BAR; PG8_SCHED;
            PG8_LDA(At, 1, 1); PG8_STAGE(PG8_SB(1, 0), b3, voffB); PG8_STAGE(PG8_SB(1, 1), b3 + hstepB, voffB); PG8_STAGE(PG8_SA(1, 0), a3, voffA);
            PG8_WAIT_V(8); PG8_WAIT_L(0); PG8_BAR; PG8_MMA(1, 0, At, B0); PG8_MMA(1, 1, At, B1); PG8_BAR; PG8_SCHED;
            } else {
            PG8_LDB(B0, 0, 0); PG8_SCHED; PG8_LDA(At, 0, 0); PG8_STAGE(PG8_SA(1, 1), a1 + hstepA, voffA);
            PG8_WAIT_L(8); PG8_BAR; PG8_WAIT_L(0); PG8_MMA(0, 0, At, B0); PG8_BAR; PG8_SCHED;
            PG8_LDB(B1, 0, 1); PG8_STAGE(PG8_SB(0, 0), b2, voffB);
            PG8_BAR; PG8_WAIT_L(0); PG8_MMA(0, 1, At, B1); PG8_BAR;
            PG8_LDA(At, 0, 1); PG8_STAGE(PG8_SA(0, 0), a2, voffA);
            PG8_BAR; PG8_WAIT_L(0); PG8_MMA(1, 0, At, B0); PG8_BAR; PG8_SCHED;
            PG8_STAGE(PG8_SB(0, 1), b2 + hstepB, voffB);
            PG8_WAIT_V(6); PG8_BAR; PG8_MMA(1, 1, At, B1); PG8_BAR;
            PG8_LDB(B0, 1, 0); PG8_SCHED; PG8_LDA(At, 1, 0); PG8_STAGE(PG8_SA(0, 1), a2 + hstepA, voffA);
            PG8_WAIT_L(8); PG8_BAR; PG8_WAIT_L(0); PG8_MMA(0, 0, At, B0); PG8_BAR; PG8_SCHED;
            PG8_LDB(B1, 1, 1); PG8_STAGE(PG8_SB(1, 0), b3, voffB);
            PG8_BAR; PG8_WAIT_L(0); PG8_MMA(0, 1, At, B1); PG8_BAR;
            PG8_LDA(At, 1, 1); PG8_STAGE(PG8_SA(1, 0), a3, voffA);
            PG8_BAR; PG8_WAIT_L(0); PG8_MMA(1, 0, At, B0); PG8_BAR; PG8_SCHED;
            PG8_STAGE(PG8_SB(1, 1), b3 + hstepB, voffB);
            PG8_WAIT_V(6); PG8_BAR; PG8_MMA(1, 1, At, B1); PG8_BAR;
            }
        }
        if constexpr (ALIGN_EPI) { if (wr == 0) PG8_BAR; }
        E(acc, cur, wr, wc, fr, fq, xlds, wid, lane);
        if (!has_next) break;
#pragma unroll
        for (int a = 0; a < 2; ++a)
#pragma unroll
            for (int b = 0; b < 2; ++b)
#pragma unroll
                for (int m = 0; m < 4; ++m)
#pragma unroll
                    for (int n = 0; n < 2; ++n) acc[a][b][m][n] = (f32x4){0.f, 0.f, 0.f, 0.f};
        cur = nxt; cA = nA; cB = nB; ++ui;
        if constexpr (ALIGN_EPI) { if (wr == 1) PG8_BAR; }
    }
    PG8_WAIT_V(0);
    if constexpr (!ALIGN_EPI) { if (wr == 0) PG8_BAR; }
    PG8_BAR;
#undef PG8_SA
#undef PG8_SB
#undef PG8_STAGE
#undef PG8_LDA
#undef PG8_LDB
#undef PG8_MMA
#undef PG8_WAIT_V
#undef PG8_WAIT_L
#undef PG8_BAR
#undef PG8_SCHED
}
}

namespace epi {
using pg8::Acc; using pg8::Unit; using pg8::HALF; using pg8::BM;
typedef float f32x2v __attribute__((ext_vector_type(2)));
#define EPI_COMMON static constexpr bool PERM = true;
#define EPI_PIN(a, b) asm volatile("" : "+v"(a), "+v"(b))
#define EPI_NOMID static constexpr bool HAS_MID = false; static constexpr int MID1 = -1, MID2 = -1;
__device__ __forceinline__ v4u pack8(const f32x4 v0, const f32x4 v1) { v4u w; w.x = cvt_pk_bf16(v0[0], v0[1]); w.y = cvt_pk_bf16(v0[2], v0[3]); w.z = cvt_pk_bf16(v1[0], v1[1]); w.w = cvt_pk_bf16(v1[2], v1[3]); return w; }
__device__ __forceinline__ void rope8(f32x4& v0, f32x4& v1, const f32x4 cs0, const f32x4 cs1, const f32x4 cs2, const f32x4 cs3) {
    (void)cs2; (void)cs3;
    const float a0 = v0[0] * cs0[0] - v0[1] * cs0[1], b0 = v0[0] * cs0[1] + v0[1] * cs0[0];
    const float a1 = v0[2] * cs0[2] - v0[3] * cs0[3], b1 = v0[2] * cs0[3] + v0[3] * cs0[2];
    const float a2 = v1[0] * cs1[0] - v1[1] * cs1[1], b2 = v1[0] * cs1[1] + v1[1] * cs1[0];
    const float a3 = v1[2] * cs1[2] - v1[3] * cs1[3], b3 = v1[2] * cs1[3] + v1[3] * cs1[2];
    v0 = (f32x4){a0, b0, a1, b1}; v1 = (f32x4){a2, b2, a3, b3};
}
__device__ __forceinline__ float sigmoidf_fast(float v) { return __builtin_amdgcn_rcpf(1.f + __builtin_amdgcn_exp2f(-LOG2E * v)); }

struct EpiZ { EPI_COMMON EPI_NOMID
    bf16* Z; float* SSQ; const float* tab; unsigned char* GT;
    __device__ __forceinline__ void operator()(Acc& acc, const Unit& u, int wr, int wc, int fr, int fq, LAS unsigned char*, int, int lane) const {
        const int pn = u.pn; int row0 = u.pm * BM + wr * 64 + fr, col0 = pn * BM + wc * 32 + 8 * fq; EPI_PIN(row0, col0);
        if (pn >= 15) {
            const int gi = pn - 15; unsigned char* blk = GT + ((size_t)((gi >> 3) * 96 + u.pm) * 8 + (gi & 7)) * 131072 + (size_t)(wr * 4 + wc) * 16384 + lane * 16;
#pragma unroll
            for (int ai = 0; ai < 2; ++ai)
#pragma unroll
                for (int m = 0; m < 4; ++m)
#pragma unroll
                    for (int bj = 0; bj < 2; ++bj) { f32x4 v0 = acc[ai][bj][m][0], v1 = acc[ai][bj][m][1];
#pragma unroll
                        for (int j = 0; j < 4; ++j) { v0[j] = sigmoidf_fast(v0[j]); v1[j] = sigmoidf_fast(v1[j]); }
                        *(v4u*)(blk + ((ai * 4 + m) * 2 + bj) * 1024) = pack8(v0, v1); }
        } else if (pn == 14) {
            const int i0 = 16 * (wc & 1) + 4 * fq;
#pragma unroll
            for (int ai = 0; ai < 2; ++ai)
#pragma unroll
                for (int m = 0; m < 4; ++m) { const int row = row0 + ai * HALF + m * 16; bf16* rowp = Z + (size_t)row * NZ + col0;
                    f32x4 v0 = acc[ai][0][m][0], v1 = acc[ai][0][m][1];
                    if (wc < 2) { const f32x4* cs = (const f32x4*)(tab + ((size_t)seq_pos(row) * 32 + i0) * 2); rope8(v0, v1, cs[0], cs[1], cs[0], cs[0]); }
                    *(v4u*)(rowp) = pack8(v0, v1);
                    *(v4u*)(rowp + HALF) = pack8(acc[ai][1][m][0], acc[ai][1][m][1]); }
        } else {
            const float sc = (pn >= 4 && pn < 8) ? C_W : ((pn >= 10) ? C_M : 1.f);
#pragma unroll
            for (int ai = 0; ai < 2; ++ai)
#pragma unroll
                for (int m = 0; m < 4; ++m) { const int row = row0 + ai * HALF + m * 16; bf16* rowp = Z + (size_t)row * NZ + col0; float ss = 0.f;
#pragma unroll
                    for (int bj = 0; bj < 2; ++bj) { const f32x4 v0 = acc[ai][bj][m][0] * sc, v1 = acc[ai][bj][m][1] * sc;
                        ss += (v0[0] * v0[0] + v0[1] * v0[1]) + (v0[2] * v0[2] + v0[3] * v0[3]) + (v1[0] * v1[0] + v1[1] * v1[1]) + (v1[2] * v1[2] + v1[3] * v1[3]);
                        *(v4u*)(rowp + bj * HALF) = pack8(v0, v1); }
                    if (pn < 4) { ss += shfl_xor_l(ss, 16, lane); ss += shfl_xor_l(ss, 32, lane); if (fq == 0) SSQ[(size_t)row * 16 + pn * 4 + wc] = ss; } }
        }
    }
};
template <int WHICH  > struct EpiLat { EPI_COMMON EPI_NOMID
    bf16* O; const float* SSQ; const float* tab;
    __device__ __forceinline__ void operator()(Acc& acc, const Unit& u, int wr, int wc, int fr, int fq, LAS unsigned char*, int, int) const {
        constexpr int LDC = WHICH == 0 ? NQC : NKVC;
        const int pn = u.pn; int row0 = u.pm * BM + wr * 64 + fr, col0 = pn * BM + wc * 32 + 8 * fq; EPI_PIN(row0, col0);
        const int i0 = 16 * (wc & 1) + 4 * fq;
#pragma unroll
        for (int ai = 0; ai < 2; ++ai)
#pragma unroll
            for (int m = 0; m < 4; ++m) { const int row = row0 + ai * HALF + m * 16; bf16* rowp = O + (size_t)row * LDC + col0;
                const f32x4* sp = (const f32x4*)(SSQ + (size_t)row * 16 + WHICH * 8); const f32x4 s0 = sp[0], s1 = sp[1];
                const float ssum = ((s0[0] + s0[1]) + (s0[2] + s0[3])) + ((s1[0] + s1[1]) + (s1[2] + s1[3]));
                const float rs = __builtin_amdgcn_rsqf(ssum * (1.f / 512.f) + EPS) * (WHICH == 0 ? C_Q : 1.f);
#pragma unroll
                for (int bj = 0; bj < 2; ++bj) { f32x4 v0 = acc[ai][bj][m][0] * rs, v1 = acc[ai][bj][m][1] * rs;
                    if (WHICH == 0 && pn >= 4) { const f32x4* cs = (const f32x4*)(tab + ((size_t)seq_pos(row) * 32 + i0) * 2); rope8(v0, v1, cs[0], cs[1], cs[0], cs[0]); }
                    *(v4u*)(rowp + bj * HALF) = pack8(v0, v1); } }
    }
};
template <int MODE> struct EpiStore { EPI_COMMON EPI_NOMID
    bf16* O; int ldc; int col_off; const float* rs;
    __device__ __forceinline__ void operator()(Acc& acc, const Unit& u, int wr, int wc, int fr, int fq, LAS unsigned char*, int, int) const {
        int row0 = u.pm * BM + wr * 64 + fr, ct = u.pn * BM + wc * 32 + 8 * fq; EPI_PIN(row0, ct); const int col0 = col_off + ct;
        f32x4 cs[2][2]; float rr[2][4];
#pragma unroll
        for (int ai = 0; ai < 2; ++ai)
#pragma unroll
            for (int m = 0; m < 4; ++m) rr[ai][m] = (MODE == 1 || MODE == 5) ? rs[row0 + ai * HALF + m * 16] : 1.f;
        if (MODE == 2) {
#pragma unroll
            for (int bj = 0; bj < 2; ++bj) { cs[bj][0] = *(const f32x4*)(rs + ct + bj * HALF); cs[bj][1] = *(const f32x4*)(rs + ct + bj * HALF + 4); } }
#pragma unroll
        for (int ai = 0; ai < 2; ++ai)
#pragma unroll
            for (int m = 0; m < 4; ++m) { const int row = row0 + ai * HALF + m * 16; bf16* rowp = O + (size_t)row * ldc + col0;
                const float r = rr[ai][m];
#pragma unroll
                for (int bj = 0; bj < 2; ++bj) { f32x4 v0 = acc[ai][bj][m][0], v1 = acc[ai][bj][m][1];
                    if (MODE == 1 || MODE == 5) { v0 = v0 * r; v1 = v1 * r; }
                    if (MODE == 2) { v0 = v0 * cs[bj][0]; v1 = v1 * cs[bj][1]; }
                    if (MODE == 3 || MODE == 5) {
#pragma unroll
                        for (int j = 0; j < 4; ++j) { const float a = fmaxf(v0[j], 0.f), b = fmaxf(v1[j], 0.f); v0[j] = a * a; v1[j] = b * b; } }
                    *(v4u*)(rowp + bj * HALF) = pack8(v0, v1); } }
    }
};
struct EpiSoftmax { EPI_COMMON EPI_NOMID
    bf16* O;
    __device__ __forceinline__ void operator()(Acc& acc, const Unit& u, int wr, int wc, int fr, int fq, LAS unsigned char* xl, int, int lane) const {
        LAS float* MX = (LAS float*)xl; LAS float* SM = (LAS float*)(xl + 4096);
        int row0 = u.pm * BM + wr * 64 + fr, col0 = u.pn * BM + wc * 32 + 8 * fq; EPI_PIN(row0, col0);
#pragma unroll
        for (int ai = 0; ai < 2; ++ai)
#pragma unroll
            for (int m = 0; m < 4; ++m) { float mx = -3.0e38f;
#pragma unroll
                for (int bj = 0; bj < 2; ++bj)
#pragma unroll
                    for (int n = 0; n < 2; ++n) { const f32x4 x = acc[ai][bj][m][n]; mx = fmaxf(mx, fmaxf(fmaxf(x[0], x[1]), fmaxf(x[2], x[3]))); }
                mx = fmaxf(mx, shfl_xor_l(mx, 16, lane)); mx = fmaxf(mx, shfl_xor_l(mx, 32, lane));
                if (fq == 0) MX[(ai * HALF + wr * 64 + m * 16 + fr) * 4 + wc] = mx; }
        asm volatile("s_waitcnt lgkmcnt(0)" ::: "memory"); __builtin_amdgcn_s_barrier(); asm volatile("" ::: "memory");
#pragma unroll
        for (int ai = 0; ai < 2; ++ai)
#pragma unroll
            for (int m = 0; m < 4; ++m) { const int lr = ai * HALF + wr * 64 + m * 16 + fr; const f32x4 q = *(LAS f32x4*)(MX + lr * 4);
                const float mx = fmaxf(fmaxf(q[0], q[1]), fmaxf(q[2], q[3])); float s = 0.f;
#pragma unroll
                for (int bj = 0; bj < 2; ++bj)
#pragma unroll
                    for (int n = 0; n < 2; ++n) { f32x4 x = acc[ai][bj][m][n];
#pragma unroll
                        for (int j = 0; j < 4; ++j) { x[j] = __builtin_amdgcn_exp2f(x[j] - mx); s += x[j]; }
                        acc[ai][bj][m][n] = x; }
                s += shfl_xor_l(s, 16, lane); s += shfl_xor_l(s, 32, lane);
                if (fq == 0) SM[lr * 4 + wc] = s; }
        asm volatile("s_waitcnt lgkmcnt(0)" ::: "memory"); __builtin_amdgcn_s_barrier(); asm volatile("" ::: "memory");
#pragma unroll
        for (int ai = 0; ai < 2; ++ai)
#pragma unroll
            for (int m = 0; m < 4; ++m) { const int lr = ai * HALF + wr * 64 + m * 16 + fr; const f32x4 q = *(LAS f32x4*)(SM + lr * 4);
                const float inv = __builtin_amdgcn_rcpf((q[0] + q[1]) + (q[2] + q[3]));
                bf16* rowp = O + (size_t)(row0 + ai * HALF + m * 16) * 1024 + col0;
#pragma unroll
                for (int bj = 0; bj < 2; ++bj) *(v4u*)(rowp + bj * HALF) = pack8(acc[ai][bj][m][0] * inv, acc[ai][bj][m][1] * inv); }
    }
};
struct EpiBranch { EPI_COMMON
    static constexpr bool HAS_MID = true; static constexpr int MID1 = 16, MID2 = 32;
    bf16* O; const unsigned char* GT;
    __device__ __forceinline__ const unsigned char* gblk(const Unit& u, int g, int wr, int wc, int fr, int fq) const {
        return GT + ((size_t)(g * 96 + u.pm) * 8 + u.pn) * 131072 + (size_t)(wr * 4 + wc) * 16384 + (fq * 16 + fr) * 16; }
    __device__ __forceinline__ void mid(Acc& acc, const Unit& u, int t, int wr, int wc, int fr, int fq) const {
        const int gxi = (t == MID1) ? 0 : 1;
        const unsigned char* px = gblk(u, gxi, wr, wc, fr, fq); const unsigned char* py = gblk(u, gxi + 1, wr, wc, fr, fq);
#pragma unroll
        for (int ai = 0; ai < 2; ++ai) {
            v4u a[4][2], b[4][2];
#pragma unroll
            for (int m = 0; m < 4; ++m)
#pragma unroll
                for (int bj = 0; bj < 2; ++bj) { a[m][bj] = *(const v4u*)(px + ((ai * 4 + m) * 2 + bj) * 1024); b[m][bj] = *(const v4u*)(py + ((ai * 4 + m) * 2 + bj) * 1024); }
            __builtin_amdgcn_sched_barrier(0);
#pragma unroll
            for (int m = 0; m < 4; ++m)
#pragma unroll
                for (int bj = 0; bj < 2; ++bj) { const v4u x = a[m][bj], y = b[m][bj]; f32x4 r0, r1;
                    r0[0] = bf_lo(x.x) * __builtin_amdgcn_rcpf(bf_lo(y.x)); r0[1] = bf_hi(x.x) * __builtin_amdgcn_rcpf(bf_hi(y.x));
                    r0[2] = bf_lo(x.y) * __builtin_amdgcn_rcpf(bf_lo(y.y)); r0[3] = bf_hi(x.y) * __builtin_amdgcn_rcpf(bf_hi(y.y));
                    r1[0] = bf_lo(x.z) * __builtin_amdgcn_rcpf(bf_lo(y.z)); r1[1] = bf_hi(x.z) * __builtin_amdgcn_rcpf(bf_hi(y.z));
                    r1[2] = bf_lo(x.w) * __builtin_amdgcn_rcpf(bf_lo(y.w)); r1[3] = bf_hi(x.w) * __builtin_amdgcn_rcpf(bf_hi(y.w));
                    acc[ai][bj][m][0] *= r0; acc[ai][bj][m][1] *= r1; }
            __builtin_amdgcn_sched_barrier(0);
        }
    }
    __device__ __forceinline__ void operator()(Acc& acc, const Unit& u, int wr, int wc, int fr, int fq, LAS unsigned char*, int, int) const {
        int row0 = u.pm * BM + wr * 64 + fr, col0 = u.pn * BM + wc * 32 + 8 * fq; EPI_PIN(row0, col0);
        const unsigned char* pz = gblk(u, 2, wr, wc, fr, fq);
#pragma unroll
        for (int ai = 0; ai < 2; ++ai) {
            v4u a[4][2];
#pragma unroll
            for (int m = 0; m < 4; ++m)
#pragma unroll
                for (int bj = 0; bj < 2; ++bj) a[m][bj] = *(const v4u*)(pz + ((ai * 4 + m) * 2 + bj) * 1024);
            __builtin_amdgcn_sched_barrier(0);
#pragma unroll
            for (int m = 0; m < 4; ++m) { bf16* rowp = O + (size_t)(row0 + ai * HALF + m * 16) * DM + col0;
#pragma unroll
                for (int bj = 0; bj < 2; ++bj) { const v4u x = a[m][bj];
                    const f32x4 g0 = {bf_lo(x.x), bf_hi(x.x), bf_lo(x.y), bf_hi(x.y)}, g1 = {bf_lo(x.z), bf_hi(x.z), bf_lo(x.w), bf_hi(x.w)};
                    *(v4u*)(rowp + bj * HALF) = pack8(acc[ai][bj][m][0] * g0, acc[ai][bj][m][1] * g1); } }
            __builtin_amdgcn_sched_barrier(0);
        }
    }
};
}

namespace att {
using s16x4 = __attribute__((ext_vector_type(4))) short;
using f32x16 = __attribute__((ext_vector_type(16))) float;
using u32x4 = __attribute__((ext_vector_type(4))) unsigned;
constexpr int NW = 8, QBLK = 32, KVBLK = 64;
constexpr float THR2 = 8.f;
constexpr float NEGBIG = -1.0e30f;
#define SBAR() __builtin_amdgcn_sched_barrier(0)
__device__ __forceinline__ int crow(int r, int hi) { return (r & 3) + 8 * (r >> 2) + 4 * hi; }
template <int KROWB> __device__ __forceinline__ int kswz(int row, int colB) { return row * KROWB + (colB ^ ((KROWB == 384 ? ((row >> 1) & 7) : (row & 15)) << 4)); }

struct Mask { int dq; float sl; };

template <bool WIN>
__device__ __forceinline__ void partialSM(f32x16& p0, f32x16& p1, float& m_reg, float& mn, float& alpha, const Mask& mk, int kt) {
  if (WIN) {
    const float fd = (float)(mk.dq - kt * KVBLK);
#pragma unroll
    for (int r = 0; r < 16; ++r) { const float d0 = fd - (float)((r & 3) + 8 * (r >> 2)), d1 = d0 - 32.f; const float a0 = fabsf(d0), a1 = fabsf(d1);
      const float t0 = p0[r] - mk.sl * a0, t1 = p1[r] - mk.sl * a1; p0[r] = (a0 <= 128.f) ? t0 : NEGBIG; p1[r] = (a1 <= 128.f) ? t1 : NEGBIG; }
  }
  float pmax = p0[0];
#pragma unroll
  for (int r = 1; r < 16; ++r) pmax = fmaxf(pmax, p0[r]);
#pragma unroll
  for (int r = 0; r < 16; ++r) pmax = fmaxf(pmax, p1[r]);
  { auto rr = __builtin_amdgcn_permlane32_swap(__float_as_uint(pmax), __float_as_uint(pmax), false, false);
    pmax = fmaxf(__uint_as_float(rr[0]), __uint_as_float(rr[1])); }
  if (__builtin_expect(__all(pmax - m_reg <= THR2), 1)) { mn = m_reg; alpha = 1.f; }
  else { mn = fmaxf(m_reg, pmax); alpha = __builtin_amdgcn_exp2f(m_reg - mn); m_reg = mn; }
#pragma unroll
  for (int r = 0; r < 16; ++r) p0[r] = p0[r] - mn;
#pragma unroll
  for (int r = 0; r < 16; ++r) p1[r] = p1[r] - mn;
#pragma unroll
  for (int r = 0; r < 16; ++r) p0[r] = __builtin_amdgcn_exp2f(p0[r]);
}
__device__ __forceinline__ void finishSM(f32x16& p0, f32x16& p1, float alpha, float& l_reg, bf16x8& pa0, bf16x8& pa1, bf16x8& pa2, bf16x8& pa3) {
#pragma unroll
  for (int r = 0; r < 16; ++r) p1[r] = __builtin_amdgcn_exp2f(p1[r]);
  float ps = 0;
#pragma unroll
  for (int r = 0; r < 16; ++r) ps += p0[r];
#pragma unroll
  for (int r = 0; r < 16; ++r) ps += p1[r];
  { auto rr = __builtin_amdgcn_permlane32_swap(__float_as_uint(ps), __float_as_uint(ps), false, false);
    ps = __uint_as_float(rr[0]) + __uint_as_float(rr[1]); }
  l_reg = l_reg * alpha + ps;
#define PK4(P, BASE, OUT) do { unsigned a0 = cvt_pk_bf16(P[BASE + 0], P[BASE + 1]), a1 = cvt_pk_bf16(P[BASE + 2], P[BASE + 3]);   \
    unsigned b0 = cvt_pk_bf16(P[BASE + 4], P[BASE + 5]), b1 = cvt_pk_bf16(P[BASE + 6], P[BASE + 7]);                              \
    auto r0 = __builtin_amdgcn_permlane32_swap(a0, b0, false, false); auto r1 = __builtin_amdgcn_permlane32_swap(a1, b1, false, false); \
    u32x4 w = {r0[0], r1[0], r0[1], r1[1]}; OUT = *reinterpret_cast<bf16x8*>(&w); } while (0)
  PK4(p0, 0, pa0); PK4(p0, 8, pa1); PK4(p1, 0, pa2); PK4(p1, 8, pa3);
#undef PK4
}
template <int NQF, int KROWB>
__device__ __forceinline__ void qkt(f32x16& p0, f32x16& p1, const LAS char* Ks, const bf16x8* qr, int r32, int hi) {
  p0 = f32x16{}; p1 = f32x16{};
#pragma unroll
  for (int d0 = 0; d0 < NQF; ++d0) { const int cb = (d0 * 16 + hi * 8) * 2;
    bf16x8 b0 = *(const LAS bf16x8*)(Ks + kswz<KROWB>(r32, cb));
    bf16x8 b1 = *(const LAS bf16x8*)(Ks + kswz<KROWB>(32 + r32, cb));
    p0 = __builtin_amdgcn_mfma_f32_32x32x16_bf16(b0, qr[d0], p0, 0, 0, 0);
    p1 = __builtin_amdgcn_mfma_f32_32x32x16_bf16(b1, qr[d0], p1, 0, 0, 0); }
}
__device__ __forceinline__ int v_st(int k, int c) { const int kk = (k & ~0xC) | ((k & 4) << 1) | ((k & 8) >> 1); return ((kk >> 3) * 4 + (c >> 5)) * 512 + ((kk & 7) * 32 + (c & 31)) * 2; }
__device__ __forceinline__ int v_rd_base(int lane) { return ((lane & 3) << 3) | (((lane >> 2) & 3) << 6) | (((lane >> 4) & 1) << 5) | (((lane >> 5) & 1) << 8); }
constexpr int v_rd_off(int d0, int ks, int half) { return d0 * 512 + ks * 4096 + half * 2048; }
template <int OFF> __device__ __forceinline__ s16x4 tr_read(int vb) {
  s16x4 r; asm volatile("ds_read_b64_tr_b16 %0, %1 offset:%2" : "=&v"(r) : "v"(vb), "i"(OFF) : "memory"); return r;
}
template <int D0> __device__ __forceinline__ void pv_one(f32x16& od, int vb, bf16x8 pa0, bf16x8 pa1, bf16x8 pa2, bf16x8 pa3) {
  const s16x4 l0 = tr_read<v_rd_off(D0, 0, 0)>(vb), h0 = tr_read<v_rd_off(D0, 0, 1)>(vb), l1 = tr_read<v_rd_off(D0, 1, 0)>(vb), h1 = tr_read<v_rd_off(D0, 1, 1)>(vb);
  const s16x4 l2 = tr_read<v_rd_off(D0, 2, 0)>(vb), h2 = tr_read<v_rd_off(D0, 2, 1)>(vb), l3 = tr_read<v_rd_off(D0, 3, 0)>(vb), h3 = tr_read<v_rd_off(D0, 3, 1)>(vb);
  asm volatile("s_waitcnt lgkmcnt(0)" ::: "memory"); SBAR();
#define PK(L, H) (bf16x8){L[0], L[1], L[2], L[3], H[0], H[1], H[2], H[3]}
  od = __builtin_amdgcn_mfma_f32_32x32x16_bf16(pa0, PK(l0, h0), od, 0, 0, 0);
  od = __builtin_amdgcn_mfma_f32_32x32x16_bf16(pa1, PK(l1, h1), od, 0, 0, 0);
  od = __builtin_amdgcn_mfma_f32_32x32x16_bf16(pa2, PK(l2, h2), od, 0, 0, 0);
  od = __builtin_amdgcn_mfma_f32_32x32x16_bf16(pa3, PK(l3, h3), od, 0, 0, 0);
#undef PK
}
__device__ __forceinline__ void pv_d0(f32x16* o, int vb, bf16x8 pa0, bf16x8 pa1, bf16x8 pa2, bf16x8 pa3) {
  pv_one<0>(o[0], vb, pa0, pa1, pa2, pa3); pv_one<1>(o[1], vb, pa0, pa1, pa2, pa3); pv_one<2>(o[2], vb, pa0, pa1, pa2, pa3); pv_one<3>(o[3], vb, pa0, pa1, pa2, pa3);
}

__device__ __forceinline__ int kn_off(int row, int colB) { return row * 256 + (colB ^ ((row & 15) << 4)); }
__device__ __forceinline__ int kr_off(int row, int colB) { return row * 128 + (colB ^ (((row >> 1) & 7) << 4)); }
template <int NQF>
__device__ __forceinline__ void qk_mm(f32x16& n0, f32x16& n1, const LAS char* Kn, const LAS char* Kr, const bf16x8* qr, int r32, int hi) {
  constexpr int PF = 2, NB = PF + 1;
  n0 = f32x16{}; n1 = f32x16{};
  bf16x8 kb[NB][2];
#define QM_LOADK(d) do { if ((d) < 8) { const int cb_ = ((d) * 16 + hi * 8) * 2; kb[(d) % NB][0] = *(const LAS bf16x8*)(Kn + kn_off(r32, cb_)); kb[(d) % NB][1] = *(const LAS bf16x8*)(Kn + kn_off(32 + r32, cb_)); } \
    else { const int cb_ = (((d) - 8) * 16 + hi * 8) * 2; kb[(d) % NB][0] = *(const LAS bf16x8*)(Kr + kr_off(r32, cb_)); kb[(d) % NB][1] = *(const LAS bf16x8*)(Kr + kr_off(32 + r32, cb_)); } } while (0)
  QM_LOADK(0); QM_LOADK(1);
#pragma unroll
  for (int k = 0; k < NQF; ++k) {
    if (k + PF < NQF) QM_LOADK(k + PF);
    n0 = __builtin_amdgcn_mfma_f32_32x32x16_bf16(kb[k % NB][0], qr[k], n0, 0, 0, 0);
    n1 = __builtin_amdgcn_mfma_f32_32x32x16_bf16(kb[k % NB][1], qr[k], n1, 0, 0, 0);
    __builtin_amdgcn_sched_barrier(0);
  }
#undef QM_LOADK
}

template <int KIND>
__device__ __forceinline__ void attn_unit(const bf16* __restrict__ Qb, const bf16* __restrict__ KVb, const bf16* __restrict__ Zb, bf16* __restrict__ Ob,
                                          int qm0, int km0, int NT, int h, int ocol, float m0, float l0, Mask mk, LAS char* lds, int tid_in) {
  constexpr int NQF = KIND == 0 ? 12 : 8;
  constexpr bool HASR = KIND == 0, WIN = KIND == 1;
  constexpr int KSLOT = HASR ? 24576 : 16384, OFF_KR = 16384, VRING = 3 * KSLOT, VSLOT = 16384, SCR = VRING + 3 * VSLOT;
  int tid_; asm volatile("v_mbcnt_lo_u32_b32 %0, -1, 0\n\tv_mbcnt_hi_u32_b32 %0, -1, %0" : "=v"(tid_)); tid_ += tid_in;
  const int tid = tid_, wid = tid >> 6, lane = tid & 63, r32 = lane & 31, hi = lane >> 5;
  const int widu = __builtin_amdgcn_readfirstlane(wid);
  const bool trailing = widu >= 4;
  LAS float* ws = (LAS float*)(lds + SCR) + wid * 64; LAS float* li_l = ws; LAS float* al_l = ws + 32;
  float m_reg = m0, l_reg = l0; f32x16 o[4] = {}; bf16x8 qr[NQF];
  mk.dq += wid * QBLK + r32 - 4 * hi;
  const int kvh = h >> 2;
  constexpr long kld2 = (KIND == 0 ? NKVC : NZ) * 2;
  const char* Kbase = KIND == 0 ? (const char*)(KVb + (long)km0 * NKVC + h * 256) : (const char*)(Zb + (long)km0 * NZ + ZC_KW + kvh * 128);
  const char* Vbase = KIND == 0 ? Kbase + 256 : (const char*)(Zb + (long)km0 * NZ + ZC_VW + kvh * 128);
  const char* Rbase = (const char*)(Zb + (long)km0 * NZ + ZC_KR);
  unsigned okn[2], ov[2], okr;
#pragma unroll
  for (int q = 0; q < 2; ++q) { const int pq = 2 * wid + q;
    { const int row = pq * 4 + (lane >> 4), ch = (lane & 15) ^ (row & 15); okn[q] = (unsigned)(row * kld2 + ch * 16); }
    { const int sub = 2 * pq + (lane >> 5), kk = (sub >> 2) * 8 + ((lane & 31) >> 2), k = (kk & ~0xC) | ((kk & 4) << 1) | ((kk & 8) >> 1), c = (sub & 3) * 32 + (lane & 3) * 8; ov[q] = (unsigned)(k * kld2 + c * 2); } }
  { const int row = wid * 8 + (lane >> 3), ch = (lane & 7) ^ ((row >> 1) & 7); okr = (unsigned)(row * (NZ * 2) + ch * 16); }
#define GLDS(src, dst) __builtin_amdgcn_global_load_lds((const unsigned*)(src), (LAS unsigned*)(dst), 16, 0, 0)
#define DMA_K(t, ks) do { const size_t to_ = (size_t)(t) * KVBLK * kld2; LAS char* sb_ = lds + (ks) * KSLOT; \
    GLDS(Kbase + to_ + okn[0], sb_ + (2 * widu) * 1024); GLDS(Kbase + to_ + okn[1], sb_ + (2 * widu + 1) * 1024); \
    if (HASR) GLDS(Rbase + (size_t)(t) * KVBLK * (NZ * 2) + okr, sb_ + OFF_KR + widu * 1024); } while (0)
#define DMA_V(t, vs) do { const size_t to_ = (size_t)(t) * KVBLK * kld2; LAS char* sb_ = lds + VRING + (vs) * VSLOT; \
    GLDS(Vbase + to_ + ov[0], sb_ + (2 * widu) * 1024); GLDS(Vbase + to_ + ov[1], sb_ + (2 * widu + 1) * 1024); } while (0)
#define WAITBAR() asm volatile("s_waitcnt vmcnt(0) lgkmcnt(0)\n\ts_barrier" ::: "memory")
#define LBAR() asm volatile("s_waitcnt lgkmcnt(0)\n\ts_barrier" ::: "memory")
#define RESC(a) do { if (__any((a) < 1.f)) { if (hi == 0) al_l[r32] = (a); asm volatile("s_waitcnt lgkmcnt(0)" ::: "memory"); \
    _Pragma("unroll") for (int d = 0; d < 4; ++d) _Pragma("unroll") for (int r = 0; r < 16; ++r) o[d][r] *= al_l[crow(r, hi)]; } } while (0)
  DMA_K(0, 0); DMA_K(1, 1); DMA_V(0, 0);
  { const long qrow = (long)(qm0 + wid * QBLK + r32);
    if (KIND == 0) {
      const bf16* Qn = Qb + qrow * NQC + h * 128 + hi * 8; const bf16* Qr = Qb + qrow * NQC + 1024 + h * 64 + hi * 8;
#pragma unroll
      for (int d0 = 0; d0 < 8; ++d0) qr[d0] = *reinterpret_cast<const bf16x8*>(Qn + d0 * 16);
#pragma unroll
      for (int d0 = 8; d0 < NQF; ++d0) qr[d0] = *reinterpret_cast<const bf16x8*>(Qr + (d0 - 8) * 16);
    } else {
      const bf16* Qn = Zb + qrow * NZ + ZC_QW + h * 128 + hi * 8;
#pragma unroll
      for (int d0 = 0; d0 < 8; ++d0) qr[d0] = *reinterpret_cast<const bf16x8*>(Qn + d0 * 16);
    } }
  const int vb0 = (int)(uintptr_t)lds + VRING + v_rd_base(lane);
  f32x16 s0, s1; float mn, al; bf16x8 pa0, pa1, pa2, pa3;
  asm volatile("s_waitcnt vmcnt(0)" ::: "memory");
  if (trailing) LBAR();
  LBAR();
  int ks = 0, vs = 2;
  for (int t = 0; t < NT; ++t) {
    __builtin_amdgcn_s_setprio(1);
    qk_mm<NQF>(s0, s1, lds + ks * KSLOT, lds + ks * KSLOT + OFF_KR, qr, r32, hi);
    if (t > 0) pv_d0(o, vb0 + vs * VSLOT, pa0, pa1, pa2, pa3);
    __builtin_amdgcn_s_setprio(0);
    WAITBAR();
    { const int kn = ks == 0 ? 2 : ks - 1, vn = vs == 2 ? 0 : vs + 1, vn2 = vn == 2 ? 0 : vn + 1;
      if (t + 2 < NT) DMA_K(t + 2, kn);
      if (t + 1 < NT) DMA_V(t + 1, vn2); }
    partialSM<WIN>(s0, s1, m_reg, mn, al, mk, t);
    finishSM(s0, s1, al, l_reg, pa0, pa1, pa2, pa3);
    RESC(al);
    LBAR();
    ks = ks == 2 ? 0 : ks + 1; vs = vs == 2 ? 0 : vs + 1;
  }
  __builtin_amdgcn_s_setprio(1);
  pv_d0(o, vb0 + vs * VSLOT, pa0, pa1, pa2, pa3);
  __builtin_amdgcn_s_setprio(0);
  if (!trailing) LBAR();
  if (hi == 0) li_l[r32] = l_reg; asm volatile("s_waitcnt lgkmcnt(0)" ::: "memory");
  float rli[16];
#pragma unroll
  for (int r = 0; r < 16; ++r) rli[r] = __builtin_amdgcn_rcpf(li_l[crow(r, hi)]);
  WAITBAR();
  { LAS bf16* stg = (LAS bf16*)(lds + wid * 8192);
#pragma unroll
    for (int r = 0; r < 16; ++r) { const int orow = crow(r, hi);
#pragma unroll
      for (int d0 = 0; d0 < 4; ++d0) { const float v = o[d0][r] * rli[r]; stg[orow * 128 + d0 * 32 + r32] = (bf16)(cvt_pk_bf16(v, v) & 0xffffu); } }
    asm volatile("s_waitcnt lgkmcnt(0)" ::: "memory");
    bf16* Ow = Ob + (long)(qm0 + wid * QBLK) * NABC + ocol;
#pragma unroll
    for (int i = 0; i < 8; ++i) { const int row = i * 4 + (lane >> 4), ch = lane & 15; const v4u v = *(const LAS v4u*)(stg + row * 128 + ch * 8); *(v4u*)(Ow + (long)row * NABC + ch * 8) = v; } }
  WAITBAR();
#undef GLDS
#undef DMA_K
#undef DMA_V
#undef WAITBAR
#undef LBAR
#undef RESC
}
#undef SBAR
}

#define XB_TMO      128
#define XB_XCNT(j)  (256  + 64 * (j))
#define XB_XSUB(j)  (1280 + 64 * (j))
#define XB_XGEN(j)  (2304 + 64 * (j))
#define XB_TOP      3328
#define XB_TOPGEN   3392
#define XCD_BAR_WORDS 3456
#define XB_SPIN_CAP (1u << 18)

__device__ __forceinline__ unsigned xb_ld(unsigned* p)              { return __hip_atomic_load(p, __ATOMIC_RELAXED, __HIP_MEMORY_SCOPE_AGENT); }
__device__ __forceinline__ unsigned xb_add(unsigned* p, unsigned v) { return __hip_atomic_fetch_add(p, v, __ATOMIC_RELAXED, __HIP_MEMORY_SCOPE_AGENT); }
__device__ __forceinline__ unsigned xb_xcc_id() { return (unsigned)__builtin_amdgcn_s_getreg((3 << 11) | 20) & 0xFu; }
#define XB_SPIN(cond, bar) do { unsigned _sp = 0; while (cond) { __builtin_amdgcn_s_sleep(1); \
    if ((++_sp & 255u) == 0u) { if (xb_ld(&(bar)[XB_TMO])) break; if (_sp > XB_SPIN_CAP) { atomicAdd(&(bar)[XB_TMO], 1u); break; } } } } while (0)

struct XcdBarrier { unsigned* bar; unsigned x; volatile LAS unsigned* st; };

__device__ __forceinline__ XcdBarrier xcd_barrier_post(unsigned* bar, volatile LAS unsigned* st) {
    XcdBarrier b; b.bar = bar; b.x = xb_xcc_id(); b.st = st;
    if (threadIdx.x == 0) (void)xb_add(&bar[XB_XCNT(b.x)], 1u);
    return b;
}
__device__ __forceinline__ void xcd_barrier_complete(unsigned* bar, unsigned x, unsigned& nloc, unsigned& nx) {
    const unsigned G = gridDim.x * gridDim.y * gridDim.z;
    unsigned sum, cnt, mine, sp = 0u;
    for (;;) {
        sum = 0u; cnt = 0u; mine = 0u;
#pragma unroll
        for (unsigned j = 0; j < 16; ++j) { const unsigned c = xb_ld(&bar[XB_XCNT(j)]); sum += c; cnt += (c > 0u) ? 1u : 0u; mine = (j == x) ? c : mine; }
        if (sum == G) break;
        __builtin_amdgcn_s_sleep(1);
        if ((++sp & 255u) == 0u) { if (xb_ld(&bar[XB_TMO])) break; if (sp > XB_SPIN_CAP) { atomicAdd(&bar[XB_TMO], 1u); break; } }
    }
    nloc = mine > 0u ? mine : 1u; nx = cnt > 0u ? cnt : 1u;
}
__device__ __forceinline__ void xcd_barrier(const XcdBarrier& b, const int tid  ) {
    asm volatile("s_waitcnt vmcnt(0)" ::: "memory");
    __syncthreads();
    if (tid == 0) {
        unsigned* bar = b.bar;
        __builtin_amdgcn_s_waitcnt(0);
        unsigned nloc = b.st[0], nx = b.st[1];
        if (nloc == 0u) { xcd_barrier_complete(bar, b.x, nloc, nx); b.st[0] = nloc; b.st[1] = nx; }
        const unsigned old = xb_add(&bar[XB_XSUB(b.x)], 1u);
        const unsigned gen = old / nloc;
        if (old + 1u == (gen + 1u) * nloc) {
            __builtin_amdgcn_fence(__ATOMIC_RELEASE, "agent");
            asm volatile("s_waitcnt vmcnt(0)" ::: "memory");
            const unsigned og = xb_add(&bar[XB_TOP], 1u);
            const unsigned tg = og / nx;
            if (og + 1u == (tg + 1u) * nx) xb_add(&bar[XB_TOPGEN], 1u);
            else XB_SPIN(xb_ld(&bar[XB_TOPGEN]) == tg, bar);
            __builtin_amdgcn_fence(__ATOMIC_ACQUIRE, "agent");
            xb_add(&bar[XB_XGEN(b.x)], 1u);
            asm volatile("s_waitcnt vmcnt(0)" ::: "memory");
        } else {
            XB_SPIN(xb_ld(&bar[XB_XGEN(b.x)]) == gen, bar);
            __builtin_amdgcn_fence(__ATOMIC_ACQUIRE, "agent");
            asm volatile("s_waitcnt vmcnt(0)" ::: "memory");
        }
    }
    __syncthreads();
}

struct Args { const float* in[22]; float* out; unsigned char* ws; int ph_lo, ph_hi; };
typedef const __attribute__((address_space(4))) Args* KArgs;
#define KARGS() ({ KArgs p_ = (KArgs)__builtin_amdgcn_kernarg_segment_ptr(); asm volatile("" : "+s"(p_)); p_; })
struct Frame { LAS unsigned char* lds; int tid, lane, wave, vcu, G; };

__device__ __forceinline__ float wave_sum(float v, int lane) {
#pragma unroll
    for (int o = 1; o < 64; o <<= 1) v += shfl_xor_l(v, o, lane);
    return v;
}
__device__ const double ROPE_REV[32] = {
    1.59154943091895346e-01, 1.19349370211248862e-01, 8.94994016088910133e-02, 6.71150830052272551e-02, 5.03292121044870353e-02, 3.77415847174197711e-02, 2.83021958306233987e-02, 2.12236527647776604e-02,
    1.59154943091895339e-02, 1.19349370211248862e-02, 8.94994016088910237e-03, 6.71150830052272534e-03, 5.03292121044870370e-03, 3.77415847174197719e-03, 2.83021958306233987e-03, 2.12236527647776622e-03,
    1.59154943091895356e-03, 1.19349370211248849e-03, 8.94994016088910237e-04, 6.71150830052272599e-04, 5.03292121044870326e-04, 3.77415847174197741e-04, 2.83021958306233954e-04, 2.12236527647776605e-04,
    1.59154943091895351e-04, 1.19349370211248862e-04, 8.94994016088910182e-05, 6.71150830052272545e-05, 5.03292121044870354e-05, 3.77415847174197768e-05, 2.83021958306233961e-05, 2.12236527647776592e-05};

enum { MAP_ID = 0, MAP_WIN = 1, MAP_WUQ = 2 };
__device__ __forceinline__ int map_col(int mode, int n) {
    if (mode == MAP_ID) return n;
    if (mode == MAP_WIN) {
        if (n < 1024) return n;
        if (n < ZC_KR) return n + 64;
        if (n < ZC_KR + 64) { const int p = n - ZC_KR, i = p >> 1; return 1024 + ((p & 1) ? i + 32 : i); }
        if (n < ZC_G) return -1;
        return n - ZC_G + 3648;
    }
    if (n < 1024) return (n >> 7) * 192 + (n & 127);
    { const int r = n - 1024, h = r >> 6, p = r & 63, i = p >> 1; return h * 192 + 128 + ((p & 1) ? i + 32 : i); }
}
__device__ __forceinline__ void conv_item(const float* W, int K, int Nsrc, int nblk, const float* g, int mode, bf16* dst, int dst_ld, LAS float* scr, int item, int lane, bool tiled = false, int koff = 0) {
    const int kb = item / nblk, nb = item % nblk, k0 = 64 * kb, n0 = 32 * nb;
    const int s0 = map_col(mode, n0), s31 = map_col(mode, n0 + 31);
    if (s0 >= 0 && s31 == s0 + 31) {
        const int ks = lane >> 3, n4 = (lane & 7) * 4;
        f32x4 v[8]; float gk[8];
#pragma unroll
        for (int i = 0; i < 8; ++i) v[i] = *(const GAS f32x4*)(W + (size_t)(k0 + 8 * i + ks) * Nsrc + s0 + n4);
#pragma unroll
        for (int i = 0; i < 8; ++i) gk[i] = g ? g[k0 + 8 * i + ks] : 1.f;
#pragma unroll
        for (int i = 0; i < 8; ++i) { LAS float* p = scr + (8 * i + ks) * 33 + n4; const f32x4 x = v[i] * gk[i]; p[0] = x[0]; p[1] = x[1]; p[2] = x[2]; p[3] = x[3]; }
    } else {
        const int src = map_col(mode, n0 + (lane & 31));
#pragma unroll 8
        for (int i = 0; i < 32; ++i) { const int kk = 2 * i + (lane >> 5); float v = 0.f;
            if (src >= 0) { v = W[(size_t)(k0 + kk) * Nsrc + src]; if (g) v *= g[k0 + kk]; }
            scr[kk * 33 + (lane & 31)] = v; }
    }
    LDS_WAIT(); asm volatile("" ::: "memory");
    const int c = lane & 7;
#pragma unroll
    for (int j = 0; j < 4; ++j) { const int n = (lane >> 3) + 8 * j; const LAS float* s = scr + (8 * c) * 33 + n;
        v4u o; o.x = cvt_pk_bf16(s[0 * 33], s[1 * 33]); o.y = cvt_pk_bf16(s[2 * 33], s[3 * 33]); o.z = cvt_pk_bf16(s[4 * 33], s[5 * 33]); o.w = cvt_pk_bf16(s[6 * 33], s[7 * 33]);
        if (!tiled) *(GAS v4u*)(dst + (size_t)(n0 + n) * dst_ld + k0 + 8 * c) = o;
        else {
            const int nn = n0 + n, pn = nn >> 8, nt_ = nn & 255, h = nt_ >> 7, rr = nt_ & 127, w = rr & 31, slot = (rr & ~31) + 16 * ((w >> 2) & 1) + 4 * (w >> 3) + (w & 3);
            const int kk = koff + k0, kt = kk >> 6;
            *(GAS v4u*)((unsigned char*)dst + ((size_t)(pn * (dst_ld >> 6) + kt) * 2 + h) * 16384 + pg8::lds_byte(slot, 8 * c)) = o; } }
    LDS_WAIT(); asm volatile("" ::: "memory");
}
__device__ __forceinline__ void convert_layer(const Frame& F, KArgs ap, int l, unsigned char* ws) {
    LAS float* scr = (LAS float*)(F.lds + RING_OFF + F.wave * 16384);
    const int gw = F.vcu * NWAVES + F.wave, NGW = F.G * NWAVES;
    unsigned char* W = ws + WS_W;
    constexpr int I_IN = 32 * (NZW / 32), I_UQ = 8 * (NQC / 32), I_UKV = 8 * (NKVC / 32), I_MEM = 32 * 64, I_BR = 16 * 64, I_OUT = 32 * 64, I_UP = 32 * 256, I_DOWN = 128 * 64;
    constexpr int NITEMS = I_IN + I_UQ + I_UKV + I_MEM + 3 * I_BR + I_OUT + I_UP + I_DOWN;
    for (int it = gw; it < NITEMS; it += NGW) {
        int r = it;
        if (r < I_IN) { conv_item(ap->in[6] + (size_t)l * DM * NZSRC, DM, NZSRC, NZW / 32, ap->in[4] + l * DM, MAP_WIN, (bf16*)(W + WO_IN), DM, scr, r, F.lane, true); continue; } r -= I_IN;
        if (r < I_UQ) { conv_item(ap->in[9] + (size_t)l * 512 * NQC, 512, NQC, NQC / 32, ap->in[7] + l * 512, MAP_WUQ, (bf16*)(W + WO_UQ), 512, scr, r, F.lane, true); continue; } r -= I_UQ;
        if (r < I_UKV) { conv_item(ap->in[10] + (size_t)l * 512 * NKVC, 512, NKVC, NKVC / 32, ap->in[8] + l * 512, MAP_ID, (bf16*)(W + WO_UKV), 512, scr, r, F.lane, true); continue; } r -= I_UKV;
        if (r < I_MEM) { conv_item(ap->in[12] + (size_t)l * DM * 2048, DM, 2048, 64, ap->in[11] + l * DM, MAP_ID, (bf16*)(W + WO_MEM), DM, scr, r, F.lane); continue; } r -= I_MEM;
        if (r < 3 * I_BR) { const int br = r / I_BR; conv_item(ap->in[14 + br] + (size_t)l * 1024 * DM, 1024, DM, 64, nullptr, MAP_ID, (bf16*)(W + WO_BR), NABC, scr, r - br * I_BR, F.lane, true, br * 1024); continue; } r -= 3 * I_BR;
        if (r < I_OUT) { conv_item(ap->in[17] + (size_t)l * DM * DM, DM, DM, 64, nullptr, MAP_ID, (bf16*)(W + WO_OUT), DM, scr, r, F.lane, true); continue; } r -= I_OUT;
        if (r < I_UP) { conv_item(ap->in[20] + (size_t)l * DM * DFF, DM, DFF, 256, ap->in[18] + l * DM, MAP_ID, (bf16*)(W + WO_UP), DM, scr, r, F.lane, true); continue; } r -= I_UP;
        conv_item(ap->in[21] + (size_t)l * DFF * DM, DFF, DM, 64, nullptr, MAP_ID, (bf16*)(W + WO_DOWN), DFF, scr, r, F.lane, true);
    }
}
__device__ __forceinline__ void rms_row_to_bf16(const float* xrow, bf16* orow, float* rs_out, int lane) {
    f32x4 v[8]; float s = 0.f;
#pragma unroll
    for (int j = 0; j < 4; ++j) { v[2 * j] = *(const GAS f32x4*)(xrow + j * 512 + lane * 8); v[2 * j + 1] = *(const GAS f32x4*)(xrow + j * 512 + lane * 8 + 4); }
#pragma unroll
    for (int j = 0; j < 8; ++j) s += (v[j][0] * v[j][0] + v[j][1] * v[j][1]) + (v[j][2] * v[j][2] + v[j][3] * v[j][3]);
    const float ms = wave_sum(s, lane) * (1.f / DM) + EPS, r = __builtin_amdgcn_rsqf(ms);
    if (lane == 0) *rs_out = ms * r;
#pragma unroll
    for (int j = 0; j < 4; ++j) *(GAS v4u*)(orow + j * 512 + lane * 8) = epi::pack8(v[2 * j] * r, v[2 * j + 1] * r);
}
__device__ __forceinline__ void prologue(const Frame& F, KArgs ap, unsigned char* ws) {
    const int gw = F.vcu * NWAVES + F.wave, NGW = F.G * NWAVES;
    float* tab = (float*)(ws + WS_TAB);
    for (int e = blockIdx.x * 512 + F.tid; e < 8192 * 32; e += F.G * 512) {
        const int pos = e >> 5, i = e & 31;
        double rev = (double)pos * ROPE_REV[i]; rev -= floor(rev);
        const double q = rint(rev * 4.0); const double r = (rev - q * 0.25) * 6.283185307179586476925;
        const double r2 = r * r;
        const double sn = r * (1.0 + r2 * (-1.0 / 6 + r2 * (1.0 / 120 + r2 * (-1.0 / 5040 + r2 * (1.0 / 362880 - r2 * (1.0 / 39916800))))));
        const double cn = 1.0 + r2 * (-0.5 + r2 * (1.0 / 24 + r2 * (-1.0 / 720 + r2 * (1.0 / 40320 + r2 * (-1.0 / 3628800 + r2 * (1.0 / 479001600))))));
        const int qi = ((int)q) & 3;
        const double s_ = qi == 0 ? sn : qi == 1 ? cn : qi == 2 ? -sn : -cn;
        const double c_ = qi == 0 ? cn : qi == 1 ? -sn : qi == 2 ? -cn : sn;
        *(GAS f32x2*)(tab + (size_t)e * 2) = (f32x2){(float)c_, (float)s_};
    }
    float* rmem = (float*)(ws + WS_RMEM); bf16* memb = (bf16*)(ws + WS_MEMB);
    for (int m = gw; m < NMEMR; m += NGW) {
        const float* xrow = (m < 1024) ? ap->in[2] + (size_t)m * DM : ap->in[3] + (size_t)(m - 1024) * DM;
        f32x4 v[8]; float s = 0.f;
#pragma unroll
        for (int j = 0; j < 4; ++j) { v[2 * j] = *(const GAS f32x4*)(xrow + j * 512 + F.lane * 8); v[2 * j + 1] = *(const GAS f32x4*)(xrow + j * 512 + F.lane * 8 + 4); }
#pragma unroll
        for (int j = 0; j < 8; ++j) s += (v[j][0] * v[j][0] + v[j][1] * v[j][1]) + (v[j][2] * v[j][2] + v[j][3] * v[j][3]);
        const float r = __builtin_amdgcn_rsqf(wave_sum(s, F.lane) * (1.f / DM) + EPS);
        if (F.lane == 0) rmem[m] = r;
#pragma unroll
        for (int j = 0; j < 4; ++j) *(GAS v4u*)(memb + (size_t)m * DM + j * 512 + F.lane * 8) = epi::pack8(v[2 * j], v[2 * j + 1]);
    }
    bf16* xn = (bf16*)(ws + WS_XN);
    for (int m = gw; m < NTOK; m += NGW) {
        const float* xrow = (m < NPROMPT) ? ap->in[0] + (size_t)m * DM : ap->in[1] + (size_t)(m - NPROMPT) * DM;
        rms_row_to_bf16(xrow, xn + (size_t)m * DM, (float*)(ws + WS_RS) + m, F.lane);
    }
    convert_layer(F, ap, 0, ws);
}
__device__ __forceinline__ void norm_pass(const Frame& F, KArgs ap, bool first, bool last, const float* gpost, unsigned char* ws, bool dummy = false) {
    const int gw = F.vcu * NWAVES + F.wave, NGW = F.G * NWAVES;
    const bf16* Y = (const bf16*)(ws + WS_Y); bf16* xb = (bf16*)(ws + WS_XN); float* rsv = (float*)(ws + WS_RS);
    bf16* xbo = dummy ? (bf16*)(ws + WS_Z + 192 * MiB) : xb; float* rso = dummy ? (float*)(ws + WS_Z + 300 * MiB) : rsv; float* xout = dummy ? (float*)(ws + WS_Z) : ap->out;
    f32x4 g[8];
#pragma unroll
    for (int j = 0; j < 4; ++j) { g[2 * j] = *(const GAS f32x4*)(gpost + j * 512 + F.lane * 8); g[2 * j + 1] = *(const GAS f32x4*)(gpost + j * 512 + F.lane * 8 + 4); }
    for (int m = gw; m < NTOK; m += NGW) {
        f32x4 x[8], y[8]; float s = 0.f;
#pragma unroll
        for (int j = 0; j < 4; ++j) { const v4u w = *(const GAS v4u*)(Y + (size_t)m * DM + j * 512 + F.lane * 8);
            y[2 * j] = (f32x4){bf_lo(w.x), bf_hi(w.x), bf_lo(w.y), bf_hi(w.y)}; y[2 * j + 1] = (f32x4){bf_lo(w.z), bf_hi(w.z), bf_lo(w.w), bf_hi(w.w)}; }
        if (first) { const float* xrow = (m < NPROMPT) ? ap->in[0] + (size_t)m * DM : ap->in[1] + (size_t)(m - NPROMPT) * DM;
#pragma unroll
            for (int j = 0; j < 4; ++j) { x[2 * j] = *(const GAS f32x4*)(xrow + j * 512 + F.lane * 8); x[2 * j + 1] = *(const GAS f32x4*)(xrow + j * 512 + F.lane * 8 + 4); }
        } else {
            const float rms = rsv[m];
#pragma unroll
            for (int j = 0; j < 4; ++j) { const v4u w = *(const GAS v4u*)(xb + (size_t)m * DM + j * 512 + F.lane * 8);
                x[2 * j] = (f32x4){bf_lo(w.x), bf_hi(w.x), bf_lo(w.y), bf_hi(w.y)} * rms; x[2 * j + 1] = (f32x4){bf_lo(w.z), bf_hi(w.z), bf_lo(w.w), bf_hi(w.w)} * rms; }
        }
#pragma unroll
        for (int j = 0; j < 8; ++j) s += (y[j][0] * y[j][0] + y[j][1] * y[j][1]) + (y[j][2] * y[j][2] + y[j][3] * y[j][3]);
        const float r = __builtin_amdgcn_rsqf(wave_sum(s, F.lane) * (1.f / DM) + EPS);
        float s2 = 0.f;
#pragma unroll
        for (int j = 0; j < 8; ++j) { x[j] = x[j] + (y[j] * r) * g[j]; s2 += (x[j][0] * x[j][0] + x[j][1] * x[j][1]) + (x[j][2] * x[j][2] + x[j][3] * x[j][3]); }
        if (last) { float* orow = xout + (size_t)m * DM;
#pragma unroll
            for (int j = 0; j < 4; ++j) { *(GAS f32x4*)(orow + j * 512 + F.lane * 8) = x[2 * j]; *(GAS f32x4*)(orow + j * 512 + F.lane * 8 + 4) = x[2 * j + 1]; }
        } else {
            const float ms2 = wave_sum(s2, F.lane) * (1.f / DM) + EPS, r2 = __builtin_amdgcn_rsqf(ms2);
            if (F.lane == 0) rso[m] = ms2 * r2;
#pragma unroll
            for (int j = 0; j < 4; ++j) *(GAS v4u*)(xbo + (size_t)m * DM + j * 512 + F.lane * 8) = epi::pack8(x[2 * j] * r2, x[2 * j + 1] * r2);
        }
    }
}

constexpr int PH_PER_LAYER = 9, N_PHASES = 1 + DEPTH * PH_PER_LAYER;
#ifndef PH_MASK
#define PH_MASK 0x3ff
#endif
#define PH_EN(k) ((PH_MASK >> (k)) & 1)
#ifndef SUB_MASK
#define SUB_MASK 7
#endif
#define SUB_EN(k) ((SUB_MASK >> (k)) & 1)
#ifndef DUP_MASK
#define DUP_MASK 0
#endif
#define DUP_EN(k) ((DUP_MASK >> (k)) & 1)
__global__ void __launch_bounds__(NWAVES * 64, 2) fwd(Args args_unused) {
    extern __shared__ __attribute__((aligned(16))) unsigned char lds_raw[];
    (void)args_unused;
    LAS unsigned char* lds0 = (LAS unsigned char*)lds_raw;
    const int wave0 = __builtin_amdgcn_readfirstlane((int)threadIdx.x >> 6);
    volatile LAS unsigned* MISC = (volatile LAS unsigned*)(lds0 + MISC_OFF);
    for (int u = threadIdx.x; u < (XCH_OFF - LDSCTL_OFF) / 4; u += NWAVES * 64) ((LAS unsigned*)(lds0 + LDSCTL_OFF))[u] = 0u;
    __syncthreads();
#ifdef PROBE_CLOCK
    if (blockIdx.x == 0 && threadIdx.x == 0) { KArgs ap = KARGS(); unsigned long long* p = (unsigned long long*)(ap->ws + 512 * 1024); p[0] = __builtin_amdgcn_s_memtime(); p[1] = __builtin_amdgcn_s_memrealtime(); }
#endif
    int lo, hi; unsigned* barw;
    { KArgs ap = KARGS(); lo = ap->ph_lo; hi = ap->ph_hi; barw = (unsigned*)(ap->ws + WS_CTL) + CW_BAR; }
    if (MK_N_LAUNCHES == 1 || (hi - lo) > 1) (void)xcd_barrier_post(barw, MISC + 8);
    if (threadIdx.x == 0) { unsigned r = 0u; const unsigned x = xb_xcc_id();
        if (MK_N_LAUNCHES == 1) { KArgs ap_ = KARGS(); r = xb_add((unsigned*)(ap_->ws + WS_CTL) + CW_RANK + 64 * x, 1u); }
        MISC[20] = x; MISC[21] = r; MISC[22] = blockIdx.x; }
    __syncthreads();
#if MK_N_LAUNCHES == 1
#define IN(k) true
#else
#define IN(k) (lo <= (k) && (k) < hi)
#endif
#if defined(PROBE_WAIT) && PROBE_WAIT
#define PROBE_WAIT_BEGIN() do { if (wave0 * 64 + t_ == 0) { const unsigned long long r_ = __builtin_amdgcn_s_memrealtime(); MISC[16] = (unsigned)r_; } } while (0)
#define PROBE_WAIT_END() do { int t2_; asm volatile("v_mbcnt_lo_u32_b32 %0, -1, 0\n\tv_mbcnt_hi_u32_b32 %0, -1, %0" : "=v"(t2_)); if (wave0 * 64 + t2_ == 0) { const unsigned long long r_ = __builtin_amdgcn_s_memrealtime(); MISC[17] = MISC[17] + ((unsigned)r_ - MISC[16]); } } while (0)
#else
#define PROBE_WAIT_BEGIN() do {} while (0)
#define PROBE_WAIT_END() do {} while (0)
#endif
#define LOCAL_BAR() XcdBarrier bar; { KArgs ap_ = KARGS(); bar.bar = (unsigned*)(ap_->ws + WS_CTL) + CW_BAR; bar.x = xb_xcc_id(); bar.st = (volatile LAS unsigned*)((LAS unsigned char*)lds_raw + MISC_OFF) + 8; }
#define BARRIER_NOW() do { int t_; asm volatile("v_mbcnt_lo_u32_b32 %0, -1, 0\n\tv_mbcnt_hi_u32_b32 %0, -1, %0" : "=v"(t_)); LOCAL_BAR(); xcd_barrier(bar, wave0 * 64 + t_); } while (0)
#define SEAM(k) do { if (IN(k) && IN((k) + 1)) { int t_; asm volatile("v_mbcnt_lo_u32_b32 %0, -1, 0\n\tv_mbcnt_hi_u32_b32 %0, -1, %0" : "=v"(t_)); PROBE_WAIT_BEGIN(); LOCAL_BAR(); xcd_barrier(bar, wave0 * 64 + t_); PROBE_WAIT_END(); if (PROBE_XBAR) { xcd_barrier(bar, wave0 * 64 + t_); xcd_barrier(bar, wave0 * 64 + t_); } } } while (0)
#define PHASE_BASE() KArgs ap = KARGS(); unsigned char* ws = ap->ws; (void)ws; int bx_ = (int)((volatile LAS unsigned*)((LAS unsigned char*)lds_raw + MISC_OFF))[22], G_ = (int)gridDim.x, t_; asm volatile("v_mbcnt_lo_u32_b32 %0, -1, 0\n\tv_mbcnt_hi_u32_b32 %0, -1, %0" : "=v"(t_)); t_ += wave0 * 64; bx_ = __builtin_amdgcn_readfirstlane(bx_); asm volatile("" : "+s"(bx_), "+s"(G_)); const int bx = bx_, G = G_; (void)bx; (void)G; Frame F; F.lds = (LAS unsigned char*)lds_raw; F.tid = t_; F.lane = t_ & 63; F.wave = __builtin_amdgcn_readfirstlane(t_ >> 6); F.G = G; F.vcu = (G % 8 == 0) ? (bx % 8) * (G / 8) + bx / 8 : bx; LAS unsigned char* ring = F.lds + RING_OFF; LAS unsigned char* xl = F.lds + XCH_OFF; (void)ring; (void)xl
#define WSP(T, off) ((T*)(ws + (off)))

    if (PH_EN(0) && IN(0)) { PHASE_BASE(); prologue(F, ap, ws); }
    SEAM(0);
    if (MK_N_LAUNCHES == 1) {
        if (threadIdx.x == 0) { KArgs ap_ = KARGS(); unsigned* bw = (unsigned*)(ap_->ws + WS_CTL) + CW_BAR; const unsigned G = gridDim.x; bool even = (G % 8u) == 0u; unsigned npop = 0u;
            for (unsigned j = 0; j < 16; ++j) { const unsigned c = xb_ld(&bw[XB_XCNT(j)]); if (c) { ++npop; even = even && (c == G / 8u) && (j < 8u); } }
            if (even && npop == 8u && MISC[21] < G / 8u) MISC[22] = MISC[20] + 8u * MISC[21]; }
        __syncthreads();
    }

    for (int l = 0; l < DEPTH; ++l) {
        const int p0 = 1 + l * PH_PER_LAYER;
        for (int rep_ = 0; rep_ <= DUP_EN(1); ++rep_) { if (rep_) BARRIER_NOW();
        if (PH_EN(1) && IN(p0 + 0)) { PHASE_BASE();
            if (SUB_EN(0)) { pg8::Gemm g = pg8::plain_gemm(WSP(bf16, WS_XN), DM, ws + WS_W + WO_IN, DM, DM, true); pg8::StaticOrder S; S.init(NTOK / 256, NZW / 256, G, bx);
              epi::EpiZ E{WSP(bf16, WS_Z), WSP(float, WS_SSQ), WSP(const float, WS_TAB), ws + WS_GT}; pg8::gemm_phase<epi::EpiZ, pg8::StaticOrder>(F.tid, ring, xl, g, S, E); }
            if (SUB_EN(1)) { pg8::Gemm g = pg8::plain_gemm(WSP(bf16, WS_MEMB), DM, ws + WS_W + WO_MEM, DM, DM); pg8::StaticOrder S; S.init(NMEMR / 256, 4, G, (bx + G - 160 % G) % G);
              epi::EpiStore<1> E{WSP(bf16, WS_MEMK), 1024, 0, WSP(const float, WS_RMEM)}; pg8::gemm_phase<epi::EpiStore<1>, pg8::StaticOrder>(F.tid, ring, xl, g, S, E); }
            if (SUB_EN(2)) { pg8::Gemm g = pg8::plain_gemm(ws + WS_W + WO_MEM + (size_t)1024 * DM * 2, DM, WSP(bf16, WS_MEMB), DM, DM); pg8::StaticOrder S; S.init(4, NMEMR / 256, G, (bx + G - 180 % G) % G);
              epi::EpiStore<2> E{WSP(bf16, WS_MEMVT), NMEMR, 0, WSP(const float, WS_RMEM)}; pg8::gemm_phase<epi::EpiStore<2>, pg8::StaticOrder>(F.tid, ring, xl, g, S, E); }
        }
        }
        SEAM(p0 + 0);
        for (int rep_ = 0; rep_ <= DUP_EN(2); ++rep_) { if (rep_) BARRIER_NOW();
        if (PH_EN(2) && IN(p0 + 1)) { PHASE_BASE();
            if (SUB_EN(0)) { pg8::Gemm g = pg8::plain_gemm(WSP(bf16, WS_Z) + ZC_CQ, NZ, ws + WS_W + WO_UQ, 512, 512, true); pg8::StaticOrder S; S.init(NTOK / 256, NQC / 256, G, bx);
              epi::EpiLat<0> E{WSP(bf16, WS_Q), WSP(const float, WS_SSQ), WSP(const float, WS_TAB)}; pg8::gemm_phase<epi::EpiLat<0>, pg8::StaticOrder>(F.tid, ring, xl, g, S, E); }
            if (SUB_EN(1)) { pg8::Gemm g = pg8::plain_gemm(WSP(bf16, WS_Z) + ZC_CKV, NZ, ws + WS_W + WO_UKV, 512, 512, true); pg8::StaticOrder S; S.init(NTOK / 256, NKVC / 256, G, bx);
              epi::EpiLat<1> E{WSP(bf16, WS_KV), WSP(const float, WS_SSQ), WSP(const float, WS_TAB)}; pg8::gemm_phase<epi::EpiLat<1>, pg8::StaticOrder>(F.tid, ring, xl, g, S, E); }
            if (SUB_EN(2)) { pg8::Gemm g; g.A = (const char*)(WSP(bf16, WS_Z) + ZC_QM); g.B = (const char*)WSP(bf16, WS_MEMK); g.a_pm = (long)256 * NZ * 2; g.a_pn = 512; g.b_pn = 512; g.b_sq = (long)256 * 1024 * 2; g.lda = NZ; g.ldb = 1024; g.K = 256; g.b_tiled = false;
              pg8::StaticOrder S; S.init(NTOK / 256, 4, G, (bx + G - 64 % G) % G);
              epi::EpiSoftmax E{WSP(bf16, WS_PM)}; pg8::gemm_phase<epi::EpiSoftmax, pg8::StaticOrder>(F.tid, ring, xl, g, S, E); }
        }
        }
        SEAM(p0 + 1);
        for (int rep_ = 0; rep_ <= DUP_EN(3); ++rep_) { if (rep_) BARRIER_NOW();
        if (PH_EN(3) && IN(p0 + 2)) {
            if (SUB_EN(0)) { PHASE_BASE(); for (int n = F.vcu; n < 768; n += G) {
                const int i = n >> 8, v = n & 255, x = v >> 5, j = v & 31;
                int h, qm0, km0, NT;
                if (i < 2) { const int pair = 4 * x + 2 * i + (j >> 4), b = pair >> 3; h = pair & 7; qm0 = b * 4096 + (j & 15) * 256; km0 = b * 4096; NT = 64; }
                else { h = x; qm0 = NPROMPT + j * 256; km0 = NPROMPT; NT = 128; }
                att::Mask mk{0, 0.f};
                att::attn_unit<0>(WSP(bf16, WS_Q), WSP(bf16, WS_KV), WSP(bf16, WS_Z), WSP(bf16, WS_ABC), qm0, km0, NT, h, h * 128, -1.0e30f, 0.f, mk, (LAS char*)ring, wave0 * 64);
            } }
            if (SUB_EN(1)) { PHASE_BASE(); const float* sink = ap->in[13] + l * 8;
              for (int n = F.vcu; n < 768; n += G) {
                const int qblk = n >> 3, h = n & 7;
                const int sstart = qblk < 64 ? (qblk >> 4) * 4096 : NPROMPT, SL = qblk < 64 ? 4096 : 8192;
                const int qm0 = qblk * 256, q0 = qm0 - sstart;
                const int klo = (q0 - 128) < 0 ? 0 : (q0 - 128), khi = (q0 + 384) > SL ? SL : (q0 + 384);
                att::Mask mk; mk.dq = q0 - klo; mk.sl = LOG2E * __builtin_amdgcn_exp2f(-(float)(h + 1));
                att::attn_unit<1>(WSP(bf16, WS_Q), WSP(bf16, WS_KV), WSP(bf16, WS_Z), WSP(bf16, WS_ABC), qm0, sstart + klo, (khi - klo) >> 6, h, 1024 + h * 128, sink[h] * LOG2E, 1.f, mk, (LAS char*)ring, wave0 * 64);
              } }
            if (SUB_EN(2)) { PHASE_BASE(); pg8::Gemm g; g.A = (const char*)WSP(bf16, WS_PM); g.B = (const char*)WSP(bf16, WS_MEMVT); g.a_pm = (long)256 * 1024 * 2; g.a_pn = 512; g.b_pn = (long)256 * NMEMR * 2; g.b_sq = 512; g.lda = 1024; g.ldb = NMEMR; g.K = 256; g.b_tiled = false;
              pg8::StaticOrder S; S.init(NTOK / 256, 4, G, bx);
              epi::EpiStore<0> E{WSP(bf16, WS_ABC), NABC, 2048, nullptr}; pg8::gemm_phase<epi::EpiStore<0>, pg8::StaticOrder>(F.tid, ring, xl, g, S, E); }
        }
        }
        SEAM(p0 + 2);
        for (int rep_ = 0; rep_ <= DUP_EN(4); ++rep_) { if (rep_) BARRIER_NOW();
        if (PH_EN(4) && IN(p0 + 3)) { PHASE_BASE();
            pg8::Gemm g = pg8::plain_gemm(WSP(bf16, WS_ABC), NABC, ws + WS_W + WO_BR, NABC, NABC, true); pg8::StaticOrder S; S.init(NTOK / 256, DM / 256, G, bx);
            epi::EpiBranch E{WSP(bf16, WS_MERGED), ws + WS_GT}; pg8::gemm_phase<epi::EpiBranch, pg8::StaticOrder>(F.tid, ring, xl, g, S, E);
        }
        }
        SEAM(p0 + 3);
        for (int rep_ = 0; rep_ <= DUP_EN(5); ++rep_) { if (rep_) BARRIER_NOW();
        if (PH_EN(5) && IN(p0 + 4)) { PHASE_BASE();
            pg8::Gemm g = pg8::plain_gemm(WSP(bf16, WS_MERGED), DM, ws + WS_W + WO_OUT, DM, DM, true); pg8::StaticOrder S; S.init(NTOK / 256, DM / 256, G, bx);
            epi::EpiStore<0> E{WSP(bf16, WS_Y), DM, 0, nullptr}; pg8::gemm_phase<epi::EpiStore<0>, pg8::StaticOrder>(F.tid, ring, xl, g, S, E);
        }
        }
        SEAM(p0 + 4);
        if (PH_EN(6) && IN(p0 + 5)) { PHASE_BASE(); if (DUP_EN(6)) norm_pass(F, ap, l == 0, false, ap->in[5] + l * DM, ws, true); norm_pass(F, ap, l == 0, false, ap->in[5] + l * DM, ws); }
        SEAM(p0 + 5);
        for (int rep_ = 0; rep_ <= DUP_EN(7); ++rep_) { if (rep_) BARRIER_NOW();
        if (PH_EN(7) && IN(p0 + 6)) { PHASE_BASE();
            pg8::Gemm g = pg8::plain_gemm(WSP(bf16, WS_XN), DM, ws + WS_W + WO_UP, DM, DM, true); pg8::StaticOrder S; S.init(NTOK / 256, DFF / 256, G, bx);
            epi::EpiStore<3> E{WSP(bf16, WS_U), DFF, 0, nullptr}; pg8::gemm_phase<epi::EpiStore<3>, pg8::StaticOrder>(F.tid, ring, xl, g, S, E);
        }
        }
        SEAM(p0 + 6);
        for (int rep_ = 0; rep_ <= DUP_EN(8); ++rep_) { if (rep_) BARRIER_NOW();
        if (PH_EN(8) && IN(p0 + 7)) { PHASE_BASE();
            pg8::Gemm g = pg8::plain_gemm(WSP(bf16, WS_U), DFF, ws + WS_W + WO_DOWN, DFF, DFF, true); pg8::StaticOrder S; S.init(NTOK / 256, DM / 256, G, bx);
            epi::EpiStore<0> E{WSP(bf16, WS_Y), DM, 0, nullptr}; pg8::gemm_phase<epi::EpiStore<0>, pg8::StaticOrder>(F.tid, ring, xl, g, S, E);
        }
        }
        SEAM(p0 + 7);
        if (PH_EN(9) && IN(p0 + 8)) { PHASE_BASE(); norm_pass(F, ap, false, l + 1 == DEPTH, ap->in[19] + l * DM, ws); if (l + 1 < DEPTH) { convert_layer(F, ap, l + 1, ws); if (DUP_EN(9)) convert_layer(F, ap, l + 1, ws); } }
        SEAM(p0 + 8);
    }
#if defined(PROBE_WAIT) && PROBE_WAIT
    { KArgs ap = KARGS(); unsigned* pw = (unsigned*)(ap->ws + 512 * 1024 + 256);
      if (threadIdx.x == 0) { const unsigned w = MISC[17]; atomicMax(pw + 0, w); atomicMin(pw + 64, 0xffffffffu - w); atomicAdd(pw + 128, w / 256u); }
      BARRIER_NOW();
      if (blockIdx.x == 0 && threadIdx.x == 0) { const unsigned v = PROBE_WAIT == 1 ? __hip_atomic_load(pw + 0, RLX_AGENT) : PROBE_WAIT == 2 ? 0xffffffffu - __hip_atomic_load(pw + 64, RLX_AGENT) : __hip_atomic_load(pw + 128, RLX_AGENT);
        const unsigned long long r1 = __builtin_amdgcn_s_memrealtime(); while (__builtin_amdgcn_s_memrealtime() - r1 < (unsigned long long)v) __builtin_amdgcn_s_sleep(32); } }
#endif
#ifdef PROBE_CLOCK
    { BARRIER_NOW(); if (blockIdx.x == 0 && threadIdx.x == 0) { const unsigned long long ck1 = __builtin_amdgcn_s_memtime(), rt1 = __builtin_amdgcn_s_memrealtime(); KArgs ap = KARGS(); const unsigned long long* p = (const unsigned long long*)(ap->ws + 512 * 1024);
        const unsigned long long mhz = (ck1 - p[0]) * 100ull / (rt1 - p[1]);
        while (__builtin_amdgcn_s_memrealtime() - rt1 < mhz * 100ull) __builtin_amdgcn_s_sleep(32); } }
#endif
#undef IN
#undef SEAM
}


#ifndef DBG_LAST
#define DBG_LAST -1
#endif
#ifndef DBG_DUMP_MASK
#define DBG_DUMP_MASK 0xff
#endif
#if DBG_LAST >= 0
__global__ void __launch_bounds__(256) dbg_dump(float* out, const unsigned char* ws) {
    const bf16* Z = (const bf16*)(ws + WS_Z); const bf16* Q = (const bf16*)(ws + WS_Q); const bf16* KV = (const bf16*)(ws + WS_KV); const bf16* PM = (const bf16*)(ws + WS_PM);
    const bf16* ABC = (const bf16*)(ws + WS_ABC); const bf16* MG = (const bf16*)(ws + WS_MERGED); const bf16* XN = (const bf16*)(ws + WS_XN); const bf16* Y = (const bf16*)(ws + WS_Y);
    for (size_t e = (size_t)blockIdx.x * 256 + threadIdx.x; e < (size_t)NTOK * DM; e += (size_t)gridDim.x * 256) {
        const size_t m = e / DM; const int c = (int)(e % DM); float v = 0.f;
        auto f = [](bf16 b) { return __uint_as_float((unsigned)b << 16); };
        if (DBG_DUMP_MASK & 1) v += f(XN[m * DM + c]);
        if (DBG_DUMP_MASK & 2) v += f(Z[m * NZ + c]) + f(Z[m * NZ + 2048 + (c % 1792)]);
        if (DBG_DUMP_MASK & 8) v += f(Q[m * NQC + (c % NQC)]) + f(KV[m * NKVC + c]);
        if (DBG_DUMP_MASK & 16) v += f(PM[m * 1024 + (c & 1023)]);
        if (DBG_DUMP_MASK & 32) v += f(ABC[m * NABC + c]) + f(ABC[m * NABC + 1024 + c]);
        if (DBG_DUMP_MASK & 64) v += f(MG[m * DM + c]);
        if (DBG_DUMP_MASK & 128) v += f(Y[m * DM + c]);
        if (DBG_DUMP_MASK & 256) v += f(((const bf16*)(ws + WS_W))[e]) + f(((const bf16*)(ws + WS_W))[e + 20000000]);
        out[e] = v;
    }
}
#endif

extern "C" void kernel_launch(void* const* d_in, const int* in_sizes, int n_in, void* d_out, int out_size, void* d_ws, size_t ws_size, hipStream_t stream) {
    static int grid = 0;
    if (grid == 0) {
        if (n_in != 22 || out_size != NTOK * DM || ws_size < WS_END) { fprintf(stderr, "kernel_launch: unexpected shapes (n_in %d out %d ws %zu)\n", n_in, out_size, ws_size); grid = -1; return; }
        int dev = 0, cus = 0, per_cu = 0;
        if (hipGetDevice(&dev) != hipSuccess || hipDeviceGetAttribute(&cus, hipDeviceAttributeMultiprocessorCount, dev) != hipSuccess) { grid = -1; return; }
        if (hipFuncSetAttribute((const void*)fwd, hipFuncAttributeMaxDynamicSharedMemorySize, LDS_BYTES) != hipSuccess) { fprintf(stderr, "kernel_launch: hipFuncSetAttribute failed\n"); grid = -1; return; }
        if (hipOccupancyMaxActiveBlocksPerMultiprocessor(&per_cu, (const void*)fwd, NWAVES * 64, LDS_BYTES) != hipSuccess || per_cu < 1)
            fprintf(stderr, "kernel_launch: note: occupancy query reports %d workgroups per CU\n", per_cu);
        (void)hipGetLastError();
        grid = cus;
    }
    if (grid < 0) return;
    (void)in_sizes;
    if (hipMemsetAsync((char*)d_ws + WS_CTL, 0, CTL_ZERO_BYTES, stream) != hipSuccess) return;
    Args a{};
    for (int i = 0; i < 22; ++i) a.in[i] = (const float*)d_in[i];
    a.out = (float*)d_out; a.ws = (unsigned char*)d_ws;
#if MK_N_LAUNCHES == 1
    a.ph_lo = 0; a.ph_hi = N_PHASES;
    hipLaunchKernelGGL(fwd, dim3(grid), dim3(NWAVES * 64), LDS_BYTES, stream, a);
#else
#if DBG_LAST >= 0
    for (int k = 0; k <= DBG_LAST; ++k) { a.ph_lo = k; a.ph_hi = k + 1; hipLaunchKernelGGL(fwd, dim3(grid), dim3(NWAVES * 64), LDS_BYTES, stream, a); }
    hipLaunchKernelGGL(dbg_dump, dim3(2048), dim3(256), 0, stream, (float*)d_out, (const unsigned char*)d_ws);
#else
    for (int k = 0; k < N_PHASES; ++k) { a.ph_lo = k; a.ph_hi = k + 1; hipLaunchKernelGGL(fwd, dim3(grid), dim3(NWAVES * 64), LDS_BYTES, stream, a); }
#endif
#endif
    const hipError_t le = hipPeekAtLastError();
    if (le != hipSuccess) fprintf(stderr, "kernel_launch: launch failed: %s\n", hipGetErrorName(le));
}
```

```cpp
#include <hip/hip_runtime.h>
#include <cstdio>
#include <cstdint>

#define DBG_LAST -1
#define DBG_DUMP_MASK 0x6

#define PROBE_XBAR 0
#define PROBE_WAIT 0
#ifndef MK_N_LAUNCHES
#define MK_N_LAUNCHES 1
#endif

constexpr int DM = 2048, NTOK = 24576, NPROMPT = 16384, DEPTH = 4, DFF = 8192;
constexpr int NZW = 9984, NZ = 3840, NZSRC = 9792;
constexpr int ZC_CQ = 0, ZC_CKV = 512, ZC_QW = 1024, ZC_KW = 2048, ZC_VW = 2304, ZC_QM = 2560, ZC_KR = 3584, ZC_G = 3840;
constexpr int NQC = 1536, NKVC = 2048, NMEMR = 1280, NABC = 3072;
constexpr float EPS = 1e-6f;
constexpr float LOG2E = 1.4426950408889634f;
constexpr float C_W = 0.088388347648318440f * LOG2E;
constexpr float C_M = 0.0625f * LOG2E;
constexpr float C_Q = 0.072168783648703220f * LOG2E;

constexpr size_t MiB = 1u << 20;
constexpr size_t WS_CTL = 0, CTL_ZERO_BYTES = 1 * MiB;
constexpr size_t WS_TAB = 2 * MiB;
constexpr size_t WS_RMEM = 4 * MiB;
constexpr size_t WS_RS = 5 * MiB;
constexpr size_t WS_SSQ = 6 * MiB;
constexpr size_t WS_MEMB = 8 * MiB;
constexpr size_t WS_MEMK = 13 * MiB;
constexpr size_t WS_MEMVT = 16 * MiB;
constexpr size_t WS_W = 32 * MiB;
constexpr size_t WO_IN = 0, WO_UQ = WO_IN + (size_t)NZW * DM * 2, WO_UKV = WO_UQ + (size_t)NQC * 512 * 2, WO_MEM = WO_UKV + (size_t)NKVC * 512 * 2,
                 WO_BR = WO_MEM + (size_t)2048 * DM * 2, WO_OUT = WO_BR + (size_t)DM * NABC * 2, WO_UP = WO_OUT + (size_t)DM * DM * 2,
                 WO_DOWN = WO_UP + (size_t)DFF * DM * 2, WO_END = WO_DOWN + (size_t)DM * DFF * 2;
static_assert(WO_END <= 136 * MiB, "weights region");
constexpr size_t WS_XN = 168 * MiB;
constexpr size_t WS_Z = 264 * MiB;
constexpr size_t WS_GT = 444 * MiB;
constexpr size_t WS_U = WS_Z;
constexpr size_t WS_Q = 732 * MiB;
constexpr size_t WS_KV = 804 * MiB;
constexpr size_t WS_PM = 900 * MiB;
constexpr size_t WS_ABC = 948 * MiB;
constexpr size_t WS_MERGED = 732 * MiB;
constexpr size_t WS_Y = 828 * MiB;
constexpr size_t WS_END = 1092 * MiB;
static_assert(WS_Z + (size_t)NTOK * NZ * 2 <= WS_GT && WS_GT + (size_t)3 * 96 * 8 * 131072 <= WS_Q && WS_MERGED + (size_t)NTOK * DM * 2 <= WS_Y && WS_Y + (size_t)NTOK * DM * 2 <= WS_ABC, "ws map");
constexpr int CW_TMO = 0, CW_BAR = 4096, CW_RANK = 16384;

constexpr int RING_OFF = 0, RING_BYTES = 131072;
constexpr int LDSCTL_OFF = RING_BYTES, MISC_OFF = LDSCTL_OFF + 320;
constexpr int XCH_OFF = RING_BYTES + 1024;
constexpr int LDS_BYTES = 147456;
static_assert(XCH_OFF + 8192 <= LDS_BYTES, "LDS map");
constexpr int NWAVES = 8;

#define GAS __attribute__((address_space(1)))
#define LAS __attribute__((address_space(3)))
typedef unsigned short bf16;
typedef unsigned v4u __attribute__((ext_vector_type(4)));
typedef float f32x4 __attribute__((ext_vector_type(4)));
typedef float f32x2 __attribute__((ext_vector_type(2)));
typedef short bf16x8 __attribute__((ext_vector_type(8)));
typedef GAS unsigned gu32;
#define RLX_AGENT __ATOMIC_RELAXED, __HIP_MEMORY_SCOPE_AGENT
#define LDS_WAIT() asm volatile("s_waitcnt lgkmcnt(0)" ::: "memory")
#define VM_WAIT() asm volatile("s_waitcnt vmcnt(0)" ::: "memory")

typedef float f32x2_t __attribute__((ext_vector_type(2))); typedef __bf16 bf16x2_t __attribute__((ext_vector_type(2)));
__device__ __forceinline__ unsigned cvt_pk_bf16(float lo, float hi) { const f32x2_t v = {lo, hi}; const bf16x2_t b = __builtin_convertvector(v, bf16x2_t); return __builtin_bit_cast(unsigned, b); }
__device__ __forceinline__ float bf_lo(unsigned w) { return __uint_as_float(w << 16); }
__device__ __forceinline__ float bf_hi(unsigned w) { return __uint_as_float(w & 0xffff0000u); }
__device__ __forceinline__ float shfl_xor_l(float v, int m, int lane) { return __int_as_float(__builtin_amdgcn_ds_bpermute((lane ^ m) << 2, __float_as_int(v))); }
__device__ __forceinline__ int seq_pos(int m) { return m < NPROMPT ? (m & 4095) : (m - NPROMPT); }
__device__ __forceinline__ int seq_of_panel(int pm) { return pm < 64 ? (pm >> 4) : 4; }

#ifndef PG8_BALANCED
#define PG8_BALANCED 1
#endif
namespace pg8 {
#define PG8_LAS __attribute__((address_space(3)))
typedef unsigned short bf16_t;
typedef short bf16x8 __attribute__((ext_vector_type(8)));
typedef float f32x4 __attribute__((ext_vector_type(4)));
typedef unsigned u32x4 __attribute__((ext_vector_type(4)));
constexpr int BM = 256, BK = 64, HALF = 128, HTB = HALF * BK * 2, STAGE_BYTES = 8 * HTB, NXCD = 8, WGM = 4;

__host__ __device__ __forceinline__ int lds_byte(int r, int c) { const int st = (r >> 4) * 2 + (c >> 5), rr = r & 15, cc = c & 31, ob = rr * 64 + cc * 2; return st * 1024 + (ob ^ (((ob >> 9) & 1) << 5)); }
__host__ __device__ __forceinline__ void stage_rc(int b, int& R, int& C) { const int st = b / 1024, sb = b % 1024, swz = sb ^ (((sb >> 9) & 1) << 5); R = (st >> 1) * 16 + swz / 64; C = (st & 1) * 32 + (swz % 64) / 2; }
__host__ __device__ __forceinline__ int perm32(int rho) { const int n = rho >> 4, i = rho & 15; return 8 * (i >> 2) + 4 * n + (i & 3); }

struct Unit { int pm, pn; };
struct Gemm { const char* A; const char* B; long a_pm, a_pn, b_pn, b_sq; int lda, ldb, K; bool b_tiled;
    __device__ __forceinline__ const char* aptr(const Unit& u) const { return A + (long)u.pm * a_pm + (long)u.pn * a_pn; }
    __device__ __forceinline__ const char* bptr(const Unit& u) const { return B + (long)u.pn * b_pn + (long)seq_of_panel(u.pm) * b_sq; } };
__device__ __forceinline__ Gemm plain_gemm(const void* A, int lda, const void* B, int ldb, int K, bool b_tiled = false) {
    Gemm g; g.A = (const char*)A; g.B = (const char*)B; g.a_pm = (long)BM * lda * 2; g.a_pn = 0; g.b_pn = b_tiled ? (long)(ldb / BK) * 32768 : (long)BM * ldb * 2; g.b_sq = 0; g.lda = lda; g.ldb = ldb; g.K = K; g.b_tiled = b_tiled; return g; }

struct StaticOrder {
    int nM, nN, nwg, G, c;
    __host__ __device__ void init(int nM_, int nN_, int G_, int c_) { nM = nM_; nN = nN_; nwg = nM * nN; G = G_; c = c_; }
    __host__ __device__ bool next(int i, Unit& u) const {
        const int L = i * G + c; if (L >= nwg) return false;
        int wgid = L; { const int q = nwg / NXCD, r = nwg % NXCD, xcd = wgid % NXCD, off = wgid / NXCD; wgid = (xcd < r ? xcd * (q + 1) : r * (q + 1) + (xcd - r) * q) + off; }
        const int nig = WGM * nN, gid = wgid / nig, fm = gid * WGM, gsz = (nM - fm) < WGM ? (nM - fm) : WGM;
        u.pm = fm + ((wgid % nig) % gsz); u.pn = (wgid % nig) / gsz; return true;
    }
};

typedef f32x4 Acc[2][2][4][2];

template <class Epi, class Sched, bool ALIGN_EPI = true, bool SP2 = true>
__device__ __forceinline__ void gemm_phase(int tid_in, PG8_LAS unsigned char* lds, PG8_LAS unsigned char* xlds, const Gemm g, const Sched& S, const Epi& E) {
    int tid_ = tid_in; asm volatile("" : "+v"(tid_));
    const int tid = tid_, wid = __builtin_amdgcn_readfirstlane(tid >> 6), lane = tid & 63, wr = wid >> 2, wc = wid & 3, fr = lane & 15, fq = lane >> 4;
    const int K = g.K, nt = K / BK;
    unsigned voffA[2], voffB[2];
#pragma unroll
    for (int i = 0; i < 2; ++i) { int R, C; stage_rc(tid * 16 + i * 8192, R, C); const int Rb = Epi::PERM ? ((R & ~31) + perm32(R & 31)) : R;
        voffA[i] = (unsigned)(R * g.lda + C) * 2u; voffB[i] = g.b_tiled ? (unsigned)(tid * 16 + i * 8192) : (unsigned)(Rb * g.ldb + C) * 2u; }
    const size_t kstep = (size_t)(BK * 2), kstepB = g.b_tiled ? (size_t)32768 : (size_t)(BK * 2);
    const size_t hstepA = (size_t)HALF * g.lda * 2, hstepB = g.b_tiled ? (size_t)16384 : (size_t)HALF * g.ldb * 2;
    const unsigned ldsw = (unsigned)wid * 1024u;
    const int aoff = lds_byte(wr * 64 + fr, fq * 8), boff = lds_byte(wc * 32 + fr, fq * 8);
#define PG8_SA(b, h) (((b) * 2 + (h)) * HTB)
#define PG8_SB(b, h) ((4 + (b) * 2 + (h)) * HTB)
#define PG8_STAGE(bufoff, gbase, voff) do { _Pragma("unroll") for (int _i = 0; _i < 2; ++_i) \
        __builtin_amdgcn_global_load_lds((const unsigned*)((const char*)(gbase) + (voff)[_i]), (PG8_LAS unsigned*)(lds + (bufoff) + ldsw + _i * 8192), 16, 0, 0); } while (0)
#define PG8_LDA(dst, b, h) do { _Pragma("unroll") for (int m = 0; m < 4; ++m) _Pragma("unroll") for (int k = 0; k < 2; ++k) dst[m][k] = *(const PG8_LAS bf16x8*)(lds + PG8_SA(b, h) + aoff + m * 2048 + k * 1024); } while (0)
#define PG8_LDB(dst, b, h) do { _Pragma("unroll") for (int n = 0; n < 2; ++n) _Pragma("unroll") for (int k = 0; k < 2; ++k) dst[n][k] = *(const PG8_LAS bf16x8*)(lds + PG8_SB(b, h) + boff + n * 2048 + k * 1024); } while (0)
#define PG8_MMA(ai, bj, At, Bt) do { __builtin_amdgcn_s_setprio(1); _Pragma("unroll") for (int m = 0; m < 4; ++m) _Pragma("unroll") for (int n = 0; n < 2; ++n) _Pragma("unroll") for (int k = 0; k < 2; ++k) \
        acc[ai][bj][m][n] = __builtin_amdgcn_mfma_f32_16x16x32_bf16(Bt[n][k], At[m][k], acc[ai][bj][m][n], 0, 0, 0); __builtin_amdgcn_s_setprio(0); } while (0)
#define PG8_WAIT_V(n) asm volatile("s_waitcnt vmcnt(" #n ")" ::: "memory")
#define PG8_WAIT_L(n) asm volatile("s_waitcnt lgkmcnt(" #n ")" ::: "memory")
#define PG8_BAR __builtin_amdgcn_s_barrier()
#define PG8_SCHED __builtin_amdgcn_sched_barrier(0)
    Unit cur, nxt; int ui = 0;
    if (!S.next(0, cur)) return;
    f32x4 acc[2][2][4][2];
#pragma unroll
    for (int a = 0; a < 2; ++a)
#pragma unroll
        for (int b = 0; b < 2; ++b)
#pragma unroll
            for (int m = 0; m < 4; ++m)
#pragma unroll
                for (int n = 0; n < 2; ++n) acc[a][b][m][n] = (f32x4){0.f, 0.f, 0.f, 0.f};
    bf16x8 At[4][2], B0[2][2], B1[2][2];
    const char* cA = g.aptr(cur); const char* cB = g.bptr(cur);
    if constexpr (SP2 && PG8_BALANCED) {
        PG8_STAGE(PG8_SB(0, 0), cB, voffB); PG8_STAGE(PG8_SB(0, 1), cB + hstepB, voffB); PG8_STAGE(PG8_SA(0, 0), cA, voffA); PG8_STAGE(PG8_SA(0, 1), cA + hstepA, voffA);
        if (wr == 1) PG8_BAR;
        PG8_WAIT_V(2); PG8_BAR;
        PG8_STAGE(PG8_SB(1, 0), cB + kstepB, voffB); PG8_STAGE(PG8_SB(1, 1), cB + hstepB + kstepB, voffB);
        PG8_WAIT_V(4); PG8_BAR;
    } else if constexpr (SP2) {
        PG8_STAGE(PG8_SB(0, 0), cB, voffB); PG8_STAGE(PG8_SB(0, 1), cB + hstepB, voffB); PG8_STAGE(PG8_SA(0, 0), cA, voffA); PG8_STAGE(PG8_SA(0, 1), cA + hstepA, voffA);
        if (wr == 1) PG8_BAR;
        PG8_WAIT_V(2); PG8_BAR;
        PG8_STAGE(PG8_SB(1, 0), cB + kstepB, voffB); PG8_STAGE(PG8_SA(1, 0), cA + kstep, voffA); PG8_STAGE(PG8_SB(1, 1), cB + hstepB + kstepB, voffB);
        PG8_WAIT_V(6); PG8_BAR;
    } else {
        PG8_STAGE(PG8_SB(0, 0), cB, voffB); PG8_STAGE(PG8_SA(0, 0), cA, voffA); PG8_STAGE(PG8_SB(0, 1), cB + hstepB, voffB); PG8_STAGE(PG8_SA(0, 1), cA + hstepA, voffA);
        if (wr == 1) PG8_BAR;
        PG8_WAIT_V(4); PG8_BAR;
        PG8_STAGE(PG8_SB(1, 0), cB + kstepB, voffB); PG8_STAGE(PG8_SA(1, 0), cA + kstep, voffA); PG8_STAGE(PG8_SB(1, 1), cB + hstepB + kstepB, voffB);
        PG8_WAIT_V(6); PG8_BAR;
    }
    for (;;) {
        const bool has_next = S.next(ui + 1, nxt);
        const char* nA = has_next ? g.aptr(nxt) : cA; const char* nB = has_next ? g.bptr(nxt) : cB;
        for (int t = 0; t < nt; t += 2) {
            const bool last = (t == nt - 2);
            if constexpr (Epi::HAS_MID) { if (t == Epi::MID1 || t == Epi::MID2) E.mid(acc, cur, t, wr, wc, fr, fq); }
            const char* a1 = cA + (size_t)(t + 1) * kstep;
            const char* a2 = last ? nA : cA + (size_t)(t + 2) * kstep; const char* b2 = last ? nB : cB + (size_t)(t + 2) * kstepB;
            const char* a3 = a2 + kstep; const char* b3 = b2 + kstepB;
            if constexpr (SP2 && PG8_BALANCED) {
            PG8_LDB(B0, 0, 0); PG8_LDB(B1, 0, 1); PG8_SCHED; PG8_LDA(At, 0, 0); PG8_STAGE(PG8_SA(1, 0), a1, voffA); PG8_STAGE(PG8_SA(1, 1), a1 + hstepA, voffA);
            PG8_WAIT_V(8); PG8_WAIT_L(0); PG8_BAR; PG8_MMA(0, 0, At, B0); PG8_MMA(0, 1, At, B1); PG8_BAR; PG8_SCHED;
            PG8_LDA(At, 0, 1); PG8_STAGE(PG8_SB(0, 0), b2, voffB); PG8_STAGE(PG8_SB(0, 1), b2 + hstepB, voffB);
            PG8_WAIT_V(6); PG8_WAIT_L(0); PG8_BAR; PG8_MMA(1, 0, At, B0); PG8_MMA(1, 1, At, B1); PG8_BAR; PG8_SCHED;
            PG8_LDB(B0, 1, 0); PG8_LDB(B1, 1, 1); PG8_SCHED; PG8_LDA(At, 1, 0); PG8_STAGE(PG8_SA(0, 0), a2, voffA); PG8_STAGE(PG8_SA(0, 1), a2 + hstepA, voffA);
            PG8_WAIT_V(8); PG8_WAIT_L(0); PG8_BAR; PG8_MMA(0, 0, At, B0); PG8_MMA(0, 1, At, B1); PG8_BAR; PG8_SCHED;
            PG8_LDA(At, 1, 1); PG8_STAGE(PG8_SB(1, 0), b3, voffB); PG8_STAGE(PG8_SB(1, 1), b3 + hstepB, voffB);
            PG8_WAIT_V(6); PG8_WAIT_L(0); PG8_BAR; PG8_MMA(1, 0, At, B0); PG8_MMA(1, 1, At, B1); PG8_BAR; PG8_SCHED;
            } else if constexpr (SP2) {
            PG8_LDB(B0, 0, 0); PG8_LDB(B1, 0, 1); PG8_SCHED; PG8_LDA(At, 0, 0); PG8_STAGE(PG8_SA(1, 1), a1 + hstepA, voffA);
            PG8_WAIT_V(8); PG8_WAIT_L(0); PG8_BAR; PG8_MMA(0, 0, At, B0); PG8_MMA(0, 1, At, B1); PG8_BAR; PG8_SCHED;
            PG8_LDA(At, 0, 1); PG8_STAGE(PG8_SB(0, 0), b2, voffB); PG8_STAGE(PG8_SB(0, 1), b2 + hstepB, voffB); PG8_STAGE(PG8_SA(0, 0), a2, voffA);
            PG8_WAIT_V(8); PG8_WAIT_L(0); PG8_BAR; PG8_MMA(1, 0, At, B0); PG8_MMA(1, 1, At, B1); PG8_BAR; PG8_SCHED;
            PG8_LDB(B0, 1, 0); PG8_LDB(B1, 1, 1); PG8_SCHED; PG8_LDA(At, 1, 0); PG8_STAGE(PG8_SA(0, 1), a2 + hstepA, voffA);
            PG8_WAIT_V(8); PG8_WAIT_L(0); PG8_BAR; PG8_MMA(0, 0, At, B0); PG8_MMA(0, 1, At, B1); PG8_BAR; PG8_SCHED;
            PG8_LDA(At, 1, 1); PG8_STAGE(PG8_SB(1, 0), b3, voffB); PG8_STAGE(PG8_SB(1, 1), b3 + hstepB, voffB); PG8_STAGE(PG8_SA(1, 0), a3, voffA);
            PG8_WAIT_V(8); PG8_WAIT_L(0); PG8_BAR; PG8_MMA(1, 0, At, B0); PG8_MMA(1, 1, At, B1); PG8_BAR; PG8_SCHED;
            } else {
            PG8_LDB(B0, 0, 0); PG8_SCHED; PG8_LDA(At, 0, 0); PG8_STAGE(PG8_SA(1, 1), a1 + hstepA, voffA);
            PG8_WAIT_L(8); PG8_BAR; PG8_WAIT_L(0); PG8_MMA(0, 0, At, B0); PG8_BAR; PG8_SCHED;
            PG8_LDB(B1, 0, 1); PG8_STAGE(PG8_SB(0, 0), b2, voffB);
            PG8_BAR; PG8_WAIT_L(0); PG8_MMA(0, 1, At, B1); PG8_BAR;
            PG8_LDA(At, 0, 1); PG8_STAGE(PG8_SA(0, 0), a2, voffA);
            PG8_BAR; PG8_WAIT_L(0); PG8_MMA(1, 0, At, B0); PG8_BAR; PG8_SCHED;
            PG8_STAGE(PG8_SB(0, 1), b2 + hstepB, voffB);
            PG8_WAIT_V(6); PG8_BAR; PG8_MMA(1, 1, At, B1); PG8_BAR;
            PG8_LDB(B0, 1, 0); PG8_SCHED; PG8_LDA(At, 1, 0); PG8_STAGE(PG8_SA(0, 1), a2 + hstepA, voffA);
            PG8_WAIT_L(8); PG8_BAR; PG8_WAIT_L(0); PG8_MMA(0, 0, At, B0); PG8_BAR; PG8_SCHED;
            PG8_LDB(B1, 1, 1); PG8_STAGE(PG8_SB(1, 0), b3, voffB);
            PG8_BAR; PG8_WAIT_L(0); PG8_MMA(0, 1, At, B1); PG8_BAR;
            PG8_LDA(At, 1, 1); PG8_STAGE(PG8_SA(1, 0), a3, voffA);
            PG8_BAR; PG8_WAIT_L(0); PG8_MMA(1, 0, At, B0); PG8_BAR; PG8_SCHED;
            PG8_STAGE(PG8_SB(1, 1), b3 + hstepB, voffB);
            PG8_WAIT_V(6); PG8_BAR; PG8_MMA(1, 1, At, B1); PG8_BAR;
            }
        }
        if constexpr (ALIGN_EPI) { if (wr == 0) PG8_BAR; }
        E(acc, cur, wr, wc, fr, fq, xlds, wid, lane);
        if (!has_next) break;
#pragma unroll
        for (int a = 0; a < 2; ++a)
#pragma unroll
            for (int b = 0; b < 2; ++b)
#pragma unroll
                for (int m = 0; m < 4; ++m)
#pragma unroll
                    for (int n = 0; n < 2; ++n) acc[a][b][m][n] = (f32x4){0.f, 0.f, 0.f, 0.f};
        cur = nxt; cA = nA; cB = nB; ++ui;
        if constexpr (ALIGN_EPI) { if (wr == 1) PG8_BAR; }
    }
    PG8_WAIT_V(0);
    if constexpr (!ALIGN_EPI) { if (wr == 0) PG8_BAR; }
    PG8_BAR;
#undef PG8_SA
#undef PG8_SB
#undef PG8_STAGE
#undef PG8_LDA
#undef PG8_LDB
#undef PG8_MMA
#undef PG8_WAIT_V
#undef PG8_WAIT_L
#undef PG8_BAR
#undef PG8_SCHED
}
}

namespace epi {
using pg8::Acc; using pg8::Unit; using pg8::HALF; using pg8::BM;
typedef float f32x2v __attribute__((ext_vector_type(2)));
#define EPI_COMMON static constexpr bool PERM = true;
#define EPI_PIN(a, b) asm volatile("" : "+v"(a), "+v"(b))
#define EPI_NOMID static constexpr bool HAS_MID = false; static constexpr int MID1 = -1, MID2 = -1;
__device__ __forceinline__ v4u pack8(const f32x4 v0, const f32x4 v1) { v4u w; w.x = cvt_pk_bf16(v0[0], v0[1]); w.y = cvt_pk_bf16(v0[2], v0[3]); w.z = cvt_pk_bf16(v1[0], v1[1]); w.w = cvt_pk_bf16(v1[2], v1[3]); return w; }
__device__ __forceinline__ void rope8(f32x4& v0, f32x4& v1, const f32x4 cs0, const f32x4 cs1, const f32x4 cs2, const f32x4 cs3) {
    (void)cs2; (void)cs3;
    const float a0 = v0[0] * cs0[0] - v0[1] * cs0[1], b0 = v0[0] * cs0[1] + v0[1] * cs0[0];
    const float a1 = v0[2] * cs0[2] - v0[3] * cs0[3], b1 = v0[2] * cs0[3] + v0[3] * cs0[2];
    const float a2 = v1[0] * cs1[0] - v1[1] * cs1[1], b2 = v1[0] * cs1[1] + v1[1] * cs1[0];
    const float a3 = v1[2] * cs1[2] - v1[3] * cs1[3], b3 = v1[2] * cs1[3] + v1[3] * cs1[2];
    v0 = (f32x4){a0, b0, a1, b1}; v1 = (f32x4){a2, b2, a3, b3};
}
__device__ __forceinline__ float sigmoidf_fast(float v) { return __builtin_amdgcn_rcpf(1.f + __builtin_amdgcn_exp2f(-LOG2E * v)); }

struct EpiZ { EPI_COMMON EPI_NOMID
    bf16* Z; float* SSQ; const float* tab; unsigned char* GT;
    __device__ __forceinline__ void operator()(Acc& acc, const Unit& u, int wr, int wc, int fr, int fq, LAS unsigned char*, int, int lane) const {
        const int pn = u.pn; int row0 = u.pm * BM + wr * 64 + fr, col0 = pn * BM + wc * 32 + 8 * fq; EPI_PIN(row0, col0);
        if (pn >= 15) {
            const int gi = pn - 15; unsigned char* blk = GT + ((size_t)((gi >> 3) * 96 + u.pm) * 8 + (gi & 7)) * 131072 + (size_t)(wr * 4 + wc) * 16384 + lane * 16;
#pragma unroll
            for (int ai = 0; ai < 2; ++ai)
#pragma unroll
                for (int m = 0; m < 4; ++m)
#pragma unroll
                    for (int bj = 0; bj < 2; ++bj) { f32x4 v0 = acc[ai][bj][m][0], v1 = acc[ai][bj][m][1];
#pragma unroll
                        for (int j = 0; j < 4; ++j) { v0[j] = sigmoidf_fast(v0[j]); v1[j] = sigmoidf_fast(v1[j]); }
                        *(v4u*)(blk + ((ai * 4 + m) * 2 + bj) * 1024) = pack8(v0, v1); }
        } else if (pn == 14) {
            const int i0 = 16 * (wc & 1) + 4 * fq;
#pragma unroll
            for (int ai = 0; ai < 2; ++ai)
#pragma unroll
                for (int m = 0; m < 4; ++m) { const int row = row0 + ai * HALF + m * 16; bf16* rowp = Z + (size_t)row * NZ + col0;
                    f32x4 v0 = acc[ai][0][m][0], v1 = acc[ai][0][m][1];
                    if (wc < 2) { const f32x4* cs = (const f32x4*)(tab + ((size_t)seq_pos(row) * 32 + i0) * 2); rope8(v0, v1, cs[0], cs[1], cs[0], cs[0]); }
                    *(v4u*)(rowp) = pack8(v0, v1);
                    *(v4u*)(rowp + HALF) = pack8(acc[ai][1][m][0], acc[ai][1][m][1]); }
        } else {
            const float sc = (pn >= 4 && pn < 8) ? C_W : ((pn >= 10) ? C_M : 1.f);
#pragma unroll
            for (int ai = 0; ai < 2; ++ai)
#pragma unroll
                for (int m = 0; m < 4; ++m) { const int row = row0 + ai * HALF + m * 16; bf16* rowp = Z + (size_t)row * NZ + col0; float ss = 0.f;
#pragma unroll
                    for (int bj = 0; bj < 2; ++bj) { const f32x4 v0 = acc[ai][bj][m][0] * sc, v1 = acc[ai][bj][m][1] * sc;
                        ss += (v0[0] * v0[0] + v0[1] * v0[1]) + (v0[2] * v0[2] + v0[3] * v0[3]) + (v1[0] * v1[0] + v1[1] * v1[1]) + (v1[2] * v1[2] + v1[3] * v1[3]);
                        *(v4u*)(rowp + bj * HALF) = pack8(v0, v1); }
                    if (pn < 4) { ss += shfl_xor_l(ss, 16, lane); ss += shfl_xor_l(ss, 32, lane); if (fq == 0) SSQ[(size_t)row * 16 + pn * 4 + wc] = ss; } }
        }
    }
};
template <int WHICH  > struct EpiLat { EPI_COMMON EPI_NOMID
    bf16* O; const float* SSQ; const float* tab;
    __device__ __forceinline__ void operator()(Acc& acc, const Unit& u, int wr, int wc, int fr, int fq, LAS unsigned char*, int, int) const {
        constexpr int LDC = WHICH == 0 ? NQC : NKVC;
        const int pn = u.pn; int row0 = u.pm * BM + wr * 64 + fr, col0 = pn * BM + wc * 32 + 8 * fq; EPI_PIN(row0, col0);
        const int i0 = 16 * (wc & 1) + 4 * fq;
#pragma unroll
        for (int ai = 0; ai < 2; ++ai)
#pragma unroll
            for (int m = 0; m < 4; ++m) { const int row = row0 + ai * HALF + m * 16; bf16* rowp = O + (size_t)row * LDC + col0;
                const f32x4* sp = (const f32x4*)(SSQ + (size_t)row * 16 + WHICH * 8); const f32x4 s0 = sp[0], s1 = sp[1];
                const float ssum = ((s0[0] + s0[1]) + (s0[2] + s0[3])) + ((s1[0] + s1[1]) + (s1[2] + s1[3]));
                const float rs = __builtin_amdgcn_rsqf(ssum * (1.f / 512.f) + EPS) * (WHICH == 0 ? C_Q : 1.f);
#pragma unroll
                for (int bj = 0; bj < 2; ++bj) { f32x4 v0 = acc[ai][bj][m][0] * rs, v1 = acc[ai][bj][m][1] * rs;
                    if (WHICH == 0 && pn >= 4) { const f32x4* cs = (const f32x4*)(tab + ((size_t)seq_pos(row) * 32 + i0) * 2); rope8(v0, v1, cs[0], cs[1], cs[0], cs[0]); }
                    *(v4u*)(rowp + bj * HALF) = pack8(v0, v1); } }
    }
};
template <int MODE> struct EpiStore { EPI_COMMON EPI_NOMID
    bf16* O; int ldc; int col_off; const float* rs;
    __device__ __forceinline__ void operator()(Acc& acc, const Unit& u, int wr, int wc, int fr, int fq, LAS unsigned char*, int, int) const {
        int row0 = u.pm * BM + wr * 64 + fr, ct = u.pn * BM + wc * 32 + 8 * fq; EPI_PIN(row0, ct); const int col0 = col_off + ct;
        f32x4 cs[2][2]; float rr[2][4];
#pragma unroll
        for (int ai = 0; ai < 2; ++ai)
#pragma unroll
            for (int m = 0; m < 4; ++m) rr[ai][m] = (MODE == 1 || MODE == 5) ? rs[row0 + ai * HALF + m * 16] : 1.f;
        if (MODE == 2) {
#pragma unroll
            for (int bj = 0; bj < 2; ++bj) { cs[bj][0] = *(const f32x4*)(rs + ct + bj * HALF); cs[bj][1] = *(const f32x4*)(rs + ct + bj * HALF + 4); } }
#pragma unroll
        for (int ai = 0; ai < 2; ++ai)
#pragma unroll
            for (int m = 0; m < 4; ++m) { const int row = row0 + ai * HALF + m * 16; bf16* rowp = O + (size_t)row * ldc + col0;
                const float r = rr[ai][m];
#pragma unroll
                for (int bj = 0; bj < 2; ++bj) { f32x4 v0 = acc[ai][bj][m][0], v1 = acc[ai][bj][m][1];
                    if (MODE == 1 || MODE == 5) { v0 = v0 * r; v1 = v1 * r; }
                    if (MODE == 2) { v0 = v0 * cs[bj][0]; v1 = v1 * cs[bj][1]; }
                    if (MODE == 3 || MODE == 5) {
#pragma unroll
                        for (int j = 0; j < 4; ++j) { const float a = fmaxf(v0[j], 0.f), b = fmaxf(v1[j], 0.f); v0[j] = a * a; v1[j] = b * b; } }
                    *(v4u*)(rowp + bj * HALF) = pack8(v0, v1); } }
    }
};
struct EpiSoftmax { EPI_COMMON EPI_NOMID
    bf16* O;
    __device__ __forceinline__ void operator()(Acc& acc, const Unit& u, int wr, int wc, int fr, int fq, LAS unsigned char* xl, int, int lane) const {
        LAS float* MX = (LAS float*)xl; LAS float* SM = (LAS float*)(xl + 4096);
        int row0 = u.pm * BM + wr * 64 + fr, col0 = u.pn * BM + wc * 32 + 8 * fq; EPI_PIN(row0, col0);
#pragma unroll
        for (int ai = 0; ai < 2; ++ai)
#pragma unroll
            for (int m = 0; m < 4; ++m) { float mx = -3.0e38f;
#pragma unroll
                for (int bj = 0; bj < 2; ++bj)
#pragma unroll
                    for (int n = 0; n < 2; ++n) { const f32x4 x = acc[ai][bj][m][n]; mx = fmaxf(mx, fmaxf(fmaxf(x[0], x[1]), fmaxf(x[2], x[3]))); }
                mx = fmaxf(mx, shfl_xor_l(mx, 16, lane)); mx = fmaxf(mx, shfl_xor_l(mx, 32, lane));
                if (fq == 0) MX[(ai * HALF + wr * 64 + m * 16 + fr) * 4 + wc] = mx; }
        asm volatile("s_waitcnt lgkmcnt(0)" ::: "memory"); __builtin_amdgcn_s_barrier(); asm volatile("" ::: "memory");
#pragma unroll
        for (int ai = 0; ai < 2; ++ai)
#pragma unroll
            for (int m = 0; m < 4; ++m) { const int lr = ai * HALF + wr * 64 + m * 16 + fr; const f32x4 q = *(LAS f32x4*)(MX + lr * 4);
                const float mx = fmaxf(fmaxf(q[0], q[1]), fmaxf(q[2], q[3])); float s = 0.f;
#pragma unroll
                for (int bj = 0; bj < 2; ++bj)
#pragma unroll
                    for (int n = 0; n < 2; ++n) { f32x4 x = acc[ai][bj][m][n];
#pragma unroll
                        for (int j = 0; j < 4; ++j) { x[j] = __builtin_amdgcn_exp2f(x[j] - mx); s += x[j]; }
                        acc[ai][bj][m][n] = x; }
                s += shfl_xor_l(s, 16, lane); s += shfl_xor_l(s, 32, lane);
                if (fq == 0) SM[lr * 4 + wc] = s; }
        asm volatile("s_waitcnt lgkmcnt(0)" ::: "memory"); __builtin_amdgcn_s_barrier(); asm volatile("" ::: "memory");
#pragma unroll
        for (int ai = 0; ai < 2; ++ai)
#pragma unroll
            for (int m = 0; m < 4; ++m) { const int lr = ai * HALF + wr * 64 + m * 16 + fr; const f32x4 q = *(LAS f32x4*)(SM + lr * 4);
                const float inv = __builtin_amdgcn_rcpf((q[0] + q[1]) + (q[2] + q[3]));
                bf16* rowp = O + (size_t)(row0 + ai * HALF + m * 16) * 1024 + col0;
#pragma unroll
                for (int bj = 0; bj < 2; ++bj) *(v4u*)(rowp + bj * HALF) = pack8(acc[ai][bj][m][0] * inv, acc[ai][bj][m][1] * inv); }
    }
};
struct EpiBranch { EPI_COMMON
    static constexpr bool HAS_MID = true; static constexpr int MID1 = 16, MID2 = 32;
    bf16* O; const unsigned char* GT;
    __device__ __forceinline__ const unsigned char* gblk(const Unit& u, int g, int wr, int wc, int fr, int fq) const {
        return GT + ((size_t)(g * 96 + u.pm) * 8 + u.pn) * 131072 + (size_t)(wr * 4 + wc) * 16384 + (fq * 16 + fr) * 16; }
    __device__ __forceinline__ void mid(Acc& acc, const Unit& u, int t, int wr, int wc, int fr, int fq) const {
        const int gxi = (t == MID1) ? 0 : 1;
        const unsigned char* px = gblk(u, gxi, wr, wc, fr, fq); const unsigned char* py = gblk(u, gxi + 1, wr, wc, fr, fq);
#pragma unroll
        for (int ai = 0; ai < 2; ++ai) {
            v4u a[4][2], b[4][2];
#pragma unroll
            for (int m = 0; m < 4; ++m)
#pragma unroll
                for (int bj = 0; bj < 2; ++bj) { a[m][bj] = *(const v4u*)(px + ((ai * 4 + m) * 2 + bj) * 1024); b[m][bj] = *(const v4u*)(py + ((ai * 4 + m) * 2 + bj) * 1024); }
            __builtin_amdgcn_sched_barrier(0);
#pragma unroll
            for (int m = 0; m < 4; ++m)
#pragma unroll
                for (int bj = 0; bj < 2; ++bj) { const v4u x = a[m][bj], y = b[m][bj]; f32x4 r0, r1;
                    r0[0] = bf_lo(x.x) * __builtin_amdgcn_rcpf(bf_lo(y.x)); r0[1] = bf_hi(x.x) * __builtin_amdgcn_rcpf(bf_hi(y.x));
                    r0[2] = bf_lo(x.y) * __builtin_amdgcn_rcpf(bf_lo(y.y)); r0[3] = bf_hi(x.y) * __builtin_amdgcn_rcpf(bf_hi(y.y));
                    r1[0] = bf_lo(x.z) * __builtin_amdgcn_rcpf(bf_lo(y.z)); r1[1] = bf_hi(x.z) * __builtin_amdgcn_rcpf(bf_hi(y.z));
                    r1[2] = bf_lo(x.w) * __builtin_amdgcn_rcpf(bf_lo(y.w)); r1[3] = bf_hi(x.w) * __builtin_amdgcn_rcpf(bf_hi(y.w));
                    acc[ai][bj][m][0] *= r0; acc[ai][bj][m][1] *= r1; }
            __builtin_amdgcn_sched_barrier(0);
        }
    }
    __device__ __forceinline__ void operator()(Acc& acc, const Unit& u, int wr, int wc, int fr, int fq, LAS unsigned char*, int, int) const {
        int row0 = u.pm * BM + wr * 64 + fr, col0 = u.pn * BM + wc * 32 + 8 * fq; EPI_PIN(row0, col0);
        const unsigned char* pz = gblk(u, 2, wr, wc, fr, fq);
#pragma unroll
        for (int ai = 0; ai < 2; ++ai) {
            v4u a[4][2];
#pragma unroll
            for (int m = 0; m < 4; ++m)
#pragma unroll
                for (int bj = 0; bj < 2; ++bj) a[m][bj] = *(const v4u*)(pz + ((ai * 4 + m) * 2 + bj) * 1024);
            __builtin_amdgcn_sched_barrier(0);
#pragma unroll
            for (int m = 0; m < 4; ++m) { bf16* rowp = O + (size_t)(row0 + ai * HALF + m * 16) * DM + col0;
#pragma unroll
                for (int bj = 0; bj < 2; ++bj) { const v4u x = a[m][bj];
                    const f32x4 g0 = {bf_lo(x.x), bf_hi(x.x), bf_lo(x.y), bf_hi(x.y)}, g1 = {bf_lo(x.z), bf_hi(x.z), bf_lo(x.w), bf_hi(x.w)};
                    *(v4u*)(rowp + bj * HALF) = pack8(acc[ai][bj][m][0] * g0, acc[ai][bj][m][1] * g1); } }
            __builtin_amdgcn_sched_barrier(0);
        }
    }
};
}

namespace att {
using s16x4 = __attribute__((ext_vector_type(4))) short;
using f32x16 = __attribute__((ext_vector_type(16))) float;
using u32x4 = __attribute__((ext_vector_type(4))) unsigned;
constexpr int NW = 8, QBLK = 32, KVBLK = 64;
constexpr float THR2 = 8.f;
constexpr float NEGBIG = -1.0e30f;
#define SBAR() __builtin_amdgcn_sched_barrier(0)
__device__ __forceinline__ int crow(int r, int hi) { return (r & 3) + 8 * (r >> 2) + 4 * hi; }
template <int KROWB> __device__ __forceinline__ int kswz(int row, int colB) { return row * KROWB + (colB ^ ((KROWB == 384 ? ((row >> 1) & 7) : (row & 15)) << 4)); }

struct Mask { int dq; float sl; };

template <bool WIN>
__device__ __forceinline__ void partialSM(f32x16& p0, f32x16& p1, float& m_reg, float& mn, float& alpha, const Mask& mk, int kt) {
  if (WIN) {
    const float fd = (float)(mk.dq - kt * KVBLK);
#pragma unroll
    for (int r = 0; r < 16; ++r) { const float d0 = fd - (float)((r & 3) + 8 * (r >> 2)), d1 = d0 - 32.f; const float a0 = fabsf(d0), a1 = fabsf(d1);
      const float t0 = p0[r] - mk.sl * a0, t1 = p1[r] - mk.sl * a1; p0[r] = (a0 <= 128.f) ? t0 : NEGBIG; p1[r] = (a1 <= 128.f) ? t1 : NEGBIG; }
  }
  float pmax = p0[0];
#pragma unroll
  for (int r = 1; r < 16; ++r) pmax = fmaxf(pmax, p0[r]);
#pragma unroll
  for (int r = 0; r < 16; ++r) pmax = fmaxf(pmax, p1[r]);
  { auto rr = __builtin_amdgcn_permlane32_swap(__float_as_uint(pmax), __float_as_uint(pmax), false, false);
    pmax = fmaxf(__uint_as_float(rr[0]), __uint_as_float(rr[1])); }
  if (__builtin_expect(__all(pmax - m_reg <= THR2), 1)) { mn = m_reg; alpha = 1.f; }
  else { mn = fmaxf(m_reg, pmax); alpha = __builtin_amdgcn_exp2f(m_reg - mn); m_reg = mn; }
#pragma unroll
  for (int r = 0; r < 16; ++r) p0[r] = p0[r] - mn;
#pragma unroll
  for (int r = 0; r < 16; ++r) p1[r] = p1[r] - mn;
#pragma unroll
  for (int r = 0; r < 16; ++r) p0[r] = __builtin_amdgcn_exp2f(p0[r]);
}
__device__ __forceinline__ void finishSM(f32x16& p0, f32x16& p1, float alpha, float& l_reg, bf16x8& pa0, bf16x8& pa1, bf16x8& pa2, bf16x8& pa3) {
#pragma unroll
  for (int r = 0; r < 16; ++r) p1[r] = __builtin_amdgcn_exp2f(p1[r]);
  float ps = 0;
#pragma unroll
  for (int r = 0; r < 16; ++r) ps += p0[r];
#pragma unroll
  for (int r = 0; r < 16; ++r) ps += p1[r];
  { auto rr = __builtin_amdgcn_permlane32_swap(__float_as_uint(ps), __float_as_uint(ps), false, false);
    ps = __uint_as_float(rr[0]) + __uint_as_float(rr[1]); }
  l_reg = l_reg * alpha + ps;
#define PK4(P, BASE, OUT) do { unsigned a0 = cvt_pk_bf16(P[BASE + 0], P[BASE + 1]), a1 = cvt_pk_bf16(P[BASE + 2], P[BASE + 3]);   \
    unsigned b0 = cvt_pk_bf16(P[BASE + 4], P[BASE + 5]), b1 = cvt_pk_bf16(P[BASE + 6], P[BASE + 7]);                              \
    auto r0 = __builtin_amdgcn_permlane32_swap(a0, b0, false, false); auto r1 = __builtin_amdgcn_permlane32_swap(a1, b1, false, false); \
    u32x4 w = {r0[0], r1[0], r0[1], r1[1]}; OUT = *reinterpret_cast<bf16x8*>(&w); } while (0)
  PK4(p0, 0, pa0); PK4(p0, 8, pa1); PK4(p1, 0, pa2); PK4(p1, 8, pa3);
#undef PK4
}
template <int NQF, int KROWB>
__device__ __forceinline__ void qkt(f32x16& p0, f32x16& p1, const LAS char* Ks, const bf16x8* qr, int r32, int hi) {
  p0 = f32x16{}; p1 = f32x16{};
#pragma unroll
  for (int d0 = 0; d0 < NQF; ++d0) { const int cb = (d0 * 16 + hi * 8) * 2;
    bf16x8 b0 = *(const LAS bf16x8*)(Ks + kswz<KROWB>(r32, cb));
    bf16x8 b1 = *(const LAS bf16x8*)(Ks + kswz<KROWB>(32 + r32, cb));
    p0 = __builtin_amdgcn_mfma_f32_32x32x16_bf16(b0, qr[d0], p0, 0, 0, 0);
    p1 = __builtin_amdgcn_mfma_f32_32x32x16_bf16(b1, qr[d0], p1, 0, 0, 0); }
}
__device__ __forceinline__ int v_st(int k, int c) { const int kk = (k & ~0xC) | ((k & 4) << 1) | ((k & 8) >> 1); return ((kk >> 3) * 4 + (c >> 5)) * 512 + ((kk & 7) * 32 + (c & 31)) * 2; }
__device__ __forceinline__ int v_rd_base(int lane) { return ((lane & 3) << 3) | (((lane >> 2) & 3) << 6) | (((lane >> 4) & 1) << 5) | (((lane >> 5) & 1) << 8); }
constexpr int v_rd_off(int d0, int ks, int half) { return d0 * 512 + ks * 4096 + half * 2048; }
template <int OFF> __device__ __forceinline__ s16x4 tr_read(int vb) {
  s16x4 r; asm volatile("ds_read_b64_tr_b16 %0, %1 offset:%2" : "=&v"(r) : "v"(vb), "i"(OFF) : "memory"); return r;
}
template <int D0> __device__ __forceinline__ void pv_one(f32x16& od, int vb, bf16x8 pa0, bf16x8 pa1, bf16x8 pa2, bf16x8 pa3) {
  const s16x4 l0 = tr_read<v_rd_off(D0, 0, 0)>(vb), h0 = tr_read<v_rd_off(D0, 0, 1)>(vb), l1 = tr_read<v_rd_off(D0, 1, 0)>(vb), h1 = tr_read<v_rd_off(D0, 1, 1)>(vb);
  const s16x4 l2 = tr_read<v_rd_off(D0, 2, 0)>(vb), h2 = tr_read<v_rd_off(D0, 2, 1)>(vb), l3 = tr_read<v_rd_off(D0, 3, 0)>(vb), h3 = tr_read<v_rd_off(D0, 3, 1)>(vb);
  asm volatile("s_waitcnt lgkmcnt(0)" ::: "memory"); SBAR();
#define PK(L, H) (bf16x8){L[0], L[1], L[2], L[3], H[0], H[1], H[2], H[3]}
  od = __builtin_amdgcn_mfma_f32_32x32x16_bf16(pa0, PK(l0, h0), od, 0, 0, 0);
  od = __builtin_amdgcn_mfma_f32_32x32x16_bf16(pa1, PK(l1, h1), od, 0, 0, 0);
  od = __builtin_amdgcn_mfma_f32_32x32x16_bf16(pa2, PK(l2, h2), od, 0, 0, 0);
  od = __builtin_amdgcn_mfma_f32_32x32x16_bf16(pa3, PK(l3, h3), od, 0, 0, 0);
#undef PK
}
__device__ __forceinline__ void pv_d0(f32x16* o, int vb, bf16x8 pa0, bf16x8 pa1, bf16x8 pa2, bf16x8 pa3) {
  pv_one<0>(o[0], vb, pa0, pa1, pa2, pa3); pv_one<1>(o[1], vb, pa0, pa1, pa2, pa3); pv_one<2>(o[2], vb, pa0, pa1, pa2, pa3); pv_one<3>(o[3], vb, pa0, pa1, pa2, pa3);
}

__device__ __forceinline__ int kn_off(int row, int colB) { return row * 256 + (colB ^ ((row & 15) << 4)); }
__device__ __forceinline__ int kr_off(int row, int colB) { return row * 128 + (colB ^ (((row >> 1) & 7) << 4)); }
template <int NQF>
__device__ __forceinline__ void qk_mm(f32x16& n0, f32x16& n1, const LAS char* Kn, const LAS char* Kr, const bf16x8* qr, int r32, int hi) {
  constexpr int PF = 2, NB = PF + 1;
  n0 = f32x16{}; n1 = f32x16{};
  bf16x8 kb[NB][2];
#define QM_LOADK(d) do { if ((d) < 8) { const int cb_ = ((d) * 16 + hi * 8) * 2; kb[(d) % NB][0] = *(const LAS bf16x8*)(Kn + kn_off(r32, cb_)); kb[(d) % NB][1] = *(const LAS bf16x8*)(Kn + kn_off(32 + r32, cb_)); } \
    else { const int cb_ = (((d) - 8) * 16 + hi * 8) * 2; kb[(d) % NB][0] = *(const LAS bf16x8*)(Kr + kr_off(r32, cb_)); kb[(d) % NB][1] = *(const LAS bf16x8*)(Kr + kr_off(32 + r32, cb_)); } } while (0)
  QM_LOADK(0); QM_LOADK(1);
#pragma unroll
  for (int k = 0; k < NQF; ++k) {
    if (k + PF < NQF) QM_LOADK(k + PF);
    n0 = __builtin_amdgcn_mfma_f32_32x32x16_bf16(kb[k % NB][0], qr[k], n0, 0, 0, 0);
    n1 = __builtin_amdgcn_mfma_f32_32x32x16_bf16(kb[k % NB][1], qr[k], n1, 0, 0, 0);
    __builtin_amdgcn_sched_barrier(0);
  }
#undef QM_LOADK
}

template <int KIND>
__device__ __forceinline__ void attn_unit(const bf16* __restrict__ Qb, const bf16* __restrict__ KVb, const bf16* __restrict__ Zb, bf16* __restrict__ Ob,
                                          int qm0, int km0, int NT, int h, int ocol, float m0, float l0, Mask mk, LAS char* lds, int tid_in) {
  constexpr int NQF = KIND == 0 ? 12 : 8;
  constexpr bool HASR = KIND == 0, WIN = KIND == 1;
  constexpr int KSLOT = HASR ? 24576 : 16384, OFF_KR = 16384, VRING = 3 * KSLOT, VSLOT = 16384, SCR = VRING + 3 * VSLOT;
  int tid_; asm volatile("v_mbcnt_lo_u32_b32 %0, -1, 0\n\tv_mbcnt_hi_u32_b32 %0, -1, %0" : "=v"(tid_)); tid_ += tid_in;
  const int tid = tid_, wid = tid >> 6, lane = tid & 63, r32 = lane & 31, hi = lane >> 5;
  const int widu = __builtin_amdgcn_readfirstlane(wid);
  const bool trailing = widu >= 4;
  LAS float* ws = (LAS float*)(lds + SCR) + wid * 64; LAS float* li_l = ws; LAS float* al_l = ws + 32;
  float m_reg = m0, l_reg = l0; f32x16 o[4] = {}; bf16x8 qr[NQF];
  mk.dq += wid * QBLK + r32 - 4 * hi;
  const int kvh = h >> 2;
  constexpr long kld2 = (KIND == 0 ? NKVC : NZ) * 2;
  const char* Kbase = KIND == 0 ? (const char*)(KVb + (long)km0 * NKVC + h * 256) : (const char*)(Zb + (long)km0 * NZ + ZC_KW + kvh * 128);
  const char* Vbase = KIND == 0 ? Kbase + 256 : (const char*)(Zb + (long)km0 * NZ + ZC_VW + kvh * 128);
  const char* Rbase = (const char*)(Zb + (long)km0 * NZ + ZC_KR);
  unsigned okn[2], ov[2], okr;
#pragma unroll
  for (int q = 0; q < 2; ++q) { const int pq = 2 * wid + q;
    { const int row = pq * 4 + (lane >> 4), ch = (lane & 15) ^ (row & 15); okn[q] = (unsigned)(row * kld2 + ch * 16); }
    { const int sub = 2 * pq + (lane >> 5), kk = (sub >> 2) * 8 + ((lane & 31) >> 2), k = (kk & ~0xC) | ((kk & 4) << 1) | ((kk & 8) >> 1), c = (sub & 3) * 32 + (lane & 3) * 8; ov[q] = (unsigned)(k * kld2 + c * 2); } }
  { const int row = wid * 8 + (lane >> 3), ch = (lane & 7) ^ ((row >> 1) & 7); okr = (unsigned)(row * (NZ * 2) + ch * 16); }
#define GLDS(src, dst) __builtin_amdgcn_global_load_lds((const unsigned*)(src), (LAS unsigned*)(dst), 16, 0, 0)
#define DMA_K(t, ks) do { const size_t to_ = (size_t)(t) * KVBLK * kld2; LAS char* sb_ = lds + (ks) * KSLOT; \
    GLDS(Kbase + to_ + okn[0], sb_ + (2 * widu) * 1024); GLDS(Kbase + to_ + okn[1], sb_ + (2 * widu + 1) * 1024); \
    if (HASR) GLDS(Rbase + (size_t)(t) * KVBLK * (NZ * 2) + okr, sb_ + OFF_KR + widu * 1024); } while (0)
#define DMA_V(t, vs) do { const size_t to_ = (size_t)(t) * KVBLK * kld2; LAS char* sb_ = lds + VRING + (vs) * VSLOT; \
    GLDS(Vbase + to_ + ov[0], sb_ + (2 * widu) * 1024); GLDS(Vbase + to_ + ov[1], sb_ + (2 * widu + 1) * 1024); } while (0)
#define WAITBAR() asm volatile("s_waitcnt vmcnt(0) lgkmcnt(0)\n\ts_barrier" ::: "memory")
#define LBAR() asm volatile("s_waitcnt lgkmcnt(0)\n\ts_barrier" ::: "memory")
#define RESC(a) do { if (__any((a) < 1.f)) { if (hi == 0) al_l[r32] = (a); asm volatile("s_waitcnt lgkmcnt(0)" ::: "memory"); \
    _Pragma("unroll") for (int d = 0; d < 4; ++d) _Pragma("unroll") for (int r = 0; r < 16; ++r) o[d][r] *= al_l[crow(r, hi)]; } } while (0)
  DMA_K(0, 0); DMA_K(1, 1); DMA_V(0, 0);
  { const long qrow = (long)(qm0 + wid * QBLK + r32);
    if (KIND == 0) {
      const bf16* Qn = Qb + qrow * NQC + h * 128 + hi * 8; const bf16* Qr = Qb + qrow * NQC + 1024 + h * 64 + hi * 8;
#pragma unroll
      for (int d0 = 0; d0 < 8; ++d0) qr[d0] = *reinterpret_cast<const bf16x8*>(Qn + d0 * 16);
#pragma unroll
      for (int d0 = 8; d0 < NQF; ++d0) qr[d0] = *reinterpret_cast<const bf16x8*>(Qr + (d0 - 8) * 16);
    } else {
      const bf16* Qn = Zb + qrow * NZ + ZC_QW + h * 128 + hi * 8;
#pragma unroll
      for (int d0 = 0; d0 < 8; ++d0) qr[d0] = *reinterpret_cast<const bf16x8*>(Qn + d0 * 16);
    } }
  const int vb0 = (int)(uintptr_t)lds + VRING + v_rd_base(lane);
  f32x16 s0, s1; float mn, al; bf16x8 pa0, pa1, pa2, pa3;
  asm volatile("s_waitcnt vmcnt(0)" ::: "memory");
  if (trailing) LBAR();
  LBAR();
  int ks = 0, vs = 2;
  for (int t = 0; t < NT; ++t) {
    __builtin_amdgcn_s_setprio(3);
    qk_mm<NQF>(s0, s1, lds + ks * KSLOT, lds + ks * KSLOT + OFF_KR, qr, r32, hi);
    if (t > 0) pv_d0(o, vb0 + vs * VSLOT, pa0, pa1, pa2, pa3);
    __builtin_amdgcn_s_setprio(0);
    WAITBAR();
    { const int kn = ks == 0 ? 2 : ks - 1, vn = vs == 2 ? 0 : vs + 1, vn2 = vn == 2 ? 0 : vn + 1;
      if (t + 2 < NT) DMA_K(t + 2, kn);
      if (t + 1 < NT) DMA_V(t + 1, vn2); }
    partialSM<WIN>(s0, s1, m_reg, mn, al, mk, t);
    finishSM(s0, s1, al, l_reg, pa0, pa1, pa2, pa3);
    RESC(al);
    LBAR();
    ks = ks == 2 ? 0 : ks + 1; vs = vs == 2 ? 0 : vs + 1;
  }
  __builtin_amdgcn_s_setprio(3);
  pv_d0(o, vb0 + vs * VSLOT, pa0, pa1, pa2, pa3);
  __builtin_amdgcn_s_setprio(0);
  if (!trailing) LBAR();
  if (hi == 0) li_l[r32] = l_reg; asm volatile("s_waitcnt lgkmcnt(0)" ::: "memory");
  float rli[16];
#pragma unroll
  for (int r = 0; r < 16; ++r) rli[r] = __builtin_amdgcn_rcpf(li_l[crow(r, hi)]);
  WAITBAR();
  { LAS bf16* stg = (LAS bf16*)(lds + wid * 8192);
#pragma unroll
    for (int r = 0; r < 16; ++r) { const int orow = crow(r, hi);
#pragma unroll
      for (int d0 = 0; d0 < 4; ++d0) { const float v = o[d0][r] * rli[r]; stg[orow * 128 + d0 * 32 + r32] = (bf16)(cvt_pk_bf16(v, v) & 0xffffu); } }
    asm volatile("s_waitcnt lgkmcnt(0)" ::: "memory");
    bf16* Ow = Ob + (long)(qm0 + wid * QBLK) * NABC + ocol;
#pragma unroll
    for (int i = 0; i < 8; ++i) { const int row = i * 4 + (lane >> 4), ch = lane & 15; const v4u v = *(const LAS v4u*)(stg + row * 128 + ch * 8); *(v4u*)(Ow + (long)row * NABC + ch * 8) = v; } }
  WAITBAR();
#undef GLDS
#undef DMA_K
#undef DMA_V
#undef WAITBAR
#undef LBAR
#undef RESC
}
#undef SBAR
}

#define XB_TMO      128
#define XB_XCNT(j)  (256  + 64 * (j))
#define XB_XSUB(j)  (1280 + 64 * (j))
#define XB_XGEN(j)  (2304 + 64 * (j))
#define XB_TOP      3328
#define XB_TOPGEN   3392
#define XCD_BAR_WORDS 3456
#define XB_SPIN_CAP (1u << 18)

__device__ __forceinline__ unsigned xb_ld(unsigned* p)              { return __hip_atomic_load(p, __ATOMIC_RELAXED, __HIP_MEMORY_SCOPE_AGENT); }
__device__ __forceinline__ unsigned xb_add(unsigned* p, unsigned v) { return __hip_atomic_fetch_add(p, v, __ATOMIC_RELAXED, __HIP_MEMORY_SCOPE_AGENT); }
__device__ __forceinline__ unsigned xb_xcc_id() { return (unsigned)__builtin_amdgcn_s_getreg((3 << 11) | 20) & 0xFu; }
#define XB_SPIN(cond, bar) do { unsigned _sp = 0; while (cond) { __builtin_amdgcn_s_sleep(1); \
    if ((++_sp & 255u) == 0u) { if (xb_ld(&(bar)[XB_TMO])) break; if (_sp > XB_SPIN_CAP) { atomicAdd(&(bar)[XB_TMO], 1u); break; } } } } while (0)

struct XcdBarrier { unsigned* bar; unsigned x; volatile LAS unsigned* st; };

__device__ __forceinline__ XcdBarrier xcd_barrier_post(unsigned* bar, volatile LAS unsigned* st) {
    XcdBarrier b; b.bar = bar; b.x = xb_xcc_id(); b.st = st;
    if (threadIdx.x == 0) (void)xb_add(&bar[XB_XCNT(b.x)], 1u);
    return b;
}
__device__ __forceinline__ void xcd_barrier_complete(unsigned* bar, unsigned x, unsigned& nloc, unsigned& nx) {
    const unsigned G = gridDim.x * gridDim.y * gridDim.z;
    unsigned sum, cnt, mine, sp = 0u;
    for (;;) {
        sum = 0u; cnt = 0u; mine = 0u;
#pragma unroll
        for (unsigned j = 0; j < 16; ++j) { const unsigned c = xb_ld(&bar[XB_XCNT(j)]); sum += c; cnt += (c > 0u) ? 1u : 0u; mine = (j == x) ? c : mine; }
        if (sum == G) break;
        __builtin_amdgcn_s_sleep(1);
        if ((++sp & 255u) == 0u) { if (xb_ld(&bar[XB_TMO])) break; if (sp > XB_SPIN_CAP) { atomicAdd(&bar[XB_TMO], 1u); break; } }
    }
    nloc = mine > 0u ? mine : 1u; nx = cnt > 0u ? cnt : 1u;
}
__device__ __forceinline__ void xcd_barrier(const XcdBarrier& b, const int tid  ) {
    asm volatile("s_waitcnt vmcnt(0)" ::: "memory");
    __syncthreads();
    if (tid == 0) {
        unsigned* bar = b.bar;
        __builtin_amdgcn_s_waitcnt(0);
        unsigned nloc = b.st[0], nx = b.st[1];
        if (nloc == 0u) { xcd_barrier_complete(bar, b.x, nloc, nx); b.st[0] = nloc; b.st[1] = nx; }
        const unsigned old = xb_add(&bar[XB_XSUB(b.x)], 1u);
        const unsigned gen = old / nloc;
        if (old + 1u == (gen + 1u) * nloc) {
            __builtin_amdgcn_fence(__ATOMIC_RELEASE, "agent");
            asm volatile("s_waitcnt vmcnt(0)" ::: "memory");
            const unsigned og = xb_add(&bar[XB_TOP], 1u);
            const unsigned tg = og / nx;
            if (og + 1u == (tg + 1u) * nx) xb_add(&bar[XB_TOPGEN], 1u);
            else XB_SPIN(xb_ld(&bar[XB_TOPGEN]) == tg, bar);
            __builtin_amdgcn_fence(__ATOMIC_ACQUIRE, "agent");
            xb_add(&bar[XB_XGEN(b.x)], 1u);
            asm volatile("s_waitcnt vmcnt(0)" ::: "memory");
        } else {
            XB_SPIN(xb_ld(&bar[XB_XGEN(b.x)]) == gen, bar);
            __builtin_amdgcn_fence(__ATOMIC_ACQUIRE, "agent");
            asm volatile("s_waitcnt vmcnt(0)" ::: "memory");
        }
    }
    __syncthreads();
}

struct Args { const float* in[22]; float* out; unsigned char* ws; int ph_lo, ph_hi; };
typedef const __attribute__((address_space(4))) Args* KArgs;
#define KARGS() ({ KArgs p_ = (KArgs)__builtin_amdgcn_kernarg_segment_ptr(); asm volatile("" : "+s"(p_)); p_; })
struct Frame { LAS unsigned char* lds; int tid, lane, wave, vcu, G; };

__device__ __forceinline__ float wave_sum(float v, int lane) {
#pragma unroll
    for (int o = 1; o < 64; o <<= 1) v += shfl_xor_l(v, o, lane);
    return v;
}
__device__ const double ROPE_REV[32] = {
    1.59154943091895346e-01, 1.19349370211248862e-01, 8.94994016088910133e-02, 6.71150830052272551e-02, 5.03292121044870353e-02, 3.77415847174197711e-02, 2.83021958306233987e-02, 2.12236527647776604e-02,
    1.59154943091895339e-02, 1.19349370211248862e-02, 8.94994016088910237e-03, 6.71150830052272534e-03, 5.03292121044870370e-03, 3.77415847174197719e-03, 2.83021958306233987e-03, 2.12236527647776622e-03,
    1.59154943091895356e-03, 1.19349370211248849e-03, 8.94994016088910237e-04, 6.71150830052272599e-04, 5.03292121044870326e-04, 3.77415847174197741e-04, 2.83021958306233954e-04, 2.12236527647776605e-04,
    1.59154943091895351e-04, 1.19349370211248862e-04, 8.94994016088910182e-05, 6.71150830052272545e-05, 5.03292121044870354e-05, 3.77415847174197768e-05, 2.83021958306233961e-05, 2.12236527647776592e-05};

enum { MAP_ID = 0, MAP_WIN = 1, MAP_WUQ = 2 };
__device__ __forceinline__ int map_col(int mode, int n) {
    if (mode == MAP_ID) return n;
    if (mode == MAP_WIN) {
        if (n < 1024) return n;
        if (n < ZC_KR) return n + 64;
        if (n < ZC_KR + 64) { const int p = n - ZC_KR, i = p >> 1; return 1024 + ((p & 1) ? i + 32 : i); }
        if (n < ZC_G) return -1;
        return n - ZC_G + 3648;
    }
    if (n < 1024) return (n >> 7) * 192 + (n & 127);
    { const int r = n - 1024, h = r >> 6, p = r & 63, i = p >> 1; return h * 192 + 128 + ((p & 1) ? i + 32 : i); }
}
__device__ __forceinline__ void conv_item(const float* W, int K, int Nsrc, int nblk, const float* g, int mode, bf16* dst, int dst_ld, LAS float* scr, int item, int lane, bool tiled = false, int koff = 0) {
    const int kb = item / nblk, nb = item % nblk, k0 = 64 * kb, n0 = 32 * nb;
    const int s0 = map_col(mode, n0), s31 = map_col(mode, n0 + 31);
    if (s0 >= 0 && s31 == s0 + 31) {
        const int ks = lane >> 3, n4 = (lane & 7) * 4;
        f32x4 v[8]; float gk[8];
#pragma unroll
        for (int i = 0; i < 8; ++i) v[i] = *(const GAS f32x4*)(W + (size_t)(k0 + 8 * i + ks) * Nsrc + s0 + n4);
#pragma unroll
        for (int i = 0; i < 8; ++i) gk[i] = g ? g[k0 + 8 * i + ks] : 1.f;
#pragma unroll
        for (int i = 0; i < 8; ++i) { LAS float* p = scr + (8 * i + ks) * 33 + n4; const f32x4 x = v[i] * gk[i]; p[0] = x[0]; p[1] = x[1]; p[2] = x[2]; p[3] = x[3]; }
    } else {
        const int src = map_col(mode, n0 + (lane & 31));
#pragma unroll 8
        for (int i = 0; i < 32; ++i) { const int kk = 2 * i + (lane >> 5); float v = 0.f;
            if (src >= 0) { v = W[(size_t)(k0 + kk) * Nsrc + src]; if (g) v *= g[k0 + kk]; }
            scr[kk * 33 + (lane & 31)] = v; }
    }
    LDS_WAIT(); asm volatile("" ::: "memory");
    const int c = lane & 7;
#pragma unroll
    for (int j = 0; j < 4; ++j) { const int n = (lane >> 3) + 8 * j; const LAS float* s = scr + (8 * c) * 33 + n;
        v4u o; o.x = cvt_pk_bf16(s[0 * 33], s[1 * 33]); o.y = cvt_pk_bf16(s[2 * 33], s[3 * 33]); o.z = cvt_pk_bf16(s[4 * 33], s[5 * 33]); o.w = cvt_pk_bf16(s[6 * 33], s[7 * 33]);
        if (!tiled) *(GAS v4u*)(dst + (size_t)(n0 + n) * dst_ld + k0 + 8 * c) = o;
        else {
            const int nn = n0 + n, pn = nn >> 8, nt_ = nn & 255, h = nt_ >> 7, rr = nt_ & 127, w = rr & 31, slot = (rr & ~31) + 16 * ((w >> 2) & 1) + 4 * (w >> 3) + (w & 3);
            const int kk = koff + k0, kt = kk >> 6;
            *(GAS v4u*)((unsigned char*)dst + ((size_t)(pn * (dst_ld >> 6) + kt) * 2 + h) * 16384 + pg8::lds_byte(slot, 8 * c)) = o; } }
    LDS_WAIT(); asm volatile("" ::: "memory");
}
__device__ __forceinline__ void convert_layer(const Frame& F, KArgs ap, int l, unsigned char* ws) {
    LAS float* scr = (LAS float*)(F.lds + RING_OFF + F.wave * 16384);
    const int gw = F.vcu * NWAVES + F.wave, NGW = F.G * NWAVES;
    unsigned char* W = ws + WS_W;
    constexpr int I_IN = 32 * (NZW / 32), I_UQ = 8 * (NQC / 32), I_UKV = 8 * (NKVC / 32), I_MEM = 32 * 64, I_BR = 16 * 64, I_OUT = 32 * 64, I_UP = 32 * 256, I_DOWN = 128 * 64;
    constexpr int NITEMS = I_IN + I_UQ + I_UKV + I_MEM + 3 * I_BR + I_OUT + I_UP + I_DOWN;
    for (int it = gw; it < NITEMS; it += NGW) {
        int r = it;
        if (r < I_IN) { conv_item(ap->in[6] + (size_t)l * DM * NZSRC, DM, NZSRC, NZW / 32, ap->in[4] + l * DM, MAP_WIN, (bf16*)(W + WO_IN), DM, scr, r, F.lane, true); continue; } r -= I_IN;
        if (r < I_UQ) { conv_item(ap->in[9] + (size_t)l * 512 * NQC, 512, NQC, NQC / 32, ap->in[7] + l * 512, MAP_WUQ, (bf16*)(W + WO_UQ), 512, scr, r, F.lane, true); continue; } r -= I_UQ;
        if (r < I_UKV) { conv_item(ap->in[10] + (size_t)l * 512 * NKVC, 512, NKVC, NKVC / 32, ap->in[8] + l * 512, MAP_ID, (bf16*)(W + WO_UKV), 512, scr, r, F.lane, true); continue; } r -= I_UKV;
        if (r < I_MEM) { conv_item(ap->in[12] + (size_t)l * DM * 2048, DM, 2048, 64, ap->in[11] + l * DM, MAP_ID, (bf16*)(W + WO_MEM), DM, scr, r, F.lane); continue; } r -= I_MEM;
        if (r < 3 * I_BR) { const int br = r / I_BR; conv_item(ap->in[14 + br] + (size_t)l * 1024 * DM, 1024, DM, 64, nullptr, MAP_ID, (bf16*)(W + WO_BR), NABC, scr, r - br * I_BR, F.lane, true, br * 1024); continue; } r -= 3 * I_BR;
        if (r < I_OUT) { conv_item(ap->in[17] + (size_t)l * DM * DM, DM, DM, 64, nullptr, MAP_ID, (bf16*)(W + WO_OUT), DM, scr, r, F.lane, true); continue; } r -= I_OUT;
        if (r < I_UP) { conv_item(ap->in[20] + (size_t)l * DM * DFF, DM, DFF, 256, ap->in[18] + l * DM, MAP_ID, (bf16*)(W + WO_UP), DM, scr, r, F.lane, true); continue; } r -= I_UP;
        conv_item(ap->in[21] + (size_t)l * DFF * DM, DFF, DM, 64, nullptr, MAP_ID, (bf16*)(W + WO_DOWN), DFF, scr, r, F.lane, true);
    }
}
__device__ __forceinline__ void rms_row_to_bf16(const float* xrow, bf16* orow, float* rs_out, int lane) {
    f32x4 v[8]; float s = 0.f;
#pragma unroll
    for (int j = 0; j < 4; ++j) { v[2 * j] = *(const GAS f32x4*)(xrow + j * 512 + lane * 8); v[2 * j + 1] = *(const GAS f32x4*)(xrow + j * 512 + lane * 8 + 4); }
#pragma unroll
    for (int j = 0; j < 8; ++j) s += (v[j][0] * v[j][0] + v[j][1] * v[j][1]) + (v[j][2] * v[j][2] + v[j][3] * v[j][3]);
    const float ms = wave_sum(s, lane) * (1.f / DM) + EPS, r = __builtin_amdgcn_rsqf(ms);
    if (lane == 0) *rs_out = ms * r;
#pragma unroll
    for (int j = 0; j < 4; ++j) *(GAS v4u*)(orow + j * 512 + lane * 8) = epi::pack8(v[2 * j] * r, v[2 * j + 1] * r);
}
__device__ __forceinline__ void prologue(const Frame& F, KArgs ap, unsigned char* ws) {
    const int gw = F.vcu * NWAVES + F.wave, NGW = F.G * NWAVES;
    float* tab = (float*)(ws + WS_TAB);
    for (int e = blockIdx.x * 512 + F.tid; e < 8192 * 32; e += F.G * 512) {
        const int pos = e >> 5, i = e & 31;
        double rev = (double)pos * ROPE_REV[i]; rev -= floor(rev);
        const double q = rint(rev * 4.0); const double r = (rev - q * 0.25) * 6.283185307179586476925;
        const double r2 = r * r;
        const double sn = r * (1.0 + r2 * (-1.0 / 6 + r2 * (1.0 / 120 + r2 * (-1.0 / 5040 + r2 * (1.0 / 362880 - r2 * (1.0 / 39916800))))));
        const double cn = 1.0 + r2 * (-0.5 + r2 * (1.0 / 24 + r2 * (-1.0 / 720 + r2 * (1.0 / 40320 + r2 * (-1.0 / 3628800 + r2 * (1.0 / 479001600))))));
        const int qi = ((int)q) & 3;
        const double s_ = qi == 0 ? sn : qi == 1 ? cn : qi == 2 ? -sn : -cn;
        const double c_ = qi == 0 ? cn : qi == 1 ? -sn : qi == 2 ? -cn : sn;
        *(GAS f32x2*)(tab + (size_t)e * 2) = (f32x2){(float)c_, (float)s_};
    }
    float* rmem = (float*)(ws + WS_RMEM); bf16* memb = (bf16*)(ws + WS_MEMB);
    for (int m = gw; m < NMEMR; m += NGW) {
        const float* xrow = (m < 1024) ? ap->in[2] + (size_t)m * DM : ap->in[3] + (size_t)(m - 1024) * DM;
        f32x4 v[8]; float s = 0.f;
#pragma unroll
        for (int j = 0; j < 4; ++j) { v[2 * j] = *(const GAS f32x4*)(xrow + j * 512 + F.lane * 8); v[2 * j + 1] = *(const GAS f32x4*)(xrow + j * 512 + F.lane * 8 + 4); }
#pragma unroll
        for (int j = 0; j < 8; ++j) s += (v[j][0] * v[j][0] + v[j][1] * v[j][1]) + (v[j][2] * v[j][2] + v[j][3] * v[j][3]);
        const float r = __builtin_amdgcn_rsqf(wave_sum(s, F.lane) * (1.f / DM) + EPS);
        if (F.lane == 0) rmem[m] = r;
#pragma unroll
        for (int j = 0; j < 4; ++j) *(GAS v4u*)(memb + (size_t)m * DM + j * 512 + F.lane * 8) = epi::pack8(v[2 * j], v[2 * j + 1]);
    }
    bf16* xn = (bf16*)(ws + WS_XN);
    for (int m = gw; m < NTOK; m += NGW) {
        const float* xrow = (m < NPROMPT) ? ap->in[0] + (size_t)m * DM : ap->in[1] + (size_t)(m - NPROMPT) * DM;
        rms_row_to_bf16(xrow, xn + (size_t)m * DM, (float*)(ws + WS_RS) + m, F.lane);
    }
    convert_layer(F, ap, 0, ws);
}
__device__ __forceinline__ void norm_pass(const Frame& F, KArgs ap, bool first, bool last, const float* gpost, unsigned char* ws, bool dummy = false) {
    const int gw = F.vcu * NWAVES + F.wave, NGW = F.G * NWAVES;
    const bf16* Y = (const bf16*)(ws + WS_Y); bf16* xb = (bf16*)(ws + WS_XN); float* rsv = (float*)(ws + WS_RS);
    bf16* xbo = dummy ? (bf16*)(ws + WS_Z + 192 * MiB) : xb; float* rso = dummy ? (float*)(ws + WS_Z + 300 * MiB) : rsv; float* xout = dummy ? (float*)(ws + WS_Z) : ap->out;
    f32x4 g[8];
#pragma unroll
    for (int j = 0; j < 4; ++j) { g[2 * j] = *(const GAS f32x4*)(gpost + j * 512 + F.lane * 8); g[2 * j + 1] = *(const GAS f32x4*)(gpost + j * 512 + F.lane * 8 + 4); }
    for (int m = gw; m < NTOK; m += NGW) {
        f32x4 x[8], y[8]; float s = 0.f;
#pragma unroll
        for (int j = 0; j < 4; ++j) { const v4u w = *(const GAS v4u*)(Y + (size_t)m * DM + j * 512 + F.lane * 8);
            y[2 * j] = (f32x4){bf_lo(w.x), bf_hi(w.x), bf_lo(w.y), bf_hi(w.y)}; y[2 * j + 1] = (f32x4){bf_lo(w.z), bf_hi(w.z), bf_lo(w.w), bf_hi(w.w)}; }
        if (first) { const float* xrow = (m < NPROMPT) ? ap->in[0] + (size_t)m * DM : ap->in[1] + (size_t)(m - NPROMPT) * DM;
#pragma unroll
            for (int j = 0; j < 4; ++j) { x[2 * j] = *(const GAS f32x4*)(xrow + j * 512 + F.lane * 8); x[2 * j + 1] = *(const GAS f32x4*)(xrow + j * 512 + F.lane * 8 + 4); }
        } else {
            const float rms = rsv[m];
#pragma unroll
            for (int j = 0; j < 4; ++j) { const v4u w = *(const GAS v4u*)(xb + (size_t)m * DM + j * 512 + F.lane * 8);
                x[2 * j] = (f32x4){bf_lo(w.x), bf_hi(w.x), bf_lo(w.y), bf_hi(w.y)} * rms; x[2 * j + 1] = (f32x4){bf_lo(w.z), bf_hi(w.z), bf_lo(w.w), bf_hi(w.w)} * rms; }
        }
#pragma unroll
        for (int j = 0; j < 8; ++j) s += (y[j][0] * y[j][0] + y[j][1] * y[j][1]) + (y[j][2] * y[j][2] + y[j][3] * y[j][3]);
        const float r = __builtin_amdgcn_rsqf(wave_sum(s, F.lane) * (1.f / DM) + EPS);
        float s2 = 0.f;
#pragma unroll
        for (int j = 0; j < 8; ++j) { x[j] = x[j] + (y[j] * r) * g[j]; s2 += (x[j][0] * x[j][0] + x[j][1] * x[j][1]) + (x[j][2] * x[j][2] + x[j][3] * x[j][3]); }
        if (last) { float* orow = xout + (size_t)m * DM;
#pragma unroll
            for (int j = 0; j < 4; ++j) { *(GAS f32x4*)(orow + j * 512 + F.lane * 8) = x[2 * j]; *(GAS f32x4*)(orow + j * 512 + F.lane * 8 + 4) = x[2 * j + 1]; }
        } else {
            const float ms2 = wave_sum(s2, F.lane) * (1.f / DM) + EPS, r2 = __builtin_amdgcn_rsqf(ms2);
            if (F.lane == 0) rso[m] = ms2 * r2;
#pragma unroll
            for (int j = 0; j < 4; ++j) *(GAS v4u*)(xbo + (size_t)m * DM + j * 512 + F.lane * 8) = epi::pack8(x[2 * j] * r2, x[2 * j + 1] * r2);
        }
    }
}

constexpr int PH_PER_LAYER = 9, N_PHASES = 1 + DEPTH * PH_PER_LAYER;
#ifndef PH_MASK
#define PH_MASK 0x3ff
#endif
#define PH_EN(k) ((PH_MASK >> (k)) & 1)
#ifndef SUB_MASK
#define SUB_MASK 7
#endif
#define SUB_EN(k) ((SUB_MASK >> (k)) & 1)
#ifndef DUP_MASK
#define DUP_MASK 0
#endif
#define DUP_EN(k) ((DUP_MASK >> (k)) & 1)
__global__ void __launch_bounds__(NWAVES * 64, 2) fwd(Args args_unused) {
    extern __shared__ __attribute__((aligned(16))) unsigned char lds_raw[];
    (void)args_unused;
    LAS unsigned char* lds0 = (LAS unsigned char*)lds_raw;
    const int wave0 = __builtin_amdgcn_readfirstlane((int)threadIdx.x >> 6);
    volatile LAS unsigned* MISC = (volatile LAS unsigned*)(lds0 + MISC_OFF);
    for (int u = threadIdx.x; u < (XCH_OFF - LDSCTL_OFF) / 4; u += NWAVES * 64) ((LAS unsigned*)(lds0 + LDSCTL_OFF))[u] = 0u;
    __syncthreads();
#ifdef PROBE_CLOCK
    if (blockIdx.x == 0 && threadIdx.x == 0) { KArgs ap = KARGS(); unsigned long long* p = (unsigned long long*)(ap->ws + 512 * 1024); p[0] = __builtin_amdgcn_s_memtime(); p[1] = __builtin_amdgcn_s_memrealtime(); }
#endif
    int lo, hi; unsigned* barw;
    { KArgs ap = KARGS(); lo = ap->ph_lo; hi = ap->ph_hi; barw = (unsigned*)(ap->ws + WS_CTL) + CW_BAR; }
    if (MK_N_LAUNCHES == 1 || (hi - lo) > 1) (void)xcd_barrier_post(barw, MISC + 8);
    if (threadIdx.x == 0) { unsigned r = 0u; const unsigned x = xb_xcc_id();
        if (MK_N_LAUNCHES == 1) { KArgs ap_ = KARGS(); r = xb_add((unsigned*)(ap_->ws + WS_CTL) + CW_RANK + 64 * x, 1u); }
        MISC[20] = x; MISC[21] = r; MISC[22] = blockIdx.x; }
    __syncthreads();
#if MK_N_LAUNCHES == 1
#define IN(k) true
#else
#define IN(k) (lo <= (k) && (k) < hi)
#endif
#if defined(PROBE_WAIT) && PROBE_WAIT
#define PROBE_WAIT_BEGIN() do { if (wave0 * 64 + t_ == 0) { const unsigned long long r_ = __builtin_amdgcn_s_memrealtime(); MISC[16] = (unsigned)r_; } } while (0)
#define PROBE_WAIT_END() do { int t2_; asm volatile("v_mbcnt_lo_u32_b32 %0, -1, 0\n\tv_mbcnt_hi_u32_b32 %0, -1, %0" : "=v"(t2_)); if (wave0 * 64 + t2_ == 0) { const unsigned long long r_ = __builtin_amdgcn_s_memrealtime(); MISC[17] = MISC[17] + ((unsigned)r_ - MISC[16]); } } while (0)
#else
#define PROBE_WAIT_BEGIN() do {} while (0)
#define PROBE_WAIT_END() do {} while (0)
#endif
#define LOCAL_BAR() XcdBarrier bar; { KArgs ap_ = KARGS(); bar.bar = (unsigned*)(ap_->ws + WS_CTL) + CW_BAR; bar.x = xb_xcc_id(); bar.st = (volatile LAS unsigned*)((LAS unsigned char*)lds_raw + MISC_OFF) + 8; }
#define BARRIER_NOW() do { int t_; asm volatile("v_mbcnt_lo_u32_b32 %0, -1, 0\n\tv_mbcnt_hi_u32_b32 %0, -1, %0" : "=v"(t_)); LOCAL_BAR(); xcd_barrier(bar, wave0 * 64 + t_); } while (0)
#define SEAM(k) do { if (IN(k) && IN((k) + 1)) { int t_; asm volatile("v_mbcnt_lo_u32_b32 %0, -1, 0\n\tv_mbcnt_hi_u32_b32 %0, -1, %0" : "=v"(t_)); PROBE_WAIT_BEGIN(); LOCAL_BAR(); xcd_barrier(bar, wave0 * 64 + t_); PROBE_WAIT_END(); if (PROBE_XBAR) { xcd_barrier(bar, wave0 * 64 + t_); xcd_barrier(bar, wave0 * 64 + t_); } } } while (0)
#define PHASE_BASE() KArgs ap = KARGS(); unsigned char* ws = ap->ws; (void)ws; int bx_ = (int)((volatile LAS unsigned*)((LAS unsigned char*)lds_raw + MISC_OFF))[22], G_ = (int)gridDim.x, t_; asm volatile("v_mbcnt_lo_u32_b32 %0, -1, 0\n\tv_mbcnt_hi_u32_b32 %0, -1, %0" : "=v"(t_)); t_ += wave0 * 64; bx_ = __builtin_amdgcn_readfirstlane(bx_); asm volatile("" : "+s"(bx_), "+s"(G_)); const int bx = bx_, G = G_; (void)bx; (void)G; Frame F; F.lds = (LAS unsigned char*)lds_raw; F.tid = t_; F.lane = t_ & 63; F.wave = __builtin_amdgcn_readfirstlane(t_ >> 6); F.G = G; F.vcu = (G % 8 == 0) ? (bx % 8) * (G / 8) + bx / 8 : bx; LAS unsigned char* ring = F.lds + RING_OFF; LAS unsigned char* xl = F.lds + XCH_OFF; (void)ring; (void)xl
#define WSP(T, off) ((T*)(ws + (off)))

    if (PH_EN(0) && IN(0)) { PHASE_BASE(); prologue(F, ap, ws); }
    SEAM(0);
    if (MK_N_LAUNCHES == 1) {
        if (threadIdx.x == 0) { KArgs ap_ = KARGS(); unsigned* bw = (unsigned*)(ap_->ws + WS_CTL) + CW_BAR; const unsigned G = gridDim.x; bool even = (G % 8u) == 0u; unsigned npop = 0u;
            for (unsigned j = 0; j < 16; ++j) { const unsigned c = xb_ld(&bw[XB_XCNT(j)]); if (c) { ++npop; even = even && (c == G / 8u) && (j < 8u); } }
            if (even && npop == 8u && MISC[21] < G / 8u) MISC[22] = MISC[20] + 8u * MISC[21]; }
        __syncthreads();
    }

    for (int l = 0; l < DEPTH; ++l) {
        const int p0 = 1 + l * PH_PER_LAYER;
        for (int rep_ = 0; rep_ <= DUP_EN(1); ++rep_) { if (rep_) BARRIER_NOW();
        if (PH_EN(1) && IN(p0 + 0)) { PHASE_BASE();
            if (SUB_EN(0)) { pg8::Gemm g = pg8::plain_gemm(WSP(bf16, WS_XN), DM, ws + WS_W + WO_IN, DM, DM, true); pg8::StaticOrder S; S.init(NTOK / 256, NZW / 256, G, bx);
              epi::EpiZ E{WSP(bf16, WS_Z), WSP(float, WS_SSQ), WSP(const float, WS_TAB), ws + WS_GT}; pg8::gemm_phase<epi::EpiZ, pg8::StaticOrder>(F.tid, ring, xl, g, S, E); }
            if (SUB_EN(1)) { pg8::Gemm g = pg8::plain_gemm(WSP(bf16, WS_MEMB), DM, ws + WS_W + WO_MEM, DM, DM); pg8::StaticOrder S; S.init(NMEMR / 256, 4, G, (bx + G - 160 % G) % G);
              epi::EpiStore<1> E{WSP(bf16, WS_MEMK), 1024, 0, WSP(const float, WS_RMEM)}; pg8::gemm_phase<epi::EpiStore<1>, pg8::StaticOrder>(F.tid, ring, xl, g, S, E); }
            if (SUB_EN(2)) { pg8::Gemm g = pg8::plain_gemm(ws + WS_W + WO_MEM + (size_t)1024 * DM * 2, DM, WSP(bf16, WS_MEMB), DM, DM); pg8::StaticOrder S; S.init(4, NMEMR / 256, G, (bx + G - 180 % G) % G);
              epi::EpiStore<2> E{WSP(bf16, WS_MEMVT), NMEMR, 0, WSP(const float, WS_RMEM)}; pg8::gemm_phase<epi::EpiStore<2>, pg8::StaticOrder>(F.tid, ring, xl, g, S, E); }
        }
        }
        SEAM(p0 + 0);
        for (int rep_ = 0; rep_ <= DUP_EN(2); ++rep_) { if (rep_) BARRIER_NOW();
        if (PH_EN(2) && IN(p0 + 1)) { PHASE_BASE();
            if (SUB_EN(0)) { pg8::Gemm g = pg8::plain_gemm(WSP(bf16, WS_Z) + ZC_CQ, NZ, ws + WS_W + WO_UQ, 512, 512, true); pg8::StaticOrder S; S.init(NTOK / 256, NQC / 256, G, bx);
              epi::EpiLat<0> E{WSP(bf16, WS_Q), WSP(const float, WS_SSQ), WSP(const float, WS_TAB)}; pg8::gemm_phase<epi::EpiLat<0>, pg8::StaticOrder>(F.tid, ring, xl, g, S, E); }
            if (SUB_EN(1)) { pg8::Gemm g = pg8::plain_gemm(WSP(bf16, WS_Z) + ZC_CKV, NZ, ws + WS_W + WO_UKV, 512, 512, true); pg8::StaticOrder S; S.init(NTOK / 256, NKVC / 256, G, bx);
              epi::EpiLat<1> E{WSP(bf16, WS_KV), WSP(const float, WS_SSQ), WSP(const float, WS_TAB)}; pg8::gemm_phase<epi::EpiLat<1>, pg8::StaticOrder>(F.tid, ring, xl, g, S, E); }
            if (SUB_EN(2)) { pg8::Gemm g; g.A = (const char*)(WSP(bf16, WS_Z) + ZC_QM); g.B = (const char*)WSP(bf16, WS_MEMK); g.a_pm = (long)256 * NZ * 2; g.a_pn = 512; g.b_pn = 512; g.b_sq = (long)256 * 1024 * 2; g.lda = NZ; g.ldb = 1024; g.K = 256; g.b_tiled = false;
              pg8::StaticOrder S; S.init(NTOK / 256, 4, G, (bx + G - 64 % G) % G);
              epi::EpiSoftmax E{WSP(bf16, WS_PM)}; pg8::gemm_phase<epi::EpiSoftmax, pg8::StaticOrder>(F.tid, ring, xl, g, S, E); }
        }
        }
        SEAM(p0 + 1);
        for (int rep_ = 0; rep_ <= DUP_EN(3); ++rep_) { if (rep_) BARRIER_NOW();
        if (PH_EN(3) && IN(p0 + 2)) {
            if (SUB_EN(0)) { PHASE_BASE(); for (int n = F.vcu; n < 768; n += G) {
                const int i = n >> 8, v = n & 255, x = v >> 5, j = v & 31;
                int h, qm0, km0, NT;
                if (i < 2) { const int pair = 4 * x + 2 * i + (j >> 4), b = pair >> 3; h = pair & 7; qm0 = b * 4096 + (j & 15) * 256; km0 = b * 4096; NT = 64; }
                else { h = x; qm0 = NPROMPT + j * 256; km0 = NPROMPT; NT = 128; }
                att::Mask mk{0, 0.f};
                att::attn_unit<0>(WSP(bf16, WS_Q), WSP(bf16, WS_KV), WSP(bf16, WS_Z), WSP(bf16, WS_ABC), qm0, km0, NT, h, h * 128, -1.0e30f, 0.f, mk, (LAS char*)ring, wave0 * 64);
            } }
            if (SUB_EN(1)) { PHASE_BASE(); const float* sink = ap->in[13] + l * 8;
              for (int n = F.vcu; n < 768; n += G) {
                const int qblk = n >> 3, h = n & 7;
                const int sstart = qblk < 64 ? (qblk >> 4) * 4096 : NPROMPT, SL = qblk < 64 ? 4096 : 8192;
                const int qm0 = qblk * 256, q0 = qm0 - sstart;
                const int klo = (q0 - 128) < 0 ? 0 : (q0 - 128), khi = (q0 + 384) > SL ? SL : (q0 + 384);
                att::Mask mk; mk.dq = q0 - klo; mk.sl = LOG2E * __builtin_amdgcn_exp2f(-(float)(h + 1));
                att::attn_unit<1>(WSP(bf16, WS_Q), WSP(bf16, WS_KV), WSP(bf16, WS_Z), WSP(bf16, WS_ABC), qm0, sstart + klo, (khi - klo) >> 6, h, 1024 + h * 128, sink[h] * LOG2E, 1.f, mk, (LAS char*)ring, wave0 * 64);
              } }
            if (SUB_EN(2)) { PHASE_BASE(); pg8::Gemm g; g.A = (const char*)WSP(bf16, WS_PM); g.B = (const char*)WSP(bf16, WS_MEMVT); g.a_pm = (long)256 * 1024 * 2; g.a_pn = 512; g.b_pn = (long)256 * NMEMR * 2; g.b_sq = 512; g.lda = 1024; g.ldb = NMEMR; g.K = 256; g.b_tiled = false;
              pg8::StaticOrder S; S.init(NTOK / 256, 4, G, bx);
              epi::EpiStore<0> E{WSP(bf16, WS_ABC), NABC, 2048, nullptr}; pg8::gemm_phase<epi::EpiStore<0>, pg8::StaticOrder>(F.tid, ring, xl, g, S, E); }
        }
        }
        SEAM(p0 + 2);
        for (int rep_ = 0; rep_ <= DUP_EN(4); ++rep_) { if (rep_) BARRIER_NOW();
        if (PH_EN(4) && IN(p0 + 3)) { PHASE_BASE();
            pg8::Gemm g = pg8::plain_gemm(WSP(bf16, WS_ABC), NABC, ws + WS_W + WO_BR, NABC, NABC, true); pg8::StaticOrder S; S.init(NTOK / 256, DM / 256, G, bx);
            epi::EpiBranch E{WSP(bf16, WS_MERGED), ws + WS_GT}; pg8::gemm_phase<epi::EpiBranch, pg8::StaticOrder>(F.tid, ring, xl, g, S, E);
        }
        }
        SEAM(p0 + 3);
        for (int rep_ = 0; rep_ <= DUP_EN(5); ++rep_) { if (rep_) BARRIER_NOW();
        if (PH_EN(5) && IN(p0 + 4)) { PHASE_BASE();
            pg8::Gemm g = pg8::plain_gemm(WSP(bf16, WS_MERGED), DM, ws + WS_W + WO_OUT, DM, DM, true); pg8::StaticOrder S; S.init(NTOK / 256, DM / 256, G, bx);
            epi::EpiStore<0> E{WSP(bf16, WS_Y), DM, 0, nullptr}; pg8::gemm_phase<epi::EpiStore<0>, pg8::StaticOrder>(F.tid, ring, xl, g, S, E);
        }
        }
        SEAM(p0 + 4);
        if (PH_EN(6) && IN(p0 + 5)) { PHASE_BASE(); if (DUP_EN(6)) norm_pass(F, ap, l == 0, false, ap->in[5] + l * DM, ws, true); norm_pass(F, ap, l == 0, false, ap->in[5] + l * DM, ws); }
        SEAM(p0 + 5);
        for (int rep_ = 0; rep_ <= DUP_EN(7); ++rep_) { if (rep_) BARRIER_NOW();
        if (PH_EN(7) && IN(p0 + 6)) { PHASE_BASE();
            pg8::Gemm g = pg8::plain_gemm(WSP(bf16, WS_XN), DM, ws + WS_W + WO_UP, DM, DM, true); pg8::StaticOrder S; S.init(NTOK / 256, DFF / 256, G, bx);
            epi::EpiStore<3> E{WSP(bf16, WS_U), DFF, 0, nullptr}; pg8::gemm_phase<epi::EpiStore<3>, pg8::StaticOrder>(F.tid, ring, xl, g, S, E);
        }
        }
        SEAM(p0 + 6);
        for (int rep_ = 0; rep_ <= DUP_EN(8); ++rep_) { if (rep_) BARRIER_NOW();
        if (PH_EN(8) && IN(p0 + 7)) { PHASE_BASE();
            pg8::Gemm g = pg8::plain_gemm(WSP(bf16, WS_U), DFF, ws + WS_W + WO_DOWN, DFF, DFF, true); pg8::StaticOrder S; S.init(NTOK / 256, DM / 256, G, bx);
            epi::EpiStore<0> E{WSP(bf16, WS_Y), DM, 0, nullptr}; pg8::gemm_phase<epi::EpiStore<0>, pg8::StaticOrder>(F.tid, ring, xl, g, S, E);
        }
        }
        SEAM(p0 + 7);
        if (PH_EN(9) && IN(p0 + 8)) { PHASE_BASE(); norm_pass(F, ap, false, l + 1 == DEPTH, ap->in[19] + l * DM, ws); if (l + 1 < DEPTH) { convert_layer(F, ap, l + 1, ws); if (DUP_EN(9)) convert_layer(F, ap, l + 1, ws); } }
        SEAM(p0 + 8);
    }
#if defined(PROBE_WAIT) && PROBE_WAIT
    { KArgs ap = KARGS(); unsigned* pw = (unsigned*)(ap->ws + 512 * 1024 + 256);
      if (threadIdx.x == 0) { const unsigned w = MISC[17]; atomicMax(pw + 0, w); atomicMin(pw + 64, 0xffffffffu - w); atomicAdd(pw + 128, w / 256u); }
      BARRIER_NOW();
      if (blockIdx.x == 0 && threadIdx.x == 0) { const unsigned v = PROBE_WAIT == 1 ? __hip_atomic_load(pw + 0, RLX_AGENT) : PROBE_WAIT == 2 ? 0xffffffffu - __hip_atomic_load(pw + 64, RLX_AGENT) : __hip_atomic_load(pw + 128, RLX_AGENT);
        const unsigned long long r1 = __builtin_amdgcn_s_memrealtime(); while (__builtin_amdgcn_s_memrealtime() - r1 < (unsigned long long)v) __builtin_amdgcn_s_sleep(32); } }
#endif
#ifdef PROBE_CLOCK
    { BARRIER_NOW(); if (blockIdx.x == 0 && threadIdx.x == 0) { const unsigned long long ck1 = __builtin_amdgcn_s_memtime(), rt1 = __builtin_amdgcn_s_memrealtime(); KArgs ap = KARGS(); const unsigned long long* p = (const unsigned long long*)(ap->ws + 512 * 1024);
        const unsigned long long mhz = (ck1 - p[0]) * 100ull / (rt1 - p[1]);
        while (__builtin_amdgcn_s_memrealtime() - rt1 < mhz * 100ull) __builtin_amdgcn_s_sleep(32); } }
#endif
#undef IN
#undef SEAM
}


#ifndef DBG_LAST
#define DBG_LAST -1
#endif
#ifndef DBG_DUMP_MASK
#define DBG_DUMP_MASK 0xff
#endif
#if DBG_LAST >= 0
__global__ void __launch_bounds__(256) dbg_dump(float* out, const unsigned char* ws) {
    const bf16* Z = (const bf16*)(ws + WS_Z); const bf16* Q = (const bf16*)(ws + WS_Q); const bf16* KV = (const bf16*)(ws + WS_KV); const bf16* PM = (const bf16*)(ws + WS_PM);
    const bf16* ABC = (const bf16*)(ws + WS_ABC); const bf16* MG = (const bf16*)(ws + WS_MERGED); const bf16* XN = (const bf16*)(ws + WS_XN); const bf16* Y = (const bf16*)(ws + WS_Y);
    for (size_t e = (size_t)blockIdx.x * 256 + threadIdx.x; e < (size_t)NTOK * DM; e += (size_t)gridDim.x * 256) {
        const size_t m = e / DM; const int c = (int)(e % DM); float v = 0.f;
        auto f = [](bf16 b) { return __uint_as_float((unsigned)b << 16); };
        if (DBG_DUMP_MASK & 1) v += f(XN[m * DM + c]);
        if (DBG_DUMP_MASK & 2) v += f(Z[m * NZ + c]) + f(Z[m * NZ + 2048 + (c % 1792)]);
        if (DBG_DUMP_MASK & 8) v += f(Q[m * NQC + (c % NQC)]) + f(KV[m * NKVC + c]);
        if (DBG_DUMP_MASK & 16) v += f(PM[m * 1024 + (c & 1023)]);
        if (DBG_DUMP_MASK & 32) v += f(ABC[m * NABC + c]) + f(ABC[m * NABC + 1024 + c]);
        if (DBG_DUMP_MASK & 64) v += f(MG[m * DM + c]);
        if (DBG_DUMP_MASK & 128) v += f(Y[m * DM + c]);
        if (DBG_DUMP_MASK & 256) v += f(((const bf16*)(ws + WS_W))[e]) + f(((const bf16*)(ws + WS_W))[e + 20000000]);
        out[e] = v;
    }
}
#endif

extern "C" void kernel_launch(void* const* d_in, const int* in_sizes, int n_in, void* d_out, int out_size, void* d_ws, size_t ws_size, hipStream_t stream) {
    static int grid = 0;
    if (grid == 0) {
        if (n_in != 22 || out_size != NTOK * DM || ws_size < WS_END) { fprintf(stderr, "kernel_launch: unexpected shapes (n_in %d out %d ws %zu)\n", n_in, out_size, ws_size); grid = -1; return; }
        int dev = 0, cus = 0, per_cu = 0;
        if (hipGetDevice(&dev) != hipSuccess || hipDeviceGetAttribute(&cus, hipDeviceAttributeMultiprocessorCount, dev) != hipSuccess) { grid = -1; return; }
        if (hipFuncSetAttribute((const void*)fwd, hipFuncAttributeMaxDynamicSharedMemorySize, LDS_BYTES) != hipSuccess) { fprintf(stderr, "kernel_launch: hipFuncSetAttribute failed\n"); grid = -1; return; }
        if (hipOccupancyMaxActiveBlocksPerMultiprocessor(&per_cu, (const void*)fwd, NWAVES * 64, LDS_BYTES) != hipSuccess || per_cu < 1)
            fprintf(stderr, "kernel_launch: note: occupancy query reports %d workgroups per CU\n", per_cu);
        (void)hipGetLastError();
        grid = cus;
    }
    if (grid < 0) return;
    (void)in_sizes;
    if (hipMemsetAsync((char*)d_ws + WS_CTL, 0, CTL_ZERO_BYTES, stream) != hipSuccess) return;
    Args a{};
    for (int i = 0; i < 22; ++i) a.in[i] = (const float*)d_in[i];
    a.out = (float*)d_out; a.ws = (unsigned char*)d_ws;
#if MK_N_LAUNCHES == 1
    a.ph_lo = 0; a.ph_hi = N_PHASES;
    hipLaunchKernelGGL(fwd, dim3(grid), dim3(NWAVES * 64), LDS_BYTES, stream, a);
#else
#if DBG_LAST >= 0
    for (int k = 0; k <= DBG_LAST; ++k) { a.ph_lo = k; a.ph_hi = k + 1; hipLaunchKernelGGL(fwd, dim3(grid), dim3(NWAVES * 64), LDS_BYTES, stream, a); }
    hipLaunchKernelGGL(dbg_dump, dim3(2048), dim3(256), 0, stream, (float*)d_out, (const unsigned char*)d_ws);
#else
    for (int k = 0; k < N_PHASES; ++k) { a.ph_lo = k; a.ph_hi = k + 1; hipLaunchKernelGGL(fwd, dim3(grid), dim3(NWAVES * 64), LDS_BYTES, stream, a); }
#endif
#endif
    const hipError_t le = hipPeekAtLastError();
    if (le != hipSuccess) fprintf(stderr, "kernel_launch: launch failed: %s\n", hipGetErrorName(le));
}
```

```cpp
#include <hip/hip_runtime.h>
#include <cstdio>
#include <cstdint>

#define DBG_LAST -1
#define DBG_DUMP_MASK 0x6

#define PROBE_XBAR 0
#define PROBE_WAIT 0
#ifndef MK_N_LAUNCHES
#define MK_N_LAUNCHES 1
#endif

constexpr int DM = 2048, NTOK = 24576, NPROMPT = 16384, DEPTH = 4, DFF = 8192;
constexpr int NZW = 9984, NZ = 3840, NZSRC = 9792;
constexpr int ZC_CQ = 0, ZC_CKV = 512, ZC_QW = 1024, ZC_KW = 2048, ZC_VW = 2304, ZC_QM = 2560, ZC_KR = 3584, ZC_G = 3840;
constexpr int NQC = 1536, NKVC = 2048, NMEMR = 1280, NABC = 3072;
constexpr float EPS = 1e-6f;
constexpr float LOG2E = 1.4426950408889634f;
constexpr float C_W = 0.088388347648318440f * LOG2E;
constexpr float C_M = 0.0625f * LOG2E;
constexpr float C_Q = 0.072168783648703220f * LOG2E;

constexpr size_t MiB = 1u << 20;
constexpr size_t WS_CTL = 0, CTL_ZERO_BYTES = 1 * MiB;
constexpr size_t WS_TAB = 2 * MiB;
constexpr size_t WS_RMEM = 4 * MiB;
constexpr size_t WS_RS = 5 * MiB;
constexpr size_t WS_SSQ = 6 * MiB;
constexpr size_t WS_MEMB = 8 * MiB;
constexpr size_t WS_MEMK = 13 * MiB;
constexpr size_t WS_MEMVT = 16 * MiB;
constexpr size_t WS_W = 32 * MiB;
constexpr size_t WO_IN = 0, WO_UQ = WO_IN + (size_t)NZW * DM * 2, WO_UKV = WO_UQ + (size_t)NQC * 512 * 2, WO_MEM = WO_UKV + (size_t)NKVC * 512 * 2,
                 WO_BR = WO_MEM + (size_t)2048 * DM * 2, WO_OUT = WO_BR + (size_t)DM * NABC * 2, WO_UP = WO_OUT + (size_t)DM * DM * 2,
                 WO_DOWN = WO_UP + (size_t)DFF * DM * 2, WO_END = WO_DOWN + (size_t)DM * DFF * 2;
static_assert(WO_END <= 136 * MiB, "weights region");
constexpr size_t WS_XN = 168 * MiB;
constexpr size_t WS_Z = 264 * MiB;
constexpr size_t WS_GT = 444 * MiB;
constexpr size_t WS_U = WS_Z;
constexpr size_t WS_Q = 732 * MiB;
constexpr size_t WS_KV = 804 * MiB;
constexpr size_t WS_PM = 900 * MiB;
constexpr size_t WS_ABC = 948 * MiB;
constexpr size_t WS_MERGED = 732 * MiB;
constexpr size_t WS_Y = 828 * MiB;
constexpr size_t WS_END = 1092 * MiB;
static_assert(WS_Z + (size_t)NTOK * NZ * 2 <= WS_GT && WS_GT + (size_t)3 * 96 * 8 * 65536 <= WS_Q && WS_MERGED + (size_t)NTOK * DM * 2 <= WS_Y && WS_Y + (size_t)NTOK * DM * 2 <= WS_ABC, "ws map");
constexpr int CW_TMO = 0, CW_BAR = 4096, CW_RANK = 16384;

constexpr int RING_OFF = 0, RING_BYTES = 131072;
constexpr int LDSCTL_OFF = RING_BYTES, MISC_OFF = LDSCTL_OFF + 320;
constexpr int XCH_OFF = RING_BYTES + 1024;
constexpr int LDS_BYTES = 147456;
static_assert(XCH_OFF + 8192 <= LDS_BYTES, "LDS map");
constexpr int NWAVES = 8;

#define GAS __attribute__((address_space(1)))
#define LAS __attribute__((address_space(3)))
typedef unsigned short bf16;
typedef unsigned v4u __attribute__((ext_vector_type(4)));
typedef float f32x4 __attribute__((ext_vector_type(4)));
typedef float f32x2 __attribute__((ext_vector_type(2)));
typedef short bf16x8 __attribute__((ext_vector_type(8)));
typedef GAS unsigned gu32;
#define RLX_AGENT __ATOMIC_RELAXED, __HIP_MEMORY_SCOPE_AGENT
#define LDS_WAIT() asm volatile("s_waitcnt lgkmcnt(0)" ::: "memory")
#define VM_WAIT() asm volatile("s_waitcnt vmcnt(0)" ::: "memory")

typedef float f32x2_t __attribute__((ext_vector_type(2))); typedef __bf16 bf16x2_t __attribute__((ext_vector_type(2)));
__device__ __forceinline__ unsigned cvt_pk_bf16(float lo, float hi) { const f32x2_t v = {lo, hi}; const bf16x2_t b = __builtin_convertvector(v, bf16x2_t); return __builtin_bit_cast(unsigned, b); }
__device__ __forceinline__ float bf_lo(unsigned w) { return __uint_as_float(w << 16); }
__device__ __forceinline__ float bf_hi(unsigned w) { return __uint_as_float(w & 0xffff0000u); }
__device__ __forceinline__ float shfl_xor_l(float v, int m, int lane) { return __int_as_float(__builtin_amdgcn_ds_bpermute((lane ^ m) << 2, __float_as_int(v))); }
__device__ __forceinline__ int seq_pos(int m) { return m < NPROMPT ? (m & 4095) : (m - NPROMPT); }
__device__ __forceinline__ int seq_of_panel(int pm) { return pm < 64 ? (pm >> 4) : 4; }

#ifndef PG8_BALANCED
#define PG8_BALANCED 1
#endif
namespace pg8 {
#define PG8_LAS __attribute__((address_space(3)))
typedef unsigned short bf16_t;
typedef short bf16x8 __attribute__((ext_vector_type(8)));
typedef float f32x4 __attribute__((ext_vector_type(4)));
typedef unsigned u32x4 __attribute__((ext_vector_type(4)));
constexpr int BM = 256, BK = 64, HALF = 128, HTB = HALF * BK * 2, STAGE_BYTES = 8 * HTB, NXCD = 8, WGM = 4;

__host__ __device__ __forceinline__ int lds_byte(int r, int c) { const int st = (r >> 4) * 2 + (c >> 5), rr = r & 15, cc = c & 31, ob = rr * 64 + cc * 2; return st * 1024 + (ob ^ (((ob >> 9) & 1) << 5)); }
__host__ __device__ __forceinline__ void stage_rc(int b, int& R, int& C) { const int st = b / 1024, sb = b % 1024, swz = sb ^ (((sb >> 9) & 1) << 5); R = (st >> 1) * 16 + swz / 64; C = (st & 1) * 32 + (swz % 64) / 2; }
__host__ __device__ __forceinline__ int perm32(int rho) { const int n = rho >> 4, i = rho & 15; return 8 * (i >> 2) + 4 * n + (i & 3); }

struct Unit { int pm, pn; };
struct Gemm { const char* A; const char* B; long a_pm, a_pn, b_pn, b_sq; int lda, ldb, K; bool b_tiled;
    __device__ __forceinline__ const char* aptr(const Unit& u) const { return A + (long)u.pm * a_pm + (long)u.pn * a_pn; }
    __device__ __forceinline__ const char* bptr(const Unit& u) const { return B + (long)u.pn * b_pn + (long)seq_of_panel(u.pm) * b_sq; } };
__device__ __forceinline__ Gemm plain_gemm(const void* A, int lda, const void* B, int ldb, int K, bool b_tiled = false) {
    Gemm g; g.A = (const char*)A; g.B = (const char*)B; g.a_pm = (long)BM * lda * 2; g.a_pn = 0; g.b_pn = b_tiled ? (long)(ldb / BK) * 32768 : (long)BM * ldb * 2; g.b_sq = 0; g.lda = lda; g.ldb = ldb; g.K = K; g.b_tiled = b_tiled; return g; }

struct StaticOrder {
    int nM, nN, nwg, G, c;
    __host__ __device__ void init(int nM_, int nN_, int G_, int c_) { nM = nM_; nN = nN_; nwg = nM * nN; G = G_; c = c_; }
    __host__ __device__ bool next(int i, Unit& u) const {
        const int L = i * G + c; if (L >= nwg) return false;
        int wgid = L; { const int q = nwg / NXCD, r = nwg % NXCD, xcd = wgid % NXCD, off = wgid / NXCD; wgid = (xcd < r ? xcd * (q + 1) : r * (q + 1) + (xcd - r) * q) + off; }
        const int nig = WGM * nN, gid = wgid / nig, fm = gid * WGM, gsz = (nM - fm) < WGM ? (nM - fm) : WGM;
        u.pm = fm + ((wgid % nig) % gsz); u.pn = (wgid % nig) / gsz; return true;
    }
};

typedef f32x4 Acc[2][2][4][2];

template <class Epi, class Sched, bool ALIGN_EPI = true, bool SP2 = true>
__device__ __forceinline__ void gemm_phase(int tid_in, PG8_LAS unsigned char* lds, PG8_LAS unsigned char* xlds, const Gemm g, const Sched& S, const Epi& E) {
    int tid_ = tid_in; asm volatile("" : "+v"(tid_));
    const int tid = tid_, wid = __builtin_amdgcn_readfirstlane(tid >> 6), lane = tid & 63, wr = wid >> 2, wc = wid & 3, fr = lane & 15, fq = lane >> 4;
    const int K = g.K, nt = K / BK;
    unsigned voffA[2], voffB[2];
#pragma unroll
    for (int i = 0; i < 2; ++i) { int R, C; stage_rc(tid * 16 + i * 8192, R, C); const int Rb = Epi::PERM ? ((R & ~31) + perm32(R & 31)) : R;
        voffA[i] = (unsigned)(R * g.lda + C) * 2u; voffB[i] = g.b_tiled ? (unsigned)(tid * 16 + i * 8192) : (unsigned)(Rb * g.ldb + C) * 2u; }
    const size_t kstep = (size_t)(BK * 2), kstepB = g.b_tiled ? (size_t)32768 : (size_t)(BK * 2);
    const size_t hstepA = (size_t)HALF * g.lda * 2, hstepB = g.b_tiled ? (size_t)16384 : (size_t)HALF * g.ldb * 2;
    const unsigned ldsw = (unsigned)wid * 1024u;
    const int aoff = lds_byte(wr * 64 + fr, fq * 8), boff = lds_byte(wc * 32 + fr, fq * 8);
#define PG8_SA(b, h) (((b) * 2 + (h)) * HTB)
#define PG8_SB(b, h) ((4 + (b) * 2 + (h)) * HTB)
#define PG8_STAGE(bufoff, gbase, voff) do { _Pragma("unroll") for (int _i = 0; _i < 2; ++_i) \
        __builtin_amdgcn_global_load_lds((const unsigned*)((const char*)(gbase) + (voff)[_i]), (PG8_LAS unsigned*)(lds + (bufoff) + ldsw + _i * 8192), 16, 0, 0); } while (0)
#define PG8_LDA(dst, b, h) do { _Pragma("unroll") for (int m = 0; m < 4; ++m) _Pragma("unroll") for (int k = 0; k < 2; ++k) dst[m][k] = *(const PG8_LAS bf16x8*)(lds + PG8_SA(b, h) + aoff + m * 2048 + k * 1024); } while (0)
#define PG8_LDB(dst, b, h) do { _Pragma("unroll") for (int n = 0; n < 2; ++n) _Pragma("unroll") for (int k = 0; k < 2; ++k) dst[n][k] = *(const PG8_LAS bf16x8*)(lds + PG8_SB(b, h) + boff + n * 2048 + k * 1024); } while (0)
#define PG8_MMA(ai, bj, At, Bt) do { __builtin_amdgcn_s_setprio(1); _Pragma("unroll") for (int m = 0; m < 4; ++m) _Pragma("unroll") for (int n = 0; n < 2; ++n) _Pragma("unroll") for (int k = 0; k < 2; ++k) \
        acc[ai][bj][m][n] = __builtin_amdgcn_mfma_f32_16x16x32_bf16(Bt[n][k], At[m][k], acc[ai][bj][m][n], 0, 0, 0); __builtin_amdgcn_s_setprio(0); } while (0)
#define PG8_WAIT_V(n) asm volatile("s_waitcnt vmcnt(" #n ")" ::: "memory")
#define PG8_WAIT_L(n) asm volatile("s_waitcnt lgkmcnt(" #n ")" ::: "memory")
#define PG8_BAR __builtin_amdgcn_s_barrier()
#define PG8_SCHED __builtin_amdgcn_sched_barrier(0)
    Unit cur, nxt; int ui = 0;
    if (!S.next(0, cur)) return;
    f32x4 acc[2][2][4][2];
#pragma unroll
    for (int a = 0; a < 2; ++a)
#pragma unroll
        for (int b = 0; b < 2; ++b)
#pragma unroll
            for (int m = 0; m < 4; ++m)
#pragma unroll
                for (int n = 0; n < 2; ++n) acc[a][b][m][n] = (f32x4){0.f, 0.f, 0.f, 0.f};
    bf16x8 At[4][2], B0[2][2], B1[2][2];
    const char* cA = g.aptr(cur); const char* cB = g.bptr(cur);
    if constexpr (SP2 && PG8_BALANCED) {
        PG8_STAGE(PG8_SB(0, 0), cB, voffB); PG8_STAGE(PG8_SB(0, 1), cB + hstepB, voffB); PG8_STAGE(PG8_SA(0, 0), cA, voffA); PG8_STAGE(PG8_SA(0, 1), cA + hstepA, voffA);
        if (wr == 1) PG8_BAR;
        PG8_WAIT_V(2); PG8_BAR;
        PG8_STAGE(PG8_SB(1, 0), cB + kstepB, voffB); PG8_STAGE(PG8_SB(1, 1), cB + hstepB + kstepB, voffB);
        PG8_WAIT_V(4); PG8_BAR;
    } else if constexpr (SP2) {
        PG8_STAGE(PG8_SB(0, 0), cB, voffB); PG8_STAGE(PG8_SB(0, 1), cB + hstepB, voffB); PG8_STAGE(PG8_SA(0, 0), cA, voffA); PG8_STAGE(PG8_SA(0, 1), cA + hstepA, voffA);
        if (wr == 1) PG8_BAR;
        PG8_WAIT_V(2); PG8_BAR;
        PG8_STAGE(PG8_SB(1, 0), cB + kstepB, voffB); PG8_STAGE(PG8_SA(1, 0), cA + kstep, voffA); PG8_STAGE(PG8_SB(1, 1), cB + hstepB + kstepB, voffB);
        PG8_WAIT_V(6); PG8_BAR;
    } else {
        PG8_STAGE(PG8_SB(0, 0), cB, voffB); PG8_STAGE(PG8_SA(0, 0), cA, voffA); PG8_STAGE(PG8_SB(0, 1), cB + hstepB, voffB); PG8_STAGE(PG8_SA(0, 1), cA + hstepA, voffA);
        if (wr == 1) PG8_BAR;
        PG8_WAIT_V(4); PG8_BAR;
        PG8_STAGE(PG8_SB(1, 0), cB + kstepB, voffB); PG8_STAGE(PG8_SA(1, 0), cA + kstep, voffA); PG8_STAGE(PG8_SB(1, 1), cB + hstepB + kstepB, voffB);
        PG8_WAIT_V(6); PG8_BAR;
    }
    for (;;) {
        const bool has_next = S.next(ui + 1, nxt);
        const char* nA = has_next ? g.aptr(nxt) : cA; const char* nB = has_next ? g.bptr(nxt) : cB;
        for (int t = 0; t < nt; t += 2) {
            const bool last = (t == nt - 2);
            if constexpr (Epi::HAS_MID) { if (t == Epi::MID1 || t == Epi::MID2) E.mid(acc, cur, t, wr, wc, fr, fq); }
            const char* a1 = cA + (size_t)(t + 1) * kstep;
            const char* a2 = last ? nA : cA + (size_t)(t + 2) * kstep; const char* b2 = last ? nB : cB + (size_t)(t + 2) * kstepB;
            const char* a3 = a2 + kstep; const char* b3 = b2 + kstepB;
            if constexpr (SP2 && PG8_BALANCED) {
            PG8_LDB(B0, 0, 0); PG8_LDB(B1, 0, 1); PG8_SCHED; PG8_LDA(At, 0, 0); PG8_STAGE(PG8_SA(1, 0), a1, voffA); PG8_STAGE(PG8_SA(1, 1), a1 + hstepA, voffA);
            PG8_WAIT_V(8); PG8_WAIT_L(0); PG8_BAR; PG8_MMA(0, 0, At, B0); PG8_MMA(0, 1, At, B1); PG8_BAR; PG8_SCHED;
            PG8_LDA(At, 0, 1); PG8_STAGE(PG8_SB(0, 0), b2, voffB); PG8_STAGE(PG8_SB(0, 1), b2 + hstepB, voffB);
            PG8_WAIT_V(6); PG8_WAIT_L(0); PG8_BAR; PG8_MMA(1, 0, At, B0); PG8_MMA(1, 1, At, B1); PG8_BAR; PG8_SCHED;
            PG8_LDB(B0, 1, 0); PG8_LDB(B1, 1, 1); PG8_SCHED; PG8_LDA(At, 1, 0); PG8_STAGE(PG8_SA(0, 0), a2, voffA); PG8_STAGE(PG8_SA(0, 1), a2 + hstepA, voffA);
            PG8_WAIT_V(8); PG8_WAIT_L(0); PG8_BAR; PG8_MMA(0, 0, At, B0); PG8_MMA(0, 1, At, B1); PG8_BAR; PG8_SCHED;
            PG8_LDA(At, 1, 1); PG8_STAGE(PG8_SB(1, 0), b3, voffB); PG8_STAGE(PG8_SB(1, 1), b3 + hstepB, voffB);
            PG8_WAIT_V(6); PG8_WAIT_L(0); PG8_BAR; PG8_MMA(1, 0, At, B0); PG8_MMA(1, 1, At, B1); PG8_BAR; PG8_SCHED;
            } else if constexpr (SP2) {
            PG8_LDB(B0, 0, 0); PG8_LDB(B1, 0, 1); PG8_SCHED; PG8_LDA(At, 0, 0); PG8_STAGE(PG8_SA(1, 1), a1 + hstepA, voffA);
            PG8_WAIT_V(8); PG8_WAIT_L(0); PG8_BAR; PG8_MMA(0, 0, At, B0); PG8_MMA(0, 1, At, B1); PG8_BAR; PG8_SCHED;
            PG8_LDA(At, 0, 1); PG8_STAGE(PG8_SB(0, 0), b2, voffB); PG8_STAGE(PG8_SB(0, 1), b2 + hstepB, voffB); PG8_STAGE(PG8_SA(0, 0), a2, voffA);
            PG8_WAIT_V(8); PG8_WAIT_L(0); PG8_BAR; PG8_MMA(1, 0, At, B0); PG8_MMA(1, 1, At, B1); PG8_BAR; PG8_SCHED;
            PG8_LDB(B0, 1, 0); PG8_LDB(B1, 1, 1); PG8_SCHED; PG8_LDA(At, 1, 0); PG8_STAGE(PG8_SA(0, 1), a2 + hstepA, voffA);
            PG8_WAIT_V(8); PG8_WAIT_L(0); PG8_BAR; PG8_MMA(0, 0, At, B0); PG8_MMA(0, 1, At, B1); PG8_BAR; PG8_SCHED;
            PG8_LDA(At, 1, 1); PG8_STAGE(PG8_SB(1, 0), b3, voffB); PG8_STAGE(PG8_SB(1, 1), b3 + hstepB, voffB); PG8_STAGE(PG8_SA(1, 0), a3, voffA);
            PG8_WAIT_V(8); PG8_WAIT_L(0); PG8_BAR; PG8_MMA(1, 0, At, B0); PG8_MMA(1, 1, At, B1); PG8_BAR; PG8_SCHED;
            } else {
            PG8_LDB(B0, 0, 0); PG8_SCHED; PG8_LDA(At, 0, 0); PG8_STAGE(PG8_SA(1, 1), a1 + hstepA, voffA);
            PG8_WAIT_L(8); PG8_BAR; PG8_WAIT_L(0); PG8_MMA(0, 0, At, B0); PG8_BAR; PG8_SCHED;
            PG8_LDB(B1, 0, 1); PG8_STAGE(PG8_SB(0, 0), b2, voffB);
            PG8_BAR; PG8_WAIT_L(0); PG8_MMA(0, 1, At, B1); PG8_BAR;
            PG8_LDA(At, 0, 1); PG8_STAGE(PG8_SA(0, 0), a2, voffA);
            PG8_BAR; PG8_WAIT_L(0); PG8_MMA(1, 0, At, B0); PG8_BAR; PG8_SCHED;
            PG8_STAGE(PG8_SB(0, 1), b2 + hstepB, voffB);
            PG8_WAIT_V(6); PG8_BAR; PG8_MMA(1, 1, At, B1); PG8_BAR;
            PG8_LDB(B0, 1, 0); PG8_SCHED; PG8_LDA(At, 1, 0); PG8_STAGE(PG8_SA(0, 1), a2 + hstepA, voffA);
            PG8_WAIT_L(8); PG8_BAR; PG8_WAIT_L(0); PG8_MMA(0, 0, At, B0); PG8_BAR; PG8_SCHED;
            PG8_LDB(B1, 1, 1); PG8_STAGE(PG8_SB(1, 0), b3, voffB);
            PG8_BAR; PG8_WAIT_L(0); PG8_MMA(0, 1, At, B1); PG8_BAR;
            PG8_LDA(At, 1, 1); PG8_STAGE(PG8_SA(1, 0), a3, voffA);
            PG8_BAR; PG8_WAIT_L(0); PG8_MMA(1, 0, At, B0); PG8_BAR; PG8_SCHED;
            PG8_STAGE(PG8_SB(1, 1), b3 + hstepB, voffB);
            PG8_WAIT_V(6); PG8_BAR; PG8_MMA(1, 1, At, B1); PG8_BAR;
            }
        }
        if constexpr (ALIGN_EPI) { if (wr == 0) PG8_BAR; }
        E(acc, cur, wr, wc, fr, fq, xlds, wid, lane);
        if (!has_next) break;
#pragma unroll
        for (int a = 0; a < 2; ++a)
#pragma unroll
            for (int b = 0; b < 2; ++b)
#pragma unroll
                for (int m = 0; m < 4; ++m)
#pragma unroll
                    for (int n = 0; n < 2; ++n) acc[a][b][m][n] = (f32x4){0.f, 0.f, 0.f, 0.f};
        cur = nxt; cA = nA; cB = nB; ++ui;
        if constexpr (ALIGN_EPI) { if (wr == 1) PG8_BAR; }
    }
    PG8_WAIT_V(0);
    if constexpr (!ALIGN_EPI) { if (wr == 0) PG8_BAR; }
    PG8_BAR;
#undef PG8_SA
#undef PG8_SB
#undef PG8_STAGE
#undef PG8_LDA
#undef PG8_LDB
#undef PG8_MMA
#undef PG8_WAIT_V
#undef PG8_WAIT_L
#undef PG8_BAR
#undef PG8_SCHED
}
}

namespace epi {
using pg8::Acc; using pg8::Unit; using pg8::HALF; using pg8::BM;
typedef float f32x2v __attribute__((ext_vector_type(2)));
#define EPI_COMMON static constexpr bool PERM = true;
#define EPI_PIN(a, b) asm volatile("" : "+v"(a), "+v"(b))
#define EPI_NOMID static constexpr bool HAS_MID = false; static constexpr int MID1 = -1, MID2 = -1;
__device__ __forceinline__ v4u pack8(const f32x4 v0, const f32x4 v1) { v4u w; w.x = cvt_pk_bf16(v0[0], v0[1]); w.y = cvt_pk_bf16(v0[2], v0[3]); w.z = cvt_pk_bf16(v1[0], v1[1]); w.w = cvt_pk_bf16(v1[2], v1[3]); return w; }
__device__ __forceinline__ void rope8(f32x4& v0, f32x4& v1, const f32x4 cs0, const f32x4 cs1, const f32x4 cs2, const f32x4 cs3) {
    (void)cs2; (void)cs3;
    const float a0 = v0[0] * cs0[0] - v0[1] * cs0[1], b0 = v0[0] * cs0[1] + v0[1] * cs0[0];
    const float a1 = v0[2] * cs0[2] - v0[3] * cs0[3], b1 = v0[2] * cs0[3] + v0[3] * cs0[2];
    const float a2 = v1[0] * cs1[0] - v1[1] * cs1[1], b2 = v1[0] * cs1[1] + v1[1] * cs1[0];
    const float a3 = v1[2] * cs1[2] - v1[3] * cs1[3], b3 = v1[2] * cs1[3] + v1[3] * cs1[2];
    v0 = (f32x4){a0, b0, a1, b1}; v1 = (f32x4){a2, b2, a3, b3};
}
__device__ __forceinline__ unsigned pack4u8(const f32x4 v) {
    unsigned b[4];
#pragma unroll
    for (int j = 0; j < 4; ++j) b[j] = __float_as_uint(fmaxf(__builtin_fmaf(v[j], 255.f, 8388608.f), 8388609.f));
    const unsigned lo = __builtin_amdgcn_perm(b[1], b[0], 0x0c0c0400u), hi = __builtin_amdgcn_perm(b[3], b[2], 0x0c0c0400u);
    return lo | (hi << 16);
}
__device__ __forceinline__ f32x4 ub4(unsigned x) { return (f32x4){(float)(x & 0xffu), (float)((x >> 8) & 0xffu), (float)((x >> 16) & 0xffu), (float)(x >> 24)}; }
__device__ __forceinline__ f32x4 rcp4(const f32x4 v) { return (f32x4){__builtin_amdgcn_rcpf(v[0]), __builtin_amdgcn_rcpf(v[1]), __builtin_amdgcn_rcpf(v[2]), __builtin_amdgcn_rcpf(v[3])}; }
__device__ __forceinline__ float sigmoidf_fast(float v) { return __builtin_amdgcn_rcpf(1.f + __builtin_amdgcn_exp2f(-LOG2E * v)); }

struct EpiZ { EPI_COMMON EPI_NOMID
    bf16* Z; float* SSQ; const float* tab; unsigned char* GT;
    __device__ __forceinline__ void operator()(Acc& acc, const Unit& u, int wr, int wc, int fr, int fq, LAS unsigned char*, int, int lane) const {
        const int pn = u.pn; int row0 = u.pm * BM + wr * 64 + fr, col0 = pn * BM + wc * 32 + 8 * fq; EPI_PIN(row0, col0);
        if (pn >= 15) {
            const int gi = pn - 15; unsigned char* blk = GT + ((size_t)((gi >> 3) * 96 + u.pm) * 8 + (gi & 7)) * 65536 + (size_t)(wr * 4 + wc) * 8192 + lane * 16;
#pragma unroll
            for (int ai = 0; ai < 2; ++ai)
#pragma unroll
                for (int m = 0; m < 4; ++m) { v4u o;
#pragma unroll
                    for (int bj = 0; bj < 2; ++bj) { f32x4 v0 = acc[ai][bj][m][0], v1 = acc[ai][bj][m][1];
#pragma unroll
                        for (int j = 0; j < 4; ++j) { v0[j] = sigmoidf_fast(v0[j]); v1[j] = sigmoidf_fast(v1[j]); }
                        const unsigned q0 = pack4u8(v0), q1 = pack4u8(v1);
                        if (bj == 0) { o.x = q0; o.y = q1; } else { o.z = q0; o.w = q1; } }
                    *(v4u*)(blk + (ai * 4 + m) * 1024) = o; }
        } else if (pn == 14) {
            const int i0 = 16 * (wc & 1) + 4 * fq;
#pragma unroll
            for (int ai = 0; ai < 2; ++ai)
#pragma unroll
                for (int m = 0; m < 4; ++m) { const int row = row0 + ai * HALF + m * 16; bf16* rowp = Z + (size_t)row * NZ + col0;
                    f32x4 v0 = acc[ai][0][m][0], v1 = acc[ai][0][m][1];
                    if (wc < 2) { const f32x4* cs = (const f32x4*)(tab + ((size_t)seq_pos(row) * 32 + i0) * 2); rope8(v0, v1, cs[0], cs[1], cs[0], cs[0]); }
                    *(v4u*)(rowp) = pack8(v0, v1);
                    *(v4u*)(rowp + HALF) = pack8(acc[ai][1][m][0], acc[ai][1][m][1]); }
        } else {
            const float sc = (pn >= 4 && pn < 8) ? C_W : ((pn >= 10) ? C_M : 1.f);
#pragma unroll
            for (int ai = 0; ai < 2; ++ai)
#pragma unroll
                for (int m = 0; m < 4; ++m) { const int row = row0 + ai * HALF + m * 16; bf16* rowp = Z + (size_t)row * NZ + col0; float ss = 0.f;
#pragma unroll
                    for (int bj = 0; bj < 2; ++bj) { const f32x4 v0 = acc[ai][bj][m][0] * sc, v1 = acc[ai][bj][m][1] * sc;
                        ss += (v0[0] * v0[0] + v0[1] * v0[1]) + (v0[2] * v0[2] + v0[3] * v0[3]) + (v1[0] * v1[0] + v1[1] * v1[1]) + (v1[2] * v1[2] + v1[3] * v1[3]);
                        *(v4u*)(rowp + bj * HALF) = pack8(v0, v1); }
                    if (pn < 4) { ss += shfl_xor_l(ss, 16, lane); ss += shfl_xor_l(ss, 32, lane); if (fq == 0) SSQ[(size_t)row * 16 + pn * 4 + wc] = ss; } }
        }
    }
};
template <int WHICH  > struct EpiLat { EPI_COMMON EPI_NOMID
    bf16* O; const float* SSQ; const float* tab;
    __device__ __forceinline__ void operator()(Acc& acc, const Unit& u, int wr, int wc, int fr, int fq, LAS unsigned char*, int, int) const {
        constexpr int LDC = WHICH == 0 ? NQC : NKVC;
        const int pn = u.pn; int row0 = u.pm * BM + wr * 64 + fr, col0 = pn * BM + wc * 32 + 8 * fq; EPI_PIN(row0, col0);
        const int i0 = 16 * (wc & 1) + 4 * fq;
#pragma unroll
        for (int ai = 0; ai < 2; ++ai)
#pragma unroll
            for (int m = 0; m < 4; ++m) { const int row = row0 + ai * HALF + m * 16; bf16* rowp = O + (size_t)row * LDC + col0;
                const f32x4* sp = (const f32x4*)(SSQ + (size_t)row * 16 + WHICH * 8); const f32x4 s0 = sp[0], s1 = sp[1];
                const float ssum = ((s0[0] + s0[1]) + (s0[2] + s0[3])) + ((s1[0] + s1[1]) + (s1[2] + s1[3]));
                const float rs = __builtin_amdgcn_rsqf(ssum * (1.f / 512.f) + EPS) * (WHICH == 0 ? C_Q : 1.f);
#pragma unroll
                for (int bj = 0; bj < 2; ++bj) { f32x4 v0 = acc[ai][bj][m][0] * rs, v1 = acc[ai][bj][m][1] * rs;
                    if (WHICH == 0 && pn >= 4) { const f32x4* cs = (const f32x4*)(tab + ((size_t)seq_pos(row) * 32 + i0) * 2); rope8(v0, v1, cs[0], cs[1], cs[0], cs[0]); }
                    *(v4u*)(rowp + bj * HALF) = pack8(v0, v1); } }
    }
};
template <int MODE> struct EpiStore { EPI_COMMON EPI_NOMID
    bf16* O; int ldc; int col_off; const float* rs;
    __device__ __forceinline__ void operator()(Acc& acc, const Unit& u, int wr, int wc, int fr, int fq, LAS unsigned char*, int, int) const {
        int row0 = u.pm * BM + wr * 64 + fr, ct = u.pn * BM + wc * 32 + 8 * fq; EPI_PIN(row0, ct); const int col0 = col_off + ct;
        f32x4 cs[2][2]; float rr[2][4];
#pragma unroll
        for (int ai = 0; ai < 2; ++ai)
#pragma unroll
            for (int m = 0; m < 4; ++m) rr[ai][m] = (MODE == 1 || MODE == 5) ? rs[row0 + ai * HALF + m * 16] : 1.f;
        if (MODE == 2) {
#pragma unroll
            for (int bj = 0; bj < 2; ++bj) { cs[bj][0] = *(const f32x4*)(rs + ct + bj * HALF); cs[bj][1] = *(const f32x4*)(rs + ct + bj * HALF + 4); } }
#pragma unroll
        for (int ai = 0; ai < 2; ++ai)
#pragma unroll
            for (int m = 0; m < 4; ++m) { const int row = row0 + ai * HALF + m * 16; bf16* rowp = O + (size_t)row * ldc + col0;
                const float r = rr[ai][m];
#pragma unroll
                for (int bj = 0; bj < 2; ++bj) { f32x4 v0 = acc[ai][bj][m][0], v1 = acc[ai][bj][m][1];
                    if (MODE == 1 || MODE == 5) { v0 = v0 * r; v1 = v1 * r; }
                    if (MODE == 2) { v0 = v0 * cs[bj][0]; v1 = v1 * cs[bj][1]; }
                    if (MODE == 3 || MODE == 5) {
#pragma unroll
                        for (int j = 0; j < 4; ++j) { const float a = fmaxf(v0[j], 0.f), b = fmaxf(v1[j], 0.f); v0[j] = a * a; v1[j] = b * b; } }
                    *(v4u*)(rowp + bj * HALF) = pack8(v0, v1); } }
    }
};
struct EpiSoftmax { EPI_COMMON EPI_NOMID
    bf16* O;
    __device__ __forceinline__ void operator()(Acc& acc, const Unit& u, int wr, int wc, int fr, int fq, LAS unsigned char* xl, int, int lane) const {
        LAS float* MX = (LAS float*)xl; LAS float* SM = (LAS float*)(xl + 4096);
        int row0 = u.pm * BM + wr * 64 + fr, col0 = u.pn * BM + wc * 32 + 8 * fq; EPI_PIN(row0, col0);
#pragma unroll
        for (int ai = 0; ai < 2; ++ai)
#pragma unroll
            for (int m = 0; m < 4; ++m) { float mx = -3.0e38f;
#pragma unroll
                for (int bj = 0; bj < 2; ++bj)
#pragma unroll
                    for (int n = 0; n < 2; ++n) { const f32x4 x = acc[ai][bj][m][n]; mx = fmaxf(mx, fmaxf(fmaxf(x[0], x[1]), fmaxf(x[2], x[3]))); }
                mx = fmaxf(mx, shfl_xor_l(mx, 16, lane)); mx = fmaxf(mx, shfl_xor_l(mx, 32, lane));
                if (fq == 0) MX[(ai * HALF + wr * 64 + m * 16 + fr) * 4 + wc] = mx; }
        asm volatile("s_waitcnt lgkmcnt(0)" ::: "memory"); __builtin_amdgcn_s_barrier(); asm volatile("" ::: "memory");
#pragma unroll
        for (int ai = 0; ai < 2; ++ai)
#pragma unroll
            for (int m = 0; m < 4; ++m) { const int lr = ai * HALF + wr * 64 + m * 16 + fr; const f32x4 q = *(LAS f32x4*)(MX + lr * 4);
                const float mx = fmaxf(fmaxf(q[0], q[1]), fmaxf(q[2], q[3])); float s = 0.f;
#pragma unroll
                for (int bj = 0; bj < 2; ++bj)
#pragma unroll
                    for (int n = 0; n < 2; ++n) { f32x4 x = acc[ai][bj][m][n];
#pragma unroll
                        for (int j = 0; j < 4; ++j) { x[j] = __builtin_amdgcn_exp2f(x[j] - mx); s += x[j]; }
                        acc[ai][bj][m][n] = x; }
                s += shfl_xor_l(s, 16, lane); s += shfl_xor_l(s, 32, lane);
                if (fq == 0) SM[lr * 4 + wc] = s; }
        asm volatile("s_waitcnt lgkmcnt(0)" ::: "memory"); __builtin_amdgcn_s_barrier(); asm volatile("" ::: "memory");
#pragma unroll
        for (int ai = 0; ai < 2; ++ai)
#pragma unroll
            for (int m = 0; m < 4; ++m) { const int lr = ai * HALF + wr * 64 + m * 16 + fr; const f32x4 q = *(LAS f32x4*)(SM + lr * 4);
                const float inv = __builtin_amdgcn_rcpf((q[0] + q[1]) + (q[2] + q[3]));
                bf16* rowp = O + (size_t)(row0 + ai * HALF + m * 16) * 1024 + col0;
#pragma unroll
                for (int bj = 0; bj < 2; ++bj) *(v4u*)(rowp + bj * HALF) = pack8(acc[ai][bj][m][0] * inv, acc[ai][bj][m][1] * inv); }
    }
};
struct EpiBranch { EPI_COMMON
    static constexpr bool HAS_MID = true; static constexpr int MID1 = 16, MID2 = 32;
    bf16* O; const unsigned char* GT;
    __device__ __forceinline__ const unsigned char* gblk(const Unit& u, int g, int wr, int wc, int fr, int fq) const {
        return GT + ((size_t)(g * 96 + u.pm) * 8 + u.pn) * 65536 + (size_t)(wr * 4 + wc) * 8192 + (fq * 16 + fr) * 16; }
    __device__ __forceinline__ void mid(Acc& acc, const Unit& u, int t, int wr, int wc, int fr, int fq) const {
        const int gxi = (t == MID1) ? 0 : 1;
        const unsigned char* px = gblk(u, gxi, wr, wc, fr, fq); const unsigned char* py = gblk(u, gxi + 1, wr, wc, fr, fq);
        v4u a[2][4], b[2][4];
#pragma unroll
        for (int ai = 0; ai < 2; ++ai)
#pragma unroll
            for (int m = 0; m < 4; ++m) { a[ai][m] = *(const v4u*)(px + (ai * 4 + m) * 1024); b[ai][m] = *(const v4u*)(py + (ai * 4 + m) * 1024); }
        __builtin_amdgcn_sched_barrier(0);
#pragma unroll
        for (int ai = 0; ai < 2; ++ai)
#pragma unroll
            for (int m = 0; m < 4; ++m) { const v4u x = a[ai][m], y = b[ai][m];
                acc[ai][0][m][0] *= ub4(x.x) * rcp4(ub4(y.x)); acc[ai][0][m][1] *= ub4(x.y) * rcp4(ub4(y.y));
                acc[ai][1][m][0] *= ub4(x.z) * rcp4(ub4(y.z)); acc[ai][1][m][1] *= ub4(x.w) * rcp4(ub4(y.w)); }
        __builtin_amdgcn_sched_barrier(0);
    }
    __device__ __forceinline__ void operator()(Acc& acc, const Unit& u, int wr, int wc, int fr, int fq, LAS unsigned char*, int, int) const {
        int row0 = u.pm * BM + wr * 64 + fr, col0 = u.pn * BM + wc * 32 + 8 * fq; EPI_PIN(row0, col0);
        const unsigned char* pz = gblk(u, 2, wr, wc, fr, fq);
        v4u a[2][4];
#pragma unroll
        for (int ai = 0; ai < 2; ++ai)
#pragma unroll
            for (int m = 0; m < 4; ++m) a[ai][m] = *(const v4u*)(pz + (ai * 4 + m) * 1024);
        __builtin_amdgcn_sched_barrier(0);
        constexpr float I255 = 1.f / 255.f;
#pragma unroll
        for (int ai = 0; ai < 2; ++ai)
#pragma unroll
            for (int m = 0; m < 4; ++m) { bf16* rowp = O + (size_t)(row0 + ai * HALF + m * 16) * DM + col0; const v4u x = a[ai][m];
                *(v4u*)(rowp) = pack8(acc[ai][0][m][0] * (ub4(x.x) * I255), acc[ai][0][m][1] * (ub4(x.y) * I255));
                *(v4u*)(rowp + HALF) = pack8(acc[ai][1][m][0] * (ub4(x.z) * I255), acc[ai][1][m][1] * (ub4(x.w) * I255)); }
        __builtin_amdgcn_sched_barrier(0);
    }
};
}

namespace att {
using s16x4 = __attribute__((ext_vector_type(4))) short;
using f32x16 = __attribute__((ext_vector_type(16))) float;
using u32x4 = __attribute__((ext_vector_type(4))) unsigned;
constexpr int NW = 8, QBLK = 32, KVBLK = 64;
constexpr float THR2 = 8.f;
constexpr float NEGBIG = -1.0e30f;
#define SBAR() __builtin_amdgcn_sched_barrier(0)
__device__ __forceinline__ int crow(int r, int hi) { return (r & 3) + 8 * (r >> 2) + 4 * hi; }
template <int KROWB> __device__ __forceinline__ int kswz(int row, int colB) { return row * KROWB + (colB ^ ((KROWB == 384 ? ((row >> 1) & 7) : (row & 15)) << 4)); }

struct Mask { int dq; float sl; };

template <bool WIN>
__device__ __forceinline__ void partialSM(f32x16& p0, f32x16& p1, float& m_reg, float& mn, float& alpha, const Mask& mk, int kt) {
  if (WIN) {
    const float fd = (float)(mk.dq - kt * KVBLK);
#pragma unroll
    for (int r = 0; r < 16; ++r) { const float d0 = fd - (float)((r & 3) + 8 * (r >> 2)), d1 = d0 - 32.f; const float a0 = fabsf(d0), a1 = fabsf(d1);
      const float t0 = p0[r] - mk.sl * a0, t1 = p1[r] - mk.sl * a1; p0[r] = (a0 <= 128.f) ? t0 : NEGBIG; p1[r] = (a1 <= 128.f) ? t1 : NEGBIG; }
  }
  float pmax = p0[0];
#pragma unroll
  for (int r = 1; r < 16; ++r) pmax = fmaxf(pmax, p0[r]);
#pragma unroll
  for (int r = 0; r < 16; ++r) pmax = fmaxf(pmax, p1[r]);
  { auto rr = __builtin_amdgcn_permlane32_swap(__float_as_uint(pmax), __float_as_uint(pmax), false, false);
    pmax = fmaxf(__uint_as_float(rr[0]), __uint_as_float(rr[1])); }
  if (__builtin_expect(__all(pmax - m_reg <= THR2), 1)) { mn = m_reg; alpha = 1.f; }
  else { mn = fmaxf(m_reg, pmax); alpha = __builtin_amdgcn_exp2f(m_reg - mn); m_reg = mn; }
#pragma unroll
  for (int r = 0; r < 16; ++r) p0[r] = p0[r] - mn;
#pragma unroll
  for (int r = 0; r < 16; ++r) p1[r] = p1[r] - mn;
#pragma unroll
  for (int r = 0; r < 16; ++r) p0[r] = __builtin_amdgcn_exp2f(p0[r]);
}
__device__ __forceinline__ void finishSM(f32x16& p0, f32x16& p1, float alpha, float& l_reg, bf16x8& pa0, bf16x8& pa1, bf16x8& pa2, bf16x8& pa3) {
#pragma unroll
  for (int r = 0; r < 16; ++r) p1[r] = __builtin_amdgcn_exp2f(p1[r]);
  float ps = 0;
#pragma unroll
  for (int r = 0; r < 16; ++r) ps += p0[r];
#pragma unroll
  for (int r = 0; r < 16; ++r) ps += p1[r];
  { auto rr = __builtin_amdgcn_permlane32_swap(__float_as_uint(ps), __float_as_uint(ps), false, false);
    ps = __uint_as_float(rr[0]) + __uint_as_float(rr[1]); }
  l_reg = l_reg * alpha + ps;
#define PK4(P, BASE, OUT) do { unsigned a0 = cvt_pk_bf16(P[BASE + 0], P[BASE + 1]), a1 = cvt_pk_bf16(P[BASE + 2], P[BASE + 3]);   \
    unsigned b0 = cvt_pk_bf16(P[BASE + 4], P[BASE + 5]), b1 = cvt_pk_bf16(P[BASE + 6], P[BASE + 7]);                              \
    auto r0 = __builtin_amdgcn_permlane32_swap(a0, b0, false, false); auto r1 = __builtin_amdgcn_permlane32_swap(a1, b1, false, false); \
    u32x4 w = {r0[0], r1[0], r0[1], r1[1]}; OUT = *reinterpret_cast<bf16x8*>(&w); } while (0)
  PK4(p0, 0, pa0); PK4(p0, 8, pa1); PK4(p1, 0, pa2); PK4(p1, 8, pa3);
#undef PK4
}
template <int NQF, int KROWB>
__device__ __forceinline__ void qkt(f32x16& p0, f32x16& p1, const LAS char* Ks, const bf16x8* qr, int r32, int hi) {
  p0 = f32x16{}; p1 = f32x16{};
#pragma unroll
  for (int d0 = 0; d0 < NQF; ++d0) { const int cb = (d0 * 16 + hi * 8) * 2;
    bf16x8 b0 = *(const LAS bf16x8*)(Ks + kswz<KROWB>(r32, cb));
    bf16x8 b1 = *(const LAS bf16x8*)(Ks + kswz<KROWB>(32 + r32, cb));
    p0 = __builtin_amdgcn_mfma_f32_32x32x16_bf16(b0, qr[d0], p0, 0, 0, 0);
    p1 = __builtin_amdgcn_mfma_f32_32x32x16_bf16(b1, qr[d0], p1, 0, 0, 0); }
}
__device__ __forceinline__ int v_st(int k, int c) { const int kk = (k & ~0xC) | ((k & 4) << 1) | ((k & 8) >> 1); return ((kk >> 3) * 4 + (c >> 5)) * 512 + ((kk & 7) * 32 + (c & 31)) * 2; }
__device__ __forceinline__ int v_rd_base(int lane) { return ((lane & 3) << 3) | (((lane >> 2) & 3) << 6) | (((lane >> 4) & 1) << 5) | (((lane >> 5) & 1) << 8); }
constexpr int v_rd_off(int d0, int ks, int half) { return d0 * 512 + ks * 4096 + half * 2048; }
template <int OFF> __device__ __forceinline__ s16x4 tr_read(int vb) {
  s16x4 r; asm volatile("ds_read_b64_tr_b16 %0, %1 offset:%2" : "=&v"(r) : "v"(vb), "i"(OFF) : "memory"); return r;
}
template <int D0> __device__ __forceinline__ void pv_one(f32x16& od, int vb, bf16x8 pa0, bf16x8 pa1, bf16x8 pa2, bf16x8 pa3) {
  const s16x4 l0 = tr_read<v_rd_off(D0, 0, 0)>(vb), h0 = tr_read<v_rd_off(D0, 0, 1)>(vb), l1 = tr_read<v_rd_off(D0, 1, 0)>(vb), h1 = tr_read<v_rd_off(D0, 1, 1)>(vb);
  const s16x4 l2 = tr_read<v_rd_off(D0, 2, 0)>(vb), h2 = tr_read<v_rd_off(D0, 2, 1)>(vb), l3 = tr_read<v_rd_off(D0, 3, 0)>(vb), h3 = tr_read<v_rd_off(D0, 3, 1)>(vb);
  asm volatile("s_waitcnt lgkmcnt(0)" ::: "memory"); SBAR();
#define PK(L, H) (bf16x8){L[0], L[1], L[2], L[3], H[0], H[1], H[2], H[3]}
  od = __builtin_amdgcn_mfma_f32_32x32x16_bf16(pa0, PK(l0, h0), od, 0, 0, 0);
  od = __builtin_amdgcn_mfma_f32_32x32x16_bf16(pa1, PK(l1, h1), od, 0, 0, 0);
  od = __builtin_amdgcn_mfma_f32_32x32x16_bf16(pa2, PK(l2, h2), od, 0, 0, 0);
  od = __builtin_amdgcn_mfma_f32_32x32x16_bf16(pa3, PK(l3, h3), od, 0, 0, 0);
#undef PK
}
__device__ __forceinline__ void pv_d0(f32x16* o, int vb, bf16x8 pa0, bf16x8 pa1, bf16x8 pa2, bf16x8 pa3) {
  pv_one<0>(o[0], vb, pa0, pa1, pa2, pa3); pv_one<1>(o[1], vb, pa0, pa1, pa2, pa3); pv_one<2>(o[2], vb, pa0, pa1, pa2, pa3); pv_one<3>(o[3], vb, pa0, pa1, pa2, pa3);
}

__device__ __forceinline__ int kn_off(int row, int colB) { return row * 256 + (colB ^ ((row & 15) << 4)); }
__device__ __forceinline__ int kr_off(int row, int colB) { return row * 128 + (colB ^ (((row >> 1) & 7) << 4)); }
template <int NQF>
__device__ __forceinline__ void qk_mm(f32x16& n0, f32x16& n1, const LAS char* Kn, const LAS char* Kr, const bf16x8* qr, int r32, int hi) {
  constexpr int PF = 2, NB = PF + 1;
  n0 = f32x16{}; n1 = f32x16{};
  bf16x8 kb[NB][2];
#define QM_LOADK(d) do { if ((d) < 8) { const int cb_ = ((d) * 16 + hi * 8) * 2; kb[(d) % NB][0] = *(const LAS bf16x8*)(Kn + kn_off(r32, cb_)); kb[(d) % NB][1] = *(const LAS bf16x8*)(Kn + kn_off(32 + r32, cb_)); } \
    else { const int cb_ = (((d) - 8) * 16 + hi * 8) * 2; kb[(d) % NB][0] = *(const LAS bf16x8*)(Kr + kr_off(r32, cb_)); kb[(d) % NB][1] = *(const LAS bf16x8*)(Kr + kr_off(32 + r32, cb_)); } } while (0)
  QM_LOADK(0); QM_LOADK(1);
#pragma unroll
  for (int k = 0; k < NQF; ++k) {
    if (k + PF < NQF) QM_LOADK(k + PF);
    n0 = __builtin_amdgcn_mfma_f32_32x32x16_bf16(kb[k % NB][0], qr[k], n0, 0, 0, 0);
    n1 = __builtin_amdgcn_mfma_f32_32x32x16_bf16(kb[k % NB][1], qr[k], n1, 0, 0, 0);
    __builtin_amdgcn_sched_barrier(0);
  }
#undef QM_LOADK
}

template <int KIND>
__device__ __forceinline__ void attn_unit(const bf16* __restrict__ Qb, const bf16* __restrict__ KVb, const bf16* __restrict__ Zb, bf16* __restrict__ Ob,
                                          int qm0, int km0, int NT, int h, int ocol, float m0, float l0, Mask mk, LAS char* lds, int tid_in) {
  constexpr int NQF = KIND == 0 ? 12 : 8;
  constexpr bool HASR = KIND == 0, WIN = KIND == 1;
  constexpr int KSLOT = HASR ? 24576 : 16384, OFF_KR = 16384, VRING = 3 * KSLOT, VSLOT = 16384, SCR = VRING + 3 * VSLOT;
  int tid_; asm volatile("v_mbcnt_lo_u32_b32 %0, -1, 0\n\tv_mbcnt_hi_u32_b32 %0, -1, %0" : "=v"(tid_)); tid_ += tid_in;
  const int tid = tid_, wid = tid >> 6, lane = tid & 63, r32 = lane & 31, hi = lane >> 5;
  const int widu = __builtin_amdgcn_readfirstlane(wid);
  const bool trailing = widu >= 4;
  LAS float* ws = (LAS float*)(lds + SCR) + wid * 64; LAS float* li_l = ws; LAS float* al_l = ws + 32;
  float m_reg = m0, l_reg = l0; f32x16 o[4] = {}; bf16x8 qr[NQF];
  mk.dq += wid * QBLK + r32 - 4 * hi;
  const int kvh = h >> 2;
  constexpr long kld2 = (KIND == 0 ? NKVC : NZ) * 2;
  const char* Kbase = KIND == 0 ? (const char*)(KVb + (long)km0 * NKVC + h * 256) : (const char*)(Zb + (long)km0 * NZ + ZC_KW + kvh * 128);
  const char* Vbase = KIND == 0 ? Kbase + 256 : (const char*)(Zb + (long)km0 * NZ + ZC_VW + kvh * 128);
  const char* Rbase = (const char*)(Zb + (long)km0 * NZ + ZC_KR);
  unsigned okn[2], ov[2], okr;
#pragma unroll
  for (int q = 0; q < 2; ++q) { const int pq = 2 * wid + q;
    { const int row = pq * 4 + (lane >> 4), ch = (lane & 15) ^ (row & 15); okn[q] = (unsigned)(row * kld2 + ch * 16); }
    { const int sub = 2 * pq + (lane >> 5), kk = (sub >> 2) * 8 + ((lane & 31) >> 2), k = (kk & ~0xC) | ((kk & 4) << 1) | ((kk & 8) >> 1), c = (sub & 3) * 32 + (lane & 3) * 8; ov[q] = (unsigned)(k * kld2 + c * 2); } }
  { const int row = wid * 8 + (lane >> 3), ch = (lane & 7) ^ ((row >> 1) & 7); okr = (unsigned)(row * (NZ * 2) + ch * 16); }
#define GLDS(src, dst) __builtin_amdgcn_global_load_lds((const unsigned*)(src), (LAS unsigned*)(dst), 16, 0, 0)
#define DMA_K(t, ks) do { const size_t to_ = (size_t)(t) * KVBLK * kld2; LAS char* sb_ = lds + (ks) * KSLOT; \
    GLDS(Kbase + to_ + okn[0], sb_ + (2 * widu) * 1024); GLDS(Kbase + to_ + okn[1], sb_ + (2 * widu + 1) * 1024); \
    if (HASR) GLDS(Rbase + (size_t)(t) * KVBLK * (NZ * 2) + okr, sb_ + OFF_KR + widu * 1024); } while (0)
#define DMA_V(t, vs) do { const size_t to_ = (size_t)(t) * KVBLK * kld2; LAS char* sb_ = lds + VRING + (vs) * VSLOT; \
    GLDS(Vbase + to_ + ov[0], sb_ + (2 * widu) * 1024); GLDS(Vbase + to_ + ov[1], sb_ + (2 * widu + 1) * 1024); } while (0)
#define WAITBAR() asm volatile("s_waitcnt vmcnt(0) lgkmcnt(0)\n\ts_barrier" ::: "memory")
#define LBAR() asm volatile("s_waitcnt lgkmcnt(0)\n\ts_barrier" ::: "memory")
#define RESC(a) do { if (__any((a) < 1.f)) { if (hi == 0) al_l[r32] = (a); asm volatile("s_waitcnt lgkmcnt(0)" ::: "memory"); \
    _Pragma("unroll") for (int d = 0; d < 4; ++d) _Pragma("unroll") for (int r = 0; r < 16; ++r) o[d][r] *= al_l[crow(r, hi)]; } } while (0)
  DMA_K(0, 0); DMA_K(1, 1); DMA_V(0, 0);
  { const long qrow = (long)(qm0 + wid * QBLK + r32);
    if (KIND == 0) {
      const bf16* Qn = Qb + qrow * NQC + h * 128 + hi * 8; const bf16* Qr = Qb + qrow * NQC + 1024 + h * 64 + hi * 8;
#pragma unroll
      for (int d0 = 0; d0 < 8; ++d0) qr[d0] = *reinterpret_cast<const bf16x8*>(Qn + d0 * 16);
#pragma unroll
      for (int d0 = 8; d0 < NQF; ++d0) qr[d0] = *reinterpret_cast<const bf16x8*>(Qr + (d0 - 8) * 16);
    } else {
      const bf16* Qn = Zb + qrow * NZ + ZC_QW + h * 128 + hi * 8;
#pragma unroll
      for (int d0 = 0; d0 < 8; ++d0) qr[d0] = *reinterpret_cast<const bf16x8*>(Qn + d0 * 16);
    } }
  const int vb0 = (int)(uintptr_t)lds + VRING + v_rd_base(lane);
  f32x16 s0, s1; float mn, al; bf16x8 pa0, pa1, pa2, pa3;
  asm volatile("s_waitcnt vmcnt(0)" ::: "memory");
  if (trailing) LBAR();
  LBAR();
  int ks = 0, vs = 2;
  for (int t = 0; t < NT; ++t) {
    __builtin_amdgcn_s_setprio(3);
    qk_mm<NQF>(s0, s1, lds + ks * KSLOT, lds + ks * KSLOT + OFF_KR, qr, r32, hi);
    if (t > 0) pv_d0(o, vb0 + vs * VSLOT, pa0, pa1, pa2, pa3);
    __builtin_amdgcn_s_setprio(0);
    WAITBAR();
    { const int kn = ks == 0 ? 2 : ks - 1, vn = vs == 2 ? 0 : vs + 1, vn2 = vn == 2 ? 0 : vn + 1;
      if (t + 2 < NT) DMA_K(t + 2, kn);
      if (t + 1 < NT) DMA_V(t + 1, vn2); }
    partialSM<WIN>(s0, s1, m_reg, mn, al, mk, t);
    finishSM(s0, s1, al, l_reg, pa0, pa1, pa2, pa3);
    RESC(al);
    LBAR();
    ks = ks == 2 ? 0 : ks + 1; vs = vs == 2 ? 0 : vs + 1;
  }
  __builtin_amdgcn_s_setprio(3);
  pv_d0(o, vb0 + vs * VSLOT, pa0, pa1, pa2, pa3);
  __builtin_amdgcn_s_setprio(0);
  if (!trailing) LBAR();
  if (hi == 0) li_l[r32] = l_reg; asm volatile("s_waitcnt lgkmcnt(0)" ::: "memory");
  float rli[16];
#pragma unroll
  for (int r = 0; r < 16; ++r) rli[r] = __builtin_amdgcn_rcpf(li_l[crow(r, hi)]);
  WAITBAR();
  { LAS bf16* stg = (LAS bf16*)(lds + wid * 8192);
#pragma unroll
    for (int r = 0; r < 16; ++r) { const int orow = crow(r, hi);
#pragma unroll
      for (int d0 = 0; d0 < 4; ++d0) { const float v = o[d0][r] * rli[r]; stg[orow * 128 + d0 * 32 + r32] = (bf16)(cvt_pk_bf16(v, v) & 0xffffu); } }
    asm volatile("s_waitcnt lgkmcnt(0)" ::: "memory");
    bf16* Ow = Ob + (long)(qm0 + wid * QBLK) * NABC + ocol;
#pragma unroll
    for (int i = 0; i < 8; ++i) { const int row = i * 4 + (lane >> 4), ch = lane & 15; const v4u v = *(const LAS v4u*)(stg + row * 128 + ch * 8); *(v4u*)(Ow + (long)row * NABC + ch * 8) = v; } }
  WAITBAR();
#undef GLDS
#undef DMA_K
#undef DMA_V
#undef WAITBAR
#undef LBAR
#undef RESC
}
#undef SBAR
}

#define XB_TMO      128
#define XB_XCNT(j)  (256  + 64 * (j))
#define XB_XSUB(j)  (1280 + 64 * (j))
#define XB_XGEN(j)  (2304 + 64 * (j))
#define XB_TOP      3328
#define XB_TOPGEN   3392
#define XCD_BAR_WORDS 3456
#define XB_SPIN_CAP (1u << 18)

__device__ __forceinline__ unsigned xb_ld(unsigned* p)              { return __hip_atomic_load(p, __ATOMIC_RELAXED, __HIP_MEMORY_SCOPE_AGENT); }
__device__ __forceinline__ unsigned xb_add(unsigned* p, unsigned v) { return __hip_atomic_fetch_add(p, v, __ATOMIC_RELAXED, __HIP_MEMORY_SCOPE_AGENT); }
__device__ __forceinline__ unsigned xb_xcc_id() { return (unsigned)__builtin_amdgcn_s_getreg((3 << 11) | 20) & 0xFu; }
#define XB_SPIN(cond, bar) do { unsigned _sp = 0; while (cond) { __builtin_amdgcn_s_sleep(1); \
    if ((++_sp & 255u) == 0u) { if (xb_ld(&(bar)[XB_TMO])) break; if (_sp > XB_SPIN_CAP) { atomicAdd(&(bar)[XB_TMO], 1u); break; } } } } while (0)

struct XcdBarrier { unsigned* bar; unsigned x; volatile LAS unsigned* st; };

__device__ __forceinline__ XcdBarrier xcd_barrier_post(unsigned* bar, volatile LAS unsigned* st) {
    XcdBarrier b; b.bar = bar; b.x = xb_xcc_id(); b.st = st;
    if (threadIdx.x == 0) (void)xb_add(&bar[XB_XCNT(b.x)], 1u);
    return b;
}
__device__ __forceinline__ void xcd_barrier_complete(unsigned* bar, unsigned x, unsigned& nloc, unsigned& nx) {
    const unsigned G = gridDim.x * gridDim.y * gridDim.z;
    unsigned sum, cnt, mine, sp = 0u;
    for (;;) {
        sum = 0u; cnt = 0u; mine = 0u;
#pragma unroll
        for (unsigned j = 0; j < 16; ++j) { const unsigned c = xb_ld(&bar[XB_XCNT(j)]); sum += c; cnt += (c > 0u) ? 1u : 0u; mine = (j == x) ? c : mine; }
        if (sum == G) break;
        __builtin_amdgcn_s_sleep(1);
        if ((++sp & 255u) == 0u) { if (xb_ld(&bar[XB_TMO])) break; if (sp > XB_SPIN_CAP) { atomicAdd(&bar[XB_TMO], 1u); break; } }
    }
    nloc = mine > 0u ? mine : 1u; nx = cnt > 0u ? cnt : 1u;
}
__device__ __forceinline__ void xcd_barrier(const XcdBarrier& b, const int tid  ) {
    asm volatile("s_waitcnt vmcnt(0)" ::: "memory");
    __syncthreads();
    if (tid == 0) {
        unsigned* bar = b.bar;
        __builtin_amdgcn_s_waitcnt(0);
        unsigned nloc = b.st[0], nx = b.st[1];
        if (nloc == 0u) { xcd_barrier_complete(bar, b.x, nloc, nx); b.st[0] = nloc; b.st[1] = nx; }
        const unsigned old = xb_add(&bar[XB_XSUB(b.x)], 1u);
        const unsigned gen = old / nloc;
        if (old + 1u == (gen + 1u) * nloc) {
            __builtin_amdgcn_fence(__ATOMIC_RELEASE, "agent");
            asm volatile("s_waitcnt vmcnt(0)" ::: "memory");
            const unsigned og = xb_add(&bar[XB_TOP], 1u);
            const unsigned tg = og / nx;
            if (og + 1u == (tg + 1u) * nx) xb_add(&bar[XB_TOPGEN], 1u);
            else XB_SPIN(xb_ld(&bar[XB_TOPGEN]) == tg, bar);
            __builtin_amdgcn_fence(__ATOMIC_ACQUIRE, "agent");
            xb_add(&bar[XB_XGEN(b.x)], 1u);
            asm volatile("s_waitcnt vmcnt(0)" ::: "memory");
        } else {
            XB_SPIN(xb_ld(&bar[XB_XGEN(b.x)]) == gen, bar);
            __builtin_amdgcn_fence(__ATOMIC_ACQUIRE, "agent");
            asm volatile("s_waitcnt vmcnt(0)" ::: "memory");
        }
    }
    __syncthreads();
}

struct Args { const float* in[22]; float* out; unsigned char* ws; int ph_lo, ph_hi; };
typedef const __attribute__((address_space(4))) Args* KArgs;
#define KARGS() ({ KArgs p_ = (KArgs)__builtin_amdgcn_kernarg_segment_ptr(); asm volatile("" : "+s"(p_)); p_; })
struct Frame { LAS unsigned char* lds; int tid, lane, wave, vcu, G; };

__device__ __forceinline__ float wave_sum(float v, int lane) {
#pragma unroll
    for (int o = 1; o < 64; o <<= 1) v += shfl_xor_l(v, o, lane);
    return v;
}
__device__ const double ROPE_REV[32] = {
    1.59154943091895346e-01, 1.19349370211248862e-01, 8.94994016088910133e-02, 6.71150830052272551e-02, 5.03292121044870353e-02, 3.77415847174197711e-02, 2.83021958306233987e-02, 2.12236527647776604e-02,
    1.59154943091895339e-02, 1.19349370211248862e-02, 8.94994016088910237e-03, 6.71150830052272534e-03, 5.03292121044870370e-03, 3.77415847174197719e-03, 2.83021958306233987e-03, 2.12236527647776622e-03,
    1.59154943091895356e-03, 1.19349370211248849e-03, 8.94994016088910237e-04, 6.71150830052272599e-04, 5.03292121044870326e-04, 3.77415847174197741e-04, 2.83021958306233954e-04, 2.12236527647776605e-04,
    1.59154943091895351e-04, 1.19349370211248862e-04, 8.94994016088910182e-05, 6.71150830052272545e-05, 5.03292121044870354e-05, 3.77415847174197768e-05, 2.83021958306233961e-05, 2.12236527647776592e-05};

enum { MAP_ID = 0, MAP_WIN = 1, MAP_WUQ = 2 };
__device__ __forceinline__ int map_col(int mode, int n) {
    if (mode == MAP_ID) return n;
    if (mode == MAP_WIN) {
        if (n < 1024) return n;
        if (n < ZC_KR) return n + 64;
        if (n < ZC_KR + 64) { const int p = n - ZC_KR, i = p >> 1; return 1024 + ((p & 1) ? i + 32 : i); }
        if (n < ZC_G) return -1;
        return n - ZC_G + 3648;
    }
    if (n < 1024) return (n >> 7) * 192 + (n & 127);
    { const int r = n - 1024, h = r >> 6, p = r & 63, i = p >> 1; return h * 192 + 128 + ((p & 1) ? i + 32 : i); }
}
__device__ __forceinline__ void conv_item(const float* W, int K, int Nsrc, int nblk, const float* g, int mode, bf16* dst, int dst_ld, LAS float* scr, int item, int lane, bool tiled = false, int koff = 0) {
    const int kb = item / nblk, nb = item % nblk, k0 = 64 * kb, n0 = 32 * nb;
    const int s0 = map_col(mode, n0), s31 = map_col(mode, n0 + 31);
    if (s0 >= 0 && s31 == s0 + 31) {
        const int ks = lane >> 3, n4 = (lane & 7) * 4;
        f32x4 v[8]; float gk[8];
#pragma unroll
        for (int i = 0; i < 8; ++i) v[i] = *(const GAS f32x4*)(W + (size_t)(k0 + 8 * i + ks) * Nsrc + s0 + n4);
#pragma unroll
        for (int i = 0; i < 8; ++i) gk[i] = g ? g[k0 + 8 * i + ks] : 1.f;
#pragma unroll
        for (int i = 0; i < 8; ++i) { LAS float* p = scr + (8 * i + ks) * 33 + n4; const f32x4 x = v[i] * gk[i]; p[0] = x[0]; p[1] = x[1]; p[2] = x[2]; p[3] = x[3]; }
    } else {
        const int src = map_col(mode, n0 + (lane & 31));
#pragma unroll 8
        for (int i = 0; i < 32; ++i) { const int kk = 2 * i + (lane >> 5); float v = 0.f;
            if (src >= 0) { v = W[(size_t)(k0 + kk) * Nsrc + src]; if (g) v *= g[k0 + kk]; }
            scr[kk * 33 + (lane & 31)] = v; }
    }
    LDS_WAIT(); asm volatile("" ::: "memory");
    const int c = lane & 7;
#pragma unroll
    for (int j = 0; j < 4; ++j) { const int n = (lane >> 3) + 8 * j; const LAS float* s = scr + (8 * c) * 33 + n;
        v4u o; o.x = cvt_pk_bf16(s[0 * 33], s[1 * 33]); o.y = cvt_pk_bf16(s[2 * 33], s[3 * 33]); o.z = cvt_pk_bf16(s[4 * 33], s[5 * 33]); o.w = cvt_pk_bf16(s[6 * 33], s[7 * 33]);
        if (!tiled) *(GAS v4u*)(dst + (size_t)(n0 + n) * dst_ld + k0 + 8 * c) = o;
        else {
            const int nn = n0 + n, pn = nn >> 8, nt_ = nn & 255, h = nt_ >> 7, rr = nt_ & 127, w = rr & 31, slot = (rr & ~31) + 16 * ((w >> 2) & 1) + 4 * (w >> 3) + (w & 3);
            const int kk = koff + k0, kt = kk >> 6;
            *(GAS v4u*)((unsigned char*)dst + ((size_t)(pn * (dst_ld >> 6) + kt) * 2 + h) * 16384 + pg8::lds_byte(slot, 8 * c)) = o; } }
    LDS_WAIT(); asm volatile("" ::: "memory");
}
__device__ __forceinline__ void convert_layer(const Frame& F, KArgs ap, int l, unsigned char* ws) {
    LAS float* scr = (LAS float*)(F.lds + RING_OFF + F.wave * 16384);
    const int gw = F.vcu * NWAVES + F.wave, NGW = F.G * NWAVES;
    unsigned char* W = ws + WS_W;
    constexpr int I_IN = 32 * (NZW / 32), I_UQ = 8 * (NQC / 32), I_UKV = 8 * (NKVC / 32), I_MEM = 32 * 64, I_BR = 16 * 64, I_OUT = 32 * 64, I_UP = 32 * 256, I_DOWN = 128 * 64;
    constexpr int NITEMS = I_IN + I_UQ + I_UKV + I_MEM + 3 * I_BR + I_OUT + I_UP + I_DOWN;
    for (int it = gw; it < NITEMS; it += NGW) {
        int r = it;
        if (r < I_IN) { conv_item(ap->in[6] + (size_t)l * DM * NZSRC, DM, NZSRC, NZW / 32, ap->in[4] + l * DM, MAP_WIN, (bf16*)(W + WO_IN), DM, scr, r, F.lane, true); continue; } r -= I_IN;
        if (r < I_UQ) { conv_item(ap->in[9] + (size_t)l * 512 * NQC, 512, NQC, NQC / 32, ap->in[7] + l * 512, MAP_WUQ, (bf16*)(W + WO_UQ), 512, scr, r, F.lane, true); continue; } r -= I_UQ;
        if (r < I_UKV) { conv_item(ap->in[10] + (size_t)l * 512 * NKVC, 512, NKVC, NKVC / 32, ap->in[8] + l * 512, MAP_ID, (bf16*)(W + WO_UKV), 512, scr, r, F.lane, true); continue; } r -= I_UKV;
        if (r < I_MEM) { conv_item(ap->in[12] + (size_t)l * DM * 2048, DM, 2048, 64, ap->in[11] + l * DM, MAP_ID, (bf16*)(W + WO_MEM), DM, scr, r, F.lane); continue; } r -= I_MEM;
        if (r < 3 * I_BR) { const int br = r / I_BR; conv_item(ap->in[14 + br] + (size_t)l * 1024 * DM, 1024, DM, 64, nullptr, MAP_ID, (bf16*)(W + WO_BR), NABC, scr, r - br * I_BR, F.lane, true, br * 1024); continue; } r -= 3 * I_BR;
        if (r < I_OUT) { conv_item(ap->in[17] + (size_t)l * DM * DM, DM, DM, 64, nullptr, MAP_ID, (bf16*)(W + WO_OUT), DM, scr, r, F.lane, true); continue; } r -= I_OUT;
        if (r < I_UP) { conv_item(ap->in[20] + (size_t)l * DM * DFF, DM, DFF, 256, ap->in[18] + l * DM, MAP_ID, (bf16*)(W + WO_UP), DM, scr, r, F.lane, true); continue; } r -= I_UP;
        conv_item(ap->in[21] + (size_t)l * DFF * DM, DFF, DM, 64, nullptr, MAP_ID, (bf16*)(W + WO_DOWN), DFF, scr, r, F.lane, true);
    }
}
__device__ __forceinline__ void rms_row_to_bf16(const float* xrow, bf16* orow, float* rs_out, int lane) {
    f32x4 v[8]; float s = 0.f;
#pragma unroll
    for (int j = 0; j < 4; ++j) { v[2 * j] = *(const GAS f32x4*)(xrow + j * 512 + lane * 8); v[2 * j + 1] = *(const GAS f32x4*)(xrow + j * 512 + lane * 8 + 4); }
#pragma unroll
    for (int j = 0; j < 8; ++j) s += (v[j][0] * v[j][0] + v[j][1] * v[j][1]) + (v[j][2] * v[j][2] + v[j][3] * v[j][3]);
    const float ms = wave_sum(s, lane) * (1.f / DM) + EPS, r = __builtin_amdgcn_rsqf(ms);
    if (lane == 0) *rs_out = ms * r;
#pragma unroll
    for (int j = 0; j < 4; ++j) *(GAS v4u*)(orow + j * 512 + lane * 8) = epi::pack8(v[2 * j] * r, v[2 * j + 1] * r);
}
__device__ __forceinline__ void prologue(const Frame& F, KArgs ap, unsigned char* ws) {
    const int gw = F.vcu * NWAVES + F.wave, NGW = F.G * NWAVES;
    float* tab = (float*)(ws + WS_TAB);
    for (int e = blockIdx.x * 512 + F.tid; e < 8192 * 32; e += F.G * 512) {
        const int pos = e >> 5, i = e & 31;
        double rev = (double)pos * ROPE_REV[i]; rev -= floor(rev);
        const double q = rint(rev * 4.0); const double r = (rev - q * 0.25) * 6.283185307179586476925;
        const double r2 = r * r;
        const double sn = r * (1.0 + r2 * (-1.0 / 6 + r2 * (1.0 / 120 + r2 * (-1.0 / 5040 + r2 * (1.0 / 362880 - r2 * (1.0 / 39916800))))));
        const double cn = 1.0 + r2 * (-0.5 + r2 * (1.0 / 24 + r2 * (-1.0 / 720 + r2 * (1.0 / 40320 + r2 * (-1.0 / 3628800 + r2 * (1.0 / 479001600))))));
        const int qi = ((int)q) & 3;
        const double s_ = qi == 0 ? sn : qi == 1 ? cn : qi == 2 ? -sn : -cn;
        const double c_ = qi == 0 ? cn : qi == 1 ? -sn : qi == 2 ? -cn : sn;
        *(GAS f32x2*)(tab + (size_t)e * 2) = (f32x2){(float)c_, (float)s_};
    }
    float* rmem = (float*)(ws + WS_RMEM); bf16* memb = (bf16*)(ws + WS_MEMB);
    for (int m = gw; m < NMEMR; m += NGW) {
        const float* xrow = (m < 1024) ? ap->in[2] + (size_t)m * DM : ap->in[3] + (size_t)(m - 1024) * DM;
        f32x4 v[8]; float s = 0.f;
#pragma unroll
        for (int j = 0; j < 4; ++j) { v[2 * j] = *(const GAS f32x4*)(xrow + j * 512 + F.lane * 8); v[2 * j + 1] = *(const GAS f32x4*)(xrow + j * 512 + F.lane * 8 + 4); }
#pragma unroll
        for (int j = 0; j < 8; ++j) s += (v[j][0] * v[j][0] + v[j][1] * v[j][1]) + (v[j][2] * v[j][2] + v[j][3] * v[j][3]);
        const float r = __builtin_amdgcn_rsqf(wave_sum(s, F.lane) * (1.f / DM) + EPS);
        if (F.lane == 0) rmem[m] = r;
#pragma unroll
        for (int j = 0; j < 4; ++j) *(GAS v4u*)(memb + (size_t)m * DM + j * 512 + F.lane * 8) = epi::pack8(v[2 * j], v[2 * j + 1]);
    }
    bf16* xn = (bf16*)(ws + WS_XN);
    for (int m = gw; m < NTOK; m += NGW) {
        const float* xrow = (m < NPROMPT) ? ap->in[0] + (size_t)m * DM : ap->in[1] + (size_t)(m - NPROMPT) * DM;
        rms_row_to_bf16(xrow, xn + (size_t)m * DM, (float*)(ws + WS_RS) + m, F.lane);
    }
    convert_layer(F, ap, 0, ws);
}
__device__ __forceinline__ void norm_pass(const Frame& F, KArgs ap, bool first, bool last, const float* gpost, unsigned char* ws, bool dummy = false) {
    const int gw = F.vcu * NWAVES + F.wave, NGW = F.G * NWAVES;
    const bf16* Y = (const bf16*)(ws + WS_Y); bf16* xb = (bf16*)(ws + WS_XN); float* rsv = (float*)(ws + WS_RS);
    bf16* xbo = dummy ? (bf16*)(ws + WS_Z + 192 * MiB) : xb; float* rso = dummy ? (float*)(ws + WS_Z + 300 * MiB) : rsv; float* xout = dummy ? (float*)(ws + WS_Z) : ap->out;
    f32x4 g[8];
#pragma unroll
    for (int j = 0; j < 4; ++j) { g[2 * j] = *(const GAS f32x4*)(gpost + j * 512 + F.lane * 8); g[2 * j + 1] = *(const GAS f32x4*)(gpost + j * 512 + F.lane * 8 + 4); }
    for (int m = gw; m < NTOK; m += NGW) {
        f32x4 x[8], y[8]; float s = 0.f;
#pragma unroll
        for (int j = 0; j < 4; ++j) { const v4u w = *(const GAS v4u*)(Y + (size_t)m * DM + j * 512 + F.lane * 8);
            y[2 * j] = (f32x4){bf_lo(w.x), bf_hi(w.x), bf_lo(w.y), bf_hi(w.y)}; y[2 * j + 1] = (f32x4){bf_lo(w.z), bf_hi(w.z), bf_lo(w.w), bf_hi(w.w)}; }
        if (first) { const float* xrow = (m < NPROMPT) ? ap->in[0] + (size_t)m * DM : ap->in[1] + (size_t)(m - NPROMPT) * DM;
#pragma unroll
            for (int j = 0; j < 4; ++j) { x[2 * j] = *(const GAS f32x4*)(xrow + j * 512 + F.lane * 8); x[2 * j + 1] = *(const GAS f32x4*)(xrow + j * 512 + F.lane * 8 + 4); }
        } else {
            const float rms = rsv[m];
#pragma unroll
            for (int j = 0; j < 4; ++j) { const v4u w = *(const GAS v4u*)(xb + (size_t)m * DM + j * 512 + F.lane * 8);
                x[2 * j] = (f32x4){bf_lo(w.x), bf_hi(w.x), bf_lo(w.y), bf_hi(w.y)} * rms; x[2 * j + 1] = (f32x4){bf_lo(w.z), bf_hi(w.z), bf_lo(w.w), bf_hi(w.w)} * rms; }
        }
#pragma unroll
        for (int j = 0; j < 8; ++j) s += (y[j][0] * y[j][0] + y[j][1] * y[j][1]) + (y[j][2] * y[j][2] + y[j][3] * y[j][3]);
        const float r = __builtin_amdgcn_rsqf(wave_sum(s, F.lane) * (1.f / DM) + EPS);
        float s2 = 0.f;
#pragma unroll
        for (int j = 0; j < 8; ++j) { x[j] = x[j] + (y[j] * r) * g[j]; s2 += (x[j][0] * x[j][0] + x[j][1] * x[j][1]) + (x[j][2] * x[j][2] + x[j][3] * x[j][3]); }
        if (last) { float* orow = xout + (size_t)m * DM;
#pragma unroll
            for (int j = 0; j < 4; ++j) { *(GAS f32x4*)(orow + j * 512 + F.lane * 8) = x[2 * j]; *(GAS f32x4*)(orow + j * 512 + F.lane * 8 + 4) = x[2 * j + 1]; }
        } else {
            const float ms2 = wave_sum(s2, F.lane) * (1.f / DM) + EPS, r2 = __builtin_amdgcn_rsqf(ms2);
            if (F.lane == 0) rso[m] = ms2 * r2;
#pragma unroll
            for (int j = 0; j < 4; ++j) *(GAS v4u*)(xbo + (size_t)m * DM + j * 512 + F.lane * 8) = epi::pack8(x[2 * j] * r2, x[2 * j + 1] * r2);
        }
    }
}

constexpr int PH_PER_LAYER = 9, N_PHASES = 1 + DEPTH * PH_PER_LAYER;
#ifndef PH_MASK
#define PH_MASK 0x3ff
#endif
#define PH_EN(k) ((PH_MASK >> (k)) & 1)
#ifndef SUB_MASK
#define SUB_MASK 7
#endif
#define SUB_EN(k) ((SUB_MASK >> (k)) & 1)
#ifndef DUP_MASK
#define DUP_MASK 0
#endif
#define DUP_EN(k) ((DUP_MASK >> (k)) & 1)
__global__ void __launch_bounds__(NWAVES * 64, 2) fwd(Args args_unused) {
    extern __shared__ __attribute__((aligned(16))) unsigned char lds_raw[];
    (void)args_unused;
    LAS unsigned char* lds0 = (LAS unsigned char*)lds_raw;
    const int wave0 = __builtin_amdgcn_readfirstlane((int)threadIdx.x >> 6);
    volatile LAS unsigned* MISC = (volatile LAS unsigned*)(lds0 + MISC_OFF);
    for (int u = threadIdx.x; u < (XCH_OFF - LDSCTL_OFF) / 4; u += NWAVES * 64) ((LAS unsigned*)(lds0 + LDSCTL_OFF))[u] = 0u;
    __syncthreads();
#ifdef PROBE_CLOCK
    if (blockIdx.x == 0 && threadIdx.x == 0) { KArgs ap = KARGS(); unsigned long long* p = (unsigned long long*)(ap->ws + 512 * 1024); p[0] = __builtin_amdgcn_s_memtime(); p[1] = __builtin_amdgcn_s_memrealtime(); }
#endif
    int lo, hi; unsigned* barw;
    { KArgs ap = KARGS(); lo = ap->ph_lo; hi = ap->ph_hi; barw = (unsigned*)(ap->ws + WS_CTL) + CW_BAR; }
    if (MK_N_LAUNCHES == 1 || (hi - lo) > 1) (void)xcd_barrier_post(barw, MISC + 8);
    if (threadIdx.x == 0) { unsigned r = 0u; const unsigned x = xb_xcc_id();
        if (MK_N_LAUNCHES == 1) { KArgs ap_ = KARGS(); r = xb_add((unsigned*)(ap_->ws + WS_CTL) + CW_RANK + 64 * x, 1u); }
        MISC[20] = x; MISC[21] = r; MISC[22] = blockIdx.x; }
    __syncthreads();
#if MK_N_LAUNCHES == 1
#define IN(k) true
#else
#define IN(k) (lo <= (k) && (k) < hi)
#endif
#if defined(PROBE_WAIT) && PROBE_WAIT
#define PROBE_WAIT_BEGIN() do { if (wave0 * 64 + t_ == 0) { const unsigned long long r_ = __builtin_amdgcn_s_memrealtime(); MISC[16] = (unsigned)r_; } } while (0)
#define PROBE_WAIT_END() do { int t2_; asm volatile("v_mbcnt_lo_u32_b32 %0, -1, 0\n\tv_mbcnt_hi_u32_b32 %0, -1, %0" : "=v"(t2_)); if (wave0 * 64 + t2_ == 0) { const unsigned long long r_ = __builtin_amdgcn_s_memrealtime(); MISC[17] = MISC[17] + ((unsigned)r_ - MISC[16]); } } while (0)
#else
#define PROBE_WAIT_BEGIN() do {} while (0)
#define PROBE_WAIT_END() do {} while (0)
#endif
#define LOCAL_BAR() XcdBarrier bar; { KArgs ap_ = KARGS(); bar.bar = (unsigned*)(ap_->ws + WS_CTL) + CW_BAR; bar.x = xb_xcc_id(); bar.st = (volatile LAS unsigned*)((LAS unsigned char*)lds_raw + MISC_OFF) + 8; }
#define BARRIER_NOW() do { int t_; asm volatile("v_mbcnt_lo_u32_b32 %0, -1, 0\n\tv_mbcnt_hi_u32_b32 %0, -1, %0" : "=v"(t_)); LOCAL_BAR(); xcd_barrier(bar, wave0 * 64 + t_); } while (0)
#define SEAM(k) do { if (IN(k) && IN((k) + 1)) { int t_; asm volatile("v_mbcnt_lo_u32_b32 %0, -1, 0\n\tv_mbcnt_hi_u32_b32 %0, -1, %0" : "=v"(t_)); PROBE_WAIT_BEGIN(); LOCAL_BAR(); xcd_barrier(bar, wave0 * 64 + t_); PROBE_WAIT_END(); if (PROBE_XBAR) { xcd_barrier(bar, wave0 * 64 + t_); xcd_barrier(bar, wave0 * 64 + t_); } } } while (0)
#define PHASE_BASE() KArgs ap = KARGS(); unsigned char* ws = ap->ws; (void)ws; int bx_ = (int)((volatile LAS unsigned*)((LAS unsigned char*)lds_raw + MISC_OFF))[22], G_ = (int)gridDim.x, t_; asm volatile("v_mbcnt_lo_u32_b32 %0, -1, 0\n\tv_mbcnt_hi_u32_b32 %0, -1, %0" : "=v"(t_)); t_ += wave0 * 64; bx_ = __builtin_amdgcn_readfirstlane(bx_); asm volatile("" : "+s"(bx_), "+s"(G_)); const int bx = bx_, G = G_; (void)bx; (void)G; Frame F; F.lds = (LAS unsigned char*)lds_raw; F.tid = t_; F.lane = t_ & 63; F.wave = __builtin_amdgcn_readfirstlane(t_ >> 6); F.G = G; F.vcu = (G % 8 == 0) ? (bx % 8) * (G / 8) + bx / 8 : bx; LAS unsigned char* ring = F.lds + RING_OFF; LAS unsigned char* xl = F.lds + XCH_OFF; (void)ring; (void)xl
#define WSP(T, off) ((T*)(ws + (off)))

    if (PH_EN(0) && IN(0)) { PHASE_BASE(); prologue(F, ap, ws); }
    SEAM(0);
    if (MK_N_LAUNCHES == 1) {
        if (threadIdx.x == 0) { KArgs ap_ = KARGS(); unsigned* bw = (unsigned*)(ap_->ws + WS_CTL) + CW_BAR; const unsigned G = gridDim.x; bool even = (G % 8u) == 0u; unsigned npop = 0u;
            for (unsigned j = 0; j < 16; ++j) { const unsigned c = xb_ld(&bw[XB_XCNT(j)]); if (c) { ++npop; even = even && (c == G / 8u) && (j < 8u); } }
            if (even && npop == 8u && MISC[21] < G / 8u) MISC[22] = MISC[20] + 8u * MISC[21]; }
        __syncthreads();
    }

    for (int l = 0; l < DEPTH; ++l) {
        const int p0 = 1 + l * PH_PER_LAYER;
        for (int rep_ = 0; rep_ <= DUP_EN(1); ++rep_) { if (rep_) BARRIER_NOW();
        if (PH_EN(1) && IN(p0 + 0)) { PHASE_BASE();
            if (SUB_EN(0)) { pg8::Gemm g = pg8::plain_gemm(WSP(bf16, WS_XN), DM, ws + WS_W + WO_IN, DM, DM, true); pg8::StaticOrder S; S.init(NTOK / 256, NZW / 256, G, bx);
              epi::EpiZ E{WSP(bf16, WS_Z), WSP(float, WS_SSQ), WSP(const float, WS_TAB), ws + WS_GT}; pg8::gemm_phase<epi::EpiZ, pg8::StaticOrder>(F.tid, ring, xl, g, S, E); }
            if (SUB_EN(1)) { pg8::Gemm g = pg8::plain_gemm(WSP(bf16, WS_MEMB), DM, ws + WS_W + WO_MEM, DM, DM); pg8::StaticOrder S; S.init(NMEMR / 256, 4, G, (bx + G - 160 % G) % G);
              epi::EpiStore<1> E{WSP(bf16, WS_MEMK), 1024, 0, WSP(const float, WS_RMEM)}; pg8::gemm_phase<epi::EpiStore<1>, pg8::StaticOrder>(F.tid, ring, xl, g, S, E); }
            if (SUB_EN(2)) { pg8::Gemm g = pg8::plain_gemm(ws + WS_W + WO_MEM + (size_t)1024 * DM * 2, DM, WSP(bf16, WS_MEMB), DM, DM); pg8::StaticOrder S; S.init(4, NMEMR / 256, G, (bx + G - 180 % G) % G);
              epi::EpiStore<2> E{WSP(bf16, WS_MEMVT), NMEMR, 0, WSP(const float, WS_RMEM)}; pg8::gemm_phase<epi::EpiStore<2>, pg8::StaticOrder>(F.tid, ring, xl, g, S, E); }
        }
        }
        SEAM(p0 + 0);
        for (int rep_ = 0; rep_ <= DUP_EN(2); ++rep_) { if (rep_) BARRIER_NOW();
        if (PH_EN(2) && IN(p0 + 1)) { PHASE_BASE();
            if (SUB_EN(0)) { pg8::Gemm g = pg8::plain_gemm(WSP(bf16, WS_Z) + ZC_CQ, NZ, ws + WS_W + WO_UQ, 512, 512, true); pg8::StaticOrder S; S.init(NTOK / 256, NQC / 256, G, bx);
              epi::EpiLat<0> E{WSP(bf16, WS_Q), WSP(const float, WS_SSQ), WSP(const float, WS_TAB)}; pg8::gemm_phase<epi::EpiLat<0>, pg8::StaticOrder>(F.tid, ring, xl, g, S, E); }
            if (SUB_EN(1)) { pg8::Gemm g = pg8::plain_gemm(WSP(bf16, WS_Z) + ZC_CKV, NZ, ws + WS_W + WO_UKV, 512, 512, true); pg8::StaticOrder S; S.init(NTOK / 256, NKVC / 256, G, bx);
              epi::EpiLat<1> E{WSP(bf16, WS_KV), WSP(const float, WS_SSQ), WSP(const float, WS_TAB)}; pg8::gemm_phase<epi::EpiLat<1>, pg8::StaticOrder>(F.tid, ring, xl, g, S, E); }
            if (SUB_EN(2)) { pg8::Gemm g; g.A = (const char*)(WSP(bf16, WS_Z) + ZC_QM); g.B = (const char*)WSP(bf16, WS_MEMK); g.a_pm = (long)256 * NZ * 2; g.a_pn = 512; g.b_pn = 512; g.b_sq = (long)256 * 1024 * 2; g.lda = NZ; g.ldb = 1024; g.K = 256; g.b_tiled = false;
              pg8::StaticOrder S; S.init(NTOK / 256, 4, G, (bx + G - 64 % G) % G);
              epi::EpiSoftmax E{WSP(bf16, WS_PM)}; pg8::gemm_phase<epi::EpiSoftmax, pg8::StaticOrder>(F.tid, ring, xl, g, S, E); }
        }
        }
        SEAM(p0 + 1);
        for (int rep_ = 0; rep_ <= DUP_EN(3); ++rep_) { if (rep_) BARRIER_NOW();
        if (PH_EN(3) && IN(p0 + 2)) {
            if (SUB_EN(0)) { PHASE_BASE(); for (int n = F.vcu; n < 768; n += G) {
                const int i = n >> 8, v = n & 255, x = v >> 5, j = v & 31;
                int h, qm0, km0, NT;
                if (i < 2) { const int pair = 4 * x + 2 * i + (j >> 4), b = pair >> 3; h = pair & 7; qm0 = b * 4096 + (j & 15) * 256; km0 = b * 4096; NT = 64; }
                else { h = x; qm0 = NPROMPT + j * 256; km0 = NPROMPT; NT = 128; }
                att::Mask mk{0, 0.f};
                att::attn_unit<0>(WSP(bf16, WS_Q), WSP(bf16, WS_KV), WSP(bf16, WS_Z), WSP(bf16, WS_ABC), qm0, km0, NT, h, h * 128, -1.0e30f, 0.f, mk, (LAS char*)ring, wave0 * 64);
            } }
            if (SUB_EN(1)) { PHASE_BASE(); const float* sink = ap->in[13] + l * 8;
              for (int n = F.vcu; n < 768; n += G) {
                const int qblk = n >> 3, h = n & 7;
                const int sstart = qblk < 64 ? (qblk >> 4) * 4096 : NPROMPT, SL = qblk < 64 ? 4096 : 8192;
                const int qm0 = qblk * 256, q0 = qm0 - sstart;
                const int klo = (q0 - 128) < 0 ? 0 : (q0 - 128), khi = (q0 + 384) > SL ? SL : (q0 + 384);
                att::Mask mk; mk.dq = q0 - klo; mk.sl = LOG2E * __builtin_amdgcn_exp2f(-(float)(h + 1));
                att::attn_unit<1>(WSP(bf16, WS_Q), WSP(bf16, WS_KV), WSP(bf16, WS_Z), WSP(bf16, WS_ABC), qm0, sstart + klo, (khi - klo) >> 6, h, 1024 + h * 128, sink[h] * LOG2E, 1.f, mk, (LAS char*)ring, wave0 * 64);
              } }
            if (SUB_EN(2)) { PHASE_BASE(); pg8::Gemm g; g.A = (const char*)WSP(bf16, WS_PM); g.B = (const char*)WSP(bf16, WS_MEMVT); g.a_pm = (long)256 * 1024 * 2; g.a_pn = 512; g.b_pn = (long)256 * NMEMR * 2; g.b_sq = 512; g.lda = 1024; g.ldb = NMEMR; g.K = 256; g.b_tiled = false;
              pg8::StaticOrder S; S.init(NTOK / 256, 4, G, bx);
              epi::EpiStore<0> E{WSP(bf16, WS_ABC), NABC, 2048, nullptr}; pg8::gemm_phase<epi::EpiStore<0>, pg8::StaticOrder>(F.tid, ring, xl, g, S, E); }
        }
        }
        SEAM(p0 + 2);
        for (int rep_ = 0; rep_ <= DUP_EN(4); ++rep_) { if (rep_) BARRIER_NOW();
        if (PH_EN(4) && IN(p0 + 3)) { PHASE_BASE();
            pg8::Gemm g = pg8::plain_gemm(WSP(bf16, WS_ABC), NABC, ws + WS_W + WO_BR, NABC, NABC, true); pg8::StaticOrder S; S.init(NTOK / 256, DM / 256, G, bx);
            epi::EpiBranch E{WSP(bf16, WS_MERGED), ws + WS_GT}; pg8::gemm_phase<epi::EpiBranch, pg8::StaticOrder>(F.tid, ring, xl, g, S, E);
        }
        }
        SEAM(p0 + 3);
        for (int rep_ = 0; rep_ <= DUP_EN(5); ++rep_) { if (rep_) BARRIER_NOW();
        if (PH_EN(5) && IN(p0 + 4)) { PHASE_BASE();
            pg8::Gemm g = pg8::plain_gemm(WSP(bf16, WS_MERGED), DM, ws + WS_W + WO_OUT, DM, DM, true); pg8::StaticOrder S; S.init(NTOK / 256, DM / 256, G, bx);
            epi::EpiStore<0> E{WSP(bf16, WS_Y), DM, 0, nullptr}; pg8::gemm_phase<epi::EpiStore<0>, pg8::StaticOrder>(F.tid, ring, xl, g, S, E);
        }
        }
        SEAM(p0 + 4);
        if (PH_EN(6) && IN(p0 + 5)) { PHASE_BASE(); if (DUP_EN(6)) norm_pass(F, ap, l == 0, false, ap->in[5] + l * DM, ws, true); norm_pass(F, ap, l == 0, false, ap->in[5] + l * DM, ws); }
        SEAM(p0 + 5);
        for (int rep_ = 0; rep_ <= DUP_EN(7); ++rep_) { if (rep_) BARRIER_NOW();
        if (PH_EN(7) && IN(p0 + 6)) { PHASE_BASE();
            pg8::Gemm g = pg8::plain_gemm(WSP(bf16, WS_XN), DM, ws + WS_W + WO_UP, DM, DM, true); pg8::StaticOrder S; S.init(NTOK / 256, DFF / 256, G, bx);
            epi::EpiStore<3> E{WSP(bf16, WS_U), DFF, 0, nullptr}; pg8::gemm_phase<epi::EpiStore<3>, pg8::StaticOrder>(F.tid, ring, xl, g, S, E);
        }
        }
        SEAM(p0 + 6);
        for (int rep_ = 0; rep_ <= DUP_EN(8); ++rep_) { if (rep_) BARRIER_NOW();
        if (PH_EN(8) && IN(p0 + 7)) { PHASE_BASE();
            pg8::Gemm g = pg8::plain_gemm(WSP(bf16, WS_U), DFF, ws + WS_W + WO_DOWN, DFF, DFF, true); pg8::StaticOrder S; S.init(NTOK / 256, DM / 256, G, bx);
            epi::EpiStore<0> E{WSP(bf16, WS_Y), DM, 0, nullptr}; pg8::gemm_phase<epi::EpiStore<0>, pg8::StaticOrder>(F.tid, ring, xl, g, S, E);
        }
        }
        SEAM(p0 + 7);
        if (PH_EN(9) && IN(p0 + 8)) { PHASE_BASE(); norm_pass(F, ap, false, l + 1 == DEPTH, ap->in[19] + l * DM, ws); if (l + 1 < DEPTH) { convert_layer(F, ap, l + 1, ws); if (DUP_EN(9)) convert_layer(F, ap, l + 1, ws); } }
        SEAM(p0 + 8);
    }
#if defined(PROBE_WAIT) && PROBE_WAIT
    { KArgs ap = KARGS(); unsigned* pw = (unsigned*)(ap->ws + 512 * 1024 + 256);
      if (threadIdx.x == 0) { const unsigned w = MISC[17]; atomicMax(pw + 0, w); atomicMin(pw + 64, 0xffffffffu - w); atomicAdd(pw + 128, w / 256u); }
      BARRIER_NOW();
      if (blockIdx.x == 0 && threadIdx.x == 0) { const unsigned v = PROBE_WAIT == 1 ? __hip_atomic_load(pw + 0, RLX_AGENT) : PROBE_WAIT == 2 ? 0xffffffffu - __hip_atomic_load(pw + 64, RLX_AGENT) : __hip_atomic_load(pw + 128, RLX_AGENT);
        const unsigned long long r1 = __builtin_amdgcn_s_memrealtime(); while (__builtin_amdgcn_s_memrealtime() - r1 < (unsigned long long)v) __builtin_amdgcn_s_sleep(32); } }
#endif
#ifdef PROBE_CLOCK
    { BARRIER_NOW(); if (blockIdx.x == 0 && threadIdx.x == 0) { const unsigned long long ck1 = __builtin_amdgcn_s_memtime(), rt1 = __builtin_amdgcn_s_memrealtime(); KArgs ap = KARGS(); const unsigned long long* p = (const unsigned long long*)(ap->ws + 512 * 1024);
        const unsigned long long mhz = (ck1 - p[0]) * 100ull / (rt1 - p[1]);
        while (__builtin_amdgcn_s_memrealtime() - rt1 < mhz * 100ull) __builtin_amdgcn_s_sleep(32); } }
#endif
#undef IN
#undef SEAM
}


#ifndef DBG_LAST
#define DBG_LAST -1
#endif
#ifndef DBG_DUMP_MASK
#define DBG_DUMP_MASK 0xff
#endif
#if DBG_LAST >= 0
__global__ void __launch_bounds__(256) dbg_dump(float* out, const unsigned char* ws) {
    const bf16* Z = (const bf16*)(ws + WS_Z); const bf16* Q = (const bf16*)(ws + WS_Q); const bf16* KV = (const bf16*)(ws + WS_KV); const bf16* PM = (const bf16*)(ws + WS_PM);
    const bf16* ABC = (const bf16*)(ws + WS_ABC); const bf16* MG = (const bf16*)(ws + WS_MERGED); const bf16* XN = (const bf16*)(ws + WS_XN); const bf16* Y = (const bf16*)(ws + WS_Y);
    for (size_t e = (size_t)blockIdx.x * 256 + threadIdx.x; e < (size_t)NTOK * DM; e += (size_t)gridDim.x * 256) {
        const size_t m = e / DM; const int c = (int)(e % DM); float v = 0.f;
        auto f = [](bf16 b) { return __uint_as_float((unsigned)b << 16); };
        if (DBG_DUMP_MASK & 1) v += f(XN[m * DM + c]);
        if (DBG_DUMP_MASK & 2) v += f(Z[m * NZ + c]) + f(Z[m * NZ + 2048 + (c % 1792)]);
        if (DBG_DUMP_MASK & 8) v += f(Q[m * NQC + (c % NQC)]) + f(KV[m * NKVC + c]);
        if (DBG_DUMP_MASK & 16) v += f(PM[m * 1024 + (c & 1023)]);
        if (DBG_DUMP_MASK & 32) v += f(ABC[m * NABC + c]) + f(ABC[m * NABC + 1024 + c]);
        if (DBG_DUMP_MASK & 64) v += f(MG[m * DM + c]);
        if (DBG_DUMP_MASK & 128) v += f(Y[m * DM + c]);
        if (DBG_DUMP_MASK & 256) v += f(((const bf16*)(ws + WS_W))[e]) + f(((const bf16*)(ws + WS_W))[e + 20000000]);
        out[e] = v;
    }
}
#endif

extern "C" void kernel_launch(void* const* d_in, const int* in_sizes, int n_in, void* d_out, int out_size, void* d_ws, size_t ws_size, hipStream_t stream) {
    static int grid = 0;
    if (grid == 0) {
        if (n_in != 22 || out_size != NTOK * DM || ws_size < WS_END) { fprintf(stderr, "kernel_launch: unexpected shapes (n_in %d out %d ws %zu)\n", n_in, out_size, ws_size); grid = -1; return; }
        int dev = 0, cus = 0, per_cu = 0;
        if (hipGetDevice(&dev) != hipSuccess || hipDeviceGetAttribute(&cus, hipDeviceAttributeMultiprocessorCount, dev) != hipSuccess) { grid = -1; return; }
        if (hipFuncSetAttribute((const void*)fwd, hipFuncAttributeMaxDynamicSharedMemorySize, LDS_BYTES) != hipSuccess) { fprintf(stderr, "kernel_launch: hipFuncSetAttribute failed\n"); grid = -1; return; }
        if (hipOccupancyMaxActiveBlocksPerMultiprocessor(&per_cu, (const void*)fwd, NWAVES * 64, LDS_BYTES) != hipSuccess || per_cu < 1)
            fprintf(stderr, "kernel_launch: note: occupancy query reports %d workgroups per CU\n", per_cu);
        (void)hipGetLastError();
        grid = cus;
    }
    if (grid < 0) return;
    (void)in_sizes;
    if (hipMemsetAsync((char*)d_ws + WS_CTL, 0, CTL_ZERO_BYTES, stream) != hipSuccess) return;
    Args a{};
    for (int i = 0; i < 22; ++i) a.in[i] = (const float*)d_in[i];
    a.out = (float*)d_out; a.ws = (unsigned char*)d_ws;
#if MK_N_LAUNCHES == 1
    a.ph_lo = 0; a.ph_hi = N_PHASES;
    hipLaunchKernelGGL(fwd, dim3(grid), dim3(NWAVES * 64), LDS_BYTES, stream, a);
#else
#if DBG_LAST >= 0
    for (int k = 0; k <= DBG_LAST; ++k) { a.ph_lo = k; a.ph_hi = k + 1; hipLaunchKernelGGL(fwd, dim3(grid), dim3(NWAVES * 64), LDS_BYTES, stream, a); }
    hipLaunchKernelGGL(dbg_dump, dim3(2048), dim3(256), 0, stream, (float*)d_out, (const unsigned char*)d_ws);
#else
    for (int k = 0; k < N_PHASES; ++k) { a.ph_lo = k; a.ph_hi = k + 1; hipLaunchKernelGGL(fwd, dim3(grid), dim3(NWAVES * 64), LDS_BYTES, stream, a); }
#endif
#endif
    const hipError_t le = hipPeekAtLastError();
    if (le != hipSuccess) fprintf(stderr, "kernel_launch: launch failed: %s\n", hipGetErrorName(le));
}
```

```cpp
#include <hip/hip_runtime.h>
#include <cstdio>
#include <cstdint>

#define DBG_LAST -1
#define DBG_DUMP_MASK 0x6

#define PROBE_XBAR 0
#define PROBE_WAIT 0
#ifndef MK_N_LAUNCHES
#define MK_N_LAUNCHES 1
#endif

constexpr int DM = 2048, NTOK = 24576, NPROMPT = 16384, DEPTH = 4, DFF = 8192;
constexpr int NZW = 9984, NZ = 3840, NZSRC = 9792;
constexpr int ZC_CQ = 0, ZC_CKV = 512, ZC_QW = 1024, ZC_KW = 2048, ZC_VW = 2304, ZC_QM = 2560, ZC_KR = 3584, ZC_G = 3840;
constexpr int NQC = 1536, NKVC = 2048, NMEMR = 1280, NABC = 3072;
constexpr float EPS = 1e-6f;
constexpr float LOG2E = 1.4426950408889634f;
constexpr float C_W = 0.088388347648318440f * LOG2E;
constexpr float C_M = 0.0625f * LOG2E;
constexpr float C_Q = 0.072168783648703220f * LOG2E;

constexpr size_t MiB = 1u << 20;
constexpr size_t WS_CTL = 0, CTL_ZERO_BYTES = 1 * MiB;
constexpr size_t WS_TAB = 2 * MiB;
constexpr size_t WS_RMEM = 4 * MiB;
constexpr size_t WS_RS = 5 * MiB;
constexpr size_t WS_SSQ = 6 * MiB;
constexpr size_t WS_MEMB = 8 * MiB;
constexpr size_t WS_MEMK = 13 * MiB;
constexpr size_t WS_MEMVT = 16 * MiB;
constexpr size_t WS_W = 32 * MiB;
constexpr size_t WO_IN = 0, WO_UQ = WO_IN + (size_t)NZW * DM * 2, WO_UKV = WO_UQ + (size_t)NQC * 512 * 2, WO_MEM = WO_UKV + (size_t)NKVC * 512 * 2,
                 WO_BR = WO_MEM + (size_t)2048 * DM * 2, WO_OUT = WO_BR + (size_t)DM * NABC * 2, WO_UP = WO_OUT + (size_t)DM * DM * 2,
                 WO_DOWN = WO_UP + (size_t)DFF * DM * 2, WO_END = WO_DOWN + (size_t)DM * DFF * 2;
static_assert(WO_END <= 136 * MiB, "weights region");
constexpr size_t WS_XN = 168 * MiB;
constexpr size_t WS_Z = 264 * MiB;
constexpr size_t WS_GT = 444 * MiB;
constexpr size_t WS_U = WS_Z;
constexpr size_t WS_Q = 732 * MiB;
constexpr size_t WS_KV = 804 * MiB;
constexpr size_t WS_PM = 900 * MiB;
constexpr size_t WS_ABC = 948 * MiB;
constexpr size_t WS_MERGED = 732 * MiB;
constexpr size_t WS_Y = 828 * MiB;
constexpr size_t WS_END = 1092 * MiB;
static_assert(WS_Z + (size_t)NTOK * NZ * 2 <= WS_GT && WS_GT + (size_t)3 * 96 * 8 * 65536 <= WS_Q && WS_MERGED + (size_t)NTOK * DM * 2 <= WS_Y && WS_Y + (size_t)NTOK * DM * 2 <= WS_ABC, "ws map");
constexpr int CW_TMO = 0, CW_BAR = 4096, CW_RANK = 16384;

constexpr int RING_OFF = 0, RING_BYTES = 131072;
constexpr int LDSCTL_OFF = RING_BYTES, MISC_OFF = LDSCTL_OFF + 320;
constexpr int XCH_OFF = RING_BYTES + 1024;
constexpr int LDS_BYTES = 147456;
static_assert(XCH_OFF + 8192 <= LDS_BYTES, "LDS map");
constexpr int NWAVES = 8;

#define GAS __attribute__((address_space(1)))
#define LAS __attribute__((address_space(3)))
typedef unsigned short bf16;
typedef unsigned v4u __attribute__((ext_vector_type(4)));
typedef float f32x4 __attribute__((ext_vector_type(4)));
typedef float f32x2 __attribute__((ext_vector_type(2)));
typedef short bf16x8 __attribute__((ext_vector_type(8)));
typedef GAS unsigned gu32;
#define RLX_AGENT __ATOMIC_RELAXED, __HIP_MEMORY_SCOPE_AGENT
#define LDS_WAIT() asm volatile("s_waitcnt lgkmcnt(0)" ::: "memory")
#define VM_WAIT() asm volatile("s_waitcnt vmcnt(0)" ::: "memory")

typedef float f32x2_t __attribute__((ext_vector_type(2))); typedef __bf16 bf16x2_t __attribute__((ext_vector_type(2)));
__device__ __forceinline__ unsigned cvt_pk_bf16(float lo, float hi) { const f32x2_t v = {lo, hi}; const bf16x2_t b = __builtin_convertvector(v, bf16x2_t); return __builtin_bit_cast(unsigned, b); }
__device__ __forceinline__ float bf_lo(unsigned w) { return __uint_as_float(w << 16); }
__device__ __forceinline__ float bf_hi(unsigned w) { return __uint_as_float(w & 0xffff0000u); }
__device__ __forceinline__ float shfl_xor_l(float v, int m, int lane) { return __int_as_float(__builtin_amdgcn_ds_bpermute((lane ^ m) << 2, __float_as_int(v))); }
__device__ __forceinline__ int seq_pos(int m) { return m < NPROMPT ? (m & 4095) : (m - NPROMPT); }
__device__ __forceinline__ int seq_of_panel(int pm) { return pm < 64 ? (pm >> 4) : 4; }

#ifndef PG8_BALANCED
#define PG8_BALANCED 1
#endif
namespace pg8 {
#define PG8_LAS __attribute__((address_space(3)))
typedef unsigned short bf16_t;
typedef short bf16x8 __attribute__((ext_vector_type(8)));
typedef float f32x4 __attribute__((ext_vector_type(4)));
typedef unsigned u32x4 __attribute__((ext_vector_type(4)));
constexpr int BM = 256, BK = 64, HALF = 128, HTB = HALF * BK * 2, STAGE_BYTES = 8 * HTB, NXCD = 8, WGM = 4;

__host__ __device__ __forceinline__ int lds_byte(int r, int c) { const int st = (r >> 4) * 2 + (c >> 5), rr = r & 15, cc = c & 31, ob = rr * 64 + cc * 2; return st * 1024 + (ob ^ (((ob >> 9) & 1) << 5)); }
__host__ __device__ __forceinline__ void stage_rc(int b, int& R, int& C) { const int st = b / 1024, sb = b % 1024, swz = sb ^ (((sb >> 9) & 1) << 5); R = (st >> 1) * 16 + swz / 64; C = (st & 1) * 32 + (swz % 64) / 2; }
__host__ __device__ __forceinline__ int perm32(int rho) { const int n = rho >> 4, i = rho & 15; return 8 * (i >> 2) + 4 * n + (i & 3); }

struct Unit { int pm, pn; };
struct Gemm { const char* A; const char* B; long a_pm, a_pn, b_pn, b_sq; int lda, ldb, K; bool b_tiled;
    __device__ __forceinline__ const char* aptr(const Unit& u) const { return A + (long)u.pm * a_pm + (long)u.pn * a_pn; }
    __device__ __forceinline__ const char* bptr(const Unit& u) const { return B + (long)u.pn * b_pn + (long)seq_of_panel(u.pm) * b_sq; } };
__device__ __forceinline__ Gemm plain_gemm(const void* A, int lda, const void* B, int ldb, int K, bool b_tiled = false) {
    Gemm g; g.A = (const char*)A; g.B = (const char*)B; g.a_pm = (long)BM * lda * 2; g.a_pn = 0; g.b_pn = b_tiled ? (long)(ldb / BK) * 32768 : (long)BM * ldb * 2; g.b_sq = 0; g.lda = lda; g.ldb = ldb; g.K = K; g.b_tiled = b_tiled; return g; }

struct StaticOrder {
    int nM, nN, nwg, G, c;
    __host__ __device__ void init(int nM_, int nN_, int G_, int c_) { nM = nM_; nN = nN_; nwg = nM * nN; G = G_; c = c_; }
    __host__ __device__ bool next(int i, Unit& u) const {
        const int L = i * G + c; if (L >= nwg) return false;
        int wgid = L; { const int q = nwg / NXCD, r = nwg % NXCD, xcd = wgid % NXCD, off = wgid / NXCD; wgid = (xcd < r ? xcd * (q + 1) : r * (q + 1) + (xcd - r) * q) + off; }
        const int nig = WGM * nN, gid = wgid / nig, fm = gid * WGM, gsz = (nM - fm) < WGM ? (nM - fm) : WGM;
        u.pm = fm + ((wgid % nig) % gsz); u.pn = (wgid % nig) / gsz; return true;
    }
};

typedef f32x4 Acc[2][2][4][2];

template <class Epi, class Sched, bool ALIGN_EPI = true, bool SP2 = true>
__device__ __forceinline__ void gemm_phase(int tid_in, PG8_LAS unsigned char* lds, PG8_LAS unsigned char* xlds, const Gemm g, const Sched& S, const Epi& E) {
    int tid_ = tid_in; asm volatile("" : "+v"(tid_));
    const int tid = tid_, wid = __builtin_amdgcn_readfirstlane(tid >> 6), lane = tid & 63, wr = wid >> 2, wc = wid & 3, fr = lane & 15, fq = lane >> 4;
    const int K = g.K, nt = K / BK;
    unsigned voffA[2], voffB[2];
#pragma unroll
    for (int i = 0; i < 2; ++i) { int R, C; stage_rc(tid * 16 + i * 8192, R, C); const int Rb = Epi::PERM ? ((R & ~31) + perm32(R & 31)) : R;
        voffA[i] = (unsigned)(R * g.lda + C) * 2u; voffB[i] = g.b_tiled ? (unsigned)(tid * 16 + i * 8192) : (unsigned)(Rb * g.ldb + C) * 2u; }
    const size_t kstep = (size_t)(BK * 2), kstepB = g.b_tiled ? (size_t)32768 : (size_t)(BK * 2);
    const size_t hstepA = (size_t)HALF * g.lda * 2, hstepB = g.b_tiled ? (size_t)16384 : (size_t)HALF * g.ldb * 2;
    const unsigned ldsw = (unsigned)wid * 1024u;
    const int aoff = lds_byte(wr * 64 + fr, fq * 8), boff = lds_byte(wc * 32 + fr, fq * 8);
#define PG8_SA(b, h) (((b) * 2 + (h)) * HTB)
#define PG8_SB(b, h) ((4 + (b) * 2 + (h)) * HTB)
#define PG8_STAGE(bufoff, gbase, voff) do { _Pragma("unroll") for (int _i = 0; _i < 2; ++_i) \
        __builtin_amdgcn_global_load_lds((const unsigned*)((const char*)(gbase) + (voff)[_i]), (PG8_LAS unsigned*)(lds + (bufoff) + ldsw + _i * 8192), 16, 0, 0); } while (0)
#define PG8_LDA(dst, b, h) do { _Pragma("unroll") for (int m = 0; m < 4; ++m) _Pragma("unroll") for (int k = 0; k < 2; ++k) dst[m][k] = *(const PG8_LAS bf16x8*)(lds + PG8_SA(b, h) + aoff + m * 2048 + k * 1024); } while (0)
#define PG8_LDB(dst, b, h) do { _Pragma("unroll") for (int n = 0; n < 2; ++n) _Pragma("unroll") for (int k = 0; k < 2; ++k) dst[n][k] = *(const PG8_LAS bf16x8*)(lds + PG8_SB(b, h) + boff + n * 2048 + k * 1024); } while (0)
#define PG8_MMA(ai, bj, At, Bt) do { __builtin_amdgcn_s_setprio(1); _Pragma("unroll") for (int m = 0; m < 4; ++m) _Pragma("unroll") for (int n = 0; n < 2; ++n) _Pragma("unroll") for (int k = 0; k < 2; ++k) \
        acc[ai][bj][m][n] = __builtin_amdgcn_mfma_f32_16x16x32_bf16(Bt[n][k], At[m][k], acc[ai][bj][m][n], 0, 0, 0); __builtin_amdgcn_s_setprio(0); } while (0)
#define PG8_WAIT_V(n) asm volatile("s_waitcnt vmcnt(" #n ")" ::: "memory")
#define PG8_WAIT_L(n) asm volatile("s_waitcnt lgkmcnt(" #n ")" ::: "memory")
#define PG8_BAR __builtin_amdgcn_s_barrier()
#define PG8_SCHED __builtin_amdgcn_sched_barrier(0)
    Unit cur, nxt; int ui = 0;
    if (!S.next(0, cur)) return;
    f32x4 acc[2][2][4][2];
#pragma unroll
    for (int a = 0; a < 2; ++a)
#pragma unroll
        for (int b = 0; b < 2; ++b)
#pragma unroll
            for (int m = 0; m < 4; ++m)
#pragma unroll
                for (int n = 0; n < 2; ++n) acc[a][b][m][n] = (f32x4){0.f, 0.f, 0.f, 0.f};
    bf16x8 At[4][2], B0[2][2], B1[2][2];
    const char* cA = g.aptr(cur); const char* cB = g.bptr(cur);
    if constexpr (SP2 && PG8_BALANCED) {
        PG8_STAGE(PG8_SB(0, 0), cB, voffB); PG8_STAGE(PG8_SB(0, 1), cB + hstepB, voffB); PG8_STAGE(PG8_SA(0, 0), cA, voffA); PG8_STAGE(PG8_SA(0, 1), cA + hstepA, voffA);
        if (wr == 1) PG8_BAR;
        PG8_WAIT_V(2); PG8_BAR;
        PG8_STAGE(PG8_SB(1, 0), cB + kstepB, voffB); PG8_STAGE(PG8_SB(1, 1), cB + hstepB + kstepB, voffB);
        PG8_WAIT_V(4); PG8_BAR;
    } else if constexpr (SP2) {
        PG8_STAGE(PG8_SB(0, 0), cB, voffB); PG8_STAGE(PG8_SB(0, 1), cB + hstepB, voffB); PG8_STAGE(PG8_SA(0, 0), cA, voffA); PG8_STAGE(PG8_SA(0, 1), cA + hstepA, voffA);
        if (wr == 1) PG8_BAR;
        PG8_WAIT_V(2); PG8_BAR;
        PG8_STAGE(PG8_SB(1, 0), cB + kstepB, voffB); PG8_STAGE(PG8_SA(1, 0), cA + kstep, voffA); PG8_STAGE(PG8_SB(1, 1), cB + hstepB + kstepB, voffB);
        PG8_WAIT_V(6); PG8_BAR;
    } else {
        PG8_STAGE(PG8_SB(0, 0), cB, voffB); PG8_STAGE(PG8_SA(0, 0), cA, voffA); PG8_STAGE(PG8_SB(0, 1), cB + hstepB, voffB); PG8_STAGE(PG8_SA(0, 1), cA + hstepA, voffA);
        if (wr == 1) PG8_BAR;
        PG8_WAIT_V(4); PG8_BAR;
        PG8_STAGE(PG8_SB(1, 0), cB + kstepB, voffB); PG8_STAGE(PG8_SA(1, 0), cA + kstep, voffA); PG8_STAGE(PG8_SB(1, 1), cB + hstepB + kstepB, voffB);
        PG8_WAIT_V(6); PG8_BAR;
    }
    for (;;) {
        const bool has_next = S.next(ui + 1, nxt);
        const char* nA = has_next ? g.aptr(nxt) : cA; const char* nB = has_next ? g.bptr(nxt) : cB;
        for (int t = 0; t < nt; t += 2) {
            const bool last = (t == nt - 2);
            if constexpr (Epi::HAS_MID) { if (t == Epi::MID1 || t == Epi::MID2) E.mid(acc, cur, t, wr, wc, fr, fq); }
            const char* a1 = cA + (size_t)(t + 1) * kstep;
            const char* a2 = last ? nA : cA + (size_t)(t + 2) * kstep; const char* b2 = last ? nB : cB + (size_t)(t + 2) * kstepB;
            const char* a3 = a2 + kstep; const char* b3 = b2 + kstepB;
            if constexpr (SP2 && PG8_BALANCED) {
            PG8_LDB(B0, 0, 0); PG8_LDB(B1, 0, 1); PG8_SCHED; PG8_LDA(At, 0, 0); PG8_STAGE(PG8_SA(1, 0), a1, voffA); PG8_STAGE(PG8_SA(1, 1), a1 + hstepA, voffA);
            PG8_WAIT_V(8); PG8_WAIT_L(0); PG8_BAR; PG8_MMA(0, 0, At, B0); PG8_MMA(0, 1, At, B1); PG8_BAR; PG8_SCHED;
            PG8_LDA(At, 0, 1); PG8_STAGE(PG8_SB(0, 0), b2, voffB); PG8_STAGE(PG8_SB(0, 1), b2 + hstepB, voffB);
            PG8_WAIT_V(6); PG8_WAIT_L(0); PG8_BAR; PG8_MMA(1, 0, At, B0); PG8_MMA(1, 1, At, B1); PG8_BAR; PG8_SCHED;
            PG8_LDB(B0, 1, 0); PG8_LDB(B1, 1, 1); PG8_SCHED; PG8_LDA(At, 1, 0); PG8_STAGE(PG8_SA(0, 0), a2, voffA); PG8_STAGE(PG8_SA(0, 1), a2 + hstepA, voffA);
            PG8_WAIT_V(8); PG8_WAIT_L(0); PG8_BAR; PG8_MMA(0, 0, At, B0); PG8_MMA(0, 1, At, B1); PG8_BAR; PG8_SCHED;
            PG8_LDA(At, 1, 1); PG8_STAGE(PG8_SB(1, 0), b3, voffB); PG8_STAGE(PG8_SB(1, 1), b3 + hstepB, voffB);
            PG8_WAIT_V(6); PG8_WAIT_L(0); PG8_BAR; PG8_MMA(1, 0, At, B0); PG8_MMA(1, 1, At, B1); PG8_BAR; PG8_SCHED;
            } else if constexpr (SP2) {
            PG8_LDB(B0, 0, 0); PG8_LDB(B1, 0, 1); PG8_SCHED; PG8_LDA(At, 0, 0); PG8_STAGE(PG8_SA(1, 1), a1 + hstepA, voffA);
            PG8_WAIT_V(8); PG8_WAIT_L(0); PG8_BAR; PG8_MMA(0, 0, At, B0); PG8_MMA(0, 1, At, B1); PG8_BAR; PG8_SCHED;
            PG8_LDA(At, 0, 1); PG8_STAGE(PG8_SB(0, 0), b2, voffB); PG8_STAGE(PG8_SB(0, 1), b2 + hstepB, voffB); PG8_STAGE(PG8_SA(0, 0), a2, voffA);
            PG8_WAIT_V(8); PG8_WAIT_L(0); PG8_BAR; PG8_MMA(1, 0, At, B0); PG8_MMA(1, 1, At, B1); PG8_BAR; PG8_SCHED;
            PG8_LDB(B0, 1, 0); PG8_LDB(B1, 1, 1); PG8_SCHED; PG8_LDA(At, 1, 0); PG8_STAGE(PG8_SA(0, 1), a2 + hstepA, voffA);
            PG8_WAIT_V(8); PG8_WAIT_L(0); PG8_BAR; PG8_MMA(0, 0, At, B0); PG8_MMA(0, 1, At, B1); PG8_BAR; PG8_SCHED;
            PG8_LDA(At, 1, 1); PG8_STAGE(PG8_SB(1, 0), b3, voffB); PG8_STAGE(PG8_SB(1, 1), b3 + hstepB, voffB); PG8_STAGE(PG8_SA(1, 0), a3, voffA);
            PG8_WAIT_V(8); PG8_WAIT_L(0); PG8_BAR; PG8_MMA(1, 0, At, B0); PG8_MMA(1, 1, At, B1); PG8_BAR; PG8_SCHED;
            } else {
            PG8_LDB(B0, 0, 0); PG8_SCHED; PG8_LDA(At, 0, 0); PG8_STAGE(PG8_SA(1, 1), a1 + hstepA, voffA);
            PG8_WAIT_L(8); PG8_BAR; PG8_WAIT_L(0); PG8_MMA(0, 0, At, B0); PG8_BAR; PG8_SCHED;
            PG8_LDB(B1, 0, 1); PG8_STAGE(PG8_SB(0, 0), b2, voffB);
            PG8_BAR; PG8_WAIT_L(0); PG8_MMA(0, 1, At, B1); PG8_BAR;
            PG8_LDA(At, 0, 1); PG8_STAGE(PG8_SA(0, 0), a2, voffA);
            PG8_BAR; PG8_WAIT_L(0); PG8_MMA(1, 0, At, B0); PG8_BAR; PG8_SCHED;
            PG8_STAGE(PG8_SB(0, 1), b2 + hstepB, voffB);
            PG8_WAIT_V(6); PG8_BAR; PG8_MMA(1, 1, At, B1); PG8_BAR;
            PG8_LDB(B0, 1, 0); PG8_SCHED; PG8_LDA(At, 1, 0); PG8_STAGE(PG8_SA(0, 1), a2 + hstepA, voffA);
            PG8_WAIT_L(8); PG8_BAR; PG8_WAIT_L(0); PG8_MMA(0, 0, At, B0); PG8_BAR; PG8_SCHED;
            PG8_LDB(B1, 1, 1); PG8_STAGE(PG8_SB(1, 0), b3, voffB);
            PG8_BAR; PG8_WAIT_L(0); PG8_MMA(0, 1, At, B1); PG8_BAR;
            PG8_LDA(At, 1, 1); PG8_STAGE(PG8_SA(1, 0), a3, voffA);
            PG8_BAR; PG8_WAIT_L(0); PG8_MMA(1, 0, At, B0); PG8_BAR; PG8_SCHED;
            PG8_STAGE(PG8_SB(1, 1), b3 + hstepB, voffB);
            PG8_WAIT_V(6); PG8_BAR; PG8_MMA(1, 1, At, B1); PG8_BAR;
            }
        }
        if constexpr (ALIGN_EPI) { if (wr == 0) PG8_BAR; }
        E(acc, cur, wr, wc, fr, fq, xlds, wid, lane);
        if (!has_next) break;
#pragma unroll
        for (int a = 0; a < 2; ++a)
#pragma unroll
            for (int b = 0; b < 2; ++b)
#pragma unroll
                for (int m = 0; m < 4; ++m)
#pragma unroll
                    for (int n = 0; n < 2; ++n) acc[a][b][m][n] = (f32x4){0.f, 0.f, 0.f, 0.f};
        cur = nxt; cA = nA; cB = nB; ++ui;
        if constexpr (ALIGN_EPI) { if (wr == 1) PG8_BAR; }
    }
    PG8_WAIT_V(0);
    if constexpr (!ALIGN_EPI) { if (wr == 0) PG8_BAR; }
    PG8_BAR;
#undef PG8_SA
#undef PG8_SB
#undef PG8_STAGE
#undef PG8_LDA
#undef PG8_LDB
#undef PG8_MMA
#undef PG8_WAIT_V
#undef PG8_WAIT_L
#undef PG8_BAR
#undef PG8_SCHED
}
}

namespace epi {
using pg8::Acc; using pg8::Unit; using pg8::HALF; using pg8::BM;
typedef float f32x2v __attribute__((ext_vector_type(2)));
#define EPI_COMMON static constexpr bool PERM = true;
#define EPI_PIN(a, b) asm volatile("" : "+v"(a), "+v"(b))
#define EPI_NOMID static constexpr bool HAS_MID = false; static constexpr int MID1 = -1, MID2 = -1;
__device__ __forceinline__ v4u pack8(const f32x4 v0, const f32x4 v1) { v4u w; w.x = cvt_pk_bf16(v0[0], v0[1]); w.y = cvt_pk_bf16(v0[2], v0[3]); w.z = cvt_pk_bf16(v1[0], v1[1]); w.w = cvt_pk_bf16(v1[2], v1[3]); return w; }
__device__ __forceinline__ void rope8(f32x4& v0, f32x4& v1, const f32x4 cs0, const f32x4 cs1, const f32x4 cs2, const f32x4 cs3) {
    (void)cs2; (void)cs3;
    const float a0 = v0[0] * cs0[0] - v0[1] * cs0[1], b0 = v0[0] * cs0[1] + v0[1] * cs0[0];
    const float a1 = v0[2] * cs0[2] - v0[3] * cs0[3], b1 = v0[2] * cs0[3] + v0[3] * cs0[2];
    const float a2 = v1[0] * cs1[0] - v1[1] * cs1[1], b2 = v1[0] * cs1[1] + v1[1] * cs1[0];
    const float a3 = v1[2] * cs1[2] - v1[3] * cs1[3], b3 = v1[2] * cs1[3] + v1[3] * cs1[2];
    v0 = (f32x4){a0, b0, a1, b1}; v1 = (f32x4){a2, b2, a3, b3};
}
__device__ __forceinline__ unsigned pack4u8(const f32x4 v) {
    unsigned b[4];
#pragma unroll
    for (int j = 0; j < 4; ++j) b[j] = __float_as_uint(fmaxf(__builtin_fmaf(v[j], 255.f, 8388608.f), 8388609.f));
    const unsigned lo = __builtin_amdgcn_perm(b[1], b[0], 0x0c0c0400u), hi = __builtin_amdgcn_perm(b[3], b[2], 0x0c0c0400u);
    return lo | (hi << 16);
}
__device__ __forceinline__ f32x4 ub4(unsigned x) { return (f32x4){(float)(x & 0xffu), (float)((x >> 8) & 0xffu), (float)((x >> 16) & 0xffu), (float)(x >> 24)}; }
__device__ __forceinline__ f32x4 rcp4(const f32x4 v) { return (f32x4){__builtin_amdgcn_rcpf(v[0]), __builtin_amdgcn_rcpf(v[1]), __builtin_amdgcn_rcpf(v[2]), __builtin_amdgcn_rcpf(v[3])}; }
__device__ __forceinline__ float sigmoidf_fast(float v) { return __builtin_amdgcn_rcpf(1.f + __builtin_amdgcn_exp2f(-LOG2E * v)); }

struct EpiZ { EPI_COMMON EPI_NOMID
    bf16* Z; float* SSQ; const float* tab; unsigned char* GT;
    __device__ __forceinline__ void operator()(Acc& acc, const Unit& u, int wr, int wc, int fr, int fq, LAS unsigned char*, int, int lane) const {
        const int pn = u.pn; int row0 = u.pm * BM + wr * 64 + fr, col0 = pn * BM + wc * 32 + 8 * fq; EPI_PIN(row0, col0);
        if (pn >= 15) {
            const int gi = pn - 15; unsigned char* blk = GT + ((size_t)((gi >> 3) * 96 + u.pm) * 8 + (gi & 7)) * 65536 + (size_t)(wr * 4 + wc) * 8192 + lane * 16;
#pragma unroll
            for (int ai = 0; ai < 2; ++ai)
#pragma unroll
                for (int m = 0; m < 4; ++m) { v4u o;
#pragma unroll
                    for (int bj = 0; bj < 2; ++bj) { f32x4 v0 = acc[ai][bj][m][0], v1 = acc[ai][bj][m][1];
#pragma unroll
                        for (int j = 0; j < 4; ++j) { v0[j] = sigmoidf_fast(v0[j]); v1[j] = sigmoidf_fast(v1[j]); }
                        const unsigned q0 = pack4u8(v0), q1 = pack4u8(v1);
                        if (bj == 0) { o.x = q0; o.y = q1; } else { o.z = q0; o.w = q1; } }
                    *(v4u*)(blk + (ai * 4 + m) * 1024) = o; }
        } else if (pn == 14) {
            const int i0 = 16 * (wc & 1) + 4 * fq;
#pragma unroll
            for (int ai = 0; ai < 2; ++ai)
#pragma unroll
                for (int m = 0; m < 4; ++m) { const int row = row0 + ai * HALF + m * 16; bf16* rowp = Z + (size_t)row * NZ + col0;
                    f32x4 v0 = acc[ai][0][m][0], v1 = acc[ai][0][m][1];
                    if (wc < 2) { const f32x4* cs = (const f32x4*)(tab + ((size_t)seq_pos(row) * 32 + i0) * 2); rope8(v0, v1, cs[0], cs[1], cs[0], cs[0]); }
                    *(v4u*)(rowp) = pack8(v0, v1);
                    *(v4u*)(rowp + HALF) = pack8(acc[ai][1][m][0], acc[ai][1][m][1]); }
        } else {
            const float sc = (pn >= 4 && pn < 8) ? C_W : ((pn >= 10) ? C_M : 1.f);
#pragma unroll
            for (int ai = 0; ai < 2; ++ai)
#pragma unroll
                for (int m = 0; m < 4; ++m) { const int row = row0 + ai * HALF + m * 16; bf16* rowp = Z + (size_t)row * NZ + col0; float ss = 0.f;
#pragma unroll
                    for (int bj = 0; bj < 2; ++bj) { const f32x4 v0 = acc[ai][bj][m][0] * sc, v1 = acc[ai][bj][m][1] * sc;
                        ss += (v0[0] * v0[0] + v0[1] * v0[1]) + (v0[2] * v0[2] + v0[3] * v0[3]) + (v1[0] * v1[0] + v1[1] * v1[1]) + (v1[2] * v1[2] + v1[3] * v1[3]);
                        *(v4u*)(rowp + bj * HALF) = pack8(v0, v1); }
                    if (pn < 4) { ss += shfl_xor_l(ss, 16, lane); ss += shfl_xor_l(ss, 32, lane); if (fq == 0) SSQ[(size_t)row * 16 + pn * 4 + wc] = ss; } }
        }
    }
};
template <int WHICH  > struct EpiLat { EPI_COMMON EPI_NOMID
    bf16* O; const float* SSQ; const float* tab;
    __device__ __forceinline__ void operator()(Acc& acc, const Unit& u, int wr, int wc, int fr, int fq, LAS unsigned char*, int, int) const {
        constexpr int LDC = WHICH == 0 ? NQC : NKVC;
        const int pn = u.pn; int row0 = u.pm * BM + wr * 64 + fr, col0 = pn * BM + wc * 32 + 8 * fq; EPI_PIN(row0, col0);
        const int i0 = 16 * (wc & 1) + 4 * fq;
#pragma unroll
        for (int ai = 0; ai < 2; ++ai)
#pragma unroll
            for (int m = 0; m < 4; ++m) { const int row = row0 + ai * HALF + m * 16; bf16* rowp = O + (size_t)row * LDC + col0;
                const f32x4* sp = (const f32x4*)(SSQ + (size_t)row * 16 + WHICH * 8); const f32x4 s0 = sp[0], s1 = sp[1];
                const float ssum = ((s0[0] + s0[1]) + (s0[2] + s0[3])) + ((s1[0] + s1[1]) + (s1[2] + s1[3]));
                const float rs = __builtin_amdgcn_rsqf(ssum * (1.f / 512.f) + EPS) * (WHICH == 0 ? C_Q : 1.f);
#pragma unroll
                for (int bj = 0; bj < 2; ++bj) { f32x4 v0 = acc[ai][bj][m][0] * rs, v1 = acc[ai][bj][m][1] * rs;
                    if (WHICH == 0 && pn >= 4) { const f32x4* cs = (const f32x4*)(tab + ((size_t)seq_pos(row) * 32 + i0) * 2); rope8(v0, v1, cs[0], cs[1], cs[0], cs[0]); }
                    *(v4u*)(rowp + bj * HALF) = pack8(v0, v1); } }
    }
};
template <int MODE> struct EpiStore { EPI_COMMON EPI_NOMID
    bf16* O; int ldc; int col_off; const float* rs;
    __device__ __forceinline__ void operator()(Acc& acc, const Unit& u, int wr, int wc, int fr, int fq, LAS unsigned char*, int, int) const {
        int row0 = u.pm * BM + wr * 64 + fr, ct = u.pn * BM + wc * 32 + 8 * fq; EPI_PIN(row0, ct); const int col0 = col_off + ct;
        f32x4 cs[2][2]; float rr[2][4];
#pragma unroll
        for (int ai = 0; ai < 2; ++ai)
#pragma unroll
            for (int m = 0; m < 4; ++m) rr[ai][m] = (MODE == 1 || MODE == 5) ? rs[row0 + ai * HALF + m * 16] : 1.f;
        if (MODE == 2) {
#pragma unroll
            for (int bj = 0; bj < 2; ++bj) { cs[bj][0] = *(const f32x4*)(rs + ct + bj * HALF); cs[bj][1] = *(const f32x4*)(rs + ct + bj * HALF + 4); } }
#pragma unroll
        for (int ai = 0; ai < 2; ++ai)
#pragma unroll
            for (int m = 0; m < 4; ++m) { const int row = row0 + ai * HALF + m * 16; bf16* rowp = O + (size_t)row * ldc + col0;
                const float r = rr[ai][m];
#pragma unroll
                for (int bj = 0; bj < 2; ++bj) { f32x4 v0 = acc[ai][bj][m][0], v1 = acc[ai][bj][m][1];
                    if (MODE == 1 || MODE == 5) { v0 = v0 * r; v1 = v1 * r; }
                    if (MODE == 2) { v0 = v0 * cs[bj][0]; v1 = v1 * cs[bj][1]; }
                    if (MODE == 3 || MODE == 5) {
#pragma unroll
                        for (int j = 0; j < 4; ++j) { const float a = fmaxf(v0[j], 0.f), b = fmaxf(v1[j], 0.f); v0[j] = a * a; v1[j] = b * b; } }
                    *(v4u*)(rowp + bj * HALF) = pack8(v0, v1); } }
    }
};
struct EpiSoftmax { EPI_COMMON EPI_NOMID
    bf16* O;
    __device__ __forceinline__ void operator()(Acc& acc, const Unit& u, int wr, int wc, int fr, int fq, LAS unsigned char* xl, int, int lane) const {
        LAS float* MX = (LAS float*)xl; LAS float* SM = (LAS float*)(xl + 4096);
        int row0 = u.pm * BM + wr * 64 + fr, col0 = u.pn * BM + wc * 32 + 8 * fq; EPI_PIN(row0, col0);
#pragma unroll
        for (int ai = 0; ai < 2; ++ai)
#pragma unroll
            for (int m = 0; m < 4; ++m) { float mx = -3.0e38f;
#pragma unroll
                for (int bj = 0; bj < 2; ++bj)
#pragma unroll
                    for (int n = 0; n < 2; ++n) { const f32x4 x = acc[ai][bj][m][n]; mx = fmaxf(mx, fmaxf(fmaxf(x[0], x[1]), fmaxf(x[2], x[3]))); }
                mx = fmaxf(mx, shfl_xor_l(mx, 16, lane)); mx = fmaxf(mx, shfl_xor_l(mx, 32, lane));
                if (fq == 0) MX[(ai * HALF + wr * 64 + m * 16 + fr) * 4 + wc] = mx; }
        asm volatile("s_waitcnt lgkmcnt(0)" ::: "memory"); __builtin_amdgcn_s_barrier(); asm volatile("" ::: "memory");
#pragma unroll
        for (int ai = 0; ai < 2; ++ai)
#pragma unroll
            for (int m = 0; m < 4; ++m) { const int lr = ai * HALF + wr * 64 + m * 16 + fr; const f32x4 q = *(LAS f32x4*)(MX + lr * 4);
                const float mx = fmaxf(fmaxf(q[0], q[1]), fmaxf(q[2], q[3])); float s = 0.f;
#pragma unroll
                for (int bj = 0; bj < 2; ++bj)
#pragma unroll
                    for (int n = 0; n < 2; ++n) { f32x4 x = acc[ai][bj][m][n];
#pragma unroll
                        for (int j = 0; j < 4; ++j) { x[j] = __builtin_amdgcn_exp2f(x[j] - mx); s += x[j]; }
                        acc[ai][bj][m][n] = x; }
                s += shfl_xor_l(s, 16, lane); s += shfl_xor_l(s, 32, lane);
                if (fq == 0) SM[lr * 4 + wc] = s; }
        asm volatile("s_waitcnt lgkmcnt(0)" ::: "memory"); __builtin_amdgcn_s_barrier(); asm volatile("" ::: "memory");
#pragma unroll
        for (int ai = 0; ai < 2; ++ai)
#pragma unroll
            for (int m = 0; m < 4; ++m) { const int lr = ai * HALF + wr * 64 + m * 16 + fr; const f32x4 q = *(LAS f32x4*)(SM + lr * 4);
                const float inv = __builtin_amdgcn_rcpf((q[0] + q[1]) + (q[2] + q[3]));
                bf16* rowp = O + (size_t)(row0 + ai * HALF + m * 16) * 1024 + col0;
#pragma unroll
                for (int bj = 0; bj < 2; ++bj) *(v4u*)(rowp + bj * HALF) = pack8(acc[ai][bj][m][0] * inv, acc[ai][bj][m][1] * inv); }
    }
};
struct EpiBranch { EPI_COMMON
    static constexpr bool HAS_MID = true; static constexpr int MID1 = 16, MID2 = 32;
    bf16* O; const unsigned char* GT;
    __device__ __forceinline__ const unsigned char* gblk(const Unit& u, int g, int wr, int wc, int fr, int fq) const {
        return GT + ((size_t)(g * 96 + u.pm) * 8 + u.pn) * 65536 + (size_t)(wr * 4 + wc) * 8192 + (fq * 16 + fr) * 16; }
    __device__ __forceinline__ void mid(Acc& acc, const Unit& u, int t, int wr, int wc, int fr, int fq) const {
        const int gxi = (t == MID1) ? 0 : 1;
        const unsigned char* px = gblk(u, gxi, wr, wc, fr, fq); const unsigned char* py = gblk(u, gxi + 1, wr, wc, fr, fq);
        v4u a[2][4], b[2][4];
#pragma unroll
        for (int ai = 0; ai < 2; ++ai)
#pragma unroll
            for (int m = 0; m < 4; ++m) { a[ai][m] = *(const v4u*)(px + (ai * 4 + m) * 1024); b[ai][m] = *(const v4u*)(py + (ai * 4 + m) * 1024); }
        __builtin_amdgcn_sched_barrier(0);
#pragma unroll
        for (int ai = 0; ai < 2; ++ai)
#pragma unroll
            for (int m = 0; m < 4; ++m) { const v4u x = a[ai][m], y = b[ai][m];
                acc[ai][0][m][0] *= ub4(x.x) * rcp4(ub4(y.x)); acc[ai][0][m][1] *= ub4(x.y) * rcp4(ub4(y.y));
                acc[ai][1][m][0] *= ub4(x.z) * rcp4(ub4(y.z)); acc[ai][1][m][1] *= ub4(x.w) * rcp4(ub4(y.w)); }
        __builtin_amdgcn_sched_barrier(0);
    }
    __device__ __forceinline__ void operator()(Acc& acc, const Unit& u, int wr, int wc, int fr, int fq, LAS unsigned char*, int, int) const {
        int row0 = u.pm * BM + wr * 64 + fr, col0 = u.pn * BM + wc * 32 + 8 * fq; EPI_PIN(row0, col0);
        const unsigned char* pz = gblk(u, 2, wr, wc, fr, fq);
        v4u a[2][4];
#pragma unroll
        for (int ai = 0; ai < 2; ++ai)
#pragma unroll
            for (int m = 0; m < 4; ++m) a[ai][m] = *(const v4u*)(pz + (ai * 4 + m) * 1024);
        __builtin_amdgcn_sched_barrier(0);
        constexpr float I255 = 1.f / 255.f;
#pragma unroll
        for (int ai = 0; ai < 2; ++ai)
#pragma unroll
            for (int m = 0; m < 4; ++m) { bf16* rowp = O + (size_t)(row0 + ai * HALF + m * 16) * DM + col0; const v4u x = a[ai][m];
                *(v4u*)(rowp) = pack8(acc[ai][0][m][0] * (ub4(x.x) * I255), acc[ai][0][m][1] * (ub4(x.y) * I255));
                *(v4u*)(rowp + HALF) = pack8(acc[ai][1][m][0] * (ub4(x.z) * I255), acc[ai][1][m][1] * (ub4(x.w) * I255)); }
        __builtin_amdgcn_sched_barrier(0);
    }
};
}

namespace att {
using s16x4 = __attribute__((ext_vector_type(4))) short;
using f32x16 = __attribute__((ext_vector_type(16))) float;
using u32x4 = __attribute__((ext_vector_type(4))) unsigned;
constexpr int NW = 8, QBLK = 32, KVBLK = 64;
constexpr float THR2 = 8.f;
constexpr float NEGBIG = -1.0e30f;
#define SBAR() __builtin_amdgcn_sched_barrier(0)
__device__ __forceinline__ int crow(int r, int hi) { return (r & 3) + 8 * (r >> 2) + 4 * hi; }
template <int KROWB> __device__ __forceinline__ int kswz(int row, int colB) { return row * KROWB + (colB ^ ((KROWB == 384 ? ((row >> 1) & 7) : (row & 15)) << 4)); }

struct Mask { int dq; float sl; };

template <bool WIN>
__device__ __forceinline__ void partialSM(f32x16& p0, f32x16& p1, float& m_reg, float& mn, float& alpha, const Mask& mk, int kt) {
  if (WIN) {
    const float fd = (float)(mk.dq - kt * KVBLK);
#pragma unroll
    for (int r = 0; r < 16; ++r) { const float d0 = fd - (float)((r & 3) + 8 * (r >> 2)), d1 = d0 - 32.f; const float a0 = fabsf(d0), a1 = fabsf(d1);
      const float t0 = p0[r] - mk.sl * a0, t1 = p1[r] - mk.sl * a1; p0[r] = (a0 <= 128.f) ? t0 : NEGBIG; p1[r] = (a1 <= 128.f) ? t1 : NEGBIG; }
  }
  float pmax = p0[0];
#pragma unroll
  for (int r = 1; r < 16; ++r) pmax = fmaxf(pmax, p0[r]);
#pragma unroll
  for (int r = 0; r < 16; ++r) pmax = fmaxf(pmax, p1[r]);
  { auto rr = __builtin_amdgcn_permlane32_swap(__float_as_uint(pmax), __float_as_uint(pmax), false, false);
    pmax = fmaxf(__uint_as_float(rr[0]), __uint_as_float(rr[1])); }
  if (__builtin_expect(__all(pmax - m_reg <= THR2), 1)) { mn = m_reg; alpha = 1.f; }
  else { mn = fmaxf(m_reg, pmax); alpha = __builtin_amdgcn_exp2f(m_reg - mn); m_reg = mn; }
#pragma unroll
  for (int r = 0; r < 16; ++r) p0[r] = p0[r] - mn;
#pragma unroll
  for (int r = 0; r < 16; ++r) p1[r] = p1[r] - mn;
#pragma unroll
  for (int r = 0; r < 16; ++r) p0[r] = __builtin_amdgcn_exp2f(p0[r]);
}
__device__ __forceinline__ void finishSM(f32x16& p0, f32x16& p1, float alpha, float& l_reg, bf16x8& pa0, bf16x8& pa1, bf16x8& pa2, bf16x8& pa3) {
#pragma unroll
  for (int r = 0; r < 16; ++r) p1[r] = __builtin_amdgcn_exp2f(p1[r]);
  float ps = 0;
#pragma unroll
  for (int r = 0; r < 16; ++r) ps += p0[r];
#pragma unroll
  for (int r = 0; r < 16; ++r) ps += p1[r];
  { auto rr = __builtin_amdgcn_permlane32_swap(__float_as_uint(ps), __float_as_uint(ps), false, false);
    ps = __uint_as_float(rr[0]) + __uint_as_float(rr[1]); }
  l_reg = l_reg * alpha + ps;
#define PK4(P, BASE, OUT) do { unsigned a0 = cvt_pk_bf16(P[BASE + 0], P[BASE + 1]), a1 = cvt_pk_bf16(P[BASE + 2], P[BASE + 3]);   \
    unsigned b0 = cvt_pk_bf16(P[BASE + 4], P[BASE + 5]), b1 = cvt_pk_bf16(P[BASE + 6], P[BASE + 7]);                              \
    auto r0 = __builtin_amdgcn_permlane32_swap(a0, b0, false, false); auto r1 = __builtin_amdgcn_permlane32_swap(a1, b1, false, false); \
    u32x4 w = {r0[0], r1[0], r0[1], r1[1]}; OUT = *reinterpret_cast<bf16x8*>(&w); } while (0)
  PK4(p0, 0, pa0); PK4(p0, 8, pa1); PK4(p1, 0, pa2); PK4(p1, 8, pa3);
#undef PK4
}
template <int NQF, int KROWB>
__device__ __forceinline__ void qkt(f32x16& p0, f32x16& p1, const LAS char* Ks, const bf16x8* qr, int r32, int hi) {
  p0 = f32x16{}; p1 = f32x16{};
#pragma unroll
  for (int d0 = 0; d0 < NQF; ++d0) { const int cb = (d0 * 16 + hi * 8) * 2;
    bf16x8 b0 = *(const LAS bf16x8*)(Ks + kswz<KROWB>(r32, cb));
    bf16x8 b1 = *(const LAS bf16x8*)(Ks + kswz<KROWB>(32 + r32, cb));
    p0 = __builtin_amdgcn_mfma_f32_32x32x16_bf16(b0, qr[d0], p0, 0, 0, 0);
    p1 = __builtin_amdgcn_mfma_f32_32x32x16_bf16(b1, qr[d0], p1, 0, 0, 0); }
}
__device__ __forceinline__ int v_st(int k, int c) { const int kk = (k & ~0xC) | ((k & 4) << 1) | ((k & 8) >> 1); return ((kk >> 3) * 4 + (c >> 5)) * 512 + ((kk & 7) * 32 + (c & 31)) * 2; }
__device__ __forceinline__ int v_rd_base(int lane) { return ((lane & 3) << 3) | (((lane >> 2) & 3) << 6) | (((lane >> 4) & 1) << 5) | (((lane >> 5) & 1) << 8); }
constexpr int v_rd_off(int d0, int ks, int half) { return d0 * 512 + ks * 4096 + half * 2048; }
template <int OFF> __device__ __forceinline__ s16x4 tr_read(int vb) {
  s16x4 r; asm volatile("ds_read_b64_tr_b16 %0, %1 offset:%2" : "=&v"(r) : "v"(vb), "i"(OFF) : "memory"); return r;
}
template <int D0> __device__ __forceinline__ void pv_one(f32x16& od, int vb, bf16x8 pa0, bf16x8 pa1, bf16x8 pa2, bf16x8 pa3) {
  const s16x4 l0 = tr_read<v_rd_off(D0, 0, 0)>(vb), h0 = tr_read<v_rd_off(D0, 0, 1)>(vb), l1 = tr_read<v_rd_off(D0, 1, 0)>(vb), h1 = tr_read<v_rd_off(D0, 1, 1)>(vb);
  const s16x4 l2 = tr_read<v_rd_off(D0, 2, 0)>(vb), h2 = tr_read<v_rd_off(D0, 2, 1)>(vb), l3 = tr_read<v_rd_off(D0, 3, 0)>(vb), h3 = tr_read<v_rd_off(D0, 3, 1)>(vb);
  asm volatile("s_waitcnt lgkmcnt(0)" ::: "memory"); SBAR();
#define PK(L, H) (bf16x8){L[0], L[1], L[2], L[3], H[0], H[1], H[2], H[3]}
  od = __builtin_amdgcn_mfma_f32_32x32x16_bf16(pa0, PK(l0, h0), od, 0, 0, 0);
  od = __builtin_amdgcn_mfma_f32_32x32x16_bf16(pa1, PK(l1, h1), od, 0, 0, 0);
  od = __builtin_amdgcn_mfma_f32_32x32x16_bf16(pa2, PK(l2, h2), od, 0, 0, 0);
  od = __builtin_amdgcn_mfma_f32_32x32x16_bf16(pa3, PK(l3, h3), od, 0, 0, 0);
#undef PK
}
__device__ __forceinline__ void pv_d0(f32x16* o, int vb, bf16x8 pa0, bf16x8 pa1, bf16x8 pa2, bf16x8 pa3) {
  pv_one<0>(o[0], vb, pa0, pa1, pa2, pa3); pv_one<1>(o[1], vb, pa0, pa1, pa2, pa3); pv_one<2>(o[2], vb, pa0, pa1, pa2, pa3); pv_one<3>(o[3], vb, pa0, pa1, pa2, pa3);
}

__device__ __forceinline__ int kn_off(int row, int colB) { return row * 256 + (colB ^ ((row & 15) << 4)); }
__device__ __forceinline__ int kr_off(int row, int colB) { return row * 128 + (colB ^ (((row >> 1) & 7) << 4)); }
template <int NQF>
__device__ __forceinline__ void qk_mm(f32x16& n0, f32x16& n1, const LAS char* Kn, const LAS char* Kr, const bf16x8* qr, int r32, int hi) {
  constexpr int PF = 2, NB = PF + 1;
  n0 = f32x16{}; n1 = f32x16{};
  bf16x8 kb[NB][2];
#define QM_LOADK(d) do { if ((d) < 8) { const int cb_ = ((d) * 16 + hi * 8) * 2; kb[(d) % NB][0] = *(const LAS bf16x8*)(Kn + kn_off(r32, cb_)); kb[(d) % NB][1] = *(const LAS bf16x8*)(Kn + kn_off(32 + r32, cb_)); } \
    else { const int cb_ = (((d) - 8) * 16 + hi * 8) * 2; kb[(d) % NB][0] = *(const LAS bf16x8*)(Kr + kr_off(r32, cb_)); kb[(d) % NB][1] = *(const LAS bf16x8*)(Kr + kr_off(32 + r32, cb_)); } } while (0)
  QM_LOADK(0); QM_LOADK(1);
#pragma unroll
  for (int k = 0; k < NQF; ++k) {
    if (k + PF < NQF) QM_LOADK(k + PF);
    n0 = __builtin_amdgcn_mfma_f32_32x32x16_bf16(kb[k % NB][0], qr[k], n0, 0, 0, 0);
    n1 = __builtin_amdgcn_mfma_f32_32x32x16_bf16(kb[k % NB][1], qr[k], n1, 0, 0, 0);
    __builtin_amdgcn_sched_barrier(0);
  }
#undef QM_LOADK
}

template <int KIND>
__device__ __forceinline__ void attn_unit(const bf16* __restrict__ Qb, const bf16* __restrict__ KVb, const bf16* __restrict__ Zb, bf16* __restrict__ Ob,
                                          int qm0, int km0, int NT, int h, int ocol, float m0, float l0, Mask mk, LAS char* lds, int tid_in) {
  constexpr int NQF = KIND == 0 ? 12 : 8;
  constexpr bool HASR = KIND == 0, WIN = KIND == 1;
  constexpr int KSLOT = HASR ? 24576 : 16384, OFF_KR = 16384, VRING = 3 * KSLOT, VSLOT = 16384, SCR = VRING + 3 * VSLOT;
  int tid_; asm volatile("v_mbcnt_lo_u32_b32 %0, -1, 0\n\tv_mbcnt_hi_u32_b32 %0, -1, %0" : "=v"(tid_)); tid_ += tid_in;
  const int tid = tid_, wid = tid >> 6, lane = tid & 63, r32 = lane & 31, hi = lane >> 5;
  const int widu = __builtin_amdgcn_readfirstlane(wid);
  const bool trailing = widu >= 4;
  LAS float* ws = (LAS float*)(lds + SCR) + wid * 64; LAS float* li_l = ws; LAS float* al_l = ws + 32;
  float m_reg = m0, l_reg = l0; f32x16 o[4] = {}; bf16x8 qr[NQF];
  mk.dq += wid * QBLK + r32 - 4 * hi;
  const int kvh = h >> 2;
  constexpr long kld2 = (KIND == 0 ? NKVC : NZ) * 2;
  const char* Kbase = KIND == 0 ? (const char*)(KVb + (long)km0 * NKVC + h * 256) : (const char*)(Zb + (long)km0 * NZ + ZC_KW + kvh * 128);
  const char* Vbase = KIND == 0 ? Kbase + 256 : (const char*)(Zb + (long)km0 * NZ + ZC_VW + kvh * 128);
  const char* Rbase = (const char*)(Zb + (long)km0 * NZ + ZC_KR);
  unsigned okn[2], ov[2], okr;
#pragma unroll
  for (int q = 0; q < 2; ++q) { const int pq = 2 * wid + q;
    { const int row = pq * 4 + (lane >> 4), ch = (lane & 15) ^ (row & 15); okn[q] = (unsigned)(row * kld2 + ch * 16); }
    { const int sub = 2 * pq + (lane >> 5), kk = (sub >> 2) * 8 + ((lane & 31) >> 2), k = (kk & ~0xC) | ((kk & 4) << 1) | ((kk & 8) >> 1), c = (sub & 3) * 32 + (lane & 3) * 8; ov[q] = (unsigned)(k * kld2 + c * 2); } }
  { const int row = wid * 8 + (lane >> 3), ch = (lane & 7) ^ ((row >> 1) & 7); okr = (unsigned)(row * (NZ * 2) + ch * 16); }
#define GLDS(src, dst) __builtin_amdgcn_global_load_lds((const unsigned*)(src), (LAS unsigned*)(dst), 16, 0, 0)
#define DMA_K(t, ks) do { const size_t to_ = (size_t)(t) * KVBLK * kld2; LAS char* sb_ = lds + (ks) * KSLOT; \
    GLDS(Kbase + to_ + okn[0], sb_ + (2 * widu) * 1024); GLDS(Kbase + to_ + okn[1], sb_ + (2 * widu + 1) * 1024); \
    if (HASR) GLDS(Rbase + (size_t)(t) * KVBLK * (NZ * 2) + okr, sb_ + OFF_KR + widu * 1024); } while (0)
#define DMA_V(t, vs) do { const size_t to_ = (size_t)(t) * KVBLK * kld2; LAS char* sb_ = lds + VRING + (vs) * VSLOT; \
    GLDS(Vbase + to_ + ov[0], sb_ + (2 * widu) * 1024); GLDS(Vbase + to_ + ov[1], sb_ + (2 * widu + 1) * 1024); } while (0)
#define WAITBAR() asm volatile("s_waitcnt vmcnt(0) lgkmcnt(0)\n\ts_barrier" ::: "memory")
#define LBAR() asm volatile("s_waitcnt lgkmcnt(0)\n\ts_barrier" ::: "memory")
#define RESC(a) do { if (__any((a) < 1.f)) { if (hi == 0) al_l[r32] = (a); asm volatile("s_waitcnt lgkmcnt(0)" ::: "memory"); \
    _Pragma("unroll") for (int d = 0; d < 4; ++d) _Pragma("unroll") for (int r = 0; r < 16; ++r) o[d][r] *= al_l[crow(r, hi)]; } } while (0)
  DMA_K(0, 0); DMA_K(1, 1); DMA_V(0, 0);
  { const long qrow = (long)(qm0 + wid * QBLK + r32);
    if (KIND == 0) {
      const bf16* Qn = Qb + qrow * NQC + h * 128 + hi * 8; const bf16* Qr = Qb + qrow * NQC + 1024 + h * 64 + hi * 8;
#pragma unroll
      for (int d0 = 0; d0 < 8; ++d0) qr[d0] = *reinterpret_cast<const bf16x8*>(Qn + d0 * 16);
#pragma unroll
      for (int d0 = 8; d0 < NQF; ++d0) qr[d0] = *reinterpret_cast<const bf16x8*>(Qr + (d0 - 8) * 16);
    } else {
      const bf16* Qn = Zb + qrow * NZ + ZC_QW + h * 128 + hi * 8;
#pragma unroll
      for (int d0 = 0; d0 < 8; ++d0) qr[d0] = *reinterpret_cast<const bf16x8*>(Qn + d0 * 16);
    } }
  const int vb0 = (int)(uintptr_t)lds + VRING + v_rd_base(lane);
  f32x16 s0, s1; float mn, al; bf16x8 pa0, pa1, pa2, pa3;
  asm volatile("s_waitcnt vmcnt(0)" ::: "memory");
  if (trailing) LBAR();
  LBAR();
  int ks = 0, vs = 2;
  for (int t = 0; t < NT; ++t) {
    __builtin_amdgcn_s_setprio(3);
    qk_mm<NQF>(s0, s1, lds + ks * KSLOT, lds + ks * KSLOT + OFF_KR, qr, r32, hi);
    if (t > 0) pv_d0(o, vb0 + vs * VSLOT, pa0, pa1, pa2, pa3);
    __builtin_amdgcn_s_setprio(0);
    WAITBAR();
    { const int kn = ks == 0 ? 2 : ks - 1, vn = vs == 2 ? 0 : vs + 1, vn2 = vn == 2 ? 0 : vn + 1;
      if (t + 2 < NT) DMA_K(t + 2, kn);
      if (t + 1 < NT) DMA_V(t + 1, vn2); }
    partialSM<WIN>(s0, s1, m_reg, mn, al, mk, t);
    finishSM(s0, s1, al, l_reg, pa0, pa1, pa2, pa3);
    RESC(al);
    LBAR();
    ks = ks == 2 ? 0 : ks + 1; vs = vs == 2 ? 0 : vs + 1;
  }
  __builtin_amdgcn_s_setprio(3);
  pv_d0(o, vb0 + vs * VSLOT, pa0, pa1, pa2, pa3);
  __builtin_amdgcn_s_setprio(0);
  if (!trailing) LBAR();
  if (hi == 0) li_l[r32] = l_reg; asm volatile("s_waitcnt lgkmcnt(0)" ::: "memory");
  float rli[16];
#pragma unroll
  for (int r = 0; r < 16; ++r) rli[r] = __builtin_amdgcn_rcpf(li_l[crow(r, hi)]);
  WAITBAR();
  { LAS bf16* stg = (LAS bf16*)(lds + wid * 8192);
#pragma unroll
    for (int r = 0; r < 16; ++r) { const int orow = crow(r, hi);
#pragma unroll
      for (int d0 = 0; d0 < 4; ++d0) { const float v = o[d0][r] * rli[r]; stg[orow * 128 + d0 * 32 + r32] = (bf16)(cvt_pk_bf16(v, v) & 0xffffu); } }
    asm volatile("s_waitcnt lgkmcnt(0)" ::: "memory");
    bf16* Ow = Ob + (long)(qm0 + wid * QBLK) * NABC + ocol;
#pragma unroll
    for (int i = 0; i < 8; ++i) { const int row = i * 4 + (lane >> 4), ch = lane & 15; const v4u v = *(const LAS v4u*)(stg + row * 128 + ch * 8); *(v4u*)(Ow + (long)row * NABC + ch * 8) = v; } }
  WAITBAR();
#undef GLDS
#undef DMA_K
#undef DMA_V
#undef WAITBAR
#undef LBAR
#undef RESC
}
#undef SBAR
}

#define XB_TMO      128
#define XB_XCNT(j)  (256  + 64 * (j))
#define XB_XSUB(j)  (1280 + 64 * (j))
#define XB_XGEN(j)  (2304 + 64 * (j))
#define XB_TOP      3328
#define XB_TOPGEN   3392
#define XCD_BAR_WORDS 3456
#define XB_SPIN_CAP (1u << 18)

__device__ __forceinline__ unsigned xb_ld(unsigned* p)              { return __hip_atomic_load(p, __ATOMIC_RELAXED, __HIP_MEMORY_SCOPE_AGENT); }
__device__ __forceinline__ unsigned xb_add(unsigned* p, unsigned v) { return __hip_atomic_fetch_add(p, v, __ATOMIC_RELAXED, __HIP_MEMORY_SCOPE_AGENT); }
__device__ __forceinline__ unsigned xb_xcc_id() { return (unsigned)__builtin_amdgcn_s_getreg((3 << 11) | 20) & 0xFu; }
#define XB_SPIN(cond, bar) do { unsigned _sp = 0; while (cond) { __builtin_amdgcn_s_sleep(1); \
    if ((++_sp & 255u) == 0u) { if (xb_ld(&(bar)[XB_TMO])) break; if (_sp > XB_SPIN_CAP) { atomicAdd(&(bar)[XB_TMO], 1u); break; } } } } while (0)

struct XcdBarrier { unsigned* bar; unsigned x; volatile LAS unsigned* st; };

__device__ __forceinline__ XcdBarrier xcd_barrier_post(unsigned* bar, volatile LAS unsigned* st) {
    XcdBarrier b; b.bar = bar; b.x = xb_xcc_id(); b.st = st;
    if (threadIdx.x == 0) (void)xb_add(&bar[XB_XCNT(b.x)], 1u);
    return b;
}
__device__ __forceinline__ void xcd_barrier_complete(unsigned* bar, unsigned x, unsigned& nloc, unsigned& nx) {
    const unsigned G = gridDim.x * gridDim.y * gridDim.z;
    unsigned sum, cnt, mine, sp = 0u;
    for (;;) {
        sum = 0u; cnt = 0u; mine = 0u;
#pragma unroll
        for (unsigned j = 0; j < 16; ++j) { const unsigned c = xb_ld(&bar[XB_XCNT(j)]); sum += c; cnt += (c > 0u) ? 1u : 0u; mine = (j == x) ? c : mine; }
        if (sum == G) break;
        __builtin_amdgcn_s_sleep(1);
        if ((++sp & 255u) == 0u) { if (xb_ld(&bar[XB_TMO])) break; if (sp > XB_SPIN_CAP) { atomicAdd(&bar[XB_TMO], 1u); break; } }
    }
    nloc = mine > 0u ? mine : 1u; nx = cnt > 0u ? cnt : 1u;
}
__device__ __forceinline__ void xcd_barrier(const XcdBarrier& b, const int tid  ) {
    asm volatile("s_waitcnt vmcnt(0)" ::: "memory");
    __syncthreads();
    if (tid == 0) {
        unsigned* bar = b.bar;
        __builtin_amdgcn_s_waitcnt(0);
        unsigned nloc = b.st[0], nx = b.st[1];
        if (nloc == 0u) { xcd_barrier_complete(bar, b.x, nloc, nx); b.st[0] = nloc; b.st[1] = nx; }
        const unsigned old = xb_add(&bar[XB_XSUB(b.x)], 1u);
        const unsigned gen = old / nloc;
        if (old + 1u == (gen + 1u) * nloc) {
            __builtin_amdgcn_fence(__ATOMIC_RELEASE, "agent");
            asm volatile("s_waitcnt vmcnt(0)" ::: "memory");
            const unsigned og = xb_add(&bar[XB_TOP], 1u);
            const unsigned tg = og / nx;
            if (og + 1u == (tg + 1u) * nx) xb_add(&bar[XB_TOPGEN], 1u);
            else XB_SPIN(xb_ld(&bar[XB_TOPGEN]) == tg, bar);
            __builtin_amdgcn_fence(__ATOMIC_ACQUIRE, "agent");
            xb_add(&bar[XB_XGEN(b.x)], 1u);
            asm volatile("s_waitcnt vmcnt(0)" ::: "memory");
        } else {
            XB_SPIN(xb_ld(&bar[XB_XGEN(b.x)]) == gen, bar);
            __builtin_amdgcn_fence(__ATOMIC_ACQUIRE, "agent");
            asm volatile("s_waitcnt vmcnt(0)" ::: "memory");
        }
    }
    __syncthreads();
}

template <class WorkFn>
__device__ __forceinline__ void xcd_barrier_work(const XcdBarrier& b, const int tid, volatile LAS unsigned* sh  , WorkFn work) {
    asm volatile("s_waitcnt vmcnt(0)" ::: "memory");
    __syncthreads();
    if (tid == 0) {
        unsigned* bar = b.bar;
        __builtin_amdgcn_s_waitcnt(0);
        unsigned nloc = b.st[0], nx = b.st[1];
        if (nloc == 0u) { xcd_barrier_complete(bar, b.x, nloc, nx); b.st[0] = nloc; b.st[1] = nx; }
        const unsigned old = xb_add(&bar[XB_XSUB(b.x)], 1u);
        const unsigned gen = old / nloc;
        const bool last = (old + 1u == (gen + 1u) * nloc);
        sh[0] = gen; sh[1] = last ? 1u : 0u;
        if (last) {
            __builtin_amdgcn_fence(__ATOMIC_RELEASE, "agent");
            asm volatile("s_waitcnt vmcnt(0)" ::: "memory");
            const unsigned og = xb_add(&bar[XB_TOP], 1u);
            const unsigned tg = og / nx;
            if (og + 1u == (tg + 1u) * nx) xb_add(&bar[XB_TOPGEN], 1u);
            else XB_SPIN(xb_ld(&bar[XB_TOPGEN]) == tg, bar);
            __builtin_amdgcn_fence(__ATOMIC_ACQUIRE, "agent");
            xb_add(&bar[XB_XGEN(b.x)], 1u);
            asm volatile("s_waitcnt vmcnt(0)" ::: "memory");
        }
    }
    __syncthreads();
    if (sh[1] == 0u) {
        const unsigned gen = sh[0];
        unsigned* flag = &b.bar[XB_XGEN(b.x)];
        for (;;) { if ((unsigned)__builtin_amdgcn_readfirstlane((int)xb_ld(flag)) != gen) break; if (!work()) break; }
        if (tid == 0) { XB_SPIN(xb_ld(flag) == gen, b.bar); __builtin_amdgcn_fence(__ATOMIC_ACQUIRE, "agent"); asm volatile("s_waitcnt vmcnt(0)" ::: "memory"); }
        asm volatile("s_waitcnt vmcnt(0) lgkmcnt(0)" ::: "memory");
        __syncthreads();
    }
}

struct Args { const float* in[22]; float* out; unsigned char* ws; int ph_lo, ph_hi; };
typedef const __attribute__((address_space(4))) Args* KArgs;
#define KARGS() ({ KArgs p_ = (KArgs)__builtin_amdgcn_kernarg_segment_ptr(); asm volatile("" : "+s"(p_)); p_; })
struct Frame { LAS unsigned char* lds; int tid, lane, wave, vcu, G; };

__device__ __forceinline__ float wave_sum(float v, int lane) {
#pragma unroll
    for (int o = 1; o < 64; o <<= 1) v += shfl_xor_l(v, o, lane);
    return v;
}
__device__ const double ROPE_REV[32] = {
    1.59154943091895346e-01, 1.19349370211248862e-01, 8.94994016088910133e-02, 6.71150830052272551e-02, 5.03292121044870353e-02, 3.77415847174197711e-02, 2.83021958306233987e-02, 2.12236527647776604e-02,
    1.59154943091895339e-02, 1.19349370211248862e-02, 8.94994016088910237e-03, 6.71150830052272534e-03, 5.03292121044870370e-03, 3.77415847174197719e-03, 2.83021958306233987e-03, 2.12236527647776622e-03,
    1.59154943091895356e-03, 1.19349370211248849e-03, 8.94994016088910237e-04, 6.71150830052272599e-04, 5.03292121044870326e-04, 3.77415847174197741e-04, 2.83021958306233954e-04, 2.12236527647776605e-04,
    1.59154943091895351e-04, 1.19349370211248862e-04, 8.94994016088910182e-05, 6.71150830052272545e-05, 5.03292121044870354e-05, 3.77415847174197768e-05, 2.83021958306233961e-05, 2.12236527647776592e-05};

enum { MAP_ID = 0, MAP_WIN = 1, MAP_WUQ = 2 };
__device__ __forceinline__ int map_col(int mode, int n) {
    if (mode == MAP_ID) return n;
    if (mode == MAP_WIN) {
        if (n < 1024) return n;
        if (n < ZC_KR) return n + 64;
        if (n < ZC_KR + 64) { const int p = n - ZC_KR, i = p >> 1; return 1024 + ((p & 1) ? i + 32 : i); }
        if (n < ZC_G) return -1;
        return n - ZC_G + 3648;
    }
    if (n < 1024) return (n >> 7) * 192 + (n & 127);
    { const int r = n - 1024, h = r >> 6, p = r & 63, i = p >> 1; return h * 192 + 128 + ((p & 1) ? i + 32 : i); }
}
__device__ __forceinline__ void conv_item(const float* W, int K, int Nsrc, int nblk, const float* g, int mode, bf16* dst, int dst_ld, LAS float* scr, int item, int lane, bool tiled = false, int koff = 0) {
    const int kb = item / nblk, nb = item % nblk, k0 = 64 * kb, n0 = 32 * nb;
    const int s0 = map_col(mode, n0), s31 = map_col(mode, n0 + 31);
    if (s0 >= 0 && s31 == s0 + 31) {
        const int ks = lane >> 3, n4 = (lane & 7) * 4;
        f32x4 v[8]; float gk[8];
#pragma unroll
        for (int i = 0; i < 8; ++i) v[i] = *(const GAS f32x4*)(W + (size_t)(k0 + 8 * i + ks) * Nsrc + s0 + n4);
#pragma unroll
        for (int i = 0; i < 8; ++i) gk[i] = g ? g[k0 + 8 * i + ks] : 1.f;
#pragma unroll
        for (int i = 0; i < 8; ++i) { LAS float* p = scr + (8 * i + ks) * 33 + n4; const f32x4 x = v[i] * gk[i]; p[0] = x[0]; p[1] = x[1]; p[2] = x[2]; p[3] = x[3]; }
    } else {
        const int src = map_col(mode, n0 + (lane & 31));
#pragma unroll 8
        for (int i = 0; i < 32; ++i) { const int kk = 2 * i + (lane >> 5); float v = 0.f;
            if (src >= 0) { v = W[(size_t)(k0 + kk) * Nsrc + src]; if (g) v *= g[k0 + kk]; }
            scr[kk * 33 + (lane & 31)] = v; }
    }
    LDS_WAIT(); asm volatile("" ::: "memory");
    const int c = lane & 7;
#pragma unroll
    for (int j = 0; j < 4; ++j) { const int n = (lane >> 3) + 8 * j; const LAS float* s = scr + (8 * c) * 33 + n;
        v4u o; o.x = cvt_pk_bf16(s[0 * 33], s[1 * 33]); o.y = cvt_pk_bf16(s[2 * 33], s[3 * 33]); o.z = cvt_pk_bf16(s[4 * 33], s[5 * 33]); o.w = cvt_pk_bf16(s[6 * 33], s[7 * 33]);
        if (!tiled) *(GAS v4u*)(dst + (size_t)(n0 + n) * dst_ld + k0 + 8 * c) = o;
        else {
            const int nn = n0 + n, pn = nn >> 8, nt_ = nn & 255, h = nt_ >> 7, rr = nt_ & 127, w = rr & 31, slot = (rr & ~31) + 16 * ((w >> 2) & 1) + 4 * (w >> 3) + (w & 3);
            const int kk = koff + k0, kt = kk >> 6;
            *(GAS v4u*)((unsigned char*)dst + ((size_t)(pn * (dst_ld >> 6) + kt) * 2 + h) * 16384 + pg8::lds_byte(slot, 8 * c)) = o; } }
    LDS_WAIT(); asm volatile("" ::: "memory");
}
__device__ __forceinline__ void convert_layer(const Frame& F, KArgs ap, int l, unsigned char* ws) {
    LAS float* scr = (LAS float*)(F.lds + RING_OFF + F.wave * 16384);
    const int gw = F.vcu * NWAVES + F.wave, NGW = F.G * NWAVES;
    unsigned char* W = ws + WS_W;
    constexpr int I_IN = 32 * (NZW / 32), I_UQ = 8 * (NQC / 32), I_UKV = 8 * (NKVC / 32), I_MEM = 32 * 64, I_BR = 16 * 64, I_OUT = 32 * 64, I_UP = 32 * 256, I_DOWN = 128 * 64;
    constexpr int NITEMS = I_IN + I_UQ + I_UKV + I_MEM + 3 * I_BR + I_OUT + I_UP + I_DOWN;
    for (int it = gw; it < NITEMS; it += NGW) {
        int r = it;
        if (r < I_IN) { conv_item(ap->in[6] + (size_t)l * DM * NZSRC, DM, NZSRC, NZW / 32, ap->in[4] + l * DM, MAP_WIN, (bf16*)(W + WO_IN), DM, scr, r, F.lane, true); continue; } r -= I_IN;
        if (r < I_UQ) { conv_item(ap->in[9] + (size_t)l * 512 * NQC, 512, NQC, NQC / 32, ap->in[7] + l * 512, MAP_WUQ, (bf16*)(W + WO_UQ), 512, scr, r, F.lane, true); continue; } r -= I_UQ;
        if (r < I_UKV) { conv_item(ap->in[10] + (size_t)l * 512 * NKVC, 512, NKVC, NKVC / 32, ap->in[8] + l * 512, MAP_ID, (bf16*)(W + WO_UKV), 512, scr, r, F.lane, true); continue; } r -= I_UKV;
        if (r < I_MEM) { conv_item(ap->in[12] + (size_t)l * DM * 2048, DM, 2048, 64, ap->in[11] + l * DM, MAP_ID, (bf16*)(W + WO_MEM), DM, scr, r, F.lane); continue; } r -= I_MEM;
        if (r < 3 * I_BR) { const int br = r / I_BR; conv_item(ap->in[14 + br] + (size_t)l * 1024 * DM, 1024, DM, 64, nullptr, MAP_ID, (bf16*)(W + WO_BR), NABC, scr, r - br * I_BR, F.lane, true, br * 1024); continue; } r -= 3 * I_BR;
        if (r < I_OUT) { conv_item(ap->in[17] + (size_t)l * DM * DM, DM, DM, 64, nullptr, MAP_ID, (bf16*)(W + WO_OUT), DM, scr, r, F.lane, true); continue; } r -= I_OUT;
        if (r < I_UP) { conv_item(ap->in[20] + (size_t)l * DM * DFF, DM, DFF, 256, ap->in[18] + l * DM, MAP_ID, (bf16*)(W + WO_UP), DM, scr, r, F.lane, true); continue; } r -= I_UP;
        conv_item(ap->in[21] + (size_t)l * DFF * DM, DFF, DM, 64, nullptr, MAP_ID, (bf16*)(W + WO_DOWN), DFF, scr, r, F.lane, true);
    }
}
constexpr int NJOBS = 10;
struct ConvJob { const float* W; const float* g; bf16* dst; int K, Nsrc, nblk, mode, dst_ld, koff, size; bool tiled; };
__device__ __forceinline__ ConvJob conv_job(KArgs ap, int l, unsigned char* ws, int j) {
    unsigned char* W = ws + WS_W; ConvJob J; J.g = nullptr; J.mode = MAP_ID; J.koff = 0; J.tiled = true;
    if (j == 0)      { J.W = ap->in[6] + (size_t)l * DM * NZSRC; J.K = DM; J.Nsrc = NZSRC; J.nblk = NZW / 32; J.g = ap->in[4] + l * DM; J.mode = MAP_WIN; J.dst = (bf16*)(W + WO_IN); J.dst_ld = DM; J.size = 32 * (NZW / 32); }
    else if (j == 1) { J.W = ap->in[12] + (size_t)l * DM * 2048; J.K = DM; J.Nsrc = 2048; J.nblk = 64; J.g = ap->in[11] + l * DM; J.dst = (bf16*)(W + WO_MEM); J.dst_ld = DM; J.size = 32 * 64; J.tiled = false; }
    else if (j == 2) { J.W = ap->in[9] + (size_t)l * 512 * NQC; J.K = 512; J.Nsrc = NQC; J.nblk = NQC / 32; J.g = ap->in[7] + l * 512; J.mode = MAP_WUQ; J.dst = (bf16*)(W + WO_UQ); J.dst_ld = 512; J.size = 8 * (NQC / 32); }
    else if (j == 3) { J.W = ap->in[10] + (size_t)l * 512 * NKVC; J.K = 512; J.Nsrc = NKVC; J.nblk = NKVC / 32; J.g = ap->in[8] + l * 512; J.dst = (bf16*)(W + WO_UKV); J.dst_ld = 512; J.size = 8 * (NKVC / 32); }
    else if (j < 7)  { const int br = j - 4; J.W = ap->in[14 + br] + (size_t)l * 1024 * DM; J.K = 1024; J.Nsrc = DM; J.nblk = 64; J.dst = (bf16*)(W + WO_BR); J.dst_ld = NABC; J.koff = br * 1024; J.size = 16 * 64; }
    else if (j == 7) { J.W = ap->in[17] + (size_t)l * DM * DM; J.K = DM; J.Nsrc = DM; J.nblk = 64; J.dst = (bf16*)(W + WO_OUT); J.dst_ld = DM; J.size = 32 * 64; }
    else if (j == 8) { J.W = ap->in[20] + (size_t)l * DM * DFF; J.K = DM; J.Nsrc = DFF; J.nblk = 256; J.g = ap->in[18] + l * DM; J.dst = (bf16*)(W + WO_UP); J.dst_ld = DM; J.size = 32 * 256; }
    else             { J.W = ap->in[21] + (size_t)l * DFF * DM; J.K = DFF; J.Nsrc = DM; J.nblk = 64; J.dst = (bf16*)(W + WO_DOWN); J.dst_ld = DFF; J.size = 128 * 64; }
    return J;
}
__device__ __forceinline__ bool conv_next(const Frame& F, KArgs ap, int l, unsigned char* ws, int njobs, volatile LAS unsigned* prog) {
    const int gw = F.vcu * NWAVES + F.wave, NGW = F.G * NWAVES;
    int j = 0, it = 0; bool found = false;
    for (; j < njobs; ++j) { const int size = (j == 0) ? 32 * (NZW / 32) : (j == 1) ? 32 * 64 : (j == 2) ? 8 * (NQC / 32) : (j == 3) ? 8 * (NKVC / 32) : (j < 7) ? 16 * 64 : (j == 7) ? 32 * 64 : (j == 8) ? 32 * 256 : 128 * 64;
        it = gw + (int)__builtin_amdgcn_readfirstlane((int)prog[j]) * NGW; if (it < size) { found = true; break; } }
    if (!found) return false;
    const ConvJob J = conv_job(ap, l, ws, j);
    conv_item(J.W, J.K, J.Nsrc, J.nblk, J.g, J.mode, J.dst, J.dst_ld, (LAS float*)(F.lds + RING_OFF + F.wave * 16384), it, F.lane, J.tiled, J.koff);
    prog[j] = prog[j] + 1u;
    return true;
}
__device__ __forceinline__ void rms_row_to_bf16(const float* xrow, bf16* orow, float* rs_out, int lane) {
    f32x4 v[8]; float s = 0.f;
#pragma unroll
    for (int j = 0; j < 4; ++j) { v[2 * j] = *(const GAS f32x4*)(xrow + j * 512 + lane * 8); v[2 * j + 1] = *(const GAS f32x4*)(xrow + j * 512 + lane * 8 + 4); }
#pragma unroll
    for (int j = 0; j < 8; ++j) s += (v[j][0] * v[j][0] + v[j][1] * v[j][1]) + (v[j][2] * v[j][2] + v[j][3] * v[j][3]);
    const float ms = wave_sum(s, lane) * (1.f / DM) + EPS, r = __builtin_amdgcn_rsqf(ms);
    if (lane == 0) *rs_out = ms * r;
#pragma unroll
    for (int j = 0; j < 4; ++j) *(GAS v4u*)(orow + j * 512 + lane * 8) = epi::pack8(v[2 * j] * r, v[2 * j + 1] * r);
}
__device__ __forceinline__ void prologue(const Frame& F, KArgs ap, unsigned char* ws) {
    const int gw = F.vcu * NWAVES + F.wave, NGW = F.G * NWAVES;
    float* tab = (float*)(ws + WS_TAB);
    for (int e = blockIdx.x * 512 + F.tid; e < 8192 * 32; e += F.G * 512) {
        const int pos = e >> 5, i = e & 31;
        double rev = (double)pos * ROPE_REV[i]; rev -= floor(rev);
        const double q = rint(rev * 4.0); const double r = (rev - q * 0.25) * 6.283185307179586476925;
        const double r2 = r * r;
        const double sn = r * (1.0 + r2 * (-1.0 / 6 + r2 * (1.0 / 120 + r2 * (-1.0 / 5040 + r2 * (1.0 / 362880 - r2 * (1.0 / 39916800))))));
        const double cn = 1.0 + r2 * (-0.5 + r2 * (1.0 / 24 + r2 * (-1.0 / 720 + r2 * (1.0 / 40320 + r2 * (-1.0 / 3628800 + r2 * (1.0 / 479001600))))));
        const int qi = ((int)q) & 3;
        const double s_ = qi == 0 ? sn : qi == 1 ? cn : qi == 2 ? -sn : -cn;
        const double c_ = qi == 0 ? cn : qi == 1 ? -sn : qi == 2 ? -cn : sn;
        *(GAS f32x2*)(tab + (size_t)e * 2) = (f32x2){(float)c_, (float)s_};
    }
    float* rmem = (float*)(ws + WS_RMEM); bf16* memb = (bf16*)(ws + WS_MEMB);
    for (int m = gw; m < NMEMR; m += NGW) {
        const float* xrow = (m < 1024) ? ap->in[2] + (size_t)m * DM : ap->in[3] + (size_t)(m - 1024) * DM;
        f32x4 v[8]; float s = 0.f;
#pragma unroll
        for (int j = 0; j < 4; ++j) { v[2 * j] = *(const GAS f32x4*)(xrow + j * 512 + F.lane * 8); v[2 * j + 1] = *(const GAS f32x4*)(xrow + j * 512 + F.lane * 8 + 4); }
#pragma unroll
        for (int j = 0; j < 8; ++j) s += (v[j][0] * v[j][0] + v[j][1] * v[j][1]) + (v[j][2] * v[j][2] + v[j][3] * v[j][3]);
        const float r = __builtin_amdgcn_rsqf(wave_sum(s, F.lane) * (1.f / DM) + EPS);
        if (F.lane == 0) rmem[m] = r;
#pragma unroll
        for (int j = 0; j < 4; ++j) *(GAS v4u*)(memb + (size_t)m * DM + j * 512 + F.lane * 8) = epi::pack8(v[2 * j], v[2 * j + 1]);
    }
    bf16* xn = (bf16*)(ws + WS_XN);
    for (int m = gw; m < NTOK; m += NGW) {
        const float* xrow = (m < NPROMPT) ? ap->in[0] + (size_t)m * DM : ap->in[1] + (size_t)(m - NPROMPT) * DM;
        rms_row_to_bf16(xrow, xn + (size_t)m * DM, (float*)(ws + WS_RS) + m, F.lane);
    }
    convert_layer(F, ap, 0, ws);
}
__device__ __forceinline__ void norm_pass(const Frame& F, KArgs ap, bool first, bool last, const float* gpost, unsigned char* ws, bool dummy = false) {
    const int gw = F.vcu * NWAVES + F.wave, NGW = F.G * NWAVES;
    const bf16* Y = (const bf16*)(ws + WS_Y); bf16* xb = (bf16*)(ws + WS_XN); float* rsv = (float*)(ws + WS_RS);
    bf16* xbo = dummy ? (bf16*)(ws + WS_Z + 192 * MiB) : xb; float* rso = dummy ? (float*)(ws + WS_Z + 300 * MiB) : rsv; float* xout = dummy ? (float*)(ws + WS_Z) : ap->out;
    f32x4 g[8];
#pragma unroll
    for (int j = 0; j < 4; ++j) { g[2 * j] = *(const GAS f32x4*)(gpost + j * 512 + F.lane * 8); g[2 * j + 1] = *(const GAS f32x4*)(gpost + j * 512 + F.lane * 8 + 4); }
    for (int m = gw; m < NTOK; m += NGW) {
        f32x4 x[8], y[8]; float s = 0.f;
#pragma unroll
        for (int j = 0; j < 4; ++j) { const v4u w = *(const GAS v4u*)(Y + (size_t)m * DM + j * 512 + F.lane * 8);
            y[2 * j] = (f32x4){bf_lo(w.x), bf_hi(w.x), bf_lo(w.y), bf_hi(w.y)}; y[2 * j + 1] = (f32x4){bf_lo(w.z), bf_hi(w.z), bf_lo(w.w), bf_hi(w.w)}; }
        if (first) { const float* xrow = (m < NPROMPT) ? ap->in[0] + (size_t)m * DM : ap->in[1] + (size_t)(m - NPROMPT) * DM;
#pragma unroll
            for (int j = 0; j < 4; ++j) { x[2 * j] = *(const GAS f32x4*)(xrow + j * 512 + F.lane * 8); x[2 * j + 1] = *(const GAS f32x4*)(xrow + j * 512 + F.lane * 8 + 4); }
        } else {
            const float rms = rsv[m];
#pragma unroll
            for (int j = 0; j < 4; ++j) { const v4u w = *(const GAS v4u*)(xb + (size_t)m * DM + j * 512 + F.lane * 8);
                x[2 * j] = (f32x4){bf_lo(w.x), bf_hi(w.x), bf_lo(w.y), bf_hi(w.y)} * rms; x[2 * j + 1] = (f32x4){bf_lo(w.z), bf_hi(w.z), bf_lo(w.w), bf_hi(w.w)} * rms; }
        }
#pragma unroll
        for (int j = 0; j < 8; ++j) s += (y[j][0] * y[j][0] + y[j][1] * y[j][1]) + (y[j][2] * y[j][2] + y[j][3] * y[j][3]);
        const float r = __builtin_amdgcn_rsqf(wave_sum(s, F.lane) * (1.f / DM) + EPS);
        float s2 = 0.f;
#pragma unroll
        for (int j = 0; j < 8; ++j) { x[j] = x[j] + (y[j] * r) * g[j]; s2 += (x[j][0] * x[j][0] + x[j][1] * x[j][1]) + (x[j][2] * x[j][2] + x[j][3] * x[j][3]); }
        if (last) { float* orow = xout + (size_t)m * DM;
#pragma unroll
            for (int j = 0; j < 4; ++j) { *(GAS f32x4*)(orow + j * 512 + F.lane * 8) = x[2 * j]; *(GAS f32x4*)(orow + j * 512 + F.lane * 8 + 4) = x[2 * j + 1]; }
        } else {
            const float ms2 = wave_sum(s2, F.lane) * (1.f / DM) + EPS, r2 = __builtin_amdgcn_rsqf(ms2);
            if (F.lane == 0) rso[m] = ms2 * r2;
#pragma unroll
            for (int j = 0; j < 4; ++j) *(GAS v4u*)(xbo + (size_t)m * DM + j * 512 + F.lane * 8) = epi::pack8(x[2 * j] * r2, x[2 * j + 1] * r2);
        }
    }
}

constexpr int PH_PER_LAYER = 9, N_PHASES = 1 + DEPTH * PH_PER_LAYER;
#ifndef PH_MASK
#define PH_MASK 0x3ff
#endif
#define PH_EN(k) ((PH_MASK >> (k)) & 1)
#ifndef SUB_MASK
#define SUB_MASK 7
#endif
#define SUB_EN(k) ((SUB_MASK >> (k)) & 1)
#ifndef DUP_MASK
#define DUP_MASK 0
#endif
#define DUP_EN(k) ((DUP_MASK >> (k)) & 1)
__global__ void __launch_bounds__(NWAVES * 64, 2) fwd(Args args_unused) {
    extern __shared__ __attribute__((aligned(16))) unsigned char lds_raw[];
    (void)args_unused;
    LAS unsigned char* lds0 = (LAS unsigned char*)lds_raw;
    const int wave0 = __builtin_amdgcn_readfirstlane((int)threadIdx.x >> 6);
    volatile LAS unsigned* MISC = (volatile LAS unsigned*)(lds0 + MISC_OFF);
    for (int u = threadIdx.x; u < (XCH_OFF - LDSCTL_OFF) / 4; u += NWAVES * 64) ((LAS unsigned*)(lds0 + LDSCTL_OFF))[u] = 0u;
    __syncthreads();
#ifdef PROBE_CLOCK
    if (blockIdx.x == 0 && threadIdx.x == 0) { KArgs ap = KARGS(); unsigned long long* p = (unsigned long long*)(ap->ws + 512 * 1024); p[0] = __builtin_amdgcn_s_memtime(); p[1] = __builtin_amdgcn_s_memrealtime(); }
#endif
    int lo, hi; unsigned* barw;
    { KArgs ap = KARGS(); lo = ap->ph_lo; hi = ap->ph_hi; barw = (unsigned*)(ap->ws + WS_CTL) + CW_BAR; }
    if (MK_N_LAUNCHES == 1 || (hi - lo) > 1) (void)xcd_barrier_post(barw, MISC + 8);
    if (threadIdx.x == 0) { unsigned r = 0u; const unsigned x = xb_xcc_id();
        if (MK_N_LAUNCHES == 1) { KArgs ap_ = KARGS(); r = xb_add((unsigned*)(ap_->ws + WS_CTL) + CW_RANK + 64 * x, 1u); }
        MISC[20] = x; MISC[21] = r; MISC[22] = blockIdx.x; }
    __syncthreads();
#if MK_N_LAUNCHES == 1
#define IN(k) true
#else
#define IN(k) (lo <= (k) && (k) < hi)
#endif
#if defined(PROBE_WAIT) && PROBE_WAIT
#define PROBE_WAIT_BEGIN() do { if (wave0 * 64 + t_ == 0) { const unsigned long long r_ = __builtin_amdgcn_s_memrealtime(); MISC[16] = (unsigned)r_; } } while (0)
#define PROBE_WAIT_END() do { int t2_; asm volatile("v_mbcnt_lo_u32_b32 %0, -1, 0\n\tv_mbcnt_hi_u32_b32 %0, -1, %0" : "=v"(t2_)); if (wave0 * 64 + t2_ == 0) { const unsigned long long r_ = __builtin_amdgcn_s_memrealtime(); MISC[17] = MISC[17] + ((unsigned)r_ - MISC[16]); } } while (0)
#else
#define PROBE_WAIT_BEGIN() do {} while (0)
#define PROBE_WAIT_END() do {} while (0)
#endif
#define LOCAL_BAR() XcdBarrier bar; { KArgs ap_ = KARGS(); bar.bar = (unsigned*)(ap_->ws + WS_CTL) + CW_BAR; bar.x = xb_xcc_id(); bar.st = (volatile LAS unsigned*)((LAS unsigned char*)lds_raw + MISC_OFF) + 8; }
#define BARRIER_NOW() do { int t_; asm volatile("v_mbcnt_lo_u32_b32 %0, -1, 0\n\tv_mbcnt_hi_u32_b32 %0, -1, %0" : "=v"(t_)); LOCAL_BAR(); xcd_barrier(bar, wave0 * 64 + t_); } while (0)
#define SEAM(k) do { if (IN(k) && IN((k) + 1)) { int t_; asm volatile("v_mbcnt_lo_u32_b32 %0, -1, 0\n\tv_mbcnt_hi_u32_b32 %0, -1, %0" : "=v"(t_)); PROBE_WAIT_BEGIN(); LOCAL_BAR(); xcd_barrier(bar, wave0 * 64 + t_); PROBE_WAIT_END(); if (PROBE_XBAR) { xcd_barrier(bar, wave0 * 64 + t_); xcd_barrier(bar, wave0 * 64 + t_); } } } while (0)
#define SEAM_WORK(k, NJ) do { if (IN(k) && IN((k) + 1)) { if (l + 1 < DEPTH) { PHASE_BASE(); LOCAL_BAR(); volatile LAS unsigned* msc_ = (volatile LAS unsigned*)((LAS unsigned char*)lds_raw + MISC_OFF); \
        volatile LAS unsigned* prog_ = msc_ + 32 + F.wave * 16; const int lw_ = l + 1; \
        xcd_barrier_work(bar, F.tid, msc_ + 24, [&]() { return conv_next(F, ap, lw_, ws, (NJ), prog_); }); } else { SEAM(k); } } } while (0)
#define PHASE_BASE() KArgs ap = KARGS(); unsigned char* ws = ap->ws; (void)ws; int bx_ = (int)((volatile LAS unsigned*)((LAS unsigned char*)lds_raw + MISC_OFF))[22], G_ = (int)gridDim.x, t_; asm volatile("v_mbcnt_lo_u32_b32 %0, -1, 0\n\tv_mbcnt_hi_u32_b32 %0, -1, %0" : "=v"(t_)); t_ += wave0 * 64; bx_ = __builtin_amdgcn_readfirstlane(bx_); asm volatile("" : "+s"(bx_), "+s"(G_)); const int bx = bx_, G = G_; (void)bx; (void)G; Frame F; F.lds = (LAS unsigned char*)lds_raw; F.tid = t_; F.lane = t_ & 63; F.wave = __builtin_amdgcn_readfirstlane(t_ >> 6); F.G = G; F.vcu = (G % 8 == 0) ? (bx % 8) * (G / 8) + bx / 8 : bx; LAS unsigned char* ring = F.lds + RING_OFF; LAS unsigned char* xl = F.lds + XCH_OFF; (void)ring; (void)xl
#define WSP(T, off) ((T*)(ws + (off)))

    if (PH_EN(0) && IN(0)) { PHASE_BASE(); prologue(F, ap, ws); }
    SEAM(0);
    if (MK_N_LAUNCHES == 1) {
        if (threadIdx.x == 0) { KArgs ap_ = KARGS(); unsigned* bw = (unsigned*)(ap_->ws + WS_CTL) + CW_BAR; const unsigned G = gridDim.x; bool even = (G % 8u) == 0u; unsigned npop = 0u;
            for (unsigned j = 0; j < 16; ++j) { const unsigned c = xb_ld(&bw[XB_XCNT(j)]); if (c) { ++npop; even = even && (c == G / 8u) && (j < 8u); } }
            if (even && npop == 8u && MISC[21] < G / 8u) MISC[22] = MISC[20] + 8u * MISC[21]; }
        __syncthreads();
    }

    for (int l = 0; l < DEPTH; ++l) {
        const int p0 = 1 + l * PH_PER_LAYER;
        for (int rep_ = 0; rep_ <= DUP_EN(1); ++rep_) { if (rep_) BARRIER_NOW();
        if (PH_EN(1) && IN(p0 + 0)) { PHASE_BASE();
            if (SUB_EN(0)) { pg8::Gemm g = pg8::plain_gemm(WSP(bf16, WS_XN), DM, ws + WS_W + WO_IN, DM, DM, true); pg8::StaticOrder S; S.init(NTOK / 256, NZW / 256, G, bx);
              epi::EpiZ E{WSP(bf16, WS_Z), WSP(float, WS_SSQ), WSP(const float, WS_TAB), ws + WS_GT}; pg8::gemm_phase<epi::EpiZ, pg8::StaticOrder>(F.tid, ring, xl, g, S, E); }
            if (SUB_EN(1)) { pg8::Gemm g = pg8::plain_gemm(WSP(bf16, WS_MEMB), DM, ws + WS_W + WO_MEM, DM, DM); pg8::StaticOrder S; S.init(NMEMR / 256, 4, G, (bx + G - 160 % G) % G);
              epi::EpiStore<1> E{WSP(bf16, WS_MEMK), 1024, 0, WSP(const float, WS_RMEM)}; pg8::gemm_phase<epi::EpiStore<1>, pg8::StaticOrder>(F.tid, ring, xl, g, S, E); }
            if (SUB_EN(2)) { pg8::Gemm g = pg8::plain_gemm(ws + WS_W + WO_MEM + (size_t)1024 * DM * 2, DM, WSP(bf16, WS_MEMB), DM, DM); pg8::StaticOrder S; S.init(4, NMEMR / 256, G, (bx + G - 180 % G) % G);
              epi::EpiStore<2> E{WSP(bf16, WS_MEMVT), NMEMR, 0, WSP(const float, WS_RMEM)}; pg8::gemm_phase<epi::EpiStore<2>, pg8::StaticOrder>(F.tid, ring, xl, g, S, E); }
        }
        }
        SEAM(p0 + 0);
        for (int rep_ = 0; rep_ <= DUP_EN(2); ++rep_) { if (rep_) BARRIER_NOW();
        if (PH_EN(2) && IN(p0 + 1)) { PHASE_BASE();
            if (SUB_EN(0)) { pg8::Gemm g = pg8::plain_gemm(WSP(bf16, WS_Z) + ZC_CQ, NZ, ws + WS_W + WO_UQ, 512, 512, true); pg8::StaticOrder S; S.init(NTOK / 256, NQC / 256, G, bx);
              epi::EpiLat<0> E{WSP(bf16, WS_Q), WSP(const float, WS_SSQ), WSP(const float, WS_TAB)}; pg8::gemm_phase<epi::EpiLat<0>, pg8::StaticOrder>(F.tid, ring, xl, g, S, E); }
            if (SUB_EN(1)) { pg8::Gemm g = pg8::plain_gemm(WSP(bf16, WS_Z) + ZC_CKV, NZ, ws + WS_W + WO_UKV, 512, 512, true); pg8::StaticOrder S; S.init(NTOK / 256, NKVC / 256, G, bx);
              epi::EpiLat<1> E{WSP(bf16, WS_KV), WSP(const float, WS_SSQ), WSP(const float, WS_TAB)}; pg8::gemm_phase<epi::EpiLat<1>, pg8::StaticOrder>(F.tid, ring, xl, g, S, E); }
            if (SUB_EN(2)) { pg8::Gemm g; g.A = (const char*)(WSP(bf16, WS_Z) + ZC_QM); g.B = (const char*)WSP(bf16, WS_MEMK); g.a_pm = (long)256 * NZ * 2; g.a_pn = 512; g.b_pn = 512; g.b_sq = (long)256 * 1024 * 2; g.lda = NZ; g.ldb = 1024; g.K = 256; g.b_tiled = false;
              pg8::StaticOrder S; S.init(NTOK / 256, 4, G, (bx + G - 64 % G) % G);
              epi::EpiSoftmax E{WSP(bf16, WS_PM)}; pg8::gemm_phase<epi::EpiSoftmax, pg8::StaticOrder>(F.tid, ring, xl, g, S, E); }
        }
        }
        SEAM_WORK(p0 + 1, 2);
        for (int rep_ = 0; rep_ <= DUP_EN(3); ++rep_) { if (rep_) BARRIER_NOW();
        if (PH_EN(3) && IN(p0 + 2)) {
            if (SUB_EN(0)) { PHASE_BASE(); for (int n = F.vcu; n < 768; n += G) {
                const int i = n >> 8, v = n & 255, x = v >> 5, j = v & 31;
                int h, qm0, km0, NT;
                if (i < 2) { const int pair = 4 * x + 2 * i + (j >> 4), b = pair >> 3; h = pair & 7; qm0 = b * 4096 + (j & 15) * 256; km0 = b * 4096; NT = 64; }
                else { h = x; qm0 = NPROMPT + j * 256; km0 = NPROMPT; NT = 128; }
                att::Mask mk{0, 0.f};
                att::attn_unit<0>(WSP(bf16, WS_Q), WSP(bf16, WS_KV), WSP(bf16, WS_Z), WSP(bf16, WS_ABC), qm0, km0, NT, h, h * 128, -1.0e30f, 0.f, mk, (LAS char*)ring, wave0 * 64);
            } }
            if (SUB_EN(1)) { PHASE_BASE(); const float* sink = ap->in[13] + l * 8;
              for (int n = F.vcu; n < 768; n += G) {
                const int qblk = n >> 3, h = n & 7;
                const int sstart = qblk < 64 ? (qblk >> 4) * 4096 : NPROMPT, SL = qblk < 64 ? 4096 : 8192;
                const int qm0 = qblk * 256, q0 = qm0 - sstart;
                const int klo = (q0 - 128) < 0 ? 0 : (q0 - 128), khi = (q0 + 384) > SL ? SL : (q0 + 384);
                att::Mask mk; mk.dq = q0 - klo; mk.sl = LOG2E * __builtin_amdgcn_exp2f(-(float)(h + 1));
                att::attn_unit<1>(WSP(bf16, WS_Q), WSP(bf16, WS_KV), WSP(bf16, WS_Z), WSP(bf16, WS_ABC), qm0, sstart + klo, (khi - klo) >> 6, h, 1024 + h * 128, sink[h] * LOG2E, 1.f, mk, (LAS char*)ring, wave0 * 64);
              } }
            if (SUB_EN(2)) { PHASE_BASE(); pg8::Gemm g; g.A = (const char*)WSP(bf16, WS_PM); g.B = (const char*)WSP(bf16, WS_MEMVT); g.a_pm = (long)256 * 1024 * 2; g.a_pn = 512; g.b_pn = (long)256 * NMEMR * 2; g.b_sq = 512; g.lda = 1024; g.ldb = NMEMR; g.K = 256; g.b_tiled = false;
              pg8::StaticOrder S; S.init(NTOK / 256, 4, G, bx);
              epi::EpiStore<0> E{WSP(bf16, WS_ABC), NABC, 2048, nullptr}; pg8::gemm_phase<epi::EpiStore<0>, pg8::StaticOrder>(F.tid, ring, xl, g, S, E); }
        }
        }
        SEAM_WORK(p0 + 2, 4);
        for (int rep_ = 0; rep_ <= DUP_EN(4); ++rep_) { if (rep_) BARRIER_NOW();
        if (PH_EN(4) && IN(p0 + 3)) { PHASE_BASE();
            pg8::Gemm g = pg8::plain_gemm(WSP(bf16, WS_ABC), NABC, ws + WS_W + WO_BR, NABC, NABC, true); pg8::StaticOrder S; S.init(NTOK / 256, DM / 256, G, bx);
            epi::EpiBranch E{WSP(bf16, WS_MERGED), ws + WS_GT}; pg8::gemm_phase<epi::EpiBranch, pg8::StaticOrder>(F.tid, ring, xl, g, S, E);
        }
        }
        SEAM_WORK(p0 + 3, 4);
        for (int rep_ = 0; rep_ <= DUP_EN(5); ++rep_) { if (rep_) BARRIER_NOW();
        if (PH_EN(5) && IN(p0 + 4)) { PHASE_BASE();
            pg8::Gemm g = pg8::plain_gemm(WSP(bf16, WS_MERGED), DM, ws + WS_W + WO_OUT, DM, DM, true); pg8::StaticOrder S; S.init(NTOK / 256, DM / 256, G, bx);
            epi::EpiStore<0> E{WSP(bf16, WS_Y), DM, 0, nullptr}; pg8::gemm_phase<epi::EpiStore<0>, pg8::StaticOrder>(F.tid, ring, xl, g, S, E);
        }
        }
        SEAM_WORK(p0 + 4, 7);
        if (PH_EN(6) && IN(p0 + 5)) { PHASE_BASE(); if (DUP_EN(6)) norm_pass(F, ap, l == 0, false, ap->in[5] + l * DM, ws, true); norm_pass(F, ap, l == 0, false, ap->in[5] + l * DM, ws); }
        SEAM_WORK(p0 + 5, 8);
        for (int rep_ = 0; rep_ <= DUP_EN(7); ++rep_) { if (rep_) BARRIER_NOW();
        if (PH_EN(7) && IN(p0 + 6)) { PHASE_BASE();
            pg8::Gemm g = pg8::plain_gemm(WSP(bf16, WS_XN), DM, ws + WS_W + WO_UP, DM, DM, true); pg8::StaticOrder S; S.init(NTOK / 256, DFF / 256, G, bx);
            epi::EpiStore<3> E{WSP(bf16, WS_U), DFF, 0, nullptr}; pg8::gemm_phase<epi::EpiStore<3>, pg8::StaticOrder>(F.tid, ring, xl, g, S, E);
        }
        }
        SEAM_WORK(p0 + 6, 8);
        for (int rep_ = 0; rep_ <= DUP_EN(8); ++rep_) { if (rep_) BARRIER_NOW();
        if (PH_EN(8) && IN(p0 + 7)) { PHASE_BASE();
            pg8::Gemm g = pg8::plain_gemm(WSP(bf16, WS_U), DFF, ws + WS_W + WO_DOWN, DFF, DFF, true); pg8::StaticOrder S; S.init(NTOK / 256, DM / 256, G, bx);
            epi::EpiStore<0> E{WSP(bf16, WS_Y), DM, 0, nullptr}; pg8::gemm_phase<epi::EpiStore<0>, pg8::StaticOrder>(F.tid, ring, xl, g, S, E);
        }
        }
        SEAM_WORK(p0 + 7, 9);
        if (PH_EN(9) && IN(p0 + 8)) { PHASE_BASE(); norm_pass(F, ap, false, l + 1 == DEPTH, ap->in[19] + l * DM, ws); if (l + 1 < DEPTH) { volatile LAS unsigned* prog_ = (volatile LAS unsigned*)((LAS unsigned char*)lds_raw + MISC_OFF) + 32 + F.wave * 16; while (conv_next(F, ap, l + 1, ws, NJOBS, prog_)) {}
            for (int j_ = 0; j_ < NJOBS; ++j_) prog_[j_] = 0u; } }
        SEAM(p0 + 8);
    }
#if defined(PROBE_WAIT) && PROBE_WAIT
    { KArgs ap = KARGS(); unsigned* pw = (unsigned*)(ap->ws + 512 * 1024 + 256);
      if (threadIdx.x == 0) { const unsigned w = MISC[17]; atomicMax(pw + 0, w); atomicMin(pw + 64, 0xffffffffu - w); atomicAdd(pw + 128, w / 256u); }
      BARRIER_NOW();
      if (blockIdx.x == 0 && threadIdx.x == 0) { const unsigned v = PROBE_WAIT == 1 ? __hip_atomic_load(pw + 0, RLX_AGENT) : PROBE_WAIT == 2 ? 0xffffffffu - __hip_atomic_load(pw + 64, RLX_AGENT) : __hip_atomic_load(pw + 128, RLX_AGENT);
        const unsigned long long r1 = __builtin_amdgcn_s_memrealtime(); while (__builtin_amdgcn_s_memrealtime() - r1 < (unsigned long long)v) __builtin_amdgcn_s_sleep(32); } }
#endif
#ifdef PROBE_CLOCK
    { BARRIER_NOW(); if (blockIdx.x == 0 && threadIdx.x == 0) { const unsigned long long ck1 = __builtin_amdgcn_s_memtime(), rt1 = __builtin_amdgcn_s_memrealtime(); KArgs ap = KARGS(); const unsigned long long* p = (const unsigned long long*)(ap->ws + 512 * 1024);
        const unsigned long long mhz = (ck1 - p[0]) * 100ull / (rt1 - p[1]);
        while (__builtin_amdgcn_s_memrealtime() - rt1 < mhz * 100ull) __builtin_amdgcn_s_sleep(32); } }
#endif
#undef IN
#undef SEAM
}


#ifndef DBG_LAST
#define DBG_LAST -1
#endif
#ifndef DBG_DUMP_MASK
#define DBG_DUMP_MASK 0xff
#endif
#if DBG_LAST >= 0
__global__ void __launch_bounds__(256) dbg_dump(float* out, const unsigned char* ws) {
    const bf16* Z = (const bf16*)(ws + WS_Z); const bf16* Q = (const bf16*)(ws + WS_Q); const bf16* KV = (const bf16*)(ws + WS_KV); const bf16* PM = (const bf16*)(ws + WS_PM);
    const bf16* ABC = (const bf16*)(ws + WS_ABC); const bf16* MG = (const bf16*)(ws + WS_MERGED); const bf16* XN = (const bf16*)(ws + WS_XN); const bf16* Y = (const bf16*)(ws + WS_Y);
    for (size_t e = (size_t)blockIdx.x * 256 + threadIdx.x; e < (size_t)NTOK * DM; e += (size_t)gridDim.x * 256) {
        const size_t m = e / DM; const int c = (int)(e % DM); float v = 0.f;
        auto f = [](bf16 b) { return __uint_as_float((unsigned)b << 16); };
        if (DBG_DUMP_MASK & 1) v += f(XN[m * DM + c]);
        if (DBG_DUMP_MASK & 2) v += f(Z[m * NZ + c]) + f(Z[m * NZ + 2048 + (c % 1792)]);
        if (DBG_DUMP_MASK & 8) v += f(Q[m * NQC + (c % NQC)]) + f(KV[m * NKVC + c]);
        if (DBG_DUMP_MASK & 16) v += f(PM[m * 1024 + (c & 1023)]);
        if (DBG_DUMP_MASK & 32) v += f(ABC[m * NABC + c]) + f(ABC[m * NABC + 1024 + c]);
        if (DBG_DUMP_MASK & 64) v += f(MG[m * DM + c]);
        if (DBG_DUMP_MASK & 128) v += f(Y[m * DM + c]);
        if (DBG_DUMP_MASK & 256) v += f(((const bf16*)(ws + WS_W))[e]) + f(((const bf16*)(ws + WS_W))[e + 20000000]);
        out[e] = v;
    }
}
#endif

extern "C" void kernel_launch(void* const* d_in, const int* in_sizes, int n_in, void* d_out, int out_size, void* d_ws, size_t ws_size, hipStream_t stream) {
    static int grid = 0;
    if (grid == 0) {
        if (n_in != 22 || out_size != NTOK * DM || ws_size < WS_END) { fprintf(stderr, "kernel_launch: unexpected shapes (n_in %d out %d ws %zu)\n", n_in, out_size, ws_size); grid = -1; return; }
        int dev = 0, cus = 0, per_cu = 0;
        if (hipGetDevice(&dev) != hipSuccess || hipDeviceGetAttribute(&cus, hipDeviceAttributeMultiprocessorCount, dev) != hipSuccess) { grid = -1; return; }
        if (hipFuncSetAttribute((const void*)fwd, hipFuncAttributeMaxDynamicSharedMemorySize, LDS_BYTES) != hipSuccess) { fprintf(stderr, "kernel_launch: hipFuncSetAttribute failed\n"); grid = -1; return; }
        if (hipOccupancyMaxActiveBlocksPerMultiprocessor(&per_cu, (const void*)fwd, NWAVES * 64, LDS_BYTES) != hipSuccess || per_cu < 1)
            fprintf(stderr, "kernel_launch: note: occupancy query reports %d workgroups per CU\n", per_cu);
        (void)hipGetLastError();
        grid = cus;
    }
    if (grid < 0) return;
    (void)in_sizes;
    if (hipMemsetAsync((char*)d_ws + WS_CTL, 0, CTL_ZERO_BYTES, stream) != hipSuccess) return;
    Args a{};
    for (int i = 0; i < 22; ++i) a.in[i] = (const float*)d_in[i];
    a.out = (float*)d_out; a.ws = (unsigned char*)d_ws;
#if MK_N_LAUNCHES == 1
    a.ph_lo = 0; a.ph_hi = N_PHASES;
    hipLaunchKernelGGL(fwd, dim3(grid), dim3(NWAVES * 64), LDS_BYTES, stream, a);
#else
#if DBG_LAST >= 0
    for (int k = 0; k <= DBG_LAST; ++k) { a.ph_lo = k; a.ph_hi = k + 1; hipLaunchKernelGGL(fwd, dim3(grid), dim3(NWAVES * 64), LDS_BYTES, stream, a); }
    hipLaunchKernelGGL(dbg_dump, dim3(2048), dim3(256), 0, stream, (float*)d_out, (const unsigned char*)d_ws);
#else
    for (int k = 0; k < N_PHASES; ++k) { a.ph_lo = k; a.ph_hi = k + 1; hipLaunchKernelGGL(fwd, dim3(grid), dim3(NWAVES * 64), LDS_BYTES, stream, a); }
#endif
#endif
    const hipError_t le = hipPeekAtLastError();
    if (le != hipSuccess) fprintf(stderr, "kernel_launch: launch failed: %s\n", hipGetErrorName(le));
}
```
